# Optimizing an MI355X kernel written in HIP

```python
import math
import jax
import jax.numpy as jnp
from jax import lax
import numpy as np

D_MODEL = 1024
BATCH = 16
SEQ = 2048
DEPTH = 1

RET_HEADS = 4
RET_DK = 128
RET_DV = D_MODEL // RET_HEADS
GDN_HEADS = 4
GDN_DK = 128
GDN_DV = D_MODEL // GDN_HEADS
CHUNK = 64
CONV_K = 4
N_GROUPS = 4
EXPERTS_PER_GROUP = 4
TOP_K = 2
D_FF_EXPERT = 512
ROPE_BASE = 10000.0
NORM_EPS = 1e-6
L2_EPS = 1e-6
N_MOD = 6

RET_QK = RET_HEADS * RET_DK
RET_V = RET_HEADS * RET_DV
GDN_QK = GDN_HEADS * GDN_DK
GDN_V = GDN_HEADS * GDN_DV
IN_WIDTHS = (RET_QK, RET_QK, RET_V, RET_V, GDN_QK, GDN_QK, GDN_V, GDN_V, GDN_HEADS, GDN_HEADS, D_MODEL, D_MODEL)
D_IN = sum(IN_WIDTHS)
F32 = jnp.float32

kernel_name = 'hybrid_retention_gdn_hmoe_block'


def _rms_norm(x, w=None):
    xf = x.astype(F32)
    y = xf * lax.rsqrt(jnp.mean(xf * xf, axis=-1, keepdims=True) + NORM_EPS)
    if w is not None:
        y = y * w.astype(F32)
    return y.astype(x.dtype)


def _l2_normalize(x):
    xf = x.astype(F32)
    return xf * lax.rsqrt(jnp.sum(xf * xf, axis=-1, keepdims=True) + L2_EPS)


def _split_columns(t, widths):
    out, start = [], 0
    for w in widths:
        out.append(t[..., start:start + w])
        start += w
    return out


def _rope(x):
    d = x.shape[-1]
    half = d // 2
    inv_freq = 1.0 / (ROPE_BASE ** (jnp.arange(half, dtype=F32) / half))
    ang = jnp.arange(x.shape[1], dtype=F32)[:, None] * inv_freq[None, :]
    cos = jnp.cos(ang)[None, :, None, :]
    sin = jnp.sin(ang)[None, :, None, :]
    xf = x.astype(F32)
    x1, x2 = xf[..., :half], xf[..., half:]
    return jnp.concatenate([x1 * cos - x2 * sin, x1 * sin + x2 * cos], axis=-1)


def _to_chunks(t):
    b, s, h, d = t.shape
    return t.reshape(b, s // CHUNK, CHUNK, h, d).transpose(0, 3, 1, 2, 4)


def _from_chunks(t):
    b, h, n, c, d = t.shape
    return t.transpose(0, 2, 3, 1, 4).reshape(b, n * c, h, d)


def _causal_conv(x, w):
    s = x.shape[1]
    xp = jnp.pad(x, ((0, 0), (CONV_K - 1, 0), (0, 0)))
    out = xp[:, 0:s] * w[0]
    for i in range(1, CONV_K):
        out = out + xp[:, i:i + s] * w[i]
    return out


def _retention_chunkwise(q, k, v):
    n_heads, dk = q.shape[2], q.shape[3]
    q = _to_chunks(q.astype(F32))
    k = _to_chunks(k.astype(F32)) * (dk ** -0.5)
    v = _to_chunks(v.astype(F32))
    b, h, _, _, dv = v.shape
    log_gamma = jnp.log(1.0 - 2.0 ** (-5.0 - jnp.arange(n_heads, dtype=F32)))
    pos = jnp.arange(CHUNK, dtype=F32)
    rel = pos[:, None] - pos[None, :]
    causal = rel >= 0
    intra_decay = jnp.where(causal, jnp.exp(jnp.where(causal, rel, 0.0) * log_gamma[:, None, None]), 0.0)
    q_decay = jnp.exp((pos + 1.0) * log_gamma[:, None])
    k_decay = jnp.exp((CHUNK - 1.0 - pos) * log_gamma[:, None])
    chunk_decay = jnp.exp(CHUNK * log_gamma)[None, :, None, None]
    scores = jnp.einsum('bhnid,bhnjd->bhnij', q, k) * intra_decay[None, :, None]
    o_intra = jnp.einsum('bhnij,bhnjv->bhniv', scores, v)
    q_in = q * q_decay[None, :, None, :, None]
    k_in = k * k_decay[None, :, None, :, None]

    def step(state, xs):
        q_n, k_n, v_n = xs
        o_n = jnp.einsum('bhcd,bhdv->bhcv', q_n, state)
        state = state * chunk_decay + jnp.einsum('bhcd,bhcv->bhdv', k_n, v_n)
        return state, o_n

    state0 = jnp.zeros((b, h, dk, dv), F32)
    _, o_inter = lax.scan(step, state0, (jnp.moveaxis(q_in, 2, 0), jnp.moveaxis(k_in, 2, 0), jnp.moveaxis(v, 2, 0)))
    return _from_chunks(o_intra + jnp.moveaxis(o_inter, 0, 2))


def _gated_delta_rule_chunked(q, k, v, log_decay, beta):
    dk = q.shape[-1]
    q = _to_chunks(q.astype(F32)) * (dk ** -0.5)
    k = _to_chunks(k.astype(F32))
    v = _to_chunks(v.astype(F32))
    b, h, n, c, dv = v.shape
    g = log_decay.astype(F32).reshape(b, n, c, h).transpose(0, 3, 1, 2)
    bt = beta.astype(F32).reshape(b, n, c, h).transpose(0, 3, 1, 2)
    g_cum = jnp.cumsum(g, axis=-1)
    idx = jnp.arange(CHUNK)
    causal = idx[:, None] >= idx[None, :]
    strict = idx[:, None] > idx[None, :]
    decay = jnp.exp(jnp.where(causal, g_cum[..., :, None] - g_cum[..., None, :], -jnp.inf))
    k_beta = k * bt[..., None]
    v_beta = v * bt[..., None]
    a_mat = jnp.where(strict, jnp.einsum('bhnid,bhnjd->bhnij', k_beta, k) * decay, 0.0) + jnp.eye(CHUNK, dtype=F32)
    rhs = jnp.concatenate([v_beta, k_beta * jnp.exp(g_cum)[..., None]], axis=-1)
    sol = lax.linalg.triangular_solve(a_mat, rhs, left_side=True, lower=True, unit_diagonal=True)
    u, w = sol[..., :dv], sol[..., dv:]
    qk = jnp.einsum('bhnid,bhnjd->bhnij', q, k) * decay
    q_g = q * jnp.exp(g_cum)[..., None]
    g_last = g_cum[..., -1]
    k_g = k * jnp.exp(g_last[..., None] - g_cum)[..., None]

    def step(state, xs):
        u_n, w_n, qk_n, q_n, k_n, gl_n = xs
        v_new = u_n - jnp.einsum('bhcd,bhdv->bhcv', w_n, state)
        o_n = jnp.einsum('bhcd,bhdv->bhcv', q_n, state) + jnp.einsum('bhij,bhjv->bhiv', qk_n, v_new)
        state = state * jnp.exp(gl_n)[..., None, None] + jnp.einsum('bhcd,bhcv->bhdv', k_n, v_new)
        return state, o_n

    xs = tuple(jnp.moveaxis(t, 2, 0) for t in (u, w, qk, q_g, k_g, g_last))
    state0 = jnp.zeros((b, h, dk, dv), F32)
    _, o = lax.scan(step, state0, xs)
    return _from_chunks(jnp.moveaxis(o, 0, 2))


def _hybrid_mixer(xm, w_in, conv_w, a_log, dt_bias, gdn_norm_w, w_out):
    b, s, _ = xm.shape
    proj = jnp.einsum('bsd,de->bse', xm, w_in)
    rq, rk, rv, rg, gq, gk, gv, gz, ga, gb, gate_a, gate_b = _split_columns(proj, IN_WIDTHS)
    q_r = _rope(rq.reshape(b, s, RET_HEADS, RET_DK))
    k_r = _rope(rk.reshape(b, s, RET_HEADS, RET_DK))
    o_r = _retention_chunkwise(q_r, k_r, rv.reshape(b, s, RET_HEADS, RET_DV))
    o_r = _rms_norm(o_r).reshape(b, s, RET_V).astype(xm.dtype)
    y_ret = jax.nn.silu(rg) * o_r
    qkv = jax.nn.silu(_causal_conv(jnp.concatenate([gq, gk, gv], axis=-1), conv_w))
    q_g, k_g, v_g = _split_columns(qkv, (GDN_QK, GDN_QK, GDN_V))
    q_g = _l2_normalize(q_g.reshape(b, s, GDN_HEADS, GDN_DK))
    k_g = _l2_normalize(k_g.reshape(b, s, GDN_HEADS, GDN_DK))
    beta = jax.nn.sigmoid(gb.astype(F32))
    log_decay = -jnp.exp(a_log.astype(F32)) * jax.nn.softplus(ga.astype(F32) + dt_bias.astype(F32))
    o_g = _gated_delta_rule_chunked(q_g, k_g, v_g.reshape(b, s, GDN_HEADS, GDN_DV), log_decay, beta)
    o_g = _rms_norm(o_g, gdn_norm_w) * jax.nn.silu(gz.reshape(b, s, GDN_HEADS, GDN_DV).astype(F32))
    y_gdn = o_g.reshape(b, s, GDN_V).astype(xm.dtype)
    merged = jax.nn.sigmoid(gate_a) * y_ret + jax.nn.sigmoid(gate_b) * y_gdn
    return jnp.einsum('bsd,de->bse', merged, w_out)


def _hierarchical_moe(xm, w_group, b_group, w_router, b_router, w_gate, w_up, w_down):
    b, s, d = xm.shape
    xf = xm.reshape(-1, d)
    t = xf.shape[0]
    group_prob = jax.nn.softmax((xf @ w_group).astype(F32) + b_group.astype(F32), axis=-1)
    g_top, g_idx = lax.top_k(group_prob, 1)
    exp_logits = (xf @ w_router).astype(F32).reshape(t, N_GROUPS, EXPERTS_PER_GROUP) + b_router.astype(F32)
    exp_logits = jnp.take_along_axis(exp_logits, g_idx[:, :, None], axis=1)[:, 0]
    exp_prob = jax.nn.softmax(exp_logits, axis=-1)
    e_top, e_idx = lax.top_k(exp_prob, TOP_K)
    e_w = e_top / jnp.sum(e_top, axis=-1, keepdims=True)
    within = jnp.sum(jax.nn.one_hot(e_idx, EXPERTS_PER_GROUP, dtype=F32) * e_w[..., None], axis=1)
    comb = jax.nn.one_hot(g_idx[:, 0], N_GROUPS, dtype=F32)[:, :, None] * (g_top[:, :, None] * within[:, None, :])
    comb = comb.astype(xm.dtype)
    out = jnp.zeros_like(xf)
    for gi in range(N_GROUPS):
        hg = jnp.einsum('td,edf->tef', xf, w_gate[gi])
        hu = jnp.einsum('td,edf->tef', xf, w_up[gi])
        act = jax.nn.silu(hg) * hu * comb[:, gi, :, None]
        out = out + jnp.einsum('tef,efd->td', act, w_down[gi])
    return out.reshape(b, s, d)


def setup_inputs(seed: int = 0) -> dict:
    key = jax.random.key(seed)
    ks = jax.random.split(key, 20)
    L, G, E, F = DEPTH, N_GROUPS, EXPERTS_PER_GROUP, D_FF_EXPERT

    def nrm(k, shape, scale):
        return jax.random.normal(k, shape, F32) * scale

    dt = jnp.exp(jax.random.uniform(ks[8], (L, GDN_HEADS), F32, math.log(1e-3), math.log(1e-1)))
    return {
        'x': nrm(ks[0], (BATCH, SEQ, D_MODEL), 1.0),
        'c': nrm(ks[1], (BATCH, D_MODEL), 1.0),
        'mod_w': nrm(ks[2], (L, D_MODEL, N_MOD * D_MODEL), 0.5 * D_MODEL ** -0.5),
        'mod_b': nrm(ks[3], (L, N_MOD * D_MODEL), 0.02),
        'norm_mix_w': 1.0 + nrm(ks[4], (L, D_MODEL), 0.02),
        'w_in': nrm(ks[5], (L, D_MODEL, D_IN), D_MODEL ** -0.5),
        'gdn_conv_w': nrm(ks[6], (L, CONV_K, 2 * GDN_QK + GDN_V), CONV_K ** -0.5),
        'gdn_a_log': jnp.log(jax.random.uniform(ks[7], (L, GDN_HEADS), F32, 1.0, 16.0)),
        'gdn_dt_bias': dt + jnp.log(-jnp.expm1(-dt)),
        'gdn_norm_w': 1.0 + nrm(ks[9], (L, GDN_DV), 0.02),
        'w_out': nrm(ks[10], (L, D_MODEL, D_MODEL), D_MODEL ** -0.5),
        'norm_ffn_w': 1.0 + nrm(ks[11], (L, D_MODEL), 0.02),
        'w_group': nrm(ks[12], (L, D_MODEL, G), D_MODEL ** -0.5),
        'b_group': nrm(ks[13], (L, G), 0.01),
        'w_router': nrm(ks[14], (L, D_MODEL, G * E), D_MODEL ** -0.5),
        'b_router': nrm(ks[15], (L, G, E), 0.01),
        'w_gate': nrm(ks[16], (L, G, E, D_MODEL, F), D_MODEL ** -0.5),
        'w_up': nrm(ks[17], (L, G, E, D_MODEL, F), D_MODEL ** -0.5),
        'w_down': nrm(ks[18], (L, G, E, F, D_MODEL), F ** -0.5),
        'norm_out_w': 1.0 + nrm(ks[19], (D_MODEL,), 0.02),
    }


def reference(x, c, mod_w, mod_b, norm_mix_w, w_in, gdn_conv_w, gdn_a_log, gdn_dt_bias, gdn_norm_w, w_out,
              norm_ffn_w, w_group, b_group, w_router, b_router, w_gate, w_up, w_down, norm_out_w):
    h = x
    for l in range(DEPTH):
        mod = jax.nn.silu(c) @ mod_w[l] + mod_b[l]
        shift_m, scale_m, gate_m, shift_f, scale_f, gate_f = jnp.split(mod[:, None, :], N_MOD, axis=-1)
        xm = _rms_norm(h, norm_mix_w[l]) * (1.0 + scale_m) + shift_m
        h = h + gate_m * _hybrid_mixer(xm, w_in[l], gdn_conv_w[l], gdn_a_log[l], gdn_dt_bias[l], gdn_norm_w[l], w_out[l])
        xf = _rms_norm(h, norm_ffn_w[l]) * (1.0 + scale_f) + shift_f
        h = h + gate_f * _hierarchical_moe(xf, w_group[l], b_group[l], w_router[l], b_router[l], w_gate[l], w_up[l], w_down[l])
    return _rms_norm(h, norm_out_w)
```

```cpp
#include <hip/hip_runtime.h>
#include <hip/hip_cooperative_groups.h>
#include <stdint.h>
namespace cg = cooperative_groups;

#define LAS __attribute__((address_space(3)))
typedef unsigned short bf16;
typedef unsigned v4u __attribute__((ext_vector_type(4)));
typedef unsigned v2u __attribute__((ext_vector_type(2)));
typedef float f4 __attribute__((ext_vector_type(4)));

namespace {
constexpr int D = 1024, NB = 16, SEQ = 2048, T = NB * SEQ, DIN = 8200;
constexpr int NH = 4, DK = 128, DV = 256;
constexpr int C_RQ = 0, C_RK = 512, C_RV = 1024, C_RG = 2048, C_GQ = 3072, C_GK = 3584, C_GV = 4096, C_GZ = 5120,
              C_GA = 6144, C_GB = 6148, C_GTA = 6152, C_GTB = 7176;
constexpr int NE = 16, FF = 512;
constexpr int MAXSLOT = 2 * T + NE * 256;
constexpr int PW = 6144, P_RQ = 0, P_RK = 512, P_RV = 1024, P_GQ = 2048, P_GK = 2560, P_GV = 3072, P_GA = 4096, P_GB = 5120;

constexpr size_t MiB = 1u << 20;
constexpr size_t WS_PROJ = 0;
constexpr size_t WS_MERGED = 384 * MiB;
constexpr size_t WS_WTOUT = 448 * MiB;
constexpr size_t WS_WTGU = 0;
constexpr size_t WS_WTD = 32 * MiB;
constexpr size_t WS_XF = 48 * MiB;
constexpr size_t WS_XS = 112 * MiB;
constexpr size_t WS_ACT = 248 * MiB;
constexpr size_t WS_Y = 316 * MiB;
constexpr size_t WS_CTL = 456 * MiB;
constexpr size_t WS_MOD = 457 * MiB;
constexpr size_t WS_ROPE = 458 * MiB;
constexpr size_t WS_BETA = 459 * MiB;
constexpr size_t WS_G = 459 * MiB + 512 * 1024;
constexpr size_t WS_SSQ = 460 * MiB;
constexpr size_t WS_TOKE = 462 * MiB;
constexpr size_t WS_TOKW = 462 * MiB + 256 * 1024;
constexpr size_t WS_TOKS = 462 * MiB + 512 * 1024;
constexpr size_t WS_HIST = 463 * MiB;
constexpr size_t WS_META = 463 * MiB + 64 * 1024;
constexpr size_t WS_NEED = 464 * MiB;
constexpr size_t DO_XM = 0;
constexpr size_t DO_WTIN = 64 * MiB;
constexpr int LDS_BYTES = 147456;

__device__ __forceinline__ float silu_f(float x) { return x / (1.0f + expf(-x)); }
__device__ __forceinline__ float sigmoid_f(float x) { return 1.0f / (1.0f + expf(-x)); }
__device__ __forceinline__ float fsigmoid(float x) { return __builtin_amdgcn_rcpf(1.0f + __expf(-x)); }
__device__ __forceinline__ float wave_sum(float v) {
#pragma unroll
    for (int o = 32; o >= 1; o >>= 1) v += __shfl_xor(v, o);
    return v;
}
__device__ __forceinline__ unsigned f2bf(float f) { unsigned u = __float_as_uint(f); return (u + 0x7fffu + ((u >> 16) & 1u)) >> 16; }
__device__ __forceinline__ unsigned pk2(float lo, float hi) { return f2bf(lo) | (f2bf(hi) << 16); }
__device__ __forceinline__ float bf2f(unsigned short b) { return __uint_as_float(((unsigned)b) << 16); }
__device__ __forceinline__ float bflo(unsigned w) { return __uint_as_float(w << 16); }
__device__ __forceinline__ float bfhi(unsigned w) { return __uint_as_float(w & 0xffff0000u); }

struct Args { const float* in[20]; float* out; unsigned char* ws; int ph_lo, ph_hi; };
}
namespace pg8 {
#define PG8_LAS __attribute__((address_space(3)))
typedef unsigned short bf16_t;
typedef short bf16x8 __attribute__((ext_vector_type(8)));
typedef float f32x4 __attribute__((ext_vector_type(4)));
typedef unsigned u32x4 __attribute__((ext_vector_type(4)));
constexpr int BM = 256, BK = 64, HALF = 128, HTB = HALF * BK * 2  , STAGE_BYTES = 8 * HTB, NXCD = 8, WGM = 8;

__host__ __device__ __forceinline__ int lds_byte(int r, int c) { const int st = (r >> 4) * 2 + (c >> 5), rr = r & 15, cc = c & 31, ob = rr * 64 + cc * 2; return st * 1024 + (ob ^ (((ob >> 9) & 1) << 5)); }
__host__ __device__ __forceinline__ void stage_rc(int b, int& R, int& C) { const int st = b / 1024, sb = b % 1024, swz = sb ^ (((sb >> 9) & 1) << 5); R = (st >> 1) * 16 + swz / 64; C = (st & 1) * 32 + (swz % 64) / 2; }
__host__ __device__ __forceinline__ int perm32(int rho) { const int n = rho >> 4, i = rho & 15; return 8 * (i >> 2) + 4 * n + (i & 3); }

struct Unit { int pm, pn; };
struct Gemm { const bf16_t* A; const bf16_t* Bt; int M, N, K; };

struct StaticOrder {
    int nM, nN, nwg, G, c;
    __host__ __device__ void init(int M, int N, int G_, int c_) { nM = M / BM; nN = N / BM; nwg = nM * nN; G = G_; c = c_; }
    __host__ __device__ bool next(int i, Unit& u) const {
        const long L = (long)i * G + c; if (L >= nwg) return false;
        int wgid = (int)L; { const int q = nwg / NXCD, r = nwg % NXCD, xcd = wgid % NXCD, off = wgid / NXCD; wgid = (xcd < r ? xcd * (q + 1) : r * (q + 1) + (xcd - r) * q) + off; }
        const int nig = WGM * nN, gid = wgid / nig, fm = gid * WGM, gsz = (nM - fm) < WGM ? (nM - fm) : WGM;
        u.pm = fm + ((wgid % nig) % gsz); u.pn = (wgid % nig) / gsz; return true;
    }
    __device__ __forceinline__ void a_ready(const Unit&) const {}
    __device__ __forceinline__ void done(const Unit&) const {}
};

__device__ __forceinline__ unsigned cvt_pk_bf16(float lo, float hi) { unsigned r; asm volatile("v_cvt_pk_bf16_f32 %0, %1, %2" : "=v"(r) : "v"(lo), "v"(hi)); return r; }
__device__ __forceinline__ float fsig(float x) { return __builtin_amdgcn_rcpf(1.0f + __expf(-x)); }

struct EpiProj {
    static constexpr bool PERM = true, AFTER_DRAIN = false;
    bf16_t* P; int pw;
    __device__ __forceinline__ void operator()(const f32x4 (&acc)[2][2][4][2], const Unit& u, int wr, int wc, int fr, int fq) const {
        const int row0 = u.pm * BM + wr * 64 + fr;
        if (u.pn < 16) {
            const int col0 = u.pn * BM + wc * 32 + 8 * fq;
#pragma unroll
            for (int ai = 0; ai < 2; ++ai)
#pragma unroll
                for (int m = 0; m < 4; ++m) { bf16_t* rowp = P + (size_t)(row0 + ai * HALF + m * 16) * pw + col0;
#pragma unroll
                    for (int bj = 0; bj < 2; ++bj) { const f32x4 v0 = acc[ai][bj][m][0], v1 = acc[ai][bj][m][1];
                        u32x4 w; w.x = cvt_pk_bf16(v0[0], v0[1]); w.y = cvt_pk_bf16(v0[2], v0[3]); w.z = cvt_pk_bf16(v1[0], v1[1]); w.w = cvt_pk_bf16(v1[2], v1[3]);
                        *(u32x4*)(rowp + bj * HALF) = w; } }
        } else {
            const int col0 = 4096 + (u.pn - 16) * 128 + wc * 32 + 8 * fq;
#pragma unroll
            for (int ai = 0; ai < 2; ++ai)
#pragma unroll
                for (int m = 0; m < 4; ++m) { bf16_t* rowp = P + (size_t)(row0 + ai * HALF + m * 16) * pw + col0;
                    float o[8];
#pragma unroll
                    for (int n = 0; n < 2; ++n)
#pragma unroll
                        for (int j = 0; j < 4; ++j) { const float g = acc[ai][0][m][n][j], s = acc[ai][1][m][n][j]; o[n * 4 + j] = g * fsig(g) * fsig(s); }
                    u32x4 w; w.x = cvt_pk_bf16(o[0], o[1]); w.y = cvt_pk_bf16(o[2], o[3]); w.z = cvt_pk_bf16(o[4], o[5]); w.w = cvt_pk_bf16(o[6], o[7]);
                    *(u32x4*)rowp = w; }
        }
    }
};
struct EpiH {
    static constexpr bool PERM = false, AFTER_DRAIN = false;
    const float* x; const float* mod; float* h;
    __device__ __forceinline__ void operator()(const f32x4 (&acc)[2][2][4][2], const Unit& u, int wr, int wc, int fr, int fq) const {
        const int row0 = u.pm * BM + wr * 64 + fr, col0 = u.pn * BM + wc * 32 + 4 * fq;
        const int b = (u.pm * BM) / 2048;
        f32x4 gv[2][2];
#pragma unroll
        for (int bj = 0; bj < 2; ++bj)
#pragma unroll
            for (int n = 0; n < 2; ++n) gv[bj][n] = *(const f32x4*)(mod + (size_t)b * 6144 + 2048 + col0 + bj * HALF + n * 16);
#pragma unroll
        for (int ai = 0; ai < 2; ++ai)
#pragma unroll
            for (int m = 0; m < 4; ++m) { const size_t off = (size_t)(row0 + ai * HALF + m * 16) * 1024 + col0;
#pragma unroll
                for (int bj = 0; bj < 2; ++bj)
#pragma unroll
                    for (int n = 0; n < 2; ++n) { const f32x4 xv = *(const f32x4*)(x + off + bj * HALF + n * 16); *(f32x4*)(h + off + bj * HALF + n * 16) = xv + gv[bj][n] * acc[ai][bj][m][n]; }
                asm volatile("" ::: "memory"); }
    }
};
struct EpiAct {
    static constexpr bool PERM = true, AFTER_DRAIN = false;
    bf16_t* act;
    __device__ __forceinline__ void operator()(const f32x4 (&acc)[2][2][4][2], const Unit& u, int wr, int wc, int fr, int fq) const {
        const int row0 = u.pm * BM + wr * 64 + fr, col0 = (u.pn & 3) * 128 + wc * 32 + 8 * fq;
#pragma unroll
        for (int ai = 0; ai < 2; ++ai)
#pragma unroll
            for (int m = 0; m < 4; ++m) { bf16_t* rowp = act + (size_t)(row0 + ai * HALF + m * 16) * 512 + col0;
                float o[8];
#pragma unroll
                for (int n = 0; n < 2; ++n)
#pragma unroll
                    for (int j = 0; j < 4; ++j) { const float g = acc[ai][0][m][n][j], up = acc[ai][1][m][n][j]; o[n * 4 + j] = g * fsig(g) * up; }
                u32x4 w; w.x = cvt_pk_bf16(o[0], o[1]); w.y = cvt_pk_bf16(o[2], o[3]); w.z = cvt_pk_bf16(o[4], o[5]); w.w = cvt_pk_bf16(o[6], o[7]);
                *(u32x4*)rowp = w; }
    }
};
struct EpiY {
    static constexpr bool PERM = true, AFTER_DRAIN = false;
    bf16_t* y;
    __device__ __forceinline__ void operator()(const f32x4 (&acc)[2][2][4][2], const Unit& u, int wr, int wc, int fr, int fq) const {
        const int row0 = u.pm * BM + wr * 64 + fr, col0 = (u.pn & 3) * BM + wc * 32 + 8 * fq;
#pragma unroll
        for (int ai = 0; ai < 2; ++ai)
#pragma unroll
            for (int m = 0; m < 4; ++m) { bf16_t* rowp = y + (size_t)(row0 + ai * HALF + m * 16) * 1024 + col0;
#pragma unroll
                for (int bj = 0; bj < 2; ++bj) { const f32x4 v0 = acc[ai][bj][m][0], v1 = acc[ai][bj][m][1];
                    u32x4 w; w.x = cvt_pk_bf16(v0[0], v0[1]); w.y = cvt_pk_bf16(v0[2], v0[3]); w.z = cvt_pk_bf16(v1[0], v1[1]); w.w = cvt_pk_bf16(v1[2], v1[3]);
                    *(u32x4*)(rowp + bj * HALF) = w; } }
    }
};
struct MoeOrder {
    const int* tile_expert; int nwg, G, c;
    __device__ void init(const int* meta, const int* te, int G_, int c_) { tile_expert = te; nwg = meta[33] * 4; G = G_; c = c_; }
    __device__ bool next(int i, Unit& u) const {
        const long L = (long)i * G + c; if (L >= nwg) return false;
        int wgid = (int)L; { const int q = nwg / NXCD, r = nwg % NXCD, xcd = wgid % NXCD, off = wgid / NXCD; wgid = (xcd < r ? xcd * (q + 1) : r * (q + 1) + (xcd - r) * q) + off; }
        u.pm = wgid >> 2; u.pn = tile_expert[u.pm] * 4 + (wgid & 3); return true;
    }
    __device__ __forceinline__ void a_ready(const Unit&) const {}
    __device__ __forceinline__ void done(const Unit&) const {}
};
template <class Epi, class Sched, bool ALIGN_EPI = false, bool SP2 = false>
__device__ __forceinline__ void gemm_phase(PG8_LAS unsigned char* lds, const Gemm g, const Sched& S, const Epi& E) {
    const int tid = threadIdx.x, wid = __builtin_amdgcn_readfirstlane(tid >> 6), lane = tid & 63, wr = wid >> 2, wc = wid & 3, fr = lane & 15, fq = lane >> 4;
    const int K = g.K, nt = K / BK;
    unsigned voffA[2], voffB[2];
#pragma unroll
    for (int i = 0; i < 2; ++i) { int R, C; stage_rc(tid * 16 + i * 8192, R, C); const int Rb = Epi::PERM ? ((R & ~31) + perm32(R & 31)) : R;
        voffA[i] = (unsigned)(R * K + C) * 2u; voffB[i] = (unsigned)(Rb * K + C) * 2u; }
    const size_t kstep = (size_t)(BK * 2);
    const size_t hstep = (size_t)HALF * K * 2;
    const size_t tstep = 2 * hstep;
    const unsigned ldsw = (unsigned)wid * 1024u;
    const int aoff = lds_byte(wr * 64 + fr, fq * 8), boff = lds_byte(wc * 32 + fr, fq * 8);
#define PG8_SA(b, h) (((b) * 2 + (h)) * HTB)
#define PG8_SB(b, h) ((4 + (b) * 2 + (h)) * HTB)
#define PG8_STAGE(bufoff, gbase, voff) do { _Pragma("unroll") for (int _i = 0; _i < 2; ++_i) \
        __builtin_amdgcn_global_load_lds((const unsigned*)((const char*)(gbase) + (voff)[_i]), (PG8_LAS unsigned*)(lds + (bufoff) + ldsw + _i * 8192), 16, 0, 0); } while (0)
#define PG8_LDA(dst, b, h) do { _Pragma("unroll") for (int m = 0; m < 4; ++m) _Pragma("unroll") for (int k = 0; k < 2; ++k) dst[m][k] = *(const PG8_LAS bf16x8*)(lds + PG8_SA(b, h) + aoff + m * 2048 + k * 1024); } while (0)
#define PG8_LDB(dst, b, h) do { _Pragma("unroll") for (int n = 0; n < 2; ++n) _Pragma("unroll") for (int k = 0; k < 2; ++k) dst[n][k] = *(const PG8_LAS bf16x8*)(lds + PG8_SB(b, h) + boff + n * 2048 + k * 1024); } while (0)
#define PG8_MMA(ai, bj, At, Bt) do { __builtin_amdgcn_s_setprio(1); _Pragma("unroll") for (int m = 0; m < 4; ++m) _Pragma("unroll") for (int n = 0; n < 2; ++n) _Pragma("unroll") for (int k = 0; k < 2; ++k) \
        acc[ai][bj][m][n] = __builtin_amdgcn_mfma_f32_16x16x32_bf16(Bt[n][k], At[m][k], acc[ai][bj][m][n], 0, 0, 0); __builtin_amdgcn_s_setprio(0); } while (0)
#define PG8_WAIT_V(n) asm volatile("s_waitcnt vmcnt(" #n ")" ::: "memory")
#define PG8_WAIT_L(n) asm volatile("s_waitcnt lgkmcnt(" #n ")" ::: "memory")
#define PG8_BAR __builtin_amdgcn_s_barrier()
#define PG8_SCHED __builtin_amdgcn_sched_barrier(0)
    Unit cur, nxt; int ui = 0;
    if (!S.next(0, cur)) return;
    f32x4 acc[2][2][4][2];
#pragma unroll
    for (int a = 0; a < 2; ++a)
#pragma unroll
        for (int b = 0; b < 2; ++b)
#pragma unroll
            for (int m = 0; m < 4; ++m)
#pragma unroll
                for (int n = 0; n < 2; ++n) acc[a][b][m][n] = (f32x4){0.f, 0.f, 0.f, 0.f};
    bf16x8 At[4][2], B0[2][2], B1[2][2];
    const char* cA = (const char*)g.A + (size_t)cur.pm * tstep; const char* cB = (const char*)g.Bt + (size_t)cur.pn * tstep;
    S.a_ready(cur);
    if constexpr (SP2) {
        PG8_STAGE(PG8_SB(0, 0), cB, voffB); PG8_STAGE(PG8_SB(0, 1), cB + hstep, voffB); PG8_STAGE(PG8_SA(0, 0), cA, voffA); PG8_STAGE(PG8_SA(0, 1), cA + hstep, voffA);
        if (wr == 1) PG8_BAR;
        PG8_WAIT_V(2); PG8_BAR;
        PG8_STAGE(PG8_SB(1, 0), cB + kstep, voffB); PG8_STAGE(PG8_SA(1, 0), cA + kstep, voffA); PG8_STAGE(PG8_SB(1, 1), cB + hstep + kstep, voffB);
        PG8_WAIT_V(6); PG8_BAR;
    } else {
        PG8_STAGE(PG8_SB(0, 0), cB, voffB); PG8_STAGE(PG8_SA(0, 0), cA, voffA); PG8_STAGE(PG8_SB(0, 1), cB + hstep, voffB); PG8_STAGE(PG8_SA(0, 1), cA + hstep, voffA);
        if (wr == 1) PG8_BAR;
        PG8_WAIT_V(4); PG8_BAR;
        PG8_STAGE(PG8_SB(1, 0), cB + kstep, voffB); PG8_STAGE(PG8_SA(1, 0), cA + kstep, voffA); PG8_STAGE(PG8_SB(1, 1), cB + hstep + kstep, voffB);
        PG8_WAIT_V(6); PG8_BAR;
    }
    for (;;) {
        const bool has_next = S.next(ui + 1, nxt);
        const char* nA = has_next ? (const char*)g.A + (size_t)nxt.pm * tstep : cA; const char* nB = has_next ? (const char*)g.Bt + (size_t)nxt.pn * tstep : cB;
        for (int t = 0; t < nt; t += 2) {
            const bool last = (t == nt - 2);
            const char* a1 = cA + (size_t)(t + 1) * kstep;
            const char* a2 = last ? nA : cA + (size_t)(t + 2) * kstep; const char* b2 = last ? nB : cB + (size_t)(t + 2) * kstep;
            const char* a3 = a2 + kstep; const char* b3 = b2 + kstep;
            if (last && has_next) S.a_ready(nxt);
            if constexpr (SP2) {
            PG8_LDB(B0, 0, 0); PG8_LDB(B1, 0, 1); PG8_SCHED; PG8_LDA(At, 0, 0); PG8_STAGE(PG8_SA(1, 1), a1 + hstep, voffA);
            PG8_WAIT_V(8); PG8_WAIT_L(0); PG8_BAR; PG8_MMA(0, 0, At, B0); PG8_MMA(0, 1, At, B1); PG8_BAR; PG8_SCHED;
            PG8_LDA(At, 0, 1); PG8_STAGE(PG8_SB(0, 0), b2, voffB); PG8_STAGE(PG8_SB(0, 1), b2 + hstep, voffB); PG8_STAGE(PG8_SA(0, 0), a2, voffA);
            PG8_WAIT_V(8); PG8_WAIT_L(0); PG8_BAR; PG8_MMA(1, 0, At, B0); PG8_MMA(1, 1, At, B1); PG8_BAR; PG8_SCHED;
            PG8_LDB(B0, 1, 0); PG8_LDB(B1, 1, 1); PG8_SCHED; PG8_LDA(At, 1, 0); PG8_STAGE(PG8_SA(0, 1), a2 + hstep, voffA);
            PG8_WAIT_V(8); PG8_WAIT_L(0); PG8_BAR; PG8_MMA(0, 0, At, B0); PG8_MMA(0, 1, At, B1); PG8_BAR; PG8_SCHED;
            PG8_LDA(At, 1, 1); PG8_STAGE(PG8_SB(1, 0), b3, voffB); PG8_STAGE(PG8_SB(1, 1), b3 + hstep, voffB); PG8_STAGE(PG8_SA(1, 0), a3, voffA);
            PG8_WAIT_V(8); PG8_WAIT_L(0); PG8_BAR; PG8_MMA(1, 0, At, B0); PG8_MMA(1, 1, At, B1); PG8_BAR; PG8_SCHED;
            } else {
            PG8_LDB(B0, 0, 0); PG8_SCHED; PG8_LDA(At, 0, 0); PG8_STAGE(PG8_SA(1, 1), a1 + hstep, voffA);
            PG8_WAIT_L(8); PG8_BAR; PG8_WAIT_L(0); PG8_MMA(0, 0, At, B0); PG8_BAR; PG8_SCHED;
            PG8_LDB(B1, 0, 1); PG8_STAGE(PG8_SB(0, 0), b2, voffB);
            PG8_BAR; PG8_WAIT_L(0); PG8_MMA(0, 1, At, B1); PG8_BAR;
            PG8_LDA(At, 0, 1); PG8_STAGE(PG8_SA(0, 0), a2, voffA);
            PG8_BAR; PG8_WAIT_L(0); PG8_MMA(1, 0, At, B0); PG8_BAR; PG8_SCHED;
            PG8_STAGE(PG8_SB(0, 1), b2 + hstep, voffB);
            PG8_WAIT_V(6); PG8_BAR; PG8_MMA(1, 1, At, B1); PG8_BAR;
            PG8_LDB(B0, 1, 0); PG8_SCHED; PG8_LDA(At, 1, 0); PG8_STAGE(PG8_SA(0, 1), a2 + hstep, voffA);
            PG8_WAIT_L(8); PG8_BAR; PG8_WAIT_L(0); PG8_MMA(0, 0, At, B0); PG8_BAR; PG8_SCHED;
            PG8_LDB(B1, 1, 1); PG8_STAGE(PG8_SB(1, 0), b3, voffB);
            PG8_BAR; PG8_WAIT_L(0); PG8_MMA(0, 1, At, B1); PG8_BAR;
            PG8_LDA(At, 1, 1); PG8_STAGE(PG8_SA(1, 0), a3, voffA);
            PG8_BAR; PG8_WAIT_L(0); PG8_MMA(1, 0, At, B0); PG8_BAR; PG8_SCHED;
            PG8_STAGE(PG8_SB(1, 1), b3 + hstep, voffB);
            PG8_WAIT_V(6); PG8_BAR; PG8_MMA(1, 1, At, B1); PG8_BAR;
            }
        }
        if constexpr (ALIGN_EPI) { if (wr == 0) PG8_BAR; }
        if constexpr (!Epi::AFTER_DRAIN) { E(acc, cur, wr, wc, fr, fq); S.done(cur); }
        if (!has_next) break;
#pragma unroll
        for (int a = 0; a < 2; ++a)
#pragma unroll
            for (int b = 0; b < 2; ++b)
#pragma unroll
                for (int m = 0; m < 4; ++m)
#pragma unroll
                    for (int n = 0; n < 2; ++n) acc[a][b][m][n] = (f32x4){0.f, 0.f, 0.f, 0.f};
        cur = nxt; cA = nA; cB = nB; ++ui;
        if constexpr (ALIGN_EPI) { if (wr == 1) PG8_BAR; }
    }
    PG8_WAIT_V(0);
    if constexpr (!ALIGN_EPI) { if (wr == 0) PG8_BAR; }
    PG8_BAR;
    if constexpr (Epi::AFTER_DRAIN) { E.fused(acc, cur, wr, wc, fr, fq, lds, wid, lane); S.done(cur); }
#undef PG8_SA
#undef PG8_SB
#undef PG8_STAGE
#undef PG8_LDA
#undef PG8_LDB
#undef PG8_MMA
#undef PG8_WAIT_V
#undef PG8_WAIT_L
#undef PG8_BAR
#undef PG8_SCHED
}
}
namespace {
__device__ __forceinline__ void phase_mod(const Args& a, LAS unsigned char* lds) {
    LAS float* sc = (LAS float*)lds;
    LAS float* part = (LAS float*)(lds + 65536);
    const float* c = a.in[1]; const float* mw = a.in[2]; const float* mb = a.in[3];
    float* mod = (float*)(a.ws + WS_MOD);
    const int tid = threadIdx.x;
    for (int i = tid; i < 16 * 1024; i += 512) sc[i] = silu_f(c[i]);
    __syncthreads();
    const int kg = tid >> 5, cj = tid & 31;
    for (int cgp = blockIdx.x; cgp < 256; cgp += gridDim.x) {
        const int j0 = cgp * 24;
        float acc[16];
#pragma unroll
        for (int b = 0; b < 16; ++b) acc[b] = 0.f;
        if (cj < 24) {
            for (int kk = 0; kk < 64; kk += 4) {
                const int k = kg * 64 + kk;
                const float w0 = mw[(size_t)(k + 0) * 6144 + j0 + cj], w1 = mw[(size_t)(k + 1) * 6144 + j0 + cj], w2 = mw[(size_t)(k + 2) * 6144 + j0 + cj], w3 = mw[(size_t)(k + 3) * 6144 + j0 + cj];
#pragma unroll
                for (int b = 0; b < 16; ++b) { const f4 s = *(const LAS f4*)(sc + b * 1024 + k); acc[b] += s.x * w0 + s.y * w1 + s.z * w2 + s.w * w3; }
            }
        }
#pragma unroll
        for (int b = 0; b < 16; ++b) part[(kg * 16 + b) * 32 + cj] = acc[b];
        __syncthreads();
        if (tid < 384) { const int b = tid / 24, cc = tid % 24; float s = mb[j0 + cc];
            for (int g2 = 0; g2 < 16; ++g2) s += part[(g2 * 16 + b) * 32 + cc];
            mod[b * 6144 + j0 + cc] = s; }
        __syncthreads();
    }
}

__device__ __forceinline__ void phase_norm1(const Args& a, LAS unsigned char* lds) {
    LAS f4* wgA = (LAS f4*)lds;
    LAS f4* wgB = (LAS f4*)(lds + 16384);
    const float* x = a.in[0]; const float* nw = a.in[4]; const float* w_in = a.in[5]; const float* a_log = a.in[7]; const float* dt_bias = a.in[8];
    const float* mod = (const float*)(a.ws + WS_MOD);
    bf16* xm = (bf16*)((unsigned char*)a.out + DO_XM);
    float* Gd = (float*)(a.ws + WS_G); float* Bd = (float*)(a.ws + WS_BETA);
    const int tid = threadIdx.x, lane = tid & 63, wave = tid >> 6;
    for (int k = tid; k < 1024; k += 512) { const int idx = (4 * (k >> 8) + (k & 3)) * 64 + ((k & 255) >> 2);
        wgA[idx] = *(const f4*)(w_in + (size_t)k * DIN + C_GA); wgB[idx] = *(const f4*)(w_in + (size_t)k * DIN + C_GB); }
    __syncthreads();
    const int gw = blockIdx.x * 8 + wave, NGW = gridDim.x * 8;
    for (int grp = gw; grp < T / 2; grp += NGW) {
        const int t0 = grp * 2, b = t0 / SEQ;
        float4 gmul[4], gadd[4];
#pragma unroll
        for (int j = 0; j < 4; ++j) { const int k = 4 * lane + 256 * j;
            const float4 wv = *(const float4*)(nw + k), sc = *(const float4*)(mod + (size_t)b * 6144 + 1024 + k), sh = *(const float4*)(mod + (size_t)b * 6144 + k);
            gmul[j] = make_float4(wv.x * (1.f + sc.x), wv.y * (1.f + sc.y), wv.z * (1.f + sc.z), wv.w * (1.f + sc.w)); gadd[j] = sh; }
        float4 xv[2][4];
#pragma unroll
        for (int r = 0; r < 2; ++r) {
            float ss = 0.f;
#pragma unroll
            for (int j = 0; j < 4; ++j) { xv[r][j] = *(const float4*)(x + (size_t)(t0 + r) * D + 4 * lane + 256 * j); ss += xv[r][j].x * xv[r][j].x + xv[r][j].y * xv[r][j].y + xv[r][j].z * xv[r][j].z + xv[r][j].w * xv[r][j].w; }
            ss = wave_sum(ss);
            const float rstd = rsqrtf(ss * (1.0f / D) + 1e-6f);
#pragma unroll
            for (int j = 0; j < 4; ++j) { float4 v = xv[r][j];
                v.x = v.x * rstd * gmul[j].x + gadd[j].x; v.y = v.y * rstd * gmul[j].y + gadd[j].y; v.z = v.z * rstd * gmul[j].z + gadd[j].z; v.w = v.w * rstd * gmul[j].w + gadd[j].w;
                xv[r][j] = v;
                v2u w; w.x = pk2(v.x, v.y); w.y = pk2(v.z, v.w);
                *(v2u*)(xm + (size_t)(t0 + r) * D + 4 * lane + 256 * j) = w; }
        }
        float acc[2][8];
#pragma unroll
        for (int r = 0; r < 2; ++r)
#pragma unroll
            for (int q = 0; q < 8; ++q) acc[r][q] = 0.f;
#pragma unroll
        for (int j = 0; j < 4; ++j) {
#pragma unroll
            for (int jj = 0; jj < 4; ++jj) {
                const f4 wa = wgA[(4 * j + jj) * 64 + lane], wb = wgB[(4 * j + jj) * 64 + lane];
#pragma unroll
                for (int r = 0; r < 2; ++r) { const float xe = (jj == 0) ? xv[r][j].x : (jj == 1) ? xv[r][j].y : (jj == 2) ? xv[r][j].z : xv[r][j].w;
                    acc[r][0] += xe * wa.x; acc[r][1] += xe * wa.y; acc[r][2] += xe * wa.z; acc[r][3] += xe * wa.w;
                    acc[r][4] += xe * wb.x; acc[r][5] += xe * wb.y; acc[r][6] += xe * wb.z; acc[r][7] += xe * wb.w; }
            }
            asm volatile("" ::: "memory");
        }
        float mine = 0.f;
#pragma unroll
        for (int r = 0; r < 2; ++r)
#pragma unroll
            for (int q = 0; q < 8; ++q) { const float s = wave_sum(acc[r][q]); if (lane == r * 8 + q) mine = s; }
        if (lane < 16) { const int r = lane >> 3, q = lane & 7, t = t0 + r;
            if (q < 4) { const float z = mine + dt_bias[q]; const float sp = (z > 20.f) ? z : log1pf(expf(z)); Gd[t * 4 + q] = -expf(a_log[q]) * sp; }
            else Bd[t * 4 + (q - 4)] = sigmoid_f(mine); }
    }
}

__device__ __forceinline__ void conv_job(const float* src, int ldsrc, int srccol, bf16* dst, int ldd, int n0, int k0, LAS float* tile) {
    const int tid = threadIdx.x;
#pragma unroll
    for (int i = 0; i < 2; ++i) { const int kk = (tid >> 4) + 32 * i, c4 = (tid & 15) * 4;
        const float4 v = *(const float4*)(src + (size_t)(k0 + kk) * ldsrc + srccol + c4);
        tile[kk * 65 + c4 + 0] = v.x; tile[kk * 65 + c4 + 1] = v.y; tile[kk * 65 + c4 + 2] = v.z; tile[kk * 65 + c4 + 3] = v.w; }
    __syncthreads();
    { const int n = tid >> 3, kc = (tid & 7) * 8;
        v4u w; w.x = pk2(tile[(kc + 0) * 65 + n], tile[(kc + 1) * 65 + n]); w.y = pk2(tile[(kc + 2) * 65 + n], tile[(kc + 3) * 65 + n]);
        w.z = pk2(tile[(kc + 4) * 65 + n], tile[(kc + 5) * 65 + n]); w.w = pk2(tile[(kc + 6) * 65 + n], tile[(kc + 7) * 65 + n]);
        *(v4u*)(dst + (size_t)(n0 + n) * ldd + k0 + kc) = w; }
    __syncthreads();
}
__device__ __forceinline__ int win_srccol(int n0) {
    if (n0 < 512) return C_RQ + n0;
    if (n0 < 1024) return C_RK + (n0 - 512);
    if (n0 < 2048) return C_RV + (n0 - 1024);
    if (n0 < 4096) return C_GQ + (n0 - 2048);
    const int j = (n0 - 4096) >> 8, r = (n0 - 4096) & 255, half = r >> 7, cc = r & 127;
    if (j < 8) return (half ? C_GTA : C_RG) + 128 * j + cc;
    return (half ? C_GTB : C_GZ) + 128 * (j - 8) + cc;
}
__device__ __forceinline__ void phase_convert_in(const Args& a, LAS unsigned char* lds) {
    LAS float* tile = (LAS float*)(lds + 32768);
    bf16* wtin = (bf16*)((unsigned char*)a.out + DO_WTIN); bf16* wtout = (bf16*)(a.ws + WS_WTOUT);
    for (int job = blockIdx.x; job < 2048 + 256; job += gridDim.x) {
        if (job < 2048) { const int nt = job >> 4, kt = job & 15; conv_job(a.in[5], DIN, win_srccol(nt * 64), wtin, 1024, nt * 64, kt * 64, tile); }
        else { const int jj = job - 2048, nt = jj >> 4, kt = jj & 15; conv_job(a.in[10], 1024, nt * 64, wtout, 1024, nt * 64, kt * 64, tile); }
    }
    float2* rope = (float2*)(a.ws + WS_ROPE);
    for (int i = blockIdx.x * 512 + threadIdx.x; i < SEQ * 64; i += gridDim.x * 512) {
        const int t = i >> 6, fi = i & 63;
        const double inv = exp(-((double)fi / 64.0) * 9.210340371976184), ang = (double)t * inv;
        rope[i] = make_float2((float)cos(ang), (float)sin(ang));
    }
}
__device__ __forceinline__ void phase_inproj(const Args& a, LAS unsigned char* lds) {
    pg8::Gemm g{(const bf16*)((unsigned char*)a.out + DO_XM), (const bf16*)((unsigned char*)a.out + DO_WTIN), T, 8192, 1024};
    pg8::StaticOrder S; S.init(T, 8192, (int)gridDim.x, (int)blockIdx.x);
    pg8::EpiProj E{(bf16*)(a.ws + WS_PROJ), PW};
    pg8::gemm_phase<pg8::EpiProj, pg8::StaticOrder, true, true>(lds, g, S, E);
}


__device__ __forceinline__ void phase_outproj(const Args& a, LAS unsigned char* lds) {
    pg8::Gemm g{(const bf16*)(a.ws + WS_MERGED), (const bf16*)(a.ws + WS_WTOUT), T, 1024, 1024};
    pg8::StaticOrder S; S.init(T, 1024, (int)gridDim.x, (int)blockIdx.x);
    pg8::EpiH E{a.in[0], (const float*)(a.ws + WS_MOD), a.out};
    pg8::gemm_phase<pg8::EpiH, pg8::StaticOrder, true, true>(lds, g, S, E);
}

__device__ __forceinline__ void phase_route(const Args& a, LAS unsigned char* lds) {
    LAS f4* wr = (LAS f4*)lds;
    LAS int* hist = (LAS int*)(lds + 5 * 16384);
    LAS float* lgl = (LAS float*)(lds + 5 * 16384 + 256);
    const float* h = a.out; const float* nw = a.in[11]; const float* w_group = a.in[12]; const float* b_group = a.in[13]; const float* w_router = a.in[14]; const float* b_router = a.in[15];
    const float* mod = (const float*)(a.ws + WS_MOD);
    bf16* xf = (bf16*)(a.ws + WS_XF);
    int* tok_e = (int*)(a.ws + WS_TOKE); float* tok_w = (float*)(a.ws + WS_TOKW);
    const int tid = threadIdx.x, lane = tid & 63, wave = tid >> 6;
    for (int k = tid; k < 1024; k += 512) { const int idx = (4 * (k >> 8) + (k & 3)) * 64 + ((k & 255) >> 2);
        wr[idx] = *(const f4*)(w_group + (size_t)k * 4);
#pragma unroll
        for (int q = 0; q < 4; ++q) wr[(q + 1) * 1024 + idx] = *(const f4*)(w_router + (size_t)k * 16 + 4 * q); }
    if (tid < 16) hist[tid] = 0;
    __syncthreads();
    const int TPB = T / (int)gridDim.x, tb0 = blockIdx.x * TPB;
#pragma unroll 1
    for (int pr = wave; pr < TPB / 2; pr += 8) {
        const int t0 = tb0 + pr * 2, b = t0 / SEQ;
        float4 gmul[4], gadd[4];
#pragma unroll
        for (int j = 0; j < 4; ++j) { const int k = 4 * lane + 256 * j;
            const float4 wv = *(const float4*)(nw + k), sc = *(const float4*)(mod + (size_t)b * 6144 + 4096 + k), sh = *(const float4*)(mod + (size_t)b * 6144 + 3072 + k);
            gmul[j] = make_float4(wv.x * (1.f + sc.x), wv.y * (1.f + sc.y), wv.z * (1.f + sc.z), wv.w * (1.f + sc.w)); gadd[j] = sh; }
        float4 xv[2][4];
#pragma unroll
        for (int r = 0; r < 2; ++r) {
            float ss = 0.f;
#pragma unroll
            for (int j = 0; j < 4; ++j) { xv[r][j] = *(const float4*)(h + (size_t)(t0 + r) * D + 4 * lane + 256 * j); ss += xv[r][j].x * xv[r][j].x + xv[r][j].y * xv[r][j].y + xv[r][j].z * xv[r][j].z + xv[r][j].w * xv[r][j].w; }
            ss = wave_sum(ss);
            const float rstd = rsqrtf(ss * (1.0f / D) + 1e-6f);
#pragma unroll
            for (int j = 0; j < 4; ++j) { float4 v = xv[r][j];
                v.x = v.x * rstd * gmul[j].x + gadd[j].x; v.y = v.y * rstd * gmul[j].y + gadd[j].y; v.z = v.z * rstd * gmul[j].z + gadd[j].z; v.w = v.w * rstd * gmul[j].w + gadd[j].w;
                xv[r][j] = v;
                v2u w; w.x = pk2(v.x, v.y); w.y = pk2(v.z, v.w);
                *(v2u*)(xf + (size_t)(t0 + r) * D + 4 * lane + 256 * j) = w; }
        }
        float acc[2][20];
#pragma unroll
        for (int r = 0; r < 2; ++r)
#pragma unroll
            for (int q = 0; q < 20; ++q) acc[r][q] = 0.f;
#pragma unroll
        for (int j = 0; j < 4; ++j) {
#pragma unroll
            for (int jj = 0; jj < 4; ++jj) {
                const int idx = (4 * j + jj) * 64 + lane;
#pragma unroll
                for (int q = 0; q < 5; ++q) { const f4 w = wr[q * 1024 + idx];
#pragma unroll
                    for (int r = 0; r < 2; ++r) { const float xe = (jj == 0) ? xv[r][j].x : (jj == 1) ? xv[r][j].y : (jj == 2) ? xv[r][j].z : xv[r][j].w;
                        acc[r][4 * q + 0] += xe * w.x; acc[r][4 * q + 1] += xe * w.y; acc[r][4 * q + 2] += xe * w.z; acc[r][4 * q + 3] += xe * w.w; } }
                asm volatile("" ::: "memory");
            }
        }
        float mine0 = 0.f, mine1 = 0.f;
#pragma unroll
        for (int q = 0; q < 20; ++q) { const float s0 = wave_sum(acc[0][q]), s1 = wave_sum(acc[1][q]); if (lane == q) { mine0 = s0; mine1 = s1; } }
        if (lane < 20) { lgl[(pr * 2 + 0) * 20 + lane] = mine0; lgl[(pr * 2 + 1) * 20 + lane] = mine1; }
    }
    __syncthreads();
    if (tid < TPB) {
        const int t = tb0 + tid;
        float lg[20];
#pragma unroll
        for (int q = 0; q < 20; ++q) lg[q] = lgl[tid * 20 + q];
        float gl[4], gmax = -1e30f; int gi = 0;
#pragma unroll
        for (int j = 0; j < 4; ++j) { gl[j] = lg[j] + b_group[j]; if (gl[j] > gmax) { gmax = gl[j]; gi = j; } }
        float gs = 0.f;
#pragma unroll
        for (int j = 0; j < 4; ++j) gs += expf(gl[j] - gmax);
        const float g_top = 1.0f / gs;
        float el[4], emax = -1e30f;
#pragma unroll
        for (int j = 0; j < 4; ++j) { const float raw = (gi == 0) ? lg[4 + j] : (gi == 1) ? lg[8 + j] : (gi == 2) ? lg[12 + j] : lg[16 + j]; el[j] = raw + b_router[gi * 4 + j]; emax = fmaxf(emax, el[j]); }
        float ep[4], es = 0.f;
#pragma unroll
        for (int j = 0; j < 4; ++j) { ep[j] = expf(el[j] - emax); es += ep[j]; }
#pragma unroll
        for (int j = 0; j < 4; ++j) ep[j] /= es;
        int i1 = 0; float p1 = ep[0];
#pragma unroll
        for (int j = 1; j < 4; ++j) if (ep[j] > p1) { p1 = ep[j]; i1 = j; }
        int i2 = -1; float p2 = -1.f;
#pragma unroll
        for (int j = 0; j < 4; ++j) if (j != i1 && ep[j] > p2) { p2 = ep[j]; i2 = j; }
        const float den = p1 + p2;
        tok_e[t * 2 + 0] = gi * 4 + i1; tok_e[t * 2 + 1] = gi * 4 + i2;
        tok_w[t * 2 + 0] = g_top * (p1 / den); tok_w[t * 2 + 1] = g_top * (p2 / den);
        __hip_atomic_fetch_add(&hist[gi * 4 + i1], 1, __ATOMIC_RELAXED, __HIP_MEMORY_SCOPE_WORKGROUP); __hip_atomic_fetch_add(&hist[gi * 4 + i2], 1, __ATOMIC_RELAXED, __HIP_MEMORY_SCOPE_WORKGROUP);
    }
    __syncthreads();
    if (tid < 16) ((int*)(a.ws + WS_HIST))[blockIdx.x * 16 + tid] = hist[tid];
}
__device__ __forceinline__ void phase_convert_experts(const Args& a, LAS unsigned char* lds) {
    LAS float* tile = (LAS float*)(lds + 98304);
    bf16* wtgu = (bf16*)(a.ws + WS_WTGU); bf16* wtd = (bf16*)(a.ws + WS_WTD);
    for (int job = blockIdx.x; job < 4096 + 2048; job += gridDim.x) {
        if (job < 4096) { const int e = job >> 8, nt = (job >> 4) & 15, kt = job & 15, n0 = nt * 64;
            const int j = n0 >> 8, r = n0 & 255, half = r >> 7, cc = r & 127;
            const float* src = (half ? a.in[17] : a.in[16]) + (size_t)e * 1024 * 512;
            conv_job(src, 512, 128 * j + cc, wtgu + (size_t)e * 1024 * 1024, 1024, n0, kt * 64, tile); }
        else { const int jj = job - 4096, e = jj >> 7, nt = (jj >> 3) & 15, kt = jj & 7;
            conv_job(a.in[18] + (size_t)e * 512 * 1024, 1024, nt * 64, wtd + (size_t)e * 1024 * 512, 512, nt * 64, kt * 64, tile); }
    }
}
__device__ __forceinline__ void phase_scatter(const Args& a, LAS unsigned char* lds) {
    LAS int* base = (LAS int*)lds;
    LAS int* mybase = base + 16;
    LAS int* elist = base + 32;
    LAS int* slots = base + 32 + 512;
    const int* hist = (const int*)(a.ws + WS_HIST); const int* tok_e = (const int*)(a.ws + WS_TOKE);
    int* tok_s = (int*)(a.ws + WS_TOKS); int* meta = (int*)(a.ws + WS_META); int* tile_expert = meta + 64;
    const bf16* xf = (const bf16*)(a.ws + WS_XF); bf16* xs = (bf16*)(a.ws + WS_XS);
    const int tid = threadIdx.x, lane = tid & 63, wave = tid >> 6, G = (int)gridDim.x;
    const int TPB = T / G, tb0 = blockIdx.x * TPB, NA = 2 * TPB;
    if (tid < 16) { int tot = 0, before = 0; for (int i = 0; i < G; ++i) { const int c = hist[i * 16 + tid]; tot += c; if (i < (int)blockIdx.x) before += c; } base[tid] = tot; mybase[tid] = before; }
    __syncthreads();
    if (tid == 0) { int off = 0;
        for (int e = 0; e < 16; ++e) { const int cnt = base[e], nt = (cnt + 255) >> 8;
            if (blockIdx.x == 0) { meta[e] = cnt; meta[16 + e] = off; for (int k = 0; k < nt; ++k) tile_expert[(off >> 8) + k] = e; }
            base[e] = off; off += nt * 256; }
        if (blockIdx.x == 0) { meta[32] = off; meta[33] = off >> 8; } }
    for (int i = tid; i < NA; i += 512) elist[i] = tok_e[tb0 * 2 + i];
    __syncthreads();
    for (int i = tid; i < NA; i += 512) { const int e = elist[i]; int rank = 0; for (int k = 0; k < i; ++k) rank += (elist[k] == e) ? 1 : 0;
        const int slot = base[e] + mybase[e] + rank; slots[i] = slot; tok_s[tb0 * 2 + i] = slot; }
    __syncthreads();
    for (int i = wave; i < NA; i += 8) { const int slot = slots[i], t = tb0 + (i >> 1);
        const v4u* src = (const v4u*)(xf + (size_t)t * D); v4u* dst = (v4u*)(xs + (size_t)slot * D);
        dst[lane] = src[lane]; dst[lane + 64] = src[lane + 64]; }
}
__device__ __forceinline__ void phase_moe1(const Args& a, LAS unsigned char* lds) {
    const int* meta = (const int*)(a.ws + WS_META);
    pg8::Gemm g{(const bf16*)(a.ws + WS_XS), (const bf16*)(a.ws + WS_WTGU), 0, 0, 1024};
    pg8::MoeOrder S; S.init(meta, meta + 64, (int)gridDim.x, (int)blockIdx.x);
    pg8::EpiAct E{(bf16*)(a.ws + WS_ACT)};
    pg8::gemm_phase<pg8::EpiAct, pg8::MoeOrder, true, true>(lds, g, S, E);
}
__device__ __forceinline__ void phase_moe2(const Args& a, LAS unsigned char* lds) {
    const int* meta = (const int*)(a.ws + WS_META);
    pg8::Gemm g{(const bf16*)(a.ws + WS_ACT), (const bf16*)(a.ws + WS_WTD), 0, 0, 512};
    pg8::MoeOrder S; S.init(meta, meta + 64, (int)gridDim.x, (int)blockIdx.x);
    pg8::EpiY E{(bf16*)(a.ws + WS_Y)};
    pg8::gemm_phase<pg8::EpiY, pg8::MoeOrder, true, true>(lds, g, S, E);
}
__device__ __forceinline__ void phase_final(const Args& a, LAS unsigned char* lds) {
    const float* mod = (const float*)(a.ws + WS_MOD); const float* now = a.in[19];
    const bf16* y = (const bf16*)(a.ws + WS_Y); const int* tok_s = (const int*)(a.ws + WS_TOKS); const float* tok_w = (const float*)(a.ws + WS_TOKW);
    float* out = a.out;
    const int tid = threadIdx.x, lane = tid & 63, wave = tid >> 6;
    const int gw = blockIdx.x * 8 + wave, NGW = gridDim.x * 8;
    for (int t = gw; t < T; t += NGW) {
        const int b = t / SEQ, s1 = tok_s[t * 2], s2 = tok_s[t * 2 + 1];
        const float w1 = tok_w[t * 2], w2 = tok_w[t * 2 + 1];
        float4 o[4]; float ss = 0.f;
#pragma unroll
        for (int j = 0; j < 4; ++j) { const int k = 4 * lane + 256 * j;
            const float4 hv = *(const float4*)(out + (size_t)t * D + k), gf = *(const float4*)(mod + (size_t)b * 6144 + 5120 + k);
            const v2u a1 = *(const v2u*)(y + (size_t)s1 * D + k), a2 = *(const v2u*)(y + (size_t)s2 * D + k);
            float4 v;
            v.x = hv.x + gf.x * (w1 * bflo(a1.x) + w2 * bflo(a2.x)); v.y = hv.y + gf.y * (w1 * bfhi(a1.x) + w2 * bfhi(a2.x));
            v.z = hv.z + gf.z * (w1 * bflo(a1.y) + w2 * bflo(a2.y)); v.w = hv.w + gf.w * (w1 * bfhi(a1.y) + w2 * bfhi(a2.y));
            o[j] = v; ss += v.x * v.x + v.y * v.y + v.z * v.z + v.w * v.w; }
        ss = wave_sum(ss);
        const float rstd = rsqrtf(ss * (1.0f / D) + 1e-6f);
#pragma unroll
        for (int j = 0; j < 4; ++j) { const int k = 4 * lane + 256 * j; const float4 nwv = *(const float4*)(now + k);
            *(float4*)(out + (size_t)t * D + k) = make_float4(o[j].x * rstd * nwv.x, o[j].y * rstd * nwv.y, o[j].z * rstd * nwv.z, o[j].w * rstd * nwv.w); }
    }
}


__device__ __forceinline__ float quad_sum(float v) { v += __shfl_xor(v, 1); v += __shfl_xor(v, 2); return v; }
template <int BR>
__device__ __forceinline__ void scan_item(const Args& a, LAS unsigned char* lds, int b, int h, int half) {
    constexpr int TG = 8;
    LAS float* kf = (LAS float*)lds;
    LAS float* qf = kf + TG * 128;
    LAS float* vf = qf + TG * 128;
    LAS float* of = vf + TG * 128;
    LAS float* sc = of + TG * 128;
    bf16* proj = (bf16*)(a.ws + WS_PROJ);
    const float2* rope = (const float2*)(a.ws + WS_ROPE);
    const float* Gd = (const float*)(a.ws + WS_G); const float* Bd = (const float*)(a.ws + WS_BETA); const float* conv_w = a.in[6];
    float* ssq = (float*)(a.ws + WS_SSQ);
    const int tid = threadIdx.x, v = tid >> 2, qd = tid & 3;
    const size_t row0 = (size_t)b * SEQ;
    const int qcol = (BR == 0 ? P_RQ : P_GQ) + h * 128, kcol = (BR == 0 ? P_RK : P_GK) + h * 128, vcol = (BR == 0 ? P_RV : P_GV) + h * 256 + half * 128;
    const float gamma = 1.0f - exp2f(-5.0f - (float)h);
    LAS float* hv = sc + TG * 2;
    float s[32];
#pragma unroll
    for (int d = 0; d < 32; ++d) s[d] = 0.f;
    for (int i = tid; i < 2 * 3 * 128; i += 512) hv[i] = 0.f;
    __syncthreads();
    for (int t0 = 0; t0 < SEQ; t0 += TG) {
        if (BR == 0) {
#pragma unroll
            for (int r = 0; r < 2; ++r) { const int idx = tid + 512 * r, isk = idx >> 9, tt = (idx >> 6) & 7, i = idx & 63, t = t0 + tt;
                const bf16* pr = proj + (row0 + t) * PW + (isk ? kcol : qcol);
                const float x1 = bf2f(pr[i]), x2 = bf2f(pr[i + 64]); const float2 cs = rope[t * 64 + i];
                const float sc_ = isk ? 0.08838834764831845f : 1.0f;
                LAS float* dst = (isk ? kf : qf) + tt * 128;
                dst[i] = (x1 * cs.x - x2 * cs.y) * sc_; dst[i + 64] = (x1 * cs.y + x2 * cs.x) * sc_; }
#pragma unroll
            for (int r = 0; r < 2; ++r) { const int idx = tid + 512 * r, tt = idx >> 7, c = idx & 127;
                vf[tt * 128 + c] = bf2f(proj[(row0 + t0 + tt) * PW + vcol + c]); }
        } else {
            if (tid < 384) {
                const bool isv = tid >= 256; const int u = isv ? tid - 256 : tid;
                const int tt = isv ? (u >> 4) : (u >> 5), part = isv ? (u & 15) : (u & 31), t = t0 + tt;
                const int col = isv ? (vcol + 8 * part) : (part < 16 ? qcol + 8 * part : kcol + 8 * (part - 16));
                const int cch = col - P_GQ;
                float acc[8];
#pragma unroll
                for (int j = 0; j < 8; ++j) acc[j] = 0.f;
#pragma unroll
                for (int i = 0; i < 4; ++i) { const int tr = t - 3 + i;
                    if (isv && tr < t0) {
                        const LAS float* hp = hv + (((t0 / TG) & 1) * 3 + (tr - (t0 - 3))) * 128 + 8 * part;
                        const float4 w0 = *(const float4*)(conv_w + i * 2048 + cch), w1 = *(const float4*)(conv_w + i * 2048 + cch + 4);
                        acc[0] += hp[0] * w0.x; acc[1] += hp[1] * w0.y; acc[2] += hp[2] * w0.z; acc[3] += hp[3] * w0.w;
                        acc[4] += hp[4] * w1.x; acc[5] += hp[5] * w1.y; acc[6] += hp[6] * w1.z; acc[7] += hp[7] * w1.w;
                    } else if (tr >= 0) { const v4u raw = *(const v4u*)(proj + (row0 + tr) * PW + col);
                        if (isv && i == 3 && tt >= TG - 3) { LAS float* hn = hv + ((((t0 / TG) + 1) & 1) * 3 + (tt - (TG - 3))) * 128 + 8 * part;
                            hn[0] = bflo(raw.x); hn[1] = bfhi(raw.x); hn[2] = bflo(raw.y); hn[3] = bfhi(raw.y); hn[4] = bflo(raw.z); hn[5] = bfhi(raw.z); hn[6] = bflo(raw.w); hn[7] = bfhi(raw.w); }
                        const float4 w0 = *(const float4*)(conv_w + i * 2048 + cch), w1 = *(const float4*)(conv_w + i * 2048 + cch + 4);
                        acc[0] += bflo(raw.x) * w0.x; acc[1] += bfhi(raw.x) * w0.y; acc[2] += bflo(raw.y) * w0.z; acc[3] += bfhi(raw.y) * w0.w;
                        acc[4] += bflo(raw.z) * w1.x; acc[5] += bfhi(raw.z) * w1.y; acc[6] += bflo(raw.w) * w1.z; acc[7] += bfhi(raw.w) * w1.w; } }
                float ss = 0.f;
#pragma unroll
                for (int j = 0; j < 8; ++j) { acc[j] = acc[j] * fsigmoid(acc[j]); ss += acc[j] * acc[j]; }
                if (!isv) {
                    ss += __shfl_xor(ss, 1); ss += __shfl_xor(ss, 2); ss += __shfl_xor(ss, 4); ss += __shfl_xor(ss, 8);
                    const float rn = rsqrtf(ss + 1e-6f) * (part < 16 ? 0.08838834764831845f : 1.0f);
                    LAS float* dst = (part < 16 ? qf : kf) + tt * 128 + 8 * (part & 15);
#pragma unroll
                    for (int j = 0; j < 8; ++j) dst[j] = acc[j] * rn;
                } else { LAS float* dst = vf + tt * 128 + 8 * part;
#pragma unroll
                    for (int j = 0; j < 8; ++j) dst[j] = acc[j]; }
            } else if (tid < 384 + TG) { const int tt = tid - 384; const size_t gi = (row0 + t0 + tt) * 4 + h; sc[tt * 2] = expf(Gd[gi]); sc[tt * 2 + 1] = Bd[gi]; }
        }
        __syncthreads();
#pragma unroll 1
        for (int tt = 0; tt < TG; ++tt) {
            const LAS f4* kp = (const LAS f4*)(kf + tt * 128 + 32 * qd); const LAS f4* qp = (const LAS f4*)(qf + tt * 128 + 32 * qd);
            const float vt = vf[tt * 128 + v];
            float o = 0.f;
            if (BR == 0) {
#pragma unroll
                for (int d4 = 0; d4 < 8; ++d4) { const f4 kk = kp[d4], qq = qp[d4];
                    s[4 * d4 + 0] = gamma * s[4 * d4 + 0] + kk.x * vt; o += qq.x * s[4 * d4 + 0];
                    s[4 * d4 + 1] = gamma * s[4 * d4 + 1] + kk.y * vt; o += qq.y * s[4 * d4 + 1];
                    s[4 * d4 + 2] = gamma * s[4 * d4 + 2] + kk.z * vt; o += qq.z * s[4 * d4 + 2];
                    s[4 * d4 + 3] = gamma * s[4 * d4 + 3] + kk.w * vt; o += qq.w * s[4 * d4 + 3]; }
            } else {
                const float al = sc[tt * 2], bt = sc[tt * 2 + 1];
                float dot = 0.f;
#pragma unroll
                for (int d4 = 0; d4 < 8; ++d4) { const f4 kk = kp[d4];
                    s[4 * d4 + 0] *= al; dot += s[4 * d4 + 0] * kk.x; s[4 * d4 + 1] *= al; dot += s[4 * d4 + 1] * kk.y;
                    s[4 * d4 + 2] *= al; dot += s[4 * d4 + 2] * kk.z; s[4 * d4 + 3] *= al; dot += s[4 * d4 + 3] * kk.w; }
                dot = quad_sum(dot);
                const float vn = bt * (vt - dot);
#pragma unroll
                for (int d4 = 0; d4 < 8; ++d4) { const f4 kk = kp[d4], qq = qp[d4];
                    s[4 * d4 + 0] += kk.x * vn; o += s[4 * d4 + 0] * qq.x; s[4 * d4 + 1] += kk.y * vn; o += s[4 * d4 + 1] * qq.y;
                    s[4 * d4 + 2] += kk.z * vn; o += s[4 * d4 + 2] * qq.z; s[4 * d4 + 3] += kk.w * vn; o += s[4 * d4 + 3] * qq.w; }
            }
            o = quad_sum(o);
            if (qd == 0) of[tt * 128 + v] = o;
        }
        __syncthreads();
        if (tid < 128) { const int tt = tid >> 4, c8 = (tid & 15) * 8;
            const LAS float* src = of + tt * 128 + c8; float ss = 0.f;
#pragma unroll
            for (int j = 0; j < 8; ++j) ss += src[j] * src[j];
            v4u w; w.x = pk2(src[0], src[1]); w.y = pk2(src[2], src[3]); w.z = pk2(src[4], src[5]); w.w = pk2(src[6], src[7]);
            *(v4u*)(proj + (row0 + t0 + tt) * PW + vcol + c8) = w;
            ss += __shfl_xor(ss, 1); ss += __shfl_xor(ss, 2); ss += __shfl_xor(ss, 4); ss += __shfl_xor(ss, 8);
            if ((tid & 15) == 0) ssq[(row0 + t0 + tt) * 16 + BR * 8 + h * 2 + half] = ss; }
        __syncthreads();
    }
}
__device__ __forceinline__ void phase_scan_simple(const Args& a, LAS unsigned char* lds) {
    for (int id = blockIdx.x; id < 256; id += gridDim.x) {
        const int br = (id >> 4) & 1, half = (id >> 3) & 1, bh = (id >> 5) * 8 + (id & 7), b = bh >> 2, h = bh & 3;
        if (br == 0) scan_item<0>(a, lds, b, h, half); else scan_item<1>(a, lds, b, h, half);
        __syncthreads();
    }
}
__device__ __forceinline__ void phase_merge(const Args& a, LAS unsigned char* lds) {
    const bf16* proj = (const bf16*)(a.ws + WS_PROJ); const float* ssq = (const float*)(a.ws + WS_SSQ); const float* gnw = a.in[9];
    bf16* merged = (bf16*)(a.ws + WS_MERGED);
    const int tid = threadIdx.x, lane = tid & 63, wave = tid >> 6;
    const int gw = blockIdx.x * 8 + wave, NGW = gridDim.x * 8;
    for (int t = gw; t < T; t += NGW) {
        const int c0 = 16 * lane, h = lane >> 4;
        const float* sq = ssq + (size_t)t * 16;
        const float rr = rsqrtf((sq[h * 2] + sq[h * 2 + 1]) * (1.0f / 256.0f) + 1e-6f), rg = rsqrtf((sq[8 + h * 2] + sq[8 + h * 2 + 1]) * (1.0f / 256.0f) + 1e-6f);
        const bf16* pr = proj + (size_t)t * PW;
#pragma unroll
        for (int part = 0; part < 2; ++part) { const int c = c0 + 8 * part;
            const v4u orv = *(const v4u*)(pr + P_RV + c), ogv = *(const v4u*)(pr + P_GV + c), ga = *(const v4u*)(pr + P_GA + c), gb = *(const v4u*)(pr + P_GB + c);
            const float4 w0 = *(const float4*)(gnw + (c & 255)), w1 = *(const float4*)(gnw + (c & 255) + 4);
            float o[8];
            o[0] = bflo(ga.x) * bflo(orv.x) * rr + bflo(gb.x) * bflo(ogv.x) * rg * w0.x; o[1] = bfhi(ga.x) * bfhi(orv.x) * rr + bfhi(gb.x) * bfhi(ogv.x) * rg * w0.y;
            o[2] = bflo(ga.y) * bflo(orv.y) * rr + bflo(gb.y) * bflo(ogv.y) * rg * w0.z; o[3] = bfhi(ga.y) * bfhi(orv.y) * rr + bfhi(gb.y) * bfhi(ogv.y) * rg * w0.w;
            o[4] = bflo(ga.z) * bflo(orv.z) * rr + bflo(gb.z) * bflo(ogv.z) * rg * w1.x; o[5] = bfhi(ga.z) * bfhi(orv.z) * rr + bfhi(gb.z) * bfhi(ogv.z) * rg * w1.y;
            o[6] = bflo(ga.w) * bflo(orv.w) * rr + bflo(gb.w) * bflo(ogv.w) * rg * w1.z; o[7] = bfhi(ga.w) * bfhi(orv.w) * rr + bfhi(gb.w) * bfhi(ogv.w) * rg * w1.w;
            v4u w; w.x = pk2(o[0], o[1]); w.y = pk2(o[2], o[3]); w.z = pk2(o[4], o[5]); w.w = pk2(o[6], o[7]);
            *(v4u*)(merged + (size_t)t * 1024 + c) = w; }
    }
}

template <int PH> __device__ __forceinline__ void run_phase(const Args& a, LAS unsigned char* lds) {
    if (PH == 0) phase_mod(a, lds);
    else if (PH == 1) { phase_norm1(a, lds); __syncthreads(); phase_convert_in(a, lds); }
    else if (PH == 2) phase_inproj(a, lds);
    else if (PH == 3) phase_scan_simple(a, lds);
    else if (PH == 4) phase_merge(a, lds);
    else if (PH == 5) phase_outproj(a, lds);
    else if (PH == 6) { phase_route(a, lds); __syncthreads(); phase_convert_experts(a, lds); }
    else if (PH == 7) phase_scatter(a, lds);
    else if (PH == 8) phase_moe1(a, lds);
    else if (PH == 9) phase_moe2(a, lds);
    else if (PH == 10) phase_final(a, lds);
}
template <int PH> __global__ void __launch_bounds__(512, 2) k_phase(Args a) {
    extern __shared__ __attribute__((aligned(16))) unsigned char smem[];
    run_phase<PH>(a, (LAS unsigned char*)smem);
}
}

template <int PH> static void launch_phase(const Args& a, hipStream_t stream) {
    static bool attr = false;
    if (!attr) { (void)hipFuncSetAttribute((const void*)k_phase<PH>, hipFuncAttributeMaxDynamicSharedMemorySize, LDS_BYTES); attr = true; }
    hipLaunchKernelGGL(k_phase<PH>, dim3(256), dim3(512), LDS_BYTES, stream, a);
}
extern "C" void kernel_launch(void* const* d_in, const int* in_sizes, int n_in, void* d_out, int out_size, void* d_ws, size_t ws_size, hipStream_t stream) {
    float* out = (float*)d_out;
    if (ws_size < 512 * MiB) return;
    Args a{};
    for (int i = 0; i < 20; ++i) a.in[i] = (const float*)d_in[i];
    a.out = out; a.ws = (unsigned char*)d_ws;
    launch_phase<0>(a, stream); launch_phase<1>(a, stream); launch_phase<2>(a, stream); launch_phase<3>(a, stream); launch_phase<4>(a, stream); launch_phase<5>(a, stream);
    launch_phase<6>(a, stream); launch_phase<7>(a, stream); launch_phase<8>(a, stream); launch_phase<9>(a, stream); launch_phase<10>(a, stream);
}
```

```cpp
#include <hip/hip_runtime.h>
#include <hip/hip_cooperative_groups.h>
#include <stdint.h>
namespace cg = cooperative_groups;

#define LAS __attribute__((address_space(3)))
typedef unsigned short bf16;
typedef unsigned v4u __attribute__((ext_vector_type(4)));
typedef unsigned v2u __attribute__((ext_vector_type(2)));
typedef float f4 __attribute__((ext_vector_type(4)));

namespace {
constexpr int D = 1024, NB = 16, SEQ = 2048, T = NB * SEQ, DIN = 8200;
constexpr int NH = 4, DK = 128, DV = 256;
constexpr int C_RQ = 0, C_RK = 512, C_RV = 1024, C_RG = 2048, C_GQ = 3072, C_GK = 3584, C_GV = 4096, C_GZ = 5120,
              C_GA = 6144, C_GB = 6148, C_GTA = 6152, C_GTB = 7176;
constexpr int NE = 16, FF = 512;
constexpr int MAXSLOT = 2 * T + NE * 256;
constexpr int PW = 6144, P_RQ = 0, P_RK = 512, P_RV = 1024, P_GQ = 2048, P_GK = 2560, P_GV = 3072, P_GA = 4096, P_GB = 5120;

constexpr size_t MiB = 1u << 20;
constexpr size_t WS_PROJ = 0;
constexpr size_t WS_MERGED = 384 * MiB;
constexpr size_t WS_WTOUT = 448 * MiB;
constexpr size_t WS_WTGU = 0;
constexpr size_t WS_WTD = 32 * MiB;
constexpr size_t WS_XF = 48 * MiB;
constexpr size_t WS_XS = 112 * MiB;
constexpr size_t WS_ACT = 248 * MiB;
constexpr size_t WS_Y = 316 * MiB;
constexpr size_t WS_CTL = 456 * MiB;
constexpr size_t WS_MOD = 457 * MiB;
constexpr size_t WS_ROPE = 458 * MiB;
constexpr size_t WS_BETA = 459 * MiB;
constexpr size_t WS_G = 459 * MiB + 512 * 1024;
constexpr size_t WS_SSQ = 460 * MiB;
constexpr size_t WS_TOKE = 462 * MiB;
constexpr size_t WS_TOKW = 462 * MiB + 256 * 1024;
constexpr size_t WS_TOKS = 462 * MiB + 512 * 1024;
constexpr size_t WS_HIST = 463 * MiB;
constexpr size_t WS_META = 463 * MiB + 64 * 1024;
constexpr size_t WS_NEED = 464 * MiB;
constexpr size_t DO_XM = 0;
constexpr size_t DO_WTIN = 64 * MiB;
constexpr int LDS_BYTES = 147456;

__device__ __forceinline__ float silu_f(float x) { return x / (1.0f + expf(-x)); }
__device__ __forceinline__ float sigmoid_f(float x) { return 1.0f / (1.0f + expf(-x)); }
__device__ __forceinline__ float fsigmoid(float x) { return __builtin_amdgcn_rcpf(1.0f + __expf(-x)); }
__device__ __forceinline__ float wave_sum(float v) {
#pragma unroll
    for (int o = 32; o >= 1; o >>= 1) v += __shfl_xor(v, o);
    return v;
}
__device__ __forceinline__ unsigned f2bf(float f) { unsigned u = __float_as_uint(f); return (u + 0x7fffu + ((u >> 16) & 1u)) >> 16; }
__device__ __forceinline__ unsigned pk2(float lo, float hi) { return f2bf(lo) | (f2bf(hi) << 16); }
__device__ __forceinline__ float bf2f(unsigned short b) { return __uint_as_float(((unsigned)b) << 16); }
__device__ __forceinline__ float bflo(unsigned w) { return __uint_as_float(w << 16); }
__device__ __forceinline__ float bfhi(unsigned w) { return __uint_as_float(w & 0xffff0000u); }

struct Args { const float* in[20]; float* out; unsigned char* ws; int ph_lo, ph_hi; };
}
namespace pg8 {
#define PG8_LAS __attribute__((address_space(3)))
typedef unsigned short bf16_t;
typedef short bf16x8 __attribute__((ext_vector_type(8)));
typedef float f32x4 __attribute__((ext_vector_type(4)));
typedef unsigned u32x4 __attribute__((ext_vector_type(4)));
constexpr int BM = 256, BK = 64, HALF = 128, HTB = HALF * BK * 2  , STAGE_BYTES = 8 * HTB, NXCD = 8, WGM = 8;

__host__ __device__ __forceinline__ int lds_byte(int r, int c) { const int st = (r >> 4) * 2 + (c >> 5), rr = r & 15, cc = c & 31, ob = rr * 64 + cc * 2; return st * 1024 + (ob ^ (((ob >> 9) & 1) << 5)); }
__host__ __device__ __forceinline__ void stage_rc(int b, int& R, int& C) { const int st = b / 1024, sb = b % 1024, swz = sb ^ (((sb >> 9) & 1) << 5); R = (st >> 1) * 16 + swz / 64; C = (st & 1) * 32 + (swz % 64) / 2; }
__host__ __device__ __forceinline__ int perm32(int rho) { const int n = rho >> 4, i = rho & 15; return 8 * (i >> 2) + 4 * n + (i & 3); }

struct Unit { int pm, pn; };
struct Gemm { const bf16_t* A; const bf16_t* Bt; int M, N, K; };

struct StaticOrder {
    int nM, nN, nwg, G, c;
    __host__ __device__ void init(int M, int N, int G_, int c_) { nM = M / BM; nN = N / BM; nwg = nM * nN; G = G_; c = c_; }
    __host__ __device__ bool next(int i, Unit& u) const {
        const long L = (long)i * G + c; if (L >= nwg) return false;
        int wgid = (int)L; { const int q = nwg / NXCD, r = nwg % NXCD, xcd = wgid % NXCD, off = wgid / NXCD; wgid = (xcd < r ? xcd * (q + 1) : r * (q + 1) + (xcd - r) * q) + off; }
        const int nig = WGM * nN, gid = wgid / nig, fm = gid * WGM, gsz = (nM - fm) < WGM ? (nM - fm) : WGM;
        u.pm = fm + ((wgid % nig) % gsz); u.pn = (wgid % nig) / gsz; return true;
    }
    __device__ __forceinline__ void a_ready(const Unit&) const {}
    __device__ __forceinline__ void done(const Unit&) const {}
};

__device__ __forceinline__ unsigned cvt_pk_bf16(float lo, float hi) { unsigned r; asm volatile("v_cvt_pk_bf16_f32 %0, %1, %2" : "=v"(r) : "v"(lo), "v"(hi)); return r; }
__device__ __forceinline__ float fsig(float x) { return __builtin_amdgcn_rcpf(1.0f + __expf(-x)); }

struct EpiProj {
    static constexpr bool PERM = true, AFTER_DRAIN = false;
    bf16_t* P; int pw;
    __device__ __forceinline__ void operator()(const f32x4 (&acc)[2][2][4][2], const Unit& u, int wr, int wc, int fr, int fq) const {
        const int row0 = u.pm * BM + wr * 64 + fr;
        if (u.pn < 16) {
            const int col0 = u.pn * BM + wc * 32 + 8 * fq;
#pragma unroll
            for (int ai = 0; ai < 2; ++ai)
#pragma unroll
                for (int m = 0; m < 4; ++m) { bf16_t* rowp = P + (size_t)(row0 + ai * HALF + m * 16) * pw + col0;
#pragma unroll
                    for (int bj = 0; bj < 2; ++bj) { const f32x4 v0 = acc[ai][bj][m][0], v1 = acc[ai][bj][m][1];
                        u32x4 w; w.x = cvt_pk_bf16(v0[0], v0[1]); w.y = cvt_pk_bf16(v0[2], v0[3]); w.z = cvt_pk_bf16(v1[0], v1[1]); w.w = cvt_pk_bf16(v1[2], v1[3]);
                        *(u32x4*)(rowp + bj * HALF) = w; } }
        } else {
            const int col0 = 4096 + (u.pn - 16) * 128 + wc * 32 + 8 * fq;
#pragma unroll
            for (int ai = 0; ai < 2; ++ai)
#pragma unroll
                for (int m = 0; m < 4; ++m) { bf16_t* rowp = P + (size_t)(row0 + ai * HALF + m * 16) * pw + col0;
                    float o[8];
#pragma unroll
                    for (int n = 0; n < 2; ++n)
#pragma unroll
                        for (int j = 0; j < 4; ++j) { const float g = acc[ai][0][m][n][j], s = acc[ai][1][m][n][j]; o[n * 4 + j] = g * fsig(g) * fsig(s); }
                    u32x4 w; w.x = cvt_pk_bf16(o[0], o[1]); w.y = cvt_pk_bf16(o[2], o[3]); w.z = cvt_pk_bf16(o[4], o[5]); w.w = cvt_pk_bf16(o[6], o[7]);
                    *(u32x4*)rowp = w; }
        }
    }
};
struct EpiH {
    static constexpr bool PERM = false, AFTER_DRAIN = false;
    const float* x; const float* mod; float* h;
    __device__ __forceinline__ void operator()(const f32x4 (&acc)[2][2][4][2], const Unit& u, int wr, int wc, int fr, int fq) const {
        const int row0 = u.pm * BM + wr * 64 + fr, col0 = u.pn * BM + wc * 32 + 4 * fq;
        const int b = (u.pm * BM) / 2048;
        f32x4 gv[2][2];
#pragma unroll
        for (int bj = 0; bj < 2; ++bj)
#pragma unroll
            for (int n = 0; n < 2; ++n) gv[bj][n] = *(const f32x4*)(mod + (size_t)b * 6144 + 2048 + col0 + bj * HALF + n * 16);
#pragma unroll
        for (int ai = 0; ai < 2; ++ai)
#pragma unroll
            for (int m = 0; m < 4; ++m) { const size_t off = (size_t)(row0 + ai * HALF + m * 16) * 1024 + col0;
#pragma unroll
                for (int bj = 0; bj < 2; ++bj)
#pragma unroll
                    for (int n = 0; n < 2; ++n) { const f32x4 xv = *(const f32x4*)(x + off + bj * HALF + n * 16); *(f32x4*)(h + off + bj * HALF + n * 16) = xv + gv[bj][n] * acc[ai][bj][m][n]; }
                asm volatile("" ::: "memory"); }
    }
};
struct EpiAct {
    static constexpr bool PERM = true, AFTER_DRAIN = false;
    bf16_t* act;
    __device__ __forceinline__ void operator()(const f32x4 (&acc)[2][2][4][2], const Unit& u, int wr, int wc, int fr, int fq) const {
        const int row0 = u.pm * BM + wr * 64 + fr, col0 = (u.pn & 3) * 128 + wc * 32 + 8 * fq;
#pragma unroll
        for (int ai = 0; ai < 2; ++ai)
#pragma unroll
            for (int m = 0; m < 4; ++m) { bf16_t* rowp = act + (size_t)(row0 + ai * HALF + m * 16) * 512 + col0;
                float o[8];
#pragma unroll
                for (int n = 0; n < 2; ++n)
#pragma unroll
                    for (int j = 0; j < 4; ++j) { const float g = acc[ai][0][m][n][j], up = acc[ai][1][m][n][j]; o[n * 4 + j] = g * fsig(g) * up; }
                u32x4 w; w.x = cvt_pk_bf16(o[0], o[1]); w.y = cvt_pk_bf16(o[2], o[3]); w.z = cvt_pk_bf16(o[4], o[5]); w.w = cvt_pk_bf16(o[6], o[7]);
                *(u32x4*)rowp = w; }
    }
};
struct EpiY {
    static constexpr bool PERM = true, AFTER_DRAIN = false;
    bf16_t* y;
    __device__ __forceinline__ void operator()(const f32x4 (&acc)[2][2][4][2], const Unit& u, int wr, int wc, int fr, int fq) const {
        const int row0 = u.pm * BM + wr * 64 + fr, col0 = (u.pn & 3) * BM + wc * 32 + 8 * fq;
#pragma unroll
        for (int ai = 0; ai < 2; ++ai)
#pragma unroll
            for (int m = 0; m < 4; ++m) { bf16_t* rowp = y + (size_t)(row0 + ai * HALF + m * 16) * 1024 + col0;
#pragma unroll
                for (int bj = 0; bj < 2; ++bj) { const f32x4 v0 = acc[ai][bj][m][0], v1 = acc[ai][bj][m][1];
                    u32x4 w; w.x = cvt_pk_bf16(v0[0], v0[1]); w.y = cvt_pk_bf16(v0[2], v0[3]); w.z = cvt_pk_bf16(v1[0], v1[1]); w.w = cvt_pk_bf16(v1[2], v1[3]);
                    *(u32x4*)(rowp + bj * HALF) = w; } }
    }
};
struct MoeOrder {
    const int* tile_expert; int nwg, G, c;
    __device__ void init(const int* meta, const int* te, int G_, int c_) { tile_expert = te; nwg = meta[33] * 4; G = G_; c = c_; }
    __device__ bool next(int i, Unit& u) const {
        const long L = (long)i * G + c; if (L >= nwg) return false;
        int wgid = (int)L; { const int q = nwg / NXCD, r = nwg % NXCD, xcd = wgid % NXCD, off = wgid / NXCD; wgid = (xcd < r ? xcd * (q + 1) : r * (q + 1) + (xcd - r) * q) + off; }
        u.pm = wgid >> 2; u.pn = tile_expert[u.pm] * 4 + (wgid & 3); return true;
    }
    __device__ __forceinline__ void a_ready(const Unit&) const {}
    __device__ __forceinline__ void done(const Unit&) const {}
};
template <class Epi, class Sched, bool ALIGN_EPI = false, bool SP2 = false>
__device__ __forceinline__ void gemm_phase(PG8_LAS unsigned char* lds, const Gemm g, const Sched& S, const Epi& E) {
    const int tid = threadIdx.x, wid = __builtin_amdgcn_readfirstlane(tid >> 6), lane = tid & 63, wr = wid >> 2, wc = wid & 3, fr = lane & 15, fq = lane >> 4;
    const int K = g.K, nt = K / BK;
    unsigned voffA[2], voffB[2];
#pragma unroll
    for (int i = 0; i < 2; ++i) { int R, C; stage_rc(tid * 16 + i * 8192, R, C); const int Rb = Epi::PERM ? ((R & ~31) + perm32(R & 31)) : R;
        voffA[i] = (unsigned)(R * K + C) * 2u; voffB[i] = (unsigned)(Rb * K + C) * 2u; }
    const size_t kstep = (size_t)(BK * 2);
    const size_t hstep = (size_t)HALF * K * 2;
    const size_t tstep = 2 * hstep;
    const unsigned ldsw = (unsigned)wid * 1024u;
    const int aoff = lds_byte(wr * 64 + fr, fq * 8), boff = lds_byte(wc * 32 + fr, fq * 8);
#define PG8_SA(b, h) (((b) * 2 + (h)) * HTB)
#define PG8_SB(b, h) ((4 + (b) * 2 + (h)) * HTB)
#define PG8_STAGE(bufoff, gbase, voff) do { _Pragma("unroll") for (int _i = 0; _i < 2; ++_i) \
        __builtin_amdgcn_global_load_lds((const unsigned*)((const char*)(gbase) + (voff)[_i]), (PG8_LAS unsigned*)(lds + (bufoff) + ldsw + _i * 8192), 16, 0, 0); } while (0)
#define PG8_LDA(dst, b, h) do { _Pragma("unroll") for (int m = 0; m < 4; ++m) _Pragma("unroll") for (int k = 0; k < 2; ++k) dst[m][k] = *(const PG8_LAS bf16x8*)(lds + PG8_SA(b, h) + aoff + m * 2048 + k * 1024); } while (0)
#define PG8_LDB(dst, b, h) do { _Pragma("unroll") for (int n = 0; n < 2; ++n) _Pragma("unroll") for (int k = 0; k < 2; ++k) dst[n][k] = *(const PG8_LAS bf16x8*)(lds + PG8_SB(b, h) + boff + n * 2048 + k * 1024); } while (0)
#define PG8_MMA(ai, bj, At, Bt) do { __builtin_amdgcn_s_setprio(1); _Pragma("unroll") for (int m = 0; m < 4; ++m) _Pragma("unroll") for (int n = 0; n < 2; ++n) _Pragma("unroll") for (int k = 0; k < 2; ++k) \
        acc[ai][bj][m][n] = __builtin_amdgcn_mfma_f32_16x16x32_bf16(Bt[n][k], At[m][k], acc[ai][bj][m][n], 0, 0, 0); __builtin_amdgcn_s_setprio(0); } while (0)
#define PG8_WAIT_V(n) asm volatile("s_waitcnt vmcnt(" #n ")" ::: "memory")
#define PG8_WAIT_L(n) asm volatile("s_waitcnt lgkmcnt(" #n ")" ::: "memory")
#define PG8_BAR __builtin_amdgcn_s_barrier()
#define PG8_SCHED __builtin_amdgcn_sched_barrier(0)
    Unit cur, nxt; int ui = 0;
    if (!S.next(0, cur)) return;
    f32x4 acc[2][2][4][2];
#pragma unroll
    for (int a = 0; a < 2; ++a)
#pragma unroll
        for (int b = 0; b < 2; ++b)
#pragma unroll
            for (int m = 0; m < 4; ++m)
#pragma unroll
                for (int n = 0; n < 2; ++n) acc[a][b][m][n] = (f32x4){0.f, 0.f, 0.f, 0.f};
    bf16x8 At[4][2], B0[2][2], B1[2][2];
    const char* cA = (const char*)g.A + (size_t)cur.pm * tstep; const char* cB = (const char*)g.Bt + (size_t)cur.pn * tstep;
    S.a_ready(cur);
    if constexpr (SP2) {
        PG8_STAGE(PG8_SB(0, 0), cB, voffB); PG8_STAGE(PG8_SB(0, 1), cB + hstep, voffB); PG8_STAGE(PG8_SA(0, 0), cA, voffA); PG8_STAGE(PG8_SA(0, 1), cA + hstep, voffA);
        if (wr == 1) PG8_BAR;
        PG8_WAIT_V(2); PG8_BAR;
        PG8_STAGE(PG8_SB(1, 0), cB + kstep, voffB); PG8_STAGE(PG8_SA(1, 0), cA + kstep, voffA); PG8_STAGE(PG8_SB(1, 1), cB + hstep + kstep, voffB);
        PG8_WAIT_V(6); PG8_BAR;
    } else {
        PG8_STAGE(PG8_SB(0, 0), cB, voffB); PG8_STAGE(PG8_SA(0, 0), cA, voffA); PG8_STAGE(PG8_SB(0, 1), cB + hstep, voffB); PG8_STAGE(PG8_SA(0, 1), cA + hstep, voffA);
        if (wr == 1) PG8_BAR;
        PG8_WAIT_V(4); PG8_BAR;
        PG8_STAGE(PG8_SB(1, 0), cB + kstep, voffB); PG8_STAGE(PG8_SA(1, 0), cA + kstep, voffA); PG8_STAGE(PG8_SB(1, 1), cB + hstep + kstep, voffB);
        PG8_WAIT_V(6); PG8_BAR;
    }
    for (;;) {
        const bool has_next = S.next(ui + 1, nxt);
        const char* nA = has_next ? (const char*)g.A + (size_t)nxt.pm * tstep : cA; const char* nB = has_next ? (const char*)g.Bt + (size_t)nxt.pn * tstep : cB;
        for (int t = 0; t < nt; t += 2) {
            const bool last = (t == nt - 2);
            const char* a1 = cA + (size_t)(t + 1) * kstep;
            const char* a2 = last ? nA : cA + (size_t)(t + 2) * kstep; const char* b2 = last ? nB : cB + (size_t)(t + 2) * kstep;
            const char* a3 = a2 + kstep; const char* b3 = b2 + kstep;
            if (last && has_next) S.a_ready(nxt);
            if constexpr (SP2) {
            PG8_LDB(B0, 0, 0); PG8_LDB(B1, 0, 1); PG8_SCHED; PG8_LDA(At, 0, 0); PG8_STAGE(PG8_SA(1, 1), a1 + hstep, voffA);
            PG8_WAIT_V(8); PG8_WAIT_L(0); PG8_BAR; PG8_MMA(0, 0, At, B0); PG8_MMA(0, 1, At, B1); PG8_BAR; PG8_SCHED;
            PG8_LDA(At, 0, 1); PG8_STAGE(PG8_SB(0, 0), b2, voffB); PG8_STAGE(PG8_SB(0, 1), b2 + hstep, voffB); PG8_STAGE(PG8_SA(0, 0), a2, voffA);
            PG8_WAIT_V(8); PG8_WAIT_L(0); PG8_BAR; PG8_MMA(1, 0, At, B0); PG8_MMA(1, 1, At, B1); PG8_BAR; PG8_SCHED;
            PG8_LDB(B0, 1, 0); PG8_LDB(B1, 1, 1); PG8_SCHED; PG8_LDA(At, 1, 0); PG8_STAGE(PG8_SA(0, 1), a2 + hstep, voffA);
            PG8_WAIT_V(8); PG8_WAIT_L(0); PG8_BAR; PG8_MMA(0, 0, At, B0); PG8_MMA(0, 1, At, B1); PG8_BAR; PG8_SCHED;
            PG8_LDA(At, 1, 1); PG8_STAGE(PG8_SB(1, 0), b3, voffB); PG8_STAGE(PG8_SB(1, 1), b3 + hstep, voffB); PG8_STAGE(PG8_SA(1, 0), a3, voffA);
            PG8_WAIT_V(8); PG8_WAIT_L(0); PG8_BAR; PG8_MMA(1, 0, At, B0); PG8_MMA(1, 1, At, B1); PG8_BAR; PG8_SCHED;
            } else {
            PG8_LDB(B0, 0, 0); PG8_SCHED; PG8_LDA(At, 0, 0); PG8_STAGE(PG8_SA(1, 1), a1 + hstep, voffA);
            PG8_WAIT_L(8); PG8_BAR; PG8_WAIT_L(0); PG8_MMA(0, 0, At, B0); PG8_BAR; PG8_SCHED;
            PG8_LDB(B1, 0, 1); PG8_STAGE(PG8_SB(0, 0), b2, voffB);
            PG8_BAR; PG8_WAIT_L(0); PG8_MMA(0, 1, At, B1); PG8_BAR;
            PG8_LDA(At, 0, 1); PG8_STAGE(PG8_SA(0, 0), a2, voffA);
            PG8_BAR; PG8_WAIT_L(0); PG8_MMA(1, 0, At, B0); PG8_BAR; PG8_SCHED;
            PG8_STAGE(PG8_SB(0, 1), b2 + hstep, voffB);
            PG8_WAIT_V(6); PG8_BAR; PG8_MMA(1, 1, At, B1); PG8_BAR;
            PG8_LDB(B0, 1, 0); PG8_SCHED; PG8_LDA(At, 1, 0); PG8_STAGE(PG8_SA(0, 1), a2 + hstep, voffA);
            PG8_WAIT_L(8); PG8_BAR; PG8_WAIT_L(0); PG8_MMA(0, 0, At, B0); PG8_BAR; PG8_SCHED;
            PG8_LDB(B1, 1, 1); PG8_STAGE(PG8_SB(1, 0), b3, voffB);
            PG8_BAR; PG8_WAIT_L(0); PG8_MMA(0, 1, At, B1); PG8_BAR;
            PG8_LDA(At, 1, 1); PG8_STAGE(PG8_SA(1, 0), a3, voffA);
            PG8_BAR; PG8_WAIT_L(0); PG8_MMA(1, 0, At, B0); PG8_BAR; PG8_SCHED;
            PG8_STAGE(PG8_SB(1, 1), b3 + hstep, voffB);
            PG8_WAIT_V(6); PG8_BAR; PG8_MMA(1, 1, At, B1); PG8_BAR;
            }
        }
        if constexpr (ALIGN_EPI) { if (wr == 0) PG8_BAR; }
        if constexpr (!Epi::AFTER_DRAIN) { E(acc, cur, wr, wc, fr, fq); S.done(cur); }
        if (!has_next) break;
#pragma unroll
        for (int a = 0; a < 2; ++a)
#pragma unroll
            for (int b = 0; b < 2; ++b)
#pragma unroll
                for (int m = 0; m < 4; ++m)
#pragma unroll
                    for (int n = 0; n < 2; ++n) acc[a][b][m][n] = (f32x4){0.f, 0.f, 0.f, 0.f};
        cur = nxt; cA = nA; cB = nB; ++ui;
        if constexpr (ALIGN_EPI) { if (wr == 1) PG8_BAR; }
    }
    PG8_WAIT_V(0);
    if constexpr (!ALIGN_EPI) { if (wr == 0) PG8_BAR; }
    PG8_BAR;
    if constexpr (Epi::AFTER_DRAIN) { E.fused(acc, cur, wr, wc, fr, fq, lds, wid, lane); S.done(cur); }
#undef PG8_SA
#undef PG8_SB
#undef PG8_STAGE
#undef PG8_LDA
#undef PG8_LDB
#undef PG8_MMA
#undef PG8_WAIT_V
#undef PG8_WAIT_L
#undef PG8_BAR
#undef PG8_SCHED
}
}
namespace {
__device__ __forceinline__ int tidx() { int t = threadIdx.x; asm volatile("" : "+v"(t)); return t; }
__device__ __forceinline__ void phase_mod(const Args& a, LAS unsigned char* lds) {
    LAS float* sc = (LAS float*)lds;
    LAS float* part = (LAS float*)(lds + 65536);
    const float* c = a.in[1]; const float* mw = a.in[2]; const float* mb = a.in[3];
    float* mod = (float*)(a.ws + WS_MOD);
    const int tid = tidx();
    for (int i = tid; i < 16 * 1024; i += 512) sc[i] = silu_f(c[i]);
    __syncthreads();
    const int kg = tid >> 5, cj = tid & 31;
    for (int cgp = blockIdx.x; cgp < 256; cgp += gridDim.x) {
        const int j0 = cgp * 24;
        float acc[16];
#pragma unroll
        for (int b = 0; b < 16; ++b) acc[b] = 0.f;
        if (cj < 24) {
            for (int kk = 0; kk < 64; kk += 4) {
                const int k = kg * 64 + kk;
                const float w0 = mw[(size_t)(k + 0) * 6144 + j0 + cj], w1 = mw[(size_t)(k + 1) * 6144 + j0 + cj], w2 = mw[(size_t)(k + 2) * 6144 + j0 + cj], w3 = mw[(size_t)(k + 3) * 6144 + j0 + cj];
#pragma unroll
                for (int b = 0; b < 16; ++b) { const f4 s = *(const LAS f4*)(sc + b * 1024 + k); acc[b] += s.x * w0 + s.y * w1 + s.z * w2 + s.w * w3; }
            }
        }
#pragma unroll
        for (int b = 0; b < 16; ++b) part[(kg * 16 + b) * 32 + cj] = acc[b];
        __syncthreads();
        if (tid < 384) { const int b = tid / 24, cc = tid % 24; float s = mb[j0 + cc];
            for (int g2 = 0; g2 < 16; ++g2) s += part[(g2 * 16 + b) * 32 + cc];
            mod[b * 6144 + j0 + cc] = s; }
        __syncthreads();
    }
}

__device__ __forceinline__ void phase_norm1(const Args& a, LAS unsigned char* lds) {
    LAS f4* wgA = (LAS f4*)lds;
    LAS f4* wgB = (LAS f4*)(lds + 16384);
    const float* x = a.in[0]; const float* nw = a.in[4]; const float* w_in = a.in[5]; const float* a_log = a.in[7]; const float* dt_bias = a.in[8];
    const float* mod = (const float*)(a.ws + WS_MOD);
    bf16* xm = (bf16*)((unsigned char*)a.out + DO_XM);
    float* Gd = (float*)(a.ws + WS_G); float* Bd = (float*)(a.ws + WS_BETA);
    const int tid = tidx(), lane = tid & 63, wave = tid >> 6;
    for (int k = tid; k < 1024; k += 512) { const int idx = (4 * (k >> 8) + (k & 3)) * 64 + ((k & 255) >> 2);
        wgA[idx] = *(const f4*)(w_in + (size_t)k * DIN + C_GA); wgB[idx] = *(const f4*)(w_in + (size_t)k * DIN + C_GB); }
    __syncthreads();
    const int gw = blockIdx.x * 8 + wave, NGW = gridDim.x * 8;
    for (int grp = gw; grp < T / 2; grp += NGW) {
        const int t0 = grp * 2, b = t0 / SEQ;
        float4 gmul[4], gadd[4];
#pragma unroll
        for (int j = 0; j < 4; ++j) { const int k = 4 * lane + 256 * j;
            const float4 wv = *(const float4*)(nw + k), sc = *(const float4*)(mod + (size_t)b * 6144 + 1024 + k), sh = *(const float4*)(mod + (size_t)b * 6144 + k);
            gmul[j] = make_float4(wv.x * (1.f + sc.x), wv.y * (1.f + sc.y), wv.z * (1.f + sc.z), wv.w * (1.f + sc.w)); gadd[j] = sh; }
        float4 xv[2][4];
#pragma unroll
        for (int r = 0; r < 2; ++r) {
            float ss = 0.f;
#pragma unroll
            for (int j = 0; j < 4; ++j) { xv[r][j] = *(const float4*)(x + (size_t)(t0 + r) * D + 4 * lane + 256 * j); ss += xv[r][j].x * xv[r][j].x + xv[r][j].y * xv[r][j].y + xv[r][j].z * xv[r][j].z + xv[r][j].w * xv[r][j].w; }
            ss = wave_sum(ss);
            const float rstd = rsqrtf(ss * (1.0f / D) + 1e-6f);
#pragma unroll
            for (int j = 0; j < 4; ++j) { float4 v = xv[r][j];
                v.x = v.x * rstd * gmul[j].x + gadd[j].x; v.y = v.y * rstd * gmul[j].y + gadd[j].y; v.z = v.z * rstd * gmul[j].z + gadd[j].z; v.w = v.w * rstd * gmul[j].w + gadd[j].w;
                xv[r][j] = v;
                v2u w; w.x = pk2(v.x, v.y); w.y = pk2(v.z, v.w);
                *(v2u*)(xm + (size_t)(t0 + r) * D + 4 * lane + 256 * j) = w; }
        }
        float acc[2][8];
#pragma unroll
        for (int r = 0; r < 2; ++r)
#pragma unroll
            for (int q = 0; q < 8; ++q) acc[r][q] = 0.f;
#pragma unroll
        for (int j = 0; j < 4; ++j) {
#pragma unroll
            for (int jj = 0; jj < 4; ++jj) {
                const f4 wa = wgA[(4 * j + jj) * 64 + lane], wb = wgB[(4 * j + jj) * 64 + lane];
#pragma unroll
                for (int r = 0; r < 2; ++r) { const float xe = (jj == 0) ? xv[r][j].x : (jj == 1) ? xv[r][j].y : (jj == 2) ? xv[r][j].z : xv[r][j].w;
                    acc[r][0] += xe * wa.x; acc[r][1] += xe * wa.y; acc[r][2] += xe * wa.z; acc[r][3] += xe * wa.w;
                    acc[r][4] += xe * wb.x; acc[r][5] += xe * wb.y; acc[r][6] += xe * wb.z; acc[r][7] += xe * wb.w; }
            }
            asm volatile("" ::: "memory");
        }
        float mine = 0.f;
#pragma unroll
        for (int r = 0; r < 2; ++r)
#pragma unroll
            for (int q = 0; q < 8; ++q) { const float s = wave_sum(acc[r][q]); if (lane == r * 8 + q) mine = s; }
        if (lane < 16) { const int r = lane >> 3, q = lane & 7, t = t0 + r;
            if (q < 4) { const float z = mine + dt_bias[q]; const float sp = (z > 20.f) ? z : log1pf(expf(z)); Gd[t * 4 + q] = -expf(a_log[q]) * sp; }
            else Bd[t * 4 + (q - 4)] = sigmoid_f(mine); }
    }
}

__device__ __forceinline__ void conv_job(const float* src, int ldsrc, int srccol, bf16* dst, int ldd, int n0, int k0, LAS float* tile) {
    const int tid = tidx();
#pragma unroll
    for (int i = 0; i < 2; ++i) { const int kk = (tid >> 4) + 32 * i, c4 = (tid & 15) * 4;
        const float4 v = *(const float4*)(src + (size_t)(k0 + kk) * ldsrc + srccol + c4);
        tile[kk * 65 + c4 + 0] = v.x; tile[kk * 65 + c4 + 1] = v.y; tile[kk * 65 + c4 + 2] = v.z; tile[kk * 65 + c4 + 3] = v.w; }
    __syncthreads();
    { const int n = tid >> 3, kc = (tid & 7) * 8;
        v4u w; w.x = pk2(tile[(kc + 0) * 65 + n], tile[(kc + 1) * 65 + n]); w.y = pk2(tile[(kc + 2) * 65 + n], tile[(kc + 3) * 65 + n]);
        w.z = pk2(tile[(kc + 4) * 65 + n], tile[(kc + 5) * 65 + n]); w.w = pk2(tile[(kc + 6) * 65 + n], tile[(kc + 7) * 65 + n]);
        *(v4u*)(dst + (size_t)(n0 + n) * ldd + k0 + kc) = w; }
    __syncthreads();
}
__device__ __forceinline__ int win_srccol(int n0) {
    if (n0 < 512) return C_RQ + n0;
    if (n0 < 1024) return C_RK + (n0 - 512);
    if (n0 < 2048) return C_RV + (n0 - 1024);
    if (n0 < 4096) return C_GQ + (n0 - 2048);
    const int j = (n0 - 4096) >> 8, r = (n0 - 4096) & 255, half = r >> 7, cc = r & 127;
    if (j < 8) return (half ? C_GTA : C_RG) + 128 * j + cc;
    return (half ? C_GTB : C_GZ) + 128 * (j - 8) + cc;
}
__device__ __forceinline__ void phase_convert_in(const Args& a, LAS unsigned char* lds) {
    LAS float* tile = (LAS float*)(lds + 32768);
    bf16* wtin = (bf16*)((unsigned char*)a.out + DO_WTIN); bf16* wtout = (bf16*)(a.ws + WS_WTOUT);
    for (int job = blockIdx.x; job < 2048 + 256; job += gridDim.x) {
        if (job < 2048) { const int nt = job >> 4, kt = job & 15; conv_job(a.in[5], DIN, win_srccol(nt * 64), wtin, 1024, nt * 64, kt * 64, tile); }
        else { const int jj = job - 2048, nt = jj >> 4, kt = jj & 15; conv_job(a.in[10], 1024, nt * 64, wtout, 1024, nt * 64, kt * 64, tile); }
    }
    float2* rope = (float2*)(a.ws + WS_ROPE);
    for (int i = blockIdx.x * 512 + tidx(); i < SEQ * 64; i += gridDim.x * 512) {
        const int t = i >> 6, fi = i & 63;
        const double inv = exp(-((double)fi / 64.0) * 9.210340371976184), ang = (double)t * inv;
        rope[i] = make_float2((float)cos(ang), (float)sin(ang));
    }
}
__device__ __forceinline__ void phase_inproj(const Args& a, LAS unsigned char* lds) {
    pg8::Gemm g{(const bf16*)((unsigned char*)a.out + DO_XM), (const bf16*)((unsigned char*)a.out + DO_WTIN), T, 8192, 1024};
    pg8::StaticOrder S; S.init(T, 8192, (int)gridDim.x, (int)blockIdx.x);
    pg8::EpiProj E{(bf16*)(a.ws + WS_PROJ), PW};
    pg8::gemm_phase<pg8::EpiProj, pg8::StaticOrder, true, true>(lds, g, S, E);
}


__device__ __forceinline__ void phase_outproj(const Args& a, LAS unsigned char* lds) {
    pg8::Gemm g{(const bf16*)(a.ws + WS_MERGED), (const bf16*)(a.ws + WS_WTOUT), T, 1024, 1024};
    pg8::StaticOrder S; S.init(T, 1024, (int)gridDim.x, (int)blockIdx.x);
    pg8::EpiH E{a.in[0], (const float*)(a.ws + WS_MOD), a.out};
    pg8::gemm_phase<pg8::EpiH, pg8::StaticOrder, true, true>(lds, g, S, E);
}

__device__ __forceinline__ void phase_route(const Args& a, LAS unsigned char* lds) {
    LAS f4* wr = (LAS f4*)lds;
    LAS int* hist = (LAS int*)(lds + 5 * 16384);
    LAS float* lgl = (LAS float*)(lds + 5 * 16384 + 256);
    const float* h = a.out; const float* nw = a.in[11]; const float* w_group = a.in[12]; const float* b_group = a.in[13]; const float* w_router = a.in[14]; const float* b_router = a.in[15];
    const float* mod = (const float*)(a.ws + WS_MOD);
    bf16* xf = (bf16*)(a.ws + WS_XF);
    int* tok_e = (int*)(a.ws + WS_TOKE); float* tok_w = (float*)(a.ws + WS_TOKW);
    const int tid = tidx(), lane = tid & 63, wave = tid >> 6;
    for (int k = tid; k < 1024; k += 512) { const int idx = (4 * (k >> 8) + (k & 3)) * 64 + ((k & 255) >> 2);
        wr[idx] = *(const f4*)(w_group + (size_t)k * 4);
#pragma unroll
        for (int q = 0; q < 4; ++q) wr[(q + 1) * 1024 + idx] = *(const f4*)(w_router + (size_t)k * 16 + 4 * q); }
    if (tid < 16) hist[tid] = 0;
    __syncthreads();
    const int TPB = T / (int)gridDim.x, tb0 = blockIdx.x * TPB;
#pragma unroll 1
    for (int pr = wave; pr < TPB / 2; pr += 8) {
        const int t0 = tb0 + pr * 2, b = t0 / SEQ;
        float4 gmul[4], gadd[4];
#pragma unroll
        for (int j = 0; j < 4; ++j) { const int k = 4 * lane + 256 * j;
            const float4 wv = *(const float4*)(nw + k), sc = *(const float4*)(mod + (size_t)b * 6144 + 4096 + k), sh = *(const float4*)(mod + (size_t)b * 6144 + 3072 + k);
            gmul[j] = make_float4(wv.x * (1.f + sc.x), wv.y * (1.f + sc.y), wv.z * (1.f + sc.z), wv.w * (1.f + sc.w)); gadd[j] = sh; }
        float4 xv[2][4];
#pragma unroll
        for (int r = 0; r < 2; ++r) {
            float ss = 0.f;
#pragma unroll
            for (int j = 0; j < 4; ++j) { xv[r][j] = *(const float4*)(h + (size_t)(t0 + r) * D + 4 * lane + 256 * j); ss += xv[r][j].x * xv[r][j].x + xv[r][j].y * xv[r][j].y + xv[r][j].z * xv[r][j].z + xv[r][j].w * xv[r][j].w; }
            ss = wave_sum(ss);
            const float rstd = rsqrtf(ss * (1.0f / D) + 1e-6f);
#pragma unroll
            for (int j = 0; j < 4; ++j) { float4 v = xv[r][j];
                v.x = v.x * rstd * gmul[j].x + gadd[j].x; v.y = v.y * rstd * gmul[j].y + gadd[j].y; v.z = v.z * rstd * gmul[j].z + gadd[j].z; v.w = v.w * rstd * gmul[j].w + gadd[j].w;
                xv[r][j] = v;
                v2u w; w.x = pk2(v.x, v.y); w.y = pk2(v.z, v.w);
                *(v2u*)(xf + (size_t)(t0 + r) * D + 4 * lane + 256 * j) = w; }
        }
        float acc[2][20];
#pragma unroll
        for (int r = 0; r < 2; ++r)
#pragma unroll
            for (int q = 0; q < 20; ++q) acc[r][q] = 0.f;
#pragma unroll
        for (int j = 0; j < 4; ++j) {
#pragma unroll
            for (int jj = 0; jj < 4; ++jj) {
                const int idx = (4 * j + jj) * 64 + lane;
#pragma unroll
                for (int q = 0; q < 5; ++q) { const f4 w = wr[q * 1024 + idx];
#pragma unroll
                    for (int r = 0; r < 2; ++r) { const float xe = (jj == 0) ? xv[r][j].x : (jj == 1) ? xv[r][j].y : (jj == 2) ? xv[r][j].z : xv[r][j].w;
                        acc[r][4 * q + 0] += xe * w.x; acc[r][4 * q + 1] += xe * w.y; acc[r][4 * q + 2] += xe * w.z; acc[r][4 * q + 3] += xe * w.w; } }
                asm volatile("" ::: "memory");
            }
        }
        float mine0 = 0.f, mine1 = 0.f;
#pragma unroll
        for (int q = 0; q < 20; ++q) { const float s0 = wave_sum(acc[0][q]), s1 = wave_sum(acc[1][q]); if (lane == q) { mine0 = s0; mine1 = s1; } }
        if (lane < 20) { lgl[(pr * 2 + 0) * 20 + lane] = mine0; lgl[(pr * 2 + 1) * 20 + lane] = mine1; }
    }
    __syncthreads();
    if (tid < TPB) {
        const int t = tb0 + tid;
        float lg[20];
#pragma unroll
        for (int q = 0; q < 20; ++q) lg[q] = lgl[tid * 20 + q];
        float gl[4], gmax = -1e30f; int gi = 0;
#pragma unroll
        for (int j = 0; j < 4; ++j) { gl[j] = lg[j] + b_group[j]; if (gl[j] > gmax) { gmax = gl[j]; gi = j; } }
        float gs = 0.f;
#pragma unroll
        for (int j = 0; j < 4; ++j) gs += expf(gl[j] - gmax);
        const float g_top = 1.0f / gs;
        float el[4], emax = -1e30f;
#pragma unroll
        for (int j = 0; j < 4; ++j) { const float raw = (gi == 0) ? lg[4 + j] : (gi == 1) ? lg[8 + j] : (gi == 2) ? lg[12 + j] : lg[16 + j]; el[j] = raw + b_router[gi * 4 + j]; emax = fmaxf(emax, el[j]); }
        float ep[4], es = 0.f;
#pragma unroll
        for (int j = 0; j < 4; ++j) { ep[j] = expf(el[j] - emax); es += ep[j]; }
#pragma unroll
        for (int j = 0; j < 4; ++j) ep[j] /= es;
        int i1 = 0; float p1 = ep[0];
#pragma unroll
        for (int j = 1; j < 4; ++j) if (ep[j] > p1) { p1 = ep[j]; i1 = j; }
        int i2 = -1; float p2 = -1.f;
#pragma unroll
        for (int j = 0; j < 4; ++j) if (j != i1 && ep[j] > p2) { p2 = ep[j]; i2 = j; }
        const float den = p1 + p2;
        tok_e[t * 2 + 0] = gi * 4 + i1; tok_e[t * 2 + 1] = gi * 4 + i2;
        tok_w[t * 2 + 0] = g_top * (p1 / den); tok_w[t * 2 + 1] = g_top * (p2 / den);
        __hip_atomic_fetch_add(&hist[gi * 4 + i1], 1, __ATOMIC_RELAXED, __HIP_MEMORY_SCOPE_WORKGROUP); __hip_atomic_fetch_add(&hist[gi * 4 + i2], 1, __ATOMIC_RELAXED, __HIP_MEMORY_SCOPE_WORKGROUP);
    }
    __syncthreads();
    if (tid < 16) ((int*)(a.ws + WS_HIST))[blockIdx.x * 16 + tid] = hist[tid];
}
__device__ __forceinline__ void phase_convert_experts(const Args& a, LAS unsigned char* lds) {
    LAS float* tile = (LAS float*)(lds + 98304);
    bf16* wtgu = (bf16*)(a.ws + WS_WTGU); bf16* wtd = (bf16*)(a.ws + WS_WTD);
    for (int job = blockIdx.x; job < 4096 + 2048; job += gridDim.x) {
        if (job < 4096) { const int e = job >> 8, nt = (job >> 4) & 15, kt = job & 15, n0 = nt * 64;
            const int j = n0 >> 8, r = n0 & 255, half = r >> 7, cc = r & 127;
            const float* src = (half ? a.in[17] : a.in[16]) + (size_t)e * 1024 * 512;
            conv_job(src, 512, 128 * j + cc, wtgu + (size_t)e * 1024 * 1024, 1024, n0, kt * 64, tile); }
        else { const int jj = job - 4096, e = jj >> 7, nt = (jj >> 3) & 15, kt = jj & 7;
            conv_job(a.in[18] + (size_t)e * 512 * 1024, 1024, nt * 64, wtd + (size_t)e * 1024 * 512, 512, nt * 64, kt * 64, tile); }
    }
}
__device__ __forceinline__ void phase_scatter(const Args& a, LAS unsigned char* lds) {
    LAS int* base = (LAS int*)lds;
    LAS int* mybase = base + 16;
    LAS int* elist = base + 32;
    LAS int* slots = base + 32 + 512;
    const int* hist = (const int*)(a.ws + WS_HIST); const int* tok_e = (const int*)(a.ws + WS_TOKE);
    int* tok_s = (int*)(a.ws + WS_TOKS); int* meta = (int*)(a.ws + WS_META); int* tile_expert = meta + 64;
    const bf16* xf = (const bf16*)(a.ws + WS_XF); bf16* xs = (bf16*)(a.ws + WS_XS);
    const int tid = tidx(), lane = tid & 63, wave = tid >> 6, G = (int)gridDim.x;
    const int TPB = T / G, tb0 = blockIdx.x * TPB, NA = 2 * TPB;
    if (tid < 16) { int tot = 0, before = 0; for (int i = 0; i < G; ++i) { const int c = hist[i * 16 + tid]; tot += c; if (i < (int)blockIdx.x) before += c; } base[tid] = tot; mybase[tid] = before; }
    __syncthreads();
    if (tid == 0) { int off = 0;
        for (int e = 0; e < 16; ++e) { const int cnt = base[e], nt = (cnt + 255) >> 8;
            if (blockIdx.x == 0) { meta[e] = cnt; meta[16 + e] = off; for (int k = 0; k < nt; ++k) tile_expert[(off >> 8) + k] = e; }
            base[e] = off; off += nt * 256; }
        if (blockIdx.x == 0) { meta[32] = off; meta[33] = off >> 8; } }
    for (int i = tid; i < NA; i += 512) elist[i] = tok_e[tb0 * 2 + i];
    __syncthreads();
    for (int i = tid; i < NA; i += 512) { const int e = elist[i]; int rank = 0; for (int k = 0; k < i; ++k) rank += (elist[k] == e) ? 1 : 0;
        const int slot = base[e] + mybase[e] + rank; slots[i] = slot; tok_s[tb0 * 2 + i] = slot; }
    __syncthreads();
    for (int i = wave; i < NA; i += 8) { const int slot = slots[i], t = tb0 + (i >> 1);
        const v4u* src = (const v4u*)(xf + (size_t)t * D); v4u* dst = (v4u*)(xs + (size_t)slot * D);
        dst[lane] = src[lane]; dst[lane + 64] = src[lane + 64]; }
}
__device__ __forceinline__ void phase_moe1(const Args& a, LAS unsigned char* lds) {
    const int* meta = (const int*)(a.ws + WS_META);
    pg8::Gemm g{(const bf16*)(a.ws + WS_XS), (const bf16*)(a.ws + WS_WTGU), 0, 0, 1024};
    pg8::MoeOrder S; S.init(meta, meta + 64, (int)gridDim.x, (int)blockIdx.x);
    pg8::EpiAct E{(bf16*)(a.ws + WS_ACT)};
    pg8::gemm_phase<pg8::EpiAct, pg8::MoeOrder, true, true>(lds, g, S, E);
}
__device__ __forceinline__ void phase_moe2(const Args& a, LAS unsigned char* lds) {
    const int* meta = (const int*)(a.ws + WS_META);
    pg8::Gemm g{(const bf16*)(a.ws + WS_ACT), (const bf16*)(a.ws + WS_WTD), 0, 0, 512};
    pg8::MoeOrder S; S.init(meta, meta + 64, (int)gridDim.x, (int)blockIdx.x);
    pg8::EpiY E{(bf16*)(a.ws + WS_Y)};
    pg8::gemm_phase<pg8::EpiY, pg8::MoeOrder, true, true>(lds, g, S, E);
}
__device__ __forceinline__ void phase_final(const Args& a, LAS unsigned char* lds) {
    const float* mod = (const float*)(a.ws + WS_MOD); const float* now = a.in[19];
    const bf16* y = (const bf16*)(a.ws + WS_Y); const int* tok_s = (const int*)(a.ws + WS_TOKS); const float* tok_w = (const float*)(a.ws + WS_TOKW);
    float* out = a.out;
    const int tid = tidx(), lane = tid & 63, wave = tid >> 6;
    const int gw = blockIdx.x * 8 + wave, NGW = gridDim.x * 8;
    for (int t = gw; t < T; t += NGW) {
        const int b = t / SEQ, s1 = tok_s[t * 2], s2 = tok_s[t * 2 + 1];
        const float w1 = tok_w[t * 2], w2 = tok_w[t * 2 + 1];
        float4 o[4]; float ss = 0.f;
#pragma unroll
        for (int j = 0; j < 4; ++j) { const int k = 4 * lane + 256 * j;
            const float4 hv = *(const float4*)(out + (size_t)t * D + k), gf = *(const float4*)(mod + (size_t)b * 6144 + 5120 + k);
            const v2u a1 = *(const v2u*)(y + (size_t)s1 * D + k), a2 = *(const v2u*)(y + (size_t)s2 * D + k);
            float4 v;
            v.x = hv.x + gf.x * (w1 * bflo(a1.x) + w2 * bflo(a2.x)); v.y = hv.y + gf.y * (w1 * bfhi(a1.x) + w2 * bfhi(a2.x));
            v.z = hv.z + gf.z * (w1 * bflo(a1.y) + w2 * bflo(a2.y)); v.w = hv.w + gf.w * (w1 * bfhi(a1.y) + w2 * bfhi(a2.y));
            o[j] = v; ss += v.x * v.x + v.y * v.y + v.z * v.z + v.w * v.w; }
        ss = wave_sum(ss);
        const float rstd = rsqrtf(ss * (1.0f / D) + 1e-6f);
#pragma unroll
        for (int j = 0; j < 4; ++j) { const int k = 4 * lane + 256 * j; const float4 nwv = *(const float4*)(now + k);
            *(float4*)(out + (size_t)t * D + k) = make_float4(o[j].x * rstd * nwv.x, o[j].y * rstd * nwv.y, o[j].z * rstd * nwv.z, o[j].w * rstd * nwv.w); }
    }
}


__device__ __forceinline__ float quad_sum(float v) { v += __shfl_xor(v, 1); v += __shfl_xor(v, 2); return v; }
template <int BR>
__device__ __forceinline__ void scan_item(const Args& a, LAS unsigned char* lds, int b, int h, int half) {
    constexpr int TG = 8;
    LAS float* kf = (LAS float*)lds;
    LAS float* qf = kf + TG * 128;
    LAS float* vf = qf + TG * 128;
    LAS float* of = vf + TG * 128;
    LAS float* sc = of + TG * 128;
    bf16* proj = (bf16*)(a.ws + WS_PROJ);
    const float2* rope = (const float2*)(a.ws + WS_ROPE);
    const float* Gd = (const float*)(a.ws + WS_G); const float* Bd = (const float*)(a.ws + WS_BETA); const float* conv_w = a.in[6];
    float* ssq = (float*)(a.ws + WS_SSQ);
    const int tid = tidx(), v = tid >> 2, qd = tid & 3;
    const size_t row0 = (size_t)b * SEQ;
    const int qcol = (BR == 0 ? P_RQ : P_GQ) + h * 128, kcol = (BR == 0 ? P_RK : P_GK) + h * 128, vcol = (BR == 0 ? P_RV : P_GV) + h * 256 + half * 128;
    const float gamma = 1.0f - exp2f(-5.0f - (float)h);
    LAS float* hv = sc + TG * 2;
    float s[32];
#pragma unroll
    for (int d = 0; d < 32; ++d) s[d] = 0.f;
    for (int i = tid; i < 2 * 3 * 128; i += 512) hv[i] = 0.f;
    __syncthreads();
    for (int t0 = 0; t0 < SEQ; t0 += TG) {
        if (BR == 0) {
#pragma unroll
            for (int r = 0; r < 2; ++r) { const int idx = tid + 512 * r, isk = idx >> 9, tt = (idx >> 6) & 7, i = idx & 63, t = t0 + tt;
                const bf16* pr = proj + (row0 + t) * PW + (isk ? kcol : qcol);
                const float x1 = bf2f(pr[i]), x2 = bf2f(pr[i + 64]); const float2 cs = rope[t * 64 + i];
                const float sc_ = isk ? 0.08838834764831845f : 1.0f;
                LAS float* dst = (isk ? kf : qf) + tt * 128;
                dst[i] = (x1 * cs.x - x2 * cs.y) * sc_; dst[i + 64] = (x1 * cs.y + x2 * cs.x) * sc_; }
#pragma unroll
            for (int r = 0; r < 2; ++r) { const int idx = tid + 512 * r, tt = idx >> 7, c = idx & 127;
                vf[tt * 128 + c] = bf2f(proj[(row0 + t0 + tt) * PW + vcol + c]); }
        } else {
            if (tid < 384) {
                const bool isv = tid >= 256; const int u = isv ? tid - 256 : tid;
                const int tt = isv ? (u >> 4) : (u >> 5), part = isv ? (u & 15) : (u & 31), t = t0 + tt;
                const int col = isv ? (vcol + 8 * part) : (part < 16 ? qcol + 8 * part : kcol + 8 * (part - 16));
                const int cch = col - P_GQ;
                float acc[8];
#pragma unroll
                for (int j = 0; j < 8; ++j) acc[j] = 0.f;
#pragma unroll
                for (int i = 0; i < 4; ++i) { const int tr = t - 3 + i;
                    if (isv && tr < t0) {
                        const LAS float* hp = hv + (((t0 / TG) & 1) * 3 + (tr - (t0 - 3))) * 128 + 8 * part;
                        const float4 w0 = *(const float4*)(conv_w + i * 2048 + cch), w1 = *(const float4*)(conv_w + i * 2048 + cch + 4);
                        acc[0] += hp[0] * w0.x; acc[1] += hp[1] * w0.y; acc[2] += hp[2] * w0.z; acc[3] += hp[3] * w0.w;
                        acc[4] += hp[4] * w1.x; acc[5] += hp[5] * w1.y; acc[6] += hp[6] * w1.z; acc[7] += hp[7] * w1.w;
                    } else if (tr >= 0) { const v4u raw = *(const v4u*)(proj + (row0 + tr) * PW + col);
                        if (isv && i == 3 && tt >= TG - 3) { LAS float* hn = hv + ((((t0 / TG) + 1) & 1) * 3 + (tt - (TG - 3))) * 128 + 8 * part;
                            hn[0] = bflo(raw.x); hn[1] = bfhi(raw.x); hn[2] = bflo(raw.y); hn[3] = bfhi(raw.y); hn[4] = bflo(raw.z); hn[5] = bfhi(raw.z); hn[6] = bflo(raw.w); hn[7] = bfhi(raw.w); }
                        const float4 w0 = *(const float4*)(conv_w + i * 2048 + cch), w1 = *(const float4*)(conv_w + i * 2048 + cch + 4);
                        acc[0] += bflo(raw.x) * w0.x; acc[1] += bfhi(raw.x) * w0.y; acc[2] += bflo(raw.y) * w0.z; acc[3] += bfhi(raw.y) * w0.w;
                        acc[4] += bflo(raw.z) * w1.x; acc[5] += bfhi(raw.z) * w1.y; acc[6] += bflo(raw.w) * w1.z; acc[7] += bfhi(raw.w) * w1.w; } }
                float ss = 0.f;
#pragma unroll
                for (int j = 0; j < 8; ++j) { acc[j] = acc[j] * fsigmoid(acc[j]); ss += acc[j] * acc[j]; }
                if (!isv) {
                    ss += __shfl_xor(ss, 1); ss += __shfl_xor(ss, 2); ss += __shfl_xor(ss, 4); ss += __shfl_xor(ss, 8);
                    const float rn = rsqrtf(ss + 1e-6f) * (part < 16 ? 0.08838834764831845f : 1.0f);
                    LAS float* dst = (part < 16 ? qf : kf) + tt * 128 + 8 * (part & 15);
#pragma unroll
                    for (int j = 0; j < 8; ++j) dst[j] = acc[j] * rn;
                } else { LAS float* dst = vf + tt * 128 + 8 * part;
#pragma unroll
                    for (int j = 0; j < 8; ++j) dst[j] = acc[j]; }
            } else if (tid < 384 + TG) { const int tt = tid - 384; const size_t gi = (row0 + t0 + tt) * 4 + h; sc[tt * 2] = expf(Gd[gi]); sc[tt * 2 + 1] = Bd[gi]; }
        }
        __syncthreads();
#pragma unroll 1
        for (int tt = 0; tt < TG; ++tt) {
            const LAS f4* kp = (const LAS f4*)(kf + tt * 128 + 32 * qd); const LAS f4* qp = (const LAS f4*)(qf + tt * 128 + 32 * qd);
            const float vt = vf[tt * 128 + v];
            float o = 0.f;
            if (BR == 0) {
#pragma unroll
                for (int d4 = 0; d4 < 8; ++d4) { const f4 kk = kp[d4], qq = qp[d4];
                    s[4 * d4 + 0] = gamma * s[4 * d4 + 0] + kk.x * vt; o += qq.x * s[4 * d4 + 0];
                    s[4 * d4 + 1] = gamma * s[4 * d4 + 1] + kk.y * vt; o += qq.y * s[4 * d4 + 1];
                    s[4 * d4 + 2] = gamma * s[4 * d4 + 2] + kk.z * vt; o += qq.z * s[4 * d4 + 2];
                    s[4 * d4 + 3] = gamma * s[4 * d4 + 3] + kk.w * vt; o += qq.w * s[4 * d4 + 3]; }
            } else {
                const float al = sc[tt * 2], bt = sc[tt * 2 + 1];
                float dot = 0.f;
#pragma unroll
                for (int d4 = 0; d4 < 8; ++d4) { const f4 kk = kp[d4];
                    s[4 * d4 + 0] *= al; dot += s[4 * d4 + 0] * kk.x; s[4 * d4 + 1] *= al; dot += s[4 * d4 + 1] * kk.y;
                    s[4 * d4 + 2] *= al; dot += s[4 * d4 + 2] * kk.z; s[4 * d4 + 3] *= al; dot += s[4 * d4 + 3] * kk.w; }
                dot = quad_sum(dot);
                const float vn = bt * (vt - dot);
#pragma unroll
                for (int d4 = 0; d4 < 8; ++d4) { const f4 kk = kp[d4], qq = qp[d4];
                    s[4 * d4 + 0] += kk.x * vn; o += s[4 * d4 + 0] * qq.x; s[4 * d4 + 1] += kk.y * vn; o += s[4 * d4 + 1] * qq.y;
                    s[4 * d4 + 2] += kk.z * vn; o += s[4 * d4 + 2] * qq.z; s[4 * d4 + 3] += kk.w * vn; o += s[4 * d4 + 3] * qq.w; }
            }
            o = quad_sum(o);
            if (qd == 0) of[tt * 128 + v] = o;
        }
        __syncthreads();
        if (tid < 128) { const int tt = tid >> 4, c8 = (tid & 15) * 8;
            const LAS float* src = of + tt * 128 + c8; float ss = 0.f;
#pragma unroll
            for (int j = 0; j < 8; ++j) ss += src[j] * src[j];
            v4u w; w.x = pk2(src[0], src[1]); w.y = pk2(src[2], src[3]); w.z = pk2(src[4], src[5]); w.w = pk2(src[6], src[7]);
            *(v4u*)(proj + (row0 + t0 + tt) * PW + vcol + c8) = w;
            ss += __shfl_xor(ss, 1); ss += __shfl_xor(ss, 2); ss += __shfl_xor(ss, 4); ss += __shfl_xor(ss, 8);
            if ((tid & 15) == 0) ssq[(row0 + t0 + tt) * 16 + BR * 8 + h * 2 + half] = ss; }
        __syncthreads();
    }
}
__device__ __forceinline__ void phase_scan_simple(const Args& a, LAS unsigned char* lds) {
    for (int id = blockIdx.x; id < 256; id += gridDim.x) {
        const int br = (id >> 4) & 1, half = (id >> 3) & 1, bh = (id >> 5) * 8 + (id & 7), b = bh >> 2, h = bh & 3;
        if (br == 0) scan_item<0>(a, lds, b, h, half); else scan_item<1>(a, lds, b, h, half);
        __syncthreads();
    }
}
__device__ __forceinline__ void phase_merge(const Args& a, LAS unsigned char* lds) {
    const bf16* proj = (const bf16*)(a.ws + WS_PROJ); const float* ssq = (const float*)(a.ws + WS_SSQ); const float* gnw = a.in[9];
    bf16* merged = (bf16*)(a.ws + WS_MERGED);
    const int tid = tidx(), lane = tid & 63, wave = tid >> 6;
    const int gw = blockIdx.x * 8 + wave, NGW = gridDim.x * 8;
    for (int t = gw; t < T; t += NGW) {
        const int c0 = 16 * lane, h = lane >> 4;
        const float* sq = ssq + (size_t)t * 16;
        const float rr = rsqrtf((sq[h * 2] + sq[h * 2 + 1]) * (1.0f / 256.0f) + 1e-6f), rg = rsqrtf((sq[8 + h * 2] + sq[8 + h * 2 + 1]) * (1.0f / 256.0f) + 1e-6f);
        const bf16* pr = proj + (size_t)t * PW;
#pragma unroll
        for (int part = 0; part < 2; ++part) { const int c = c0 + 8 * part;
            const v4u orv = *(const v4u*)(pr + P_RV + c), ogv = *(const v4u*)(pr + P_GV + c), ga = *(const v4u*)(pr + P_GA + c), gb = *(const v4u*)(pr + P_GB + c);
            const float4 w0 = *(const float4*)(gnw + (c & 255)), w1 = *(const float4*)(gnw + (c & 255) + 4);
            float o[8];
            o[0] = bflo(ga.x) * bflo(orv.x) * rr + bflo(gb.x) * bflo(ogv.x) * rg * w0.x; o[1] = bfhi(ga.x) * bfhi(orv.x) * rr + bfhi(gb.x) * bfhi(ogv.x) * rg * w0.y;
            o[2] = bflo(ga.y) * bflo(orv.y) * rr + bflo(gb.y) * bflo(ogv.y) * rg * w0.z; o[3] = bfhi(ga.y) * bfhi(orv.y) * rr + bfhi(gb.y) * bfhi(ogv.y) * rg * w0.w;
            o[4] = bflo(ga.z) * bflo(orv.z) * rr + bflo(gb.z) * bflo(ogv.z) * rg * w1.x; o[5] = bfhi(ga.z) * bfhi(orv.z) * rr + bfhi(gb.z) * bfhi(ogv.z) * rg * w1.y;
            o[6] = bflo(ga.w) * bflo(orv.w) * rr + bflo(gb.w) * bflo(ogv.w) * rg * w1.z; o[7] = bfhi(ga.w) * bfhi(orv.w) * rr + bfhi(gb.w) * bfhi(ogv.w) * rg * w1.w;
            v4u w; w.x = pk2(o[0], o[1]); w.y = pk2(o[2], o[3]); w.z = pk2(o[4], o[5]); w.w = pk2(o[6], o[7]);
            *(v4u*)(merged + (size_t)t * 1024 + c) = w; }
    }
}

template <int PH> __device__ __forceinline__ void run_phase(const Args& a, LAS unsigned char* lds) {
    if (PH == 0) phase_mod(a, lds);
    else if (PH == 1) { phase_norm1(a, lds); __syncthreads(); phase_convert_in(a, lds); }
    else if (PH == 2) phase_inproj(a, lds);
    else if (PH == 3) phase_scan_simple(a, lds);
    else if (PH == 4) phase_merge(a, lds);
    else if (PH == 5) phase_outproj(a, lds);
    else if (PH == 6) { phase_route(a, lds); __syncthreads(); phase_convert_experts(a, lds); }
    else if (PH == 7) phase_scatter(a, lds);
    else if (PH == 8) phase_moe1(a, lds);
    else if (PH == 9) phase_moe2(a, lds);
    else if (PH == 10) phase_final(a, lds);
}
template <int PH> __global__ void __launch_bounds__(512, 2) k_phase(Args a) {
    extern __shared__ __attribute__((aligned(16))) unsigned char smem[];
    run_phase<PH>(a, (LAS unsigned char*)smem);
}
}
namespace {
__global__ void __launch_bounds__(512, 2) k_mega(Args a) {
    extern __shared__ __attribute__((aligned(16))) unsigned char smem[];
    LAS unsigned char* lds = (LAS unsigned char*)smem;
    cg::grid_group grid = cg::this_grid();
    run_phase<0>(a, lds); grid.sync();
    run_phase<1>(a, lds); grid.sync();
    run_phase<2>(a, lds); grid.sync();
    run_phase<3>(a, lds); grid.sync();
    run_phase<4>(a, lds); grid.sync();
    run_phase<5>(a, lds); grid.sync();
    run_phase<6>(a, lds); grid.sync();
    run_phase<7>(a, lds); grid.sync();
    run_phase<8>(a, lds); grid.sync();
    run_phase<9>(a, lds); grid.sync();
    run_phase<10>(a, lds);
}
}
extern "C" void kernel_launch(void* const* d_in, const int* in_sizes, int n_in, void* d_out, int out_size, void* d_ws, size_t ws_size, hipStream_t stream) {
    if (ws_size < 512 * MiB) return;
    static int grid_blocks = 0;
    if (!grid_blocks) {
        int dev = 0, cus = 0, per_cu = 0;
        (void)hipGetDevice(&dev);
        (void)hipDeviceGetAttribute(&cus, hipDeviceAttributeMultiprocessorCount, dev);
        (void)hipFuncSetAttribute((const void*)k_mega, hipFuncAttributeMaxDynamicSharedMemorySize, LDS_BYTES);
        (void)hipOccupancyMaxActiveBlocksPerMultiprocessor(&per_cu, (const void*)k_mega, 512, LDS_BYTES);
        if (per_cu < 1) per_cu = 1;
        grid_blocks = cus * per_cu;
        if (grid_blocks > 256) grid_blocks = 256;
    }
    Args a{};
    for (int i = 0; i < 20; ++i) a.in[i] = (const float*)d_in[i];
    a.out = (float*)d_out; a.ws = (unsigned char*)d_ws;
    void* args[] = {&a};
    (void)hipLaunchCooperativeKernel((const void*)k_mega, dim3(grid_blocks), dim3(512), args, LDS_BYTES, stream);
}
```

```cpp
#include <hip/hip_runtime.h>
#include <hip/hip_cooperative_groups.h>
#include <stdint.h>
namespace cg = cooperative_groups;

#define LAS __attribute__((address_space(3)))
typedef unsigned short bf16;
typedef unsigned v4u __attribute__((ext_vector_type(4)));
typedef unsigned v2u __attribute__((ext_vector_type(2)));
typedef float f4 __attribute__((ext_vector_type(4)));

namespace {
constexpr int D = 1024, NB = 16, SEQ = 2048, T = NB * SEQ, DIN = 8200;
constexpr int NH = 4, DK = 128, DV = 256;
constexpr int C_RQ = 0, C_RK = 512, C_RV = 1024, C_RG = 2048, C_GQ = 3072, C_GK = 3584, C_GV = 4096, C_GZ = 5120,
              C_GA = 6144, C_GB = 6148, C_GTA = 6152, C_GTB = 7176;
constexpr int NE = 16, FF = 512;
constexpr int MAXSLOT = 2 * T + NE * 256;
constexpr int PW = 6144, P_RQ = 0, P_RK = 512, P_RV = 1024, P_GQ = 2048, P_GK = 2560, P_GV = 3072, P_GA = 4096, P_GB = 5120;

constexpr size_t MiB = 1u << 20;
constexpr size_t WS_PROJ = 0;
constexpr size_t WS_MERGED = 384 * MiB;
constexpr size_t WS_WTOUT = 448 * MiB;
constexpr size_t WS_WTGU = 0;
constexpr size_t WS_WTD = 32 * MiB;
constexpr size_t WS_XF = 48 * MiB;
constexpr size_t WS_XS = 112 * MiB;
constexpr size_t WS_ACT = 248 * MiB;
constexpr size_t WS_Y = 316 * MiB;
constexpr size_t WS_CTL = 456 * MiB;
constexpr size_t WS_MOD = 457 * MiB;
constexpr size_t WS_ROPE = 458 * MiB;
constexpr size_t WS_BETA = 459 * MiB;
constexpr size_t WS_G = 459 * MiB + 512 * 1024;
constexpr size_t WS_SSQ = 460 * MiB;
constexpr size_t WS_TOKE = 462 * MiB;
constexpr size_t WS_TOKW = 462 * MiB + 256 * 1024;
constexpr size_t WS_TOKS = 462 * MiB + 512 * 1024;
constexpr size_t WS_HIST = 463 * MiB;
constexpr size_t WS_META = 463 * MiB + 64 * 1024;
constexpr size_t WS_NEED = 464 * MiB;
constexpr size_t DO_XM = 0;
constexpr size_t DO_WTIN = 64 * MiB;
constexpr int LDS_BYTES = 147456;

__device__ __forceinline__ float silu_f(float x) { return x / (1.0f + expf(-x)); }
__device__ __forceinline__ float sigmoid_f(float x) { return 1.0f / (1.0f + expf(-x)); }
__device__ __forceinline__ float fsigmoid(float x) { return __builtin_amdgcn_rcpf(1.0f + __expf(-x)); }
__device__ __forceinline__ float wave_sum(float v) {
#pragma unroll
    for (int o = 32; o >= 1; o >>= 1) v += __shfl_xor(v, o);
    return v;
}
__device__ __forceinline__ unsigned f2bf(float f) { unsigned u = __float_as_uint(f); return (u + 0x7fffu + ((u >> 16) & 1u)) >> 16; }
__device__ __forceinline__ unsigned pk2(float lo, float hi) { return f2bf(lo) | (f2bf(hi) << 16); }
__device__ __forceinline__ float bf2f(unsigned short b) { return __uint_as_float(((unsigned)b) << 16); }
__device__ __forceinline__ float bflo(unsigned w) { return __uint_as_float(w << 16); }
__device__ __forceinline__ float bfhi(unsigned w) { return __uint_as_float(w & 0xffff0000u); }

struct Args { const float* in[20]; float* out; unsigned char* ws; int ph_lo, ph_hi; };
}
namespace pg8 {
#define PG8_LAS __attribute__((address_space(3)))
typedef unsigned short bf16_t;
typedef short bf16x8 __attribute__((ext_vector_type(8)));
typedef float f32x4 __attribute__((ext_vector_type(4)));
typedef unsigned u32x4 __attribute__((ext_vector_type(4)));
constexpr int BM = 256, BK = 64, HALF = 128, HTB = HALF * BK * 2  , STAGE_BYTES = 8 * HTB, NXCD = 8, WGM = 8;

__host__ __device__ __forceinline__ int lds_byte(int r, int c) { const int st = (r >> 4) * 2 + (c >> 5), rr = r & 15, cc = c & 31, ob = rr * 64 + cc * 2; return st * 1024 + (ob ^ (((ob >> 9) & 1) << 5)); }
__host__ __device__ __forceinline__ void stage_rc(int b, int& R, int& C) { const int st = b / 1024, sb = b % 1024, swz = sb ^ (((sb >> 9) & 1) << 5); R = (st >> 1) * 16 + swz / 64; C = (st & 1) * 32 + (swz % 64) / 2; }
__host__ __device__ __forceinline__ int perm32(int rho) { const int n = rho >> 4, i = rho & 15; return 8 * (i >> 2) + 4 * n + (i & 3); }

struct Unit { int pm, pn; };
struct Gemm { const bf16_t* A; const bf16_t* Bt; int M, N, K; };

struct StaticOrder {
    int nM, nN, nwg, G, c;
    __host__ __device__ void init(int M, int N, int G_, int c_) { nM = M / BM; nN = N / BM; nwg = nM * nN; G = G_; c = c_; }
    __host__ __device__ bool next(int i, Unit& u) const {
        const long L = (long)i * G + c; if (L >= nwg) return false;
        int wgid = (int)L; { const int q = nwg / NXCD, r = nwg % NXCD, xcd = wgid % NXCD, off = wgid / NXCD; wgid = (xcd < r ? xcd * (q + 1) : r * (q + 1) + (xcd - r) * q) + off; }
        const int nig = WGM * nN, gid = wgid / nig, fm = gid * WGM, gsz = (nM - fm) < WGM ? (nM - fm) : WGM;
        u.pm = fm + ((wgid % nig) % gsz); u.pn = (wgid % nig) / gsz; return true;
    }
    __device__ __forceinline__ void a_ready(const Unit&) const {}
    __device__ __forceinline__ void done(const Unit&) const {}
};

__device__ __forceinline__ unsigned cvt_pk_bf16(float lo, float hi) { unsigned r; asm volatile("v_cvt_pk_bf16_f32 %0, %1, %2" : "=v"(r) : "v"(lo), "v"(hi)); return r; }
__device__ __forceinline__ float fsig(float x) { return __builtin_amdgcn_rcpf(1.0f + __expf(-x)); }

struct EpiProj {
    static constexpr bool PERM = true, AFTER_DRAIN = false;
    bf16_t* P; int pw;
    __device__ __forceinline__ void operator()(const f32x4 (&acc)[2][2][4][2], const Unit& u, int wr, int wc, int fr, int fq) const {
        const int row0 = u.pm * BM + wr * 64 + fr;
        if (u.pn < 16) {
            const int col0 = u.pn * BM + wc * 32 + 8 * fq;
#pragma unroll
            for (int ai = 0; ai < 2; ++ai)
#pragma unroll
                for (int m = 0; m < 4; ++m) { bf16_t* rowp = P + (size_t)(row0 + ai * HALF + m * 16) * pw + col0;
#pragma unroll
                    for (int bj = 0; bj < 2; ++bj) { const f32x4 v0 = acc[ai][bj][m][0], v1 = acc[ai][bj][m][1];
                        u32x4 w; w.x = cvt_pk_bf16(v0[0], v0[1]); w.y = cvt_pk_bf16(v0[2], v0[3]); w.z = cvt_pk_bf16(v1[0], v1[1]); w.w = cvt_pk_bf16(v1[2], v1[3]);
                        *(u32x4*)(rowp + bj * HALF) = w; } }
        } else {
            const int col0 = 4096 + (u.pn - 16) * 128 + wc * 32 + 8 * fq;
#pragma unroll
            for (int ai = 0; ai < 2; ++ai)
#pragma unroll
                for (int m = 0; m < 4; ++m) { bf16_t* rowp = P + (size_t)(row0 + ai * HALF + m * 16) * pw + col0;
                    float o[8];
#pragma unroll
                    for (int n = 0; n < 2; ++n)
#pragma unroll
                        for (int j = 0; j < 4; ++j) { const float g = acc[ai][0][m][n][j], s = acc[ai][1][m][n][j]; o[n * 4 + j] = g * fsig(g) * fsig(s); }
                    u32x4 w; w.x = cvt_pk_bf16(o[0], o[1]); w.y = cvt_pk_bf16(o[2], o[3]); w.z = cvt_pk_bf16(o[4], o[5]); w.w = cvt_pk_bf16(o[6], o[7]);
                    *(u32x4*)rowp = w; }
        }
    }
};
struct EpiH {
    static constexpr bool PERM = false, AFTER_DRAIN = false;
    const float* x; const float* mod; float* h;
    __device__ __forceinline__ void operator()(const f32x4 (&acc)[2][2][4][2], const Unit& u, int wr, int wc, int fr, int fq) const {
        const int row0 = u.pm * BM + wr * 64 + fr, col0 = u.pn * BM + wc * 32 + 4 * fq;
        const int b = (u.pm * BM) / 2048;
        f32x4 gv[2][2];
#pragma unroll
        for (int bj = 0; bj < 2; ++bj)
#pragma unroll
            for (int n = 0; n < 2; ++n) gv[bj][n] = *(const f32x4*)(mod + (size_t)b * 6144 + 2048 + col0 + bj * HALF + n * 16);
#pragma unroll
        for (int ai = 0; ai < 2; ++ai)
#pragma unroll
            for (int m = 0; m < 4; ++m) { const size_t off = (size_t)(row0 + ai * HALF + m * 16) * 1024 + col0;
#pragma unroll
                for (int bj = 0; bj < 2; ++bj)
#pragma unroll
                    for (int n = 0; n < 2; ++n) { const f32x4 xv = *(const f32x4*)(x + off + bj * HALF + n * 16); *(f32x4*)(h + off + bj * HALF + n * 16) = xv + gv[bj][n] * acc[ai][bj][m][n]; }
                asm volatile("" ::: "memory"); }
    }
};
struct EpiAct {
    static constexpr bool PERM = true, AFTER_DRAIN = false;
    bf16_t* act;
    __device__ __forceinline__ void operator()(const f32x4 (&acc)[2][2][4][2], const Unit& u, int wr, int wc, int fr, int fq) const {
        const int row0 = u.pm * BM + wr * 64 + fr, col0 = (u.pn & 3) * 128 + wc * 32 + 8 * fq;
#pragma unroll
        for (int ai = 0; ai < 2; ++ai)
#pragma unroll
            for (int m = 0; m < 4; ++m) { bf16_t* rowp = act + (size_t)(row0 + ai * HALF + m * 16) * 512 + col0;
                float o[8];
#pragma unroll
                for (int n = 0; n < 2; ++n)
#pragma unroll
                    for (int j = 0; j < 4; ++j) { const float g = acc[ai][0][m][n][j], up = acc[ai][1][m][n][j]; o[n * 4 + j] = g * fsig(g) * up; }
                u32x4 w; w.x = cvt_pk_bf16(o[0], o[1]); w.y = cvt_pk_bf16(o[2], o[3]); w.z = cvt_pk_bf16(o[4], o[5]); w.w = cvt_pk_bf16(o[6], o[7]);
                *(u32x4*)rowp = w; }
    }
};
struct EpiY {
    static constexpr bool PERM = true, AFTER_DRAIN = false;
    bf16_t* y;
    __device__ __forceinline__ void operator()(const f32x4 (&acc)[2][2][4][2], const Unit& u, int wr, int wc, int fr, int fq) const {
        const int row0 = u.pm * BM + wr * 64 + fr, col0 = (u.pn & 3) * BM + wc * 32 + 8 * fq;
#pragma unroll
        for (int ai = 0; ai < 2; ++ai)
#pragma unroll
            for (int m = 0; m < 4; ++m) { bf16_t* rowp = y + (size_t)(row0 + ai * HALF + m * 16) * 1024 + col0;
#pragma unroll
                for (int bj = 0; bj < 2; ++bj) { const f32x4 v0 = acc[ai][bj][m][0], v1 = acc[ai][bj][m][1];
                    u32x4 w; w.x = cvt_pk_bf16(v0[0], v0[1]); w.y = cvt_pk_bf16(v0[2], v0[3]); w.z = cvt_pk_bf16(v1[0], v1[1]); w.w = cvt_pk_bf16(v1[2], v1[3]);
                    *(u32x4*)(rowp + bj * HALF) = w; } }
    }
};
struct MoeOrder {
    const int* tile_expert; int nwg, G, c;
    __device__ void init(const int* meta, const int* te, int G_, int c_) { tile_expert = te; nwg = meta[33] * 4; G = G_; c = c_; }
    __device__ bool next(int i, Unit& u) const {
        const long L = (long)i * G + c; if (L >= nwg) return false;
        int wgid = (int)L; { const int q = nwg / NXCD, r = nwg % NXCD, xcd = wgid % NXCD, off = wgid / NXCD; wgid = (xcd < r ? xcd * (q + 1) : r * (q + 1) + (xcd - r) * q) + off; }
        u.pm = wgid >> 2; u.pn = tile_expert[u.pm] * 4 + (wgid & 3); return true;
    }
    __device__ __forceinline__ void a_ready(const Unit&) const {}
    __device__ __forceinline__ void done(const Unit&) const {}
};
template <class Epi, class Sched, bool ALIGN_EPI = false, bool SP2 = false>
__device__ __forceinline__ void gemm_phase(PG8_LAS unsigned char* lds, const Gemm g, const Sched& S, const Epi& E) {
    const int tid = threadIdx.x, wid = __builtin_amdgcn_readfirstlane(tid >> 6), lane = tid & 63, wr = wid >> 2, wc = wid & 3, fr = lane & 15, fq = lane >> 4;
    const int K = g.K, nt = K / BK;
    unsigned voffA[2], voffB[2];
#pragma unroll
    for (int i = 0; i < 2; ++i) { int R, C; stage_rc(tid * 16 + i * 8192, R, C); const int Rb = Epi::PERM ? ((R & ~31) + perm32(R & 31)) : R;
        voffA[i] = (unsigned)(R * K + C) * 2u; voffB[i] = (unsigned)(Rb * K + C) * 2u; }
    const size_t kstep = (size_t)(BK * 2);
    const size_t hstep = (size_t)HALF * K * 2;
    const size_t tstep = 2 * hstep;
    const unsigned ldsw = (unsigned)wid * 1024u;
    const int aoff = lds_byte(wr * 64 + fr, fq * 8), boff = lds_byte(wc * 32 + fr, fq * 8);
#define PG8_SA(b, h) (((b) * 2 + (h)) * HTB)
#define PG8_SB(b, h) ((4 + (b) * 2 + (h)) * HTB)
#define PG8_STAGE(bufoff, gbase, voff) do { _Pragma("unroll") for (int _i = 0; _i < 2; ++_i) \
        __builtin_amdgcn_global_load_lds((const unsigned*)((const char*)(gbase) + (voff)[_i]), (PG8_LAS unsigned*)(lds + (bufoff) + ldsw + _i * 8192), 16, 0, 0); } while (0)
#define PG8_LDA(dst, b, h) do { _Pragma("unroll") for (int m = 0; m < 4; ++m) _Pragma("unroll") for (int k = 0; k < 2; ++k) dst[m][k] = *(const PG8_LAS bf16x8*)(lds + PG8_SA(b, h) + aoff + m * 2048 + k * 1024); } while (0)
#define PG8_LDB(dst, b, h) do { _Pragma("unroll") for (int n = 0; n < 2; ++n) _Pragma("unroll") for (int k = 0; k < 2; ++k) dst[n][k] = *(const PG8_LAS bf16x8*)(lds + PG8_SB(b, h) + boff + n * 2048 + k * 1024); } while (0)
#define PG8_MMA(ai, bj, At, Bt) do { __builtin_amdgcn_s_setprio(1); _Pragma("unroll") for (int m = 0; m < 4; ++m) _Pragma("unroll") for (int n = 0; n < 2; ++n) _Pragma("unroll") for (int k = 0; k < 2; ++k) \
        acc[ai][bj][m][n] = __builtin_amdgcn_mfma_f32_16x16x32_bf16(Bt[n][k], At[m][k], acc[ai][bj][m][n], 0, 0, 0); __builtin_amdgcn_s_setprio(0); } while (0)
#define PG8_WAIT_V(n) asm volatile("s_waitcnt vmcnt(" #n ")" ::: "memory")
#define PG8_WAIT_L(n) asm volatile("s_waitcnt lgkmcnt(" #n ")" ::: "memory")
#define PG8_BAR __builtin_amdgcn_s_barrier()
#define PG8_SCHED __builtin_amdgcn_sched_barrier(0)
    Unit cur, nxt; int ui = 0;
    if (!S.next(0, cur)) return;
    f32x4 acc[2][2][4][2];
#pragma unroll
    for (int a = 0; a < 2; ++a)
#pragma unroll
        for (int b = 0; b < 2; ++b)
#pragma unroll
            for (int m = 0; m < 4; ++m)
#pragma unroll
                for (int n = 0; n < 2; ++n) acc[a][b][m][n] = (f32x4){0.f, 0.f, 0.f, 0.f};
    bf16x8 At[4][2], B0[2][2], B1[2][2];
    const char* cA = (const char*)g.A + (size_t)cur.pm * tstep; const char* cB = (const char*)g.Bt + (size_t)cur.pn * tstep;
    S.a_ready(cur);
    if constexpr (SP2) {
        PG8_STAGE(PG8_SB(0, 0), cB, voffB); PG8_STAGE(PG8_SB(0, 1), cB + hstep, voffB); PG8_STAGE(PG8_SA(0, 0), cA, voffA); PG8_STAGE(PG8_SA(0, 1), cA + hstep, voffA);
        if (wr == 1) PG8_BAR;
        PG8_WAIT_V(2); PG8_BAR;
        PG8_STAGE(PG8_SB(1, 0), cB + kstep, voffB); PG8_STAGE(PG8_SA(1, 0), cA + kstep, voffA); PG8_STAGE(PG8_SB(1, 1), cB + hstep + kstep, voffB);
        PG8_WAIT_V(6); PG8_BAR;
    } else {
        PG8_STAGE(PG8_SB(0, 0), cB, voffB); PG8_STAGE(PG8_SA(0, 0), cA, voffA); PG8_STAGE(PG8_SB(0, 1), cB + hstep, voffB); PG8_STAGE(PG8_SA(0, 1), cA + hstep, voffA);
        if (wr == 1) PG8_BAR;
        PG8_WAIT_V(4); PG8_BAR;
        PG8_STAGE(PG8_SB(1, 0), cB + kstep, voffB); PG8_STAGE(PG8_SA(1, 0), cA + kstep, voffA); PG8_STAGE(PG8_SB(1, 1), cB + hstep + kstep, voffB);
        PG8_WAIT_V(6); PG8_BAR;
    }
    for (;;) {
        const bool has_next = S.next(ui + 1, nxt);
        const char* nA = has_next ? (const char*)g.A + (size_t)nxt.pm * tstep : cA; const char* nB = has_next ? (const char*)g.Bt + (size_t)nxt.pn * tstep : cB;
        for (int t = 0; t < nt; t += 2) {
            const bool last = (t == nt - 2);
            const char* a1 = cA + (size_t)(t + 1) * kstep;
            const char* a2 = last ? nA : cA + (size_t)(t + 2) * kstep; const char* b2 = last ? nB : cB + (size_t)(t + 2) * kstep;
            const char* a3 = a2 + kstep; const char* b3 = b2 + kstep;
            if (last && has_next) S.a_ready(nxt);
            if constexpr (SP2) {
            PG8_LDB(B0, 0, 0); PG8_LDB(B1, 0, 1); PG8_SCHED; PG8_LDA(At, 0, 0); PG8_STAGE(PG8_SA(1, 1), a1 + hstep, voffA);
            PG8_WAIT_V(8); PG8_WAIT_L(0); PG8_BAR; PG8_MMA(0, 0, At, B0); PG8_MMA(0, 1, At, B1); PG8_BAR; PG8_SCHED;
            PG8_LDA(At, 0, 1); PG8_STAGE(PG8_SB(0, 0), b2, voffB); PG8_STAGE(PG8_SB(0, 1), b2 + hstep, voffB); PG8_STAGE(PG8_SA(0, 0), a2, voffA);
            PG8_WAIT_V(8); PG8_WAIT_L(0); PG8_BAR; PG8_MMA(1, 0, At, B0); PG8_MMA(1, 1, At, B1); PG8_BAR; PG8_SCHED;
            PG8_LDB(B0, 1, 0); PG8_LDB(B1, 1, 1); PG8_SCHED; PG8_LDA(At, 1, 0); PG8_STAGE(PG8_SA(0, 1), a2 + hstep, voffA);
            PG8_WAIT_V(8); PG8_WAIT_L(0); PG8_BAR; PG8_MMA(0, 0, At, B0); PG8_MMA(0, 1, At, B1); PG8_BAR; PG8_SCHED;
            PG8_LDA(At, 1, 1); PG8_STAGE(PG8_SB(1, 0), b3, voffB); PG8_STAGE(PG8_SB(1, 1), b3 + hstep, voffB); PG8_STAGE(PG8_SA(1, 0), a3, voffA);
            PG8_WAIT_V(8); PG8_WAIT_L(0); PG8_BAR; PG8_MMA(1, 0, At, B0); PG8_MMA(1, 1, At, B1); PG8_BAR; PG8_SCHED;
            } else {
            PG8_LDB(B0, 0, 0); PG8_SCHED; PG8_LDA(At, 0, 0); PG8_STAGE(PG8_SA(1, 1), a1 + hstep, voffA);
            PG8_WAIT_L(8); PG8_BAR; PG8_WAIT_L(0); PG8_MMA(0, 0, At, B0); PG8_BAR; PG8_SCHED;
            PG8_LDB(B1, 0, 1); PG8_STAGE(PG8_SB(0, 0), b2, voffB);
            PG8_BAR; PG8_WAIT_L(0); PG8_MMA(0, 1, At, B1); PG8_BAR;
            PG8_LDA(At, 0, 1); PG8_STAGE(PG8_SA(0, 0), a2, voffA);
            PG8_BAR; PG8_WAIT_L(0); PG8_MMA(1, 0, At, B0); PG8_BAR; PG8_SCHED;
            PG8_STAGE(PG8_SB(0, 1), b2 + hstep, voffB);
            PG8_WAIT_V(6); PG8_BAR; PG8_MMA(1, 1, At, B1); PG8_BAR;
            PG8_LDB(B0, 1, 0); PG8_SCHED; PG8_LDA(At, 1, 0); PG8_STAGE(PG8_SA(0, 1), a2 + hstep, voffA);
            PG8_WAIT_L(8); PG8_BAR; PG8_WAIT_L(0); PG8_MMA(0, 0, At, B0); PG8_BAR; PG8_SCHED;
            PG8_LDB(B1, 1, 1); PG8_STAGE(PG8_SB(1, 0), b3, voffB);
            PG8_BAR; PG8_WAIT_L(0); PG8_MMA(0, 1, At, B1); PG8_BAR;
            PG8_LDA(At, 1, 1); PG8_STAGE(PG8_SA(1, 0), a3, voffA);
            PG8_BAR; PG8_WAIT_L(0); PG8_MMA(1, 0, At, B0); PG8_BAR; PG8_SCHED;
            PG8_STAGE(PG8_SB(1, 1), b3 + hstep, voffB);
            PG8_WAIT_V(6); PG8_BAR; PG8_MMA(1, 1, At, B1); PG8_BAR;
            }
        }
        if constexpr (ALIGN_EPI) { if (wr == 0) PG8_BAR; }
        if constexpr (!Epi::AFTER_DRAIN) { E(acc, cur, wr, wc, fr, fq); S.done(cur); }
        if (!has_next) break;
#pragma unroll
        for (int a = 0; a < 2; ++a)
#pragma unroll
            for (int b = 0; b < 2; ++b)
#pragma unroll
                for (int m = 0; m < 4; ++m)
#pragma unroll
                    for (int n = 0; n < 2; ++n) acc[a][b][m][n] = (f32x4){0.f, 0.f, 0.f, 0.f};
        cur = nxt; cA = nA; cB = nB; ++ui;
        if constexpr (ALIGN_EPI) { if (wr == 1) PG8_BAR; }
    }
    PG8_WAIT_V(0);
    if constexpr (!ALIGN_EPI) { if (wr == 0) PG8_BAR; }
    PG8_BAR;
    if constexpr (Epi::AFTER_DRAIN) { E.fused(acc, cur, wr, wc, fr, fq, lds, wid, lane); S.done(cur); }
#undef PG8_SA
#undef PG8_SB
#undef PG8_STAGE
#undef PG8_LDA
#undef PG8_LDB
#undef PG8_MMA
#undef PG8_WAIT_V
#undef PG8_WAIT_L
#undef PG8_BAR
#undef PG8_SCHED
}
}
namespace {
__device__ __forceinline__ int tidx() { int t = threadIdx.x; asm volatile("" : "+v"(t)); return t; }
__device__ __forceinline__ void phase_mod(const Args& a, LAS unsigned char* lds) {
    LAS float* sc = (LAS float*)lds;
    LAS float* part = (LAS float*)(lds + 65536);
    const float* c = a.in[1]; const float* mw = a.in[2]; const float* mb = a.in[3];
    float* mod = (float*)(a.ws + WS_MOD);
    const int tid = tidx();
    for (int i = tid; i < 16 * 1024; i += 512) sc[i] = silu_f(c[i]);
    __syncthreads();
    const int kg = tid >> 5, cj = tid & 31;
    for (int cgp = blockIdx.x; cgp < 256; cgp += gridDim.x) {
        const int j0 = cgp * 24;
        float acc[16];
#pragma unroll
        for (int b = 0; b < 16; ++b) acc[b] = 0.f;
        if (cj < 24) {
            for (int kk = 0; kk < 64; kk += 4) {
                const int k = kg * 64 + kk;
                const float w0 = mw[(size_t)(k + 0) * 6144 + j0 + cj], w1 = mw[(size_t)(k + 1) * 6144 + j0 + cj], w2 = mw[(size_t)(k + 2) * 6144 + j0 + cj], w3 = mw[(size_t)(k + 3) * 6144 + j0 + cj];
#pragma unroll
                for (int b = 0; b < 16; ++b) { const f4 s = *(const LAS f4*)(sc + b * 1024 + k); acc[b] += s.x * w0 + s.y * w1 + s.z * w2 + s.w * w3; }
            }
        }
#pragma unroll
        for (int b = 0; b < 16; ++b) part[(kg * 16 + b) * 32 + cj] = acc[b];
        __syncthreads();
        if (tid < 384) { const int b = tid / 24, cc = tid % 24; float s = mb[j0 + cc];
            for (int g2 = 0; g2 < 16; ++g2) s += part[(g2 * 16 + b) * 32 + cc];
            mod[b * 6144 + j0 + cc] = s; }
        __syncthreads();
    }
}

__device__ __forceinline__ void phase_norm1(const Args& a, LAS unsigned char* lds) {
    LAS f4* wgA = (LAS f4*)lds;
    LAS f4* wgB = (LAS f4*)(lds + 16384);
    const float* x = a.in[0]; const float* nw = a.in[4]; const float* w_in = a.in[5]; const float* a_log = a.in[7]; const float* dt_bias = a.in[8];
    const float* mod = (const float*)(a.ws + WS_MOD);
    bf16* xm = (bf16*)((unsigned char*)a.out + DO_XM);
    float* Gd = (float*)(a.ws + WS_G); float* Bd = (float*)(a.ws + WS_BETA);
    const int tid = tidx(), lane = tid & 63, wave = tid >> 6;
    for (int k = tid; k < 1024; k += 512) { const int idx = (4 * (k >> 8) + (k & 3)) * 64 + ((k & 255) >> 2);
        wgA[idx] = *(const f4*)(w_in + (size_t)k * DIN + C_GA); wgB[idx] = *(const f4*)(w_in + (size_t)k * DIN + C_GB); }
    __syncthreads();
    const int gw = blockIdx.x * 8 + wave, NGW = gridDim.x * 8;
    for (int grp = gw; grp < T / 2; grp += NGW) {
        const int t0 = grp * 2, b = t0 / SEQ;
        float4 gmul[4], gadd[4];
#pragma unroll
        for (int j = 0; j < 4; ++j) { const int k = 4 * lane + 256 * j;
            const float4 wv = *(const float4*)(nw + k), sc = *(const float4*)(mod + (size_t)b * 6144 + 1024 + k), sh = *(const float4*)(mod + (size_t)b * 6144 + k);
            gmul[j] = make_float4(wv.x * (1.f + sc.x), wv.y * (1.f + sc.y), wv.z * (1.f + sc.z), wv.w * (1.f + sc.w)); gadd[j] = sh; }
        float4 xv[2][4];
#pragma unroll
        for (int r = 0; r < 2; ++r) {
            float ss = 0.f;
#pragma unroll
            for (int j = 0; j < 4; ++j) { xv[r][j] = *(const float4*)(x + (size_t)(t0 + r) * D + 4 * lane + 256 * j); ss += xv[r][j].x * xv[r][j].x + xv[r][j].y * xv[r][j].y + xv[r][j].z * xv[r][j].z + xv[r][j].w * xv[r][j].w; }
            ss = wave_sum(ss);
            const float rstd = rsqrtf(ss * (1.0f / D) + 1e-6f);
#pragma unroll
            for (int j = 0; j < 4; ++j) { float4 v = xv[r][j];
                v.x = v.x * rstd * gmul[j].x + gadd[j].x; v.y = v.y * rstd * gmul[j].y + gadd[j].y; v.z = v.z * rstd * gmul[j].z + gadd[j].z; v.w = v.w * rstd * gmul[j].w + gadd[j].w;
                xv[r][j] = v;
                v2u w; w.x = pk2(v.x, v.y); w.y = pk2(v.z, v.w);
                *(v2u*)(xm + (size_t)(t0 + r) * D + 4 * lane + 256 * j) = w; }
        }
        float acc[2][8];
#pragma unroll
        for (int r = 0; r < 2; ++r)
#pragma unroll
            for (int q = 0; q < 8; ++q) acc[r][q] = 0.f;
#pragma unroll
        for (int j = 0; j < 4; ++j) {
#pragma unroll
            for (int jj = 0; jj < 4; ++jj) {
                const f4 wa = wgA[(4 * j + jj) * 64 + lane], wb = wgB[(4 * j + jj) * 64 + lane];
#pragma unroll
                for (int r = 0; r < 2; ++r) { const float xe = (jj == 0) ? xv[r][j].x : (jj == 1) ? xv[r][j].y : (jj == 2) ? xv[r][j].z : xv[r][j].w;
                    acc[r][0] += xe * wa.x; acc[r][1] += xe * wa.y; acc[r][2] += xe * wa.z; acc[r][3] += xe * wa.w;
                    acc[r][4] += xe * wb.x; acc[r][5] += xe * wb.y; acc[r][6] += xe * wb.z; acc[r][7] += xe * wb.w; }
            }
            asm volatile("" ::: "memory");
        }
        float mine = 0.f;
#pragma unroll
        for (int r = 0; r < 2; ++r)
#pragma unroll
            for (int q = 0; q < 8; ++q) { const float s = wave_sum(acc[r][q]); if (lane == r * 8 + q) mine = s; }
        if (lane < 16) { const int r = lane >> 3, q = lane & 7, t = t0 + r;
            if (q < 4) { const float z = mine + dt_bias[q]; const float sp = (z > 20.f) ? z : log1pf(expf(z)); Gd[t * 4 + q] = -expf(a_log[q]) * sp; }
            else Bd[t * 4 + (q - 4)] = sigmoid_f(mine); }
    }
}

__device__ __forceinline__ void conv_job(const float* src, int ldsrc, int srccol, bf16* dst, int ldd, int n0, int k0, LAS float* tile) {
    const int tid = tidx();
#pragma unroll
    for (int i = 0; i < 2; ++i) { const int kk = (tid >> 4) + 32 * i, c4 = (tid & 15) * 4;
        const float4 v = *(const float4*)(src + (size_t)(k0 + kk) * ldsrc + srccol + c4);
        tile[kk * 65 + c4 + 0] = v.x; tile[kk * 65 + c4 + 1] = v.y; tile[kk * 65 + c4 + 2] = v.z; tile[kk * 65 + c4 + 3] = v.w; }
    __syncthreads();
    { const int n = tid >> 3, kc = (tid & 7) * 8;
        v4u w; w.x = pk2(tile[(kc + 0) * 65 + n], tile[(kc + 1) * 65 + n]); w.y = pk2(tile[(kc + 2) * 65 + n], tile[(kc + 3) * 65 + n]);
        w.z = pk2(tile[(kc + 4) * 65 + n], tile[(kc + 5) * 65 + n]); w.w = pk2(tile[(kc + 6) * 65 + n], tile[(kc + 7) * 65 + n]);
        *(v4u*)(dst + (size_t)(n0 + n) * ldd + k0 + kc) = w; }
    __syncthreads();
}
__device__ __forceinline__ int win_srccol(int n0) {
    if (n0 < 512) return C_RQ + n0;
    if (n0 < 1024) return C_RK + (n0 - 512);
    if (n0 < 2048) return C_RV + (n0 - 1024);
    if (n0 < 4096) return C_GQ + (n0 - 2048);
    const int j = (n0 - 4096) >> 8, r = (n0 - 4096) & 255, half = r >> 7, cc = r & 127;
    if (j < 8) return (half ? C_GTA : C_RG) + 128 * j + cc;
    return (half ? C_GTB : C_GZ) + 128 * (j - 8) + cc;
}
__device__ __forceinline__ void phase_convert_in(const Args& a, LAS unsigned char* lds) {
    LAS float* tile = (LAS float*)(lds + 32768);
    bf16* wtin = (bf16*)((unsigned char*)a.out + DO_WTIN); bf16* wtout = (bf16*)(a.ws + WS_WTOUT);
    for (int job = blockIdx.x; job < 2048 + 256; job += gridDim.x) {
        if (job < 2048) { const int nt = job >> 4, kt = job & 15; conv_job(a.in[5], DIN, win_srccol(nt * 64), wtin, 1024, nt * 64, kt * 64, tile); }
        else { const int jj = job - 2048, nt = jj >> 4, kt = jj & 15; conv_job(a.in[10], 1024, nt * 64, wtout, 1024, nt * 64, kt * 64, tile); }
    }
    float2* rope = (float2*)(a.ws + WS_ROPE);
    for (int i = blockIdx.x * 512 + tidx(); i < SEQ * 64; i += gridDim.x * 512) {
        const int t = i >> 6, fi = i & 63;
        const double inv = exp(-((double)fi / 64.0) * 9.210340371976184), ang = (double)t * inv;
        rope[i] = make_float2((float)cos(ang), (float)sin(ang));
    }
}
__device__ __forceinline__ void phase_inproj(const Args& a, LAS unsigned char* lds) {
    pg8::Gemm g{(const bf16*)((unsigned char*)a.out + DO_XM), (const bf16*)((unsigned char*)a.out + DO_WTIN), T, 8192, 1024};
    pg8::StaticOrder S; S.init(T, 8192, (int)gridDim.x, (int)blockIdx.x);
    pg8::EpiProj E{(bf16*)(a.ws + WS_PROJ), PW};
    pg8::gemm_phase<pg8::EpiProj, pg8::StaticOrder, true, true>(lds, g, S, E);
}


__device__ __forceinline__ void phase_outproj(const Args& a, LAS unsigned char* lds) {
    pg8::Gemm g{(const bf16*)(a.ws + WS_MERGED), (const bf16*)(a.ws + WS_WTOUT), T, 1024, 1024};
    pg8::StaticOrder S; S.init(T, 1024, (int)gridDim.x, (int)blockIdx.x);
    pg8::EpiH E{a.in[0], (const float*)(a.ws + WS_MOD), a.out};
    pg8::gemm_phase<pg8::EpiH, pg8::StaticOrder, true, true>(lds, g, S, E);
}

__device__ __forceinline__ void phase_route(const Args& a, LAS unsigned char* lds) {
    LAS f4* wr = (LAS f4*)lds;
    LAS int* hist = (LAS int*)(lds + 5 * 16384);
    LAS float* lgl = (LAS float*)(lds + 5 * 16384 + 256);
    const float* h = a.out; const float* nw = a.in[11]; const float* w_group = a.in[12]; const float* b_group = a.in[13]; const float* w_router = a.in[14]; const float* b_router = a.in[15];
    const float* mod = (const float*)(a.ws + WS_MOD);
    bf16* xf = (bf16*)(a.ws + WS_XF);
    int* tok_e = (int*)(a.ws + WS_TOKE); float* tok_w = (float*)(a.ws + WS_TOKW);
    const int tid = tidx(), lane = tid & 63, wave = tid >> 6;
    for (int k = tid; k < 1024; k += 512) { const int idx = (4 * (k >> 8) + (k & 3)) * 64 + ((k & 255) >> 2);
        wr[idx] = *(const f4*)(w_group + (size_t)k * 4);
#pragma unroll
        for (int q = 0; q < 4; ++q) wr[(q + 1) * 1024 + idx] = *(const f4*)(w_router + (size_t)k * 16 + 4 * q); }
    if (tid < 16) hist[tid] = 0;
    __syncthreads();
    const int TPB = T / (int)gridDim.x, tb0 = blockIdx.x * TPB;
#pragma unroll 1
    for (int pr = wave; pr < TPB / 2; pr += 8) {
        const int t0 = tb0 + pr * 2, b = t0 / SEQ;
        float4 gmul[4], gadd[4];
#pragma unroll
        for (int j = 0; j < 4; ++j) { const int k = 4 * lane + 256 * j;
            const float4 wv = *(const float4*)(nw + k), sc = *(const float4*)(mod + (size_t)b * 6144 + 4096 + k), sh = *(const float4*)(mod + (size_t)b * 6144 + 3072 + k);
            gmul[j] = make_float4(wv.x * (1.f + sc.x), wv.y * (1.f + sc.y), wv.z * (1.f + sc.z), wv.w * (1.f + sc.w)); gadd[j] = sh; }
        float4 xv[2][4];
#pragma unroll
        for (int r = 0; r < 2; ++r) {
            float ss = 0.f;
#pragma unroll
            for (int j = 0; j < 4; ++j) { xv[r][j] = *(const float4*)(h + (size_t)(t0 + r) * D + 4 * lane + 256 * j); ss += xv[r][j].x * xv[r][j].x + xv[r][j].y * xv[r][j].y + xv[r][j].z * xv[r][j].z + xv[r][j].w * xv[r][j].w; }
            ss = wave_sum(ss);
            const float rstd = rsqrtf(ss * (1.0f / D) + 1e-6f);
#pragma unroll
            for (int j = 0; j < 4; ++j) { float4 v = xv[r][j];
                v.x = v.x * rstd * gmul[j].x + gadd[j].x; v.y = v.y * rstd * gmul[j].y + gadd[j].y; v.z = v.z * rstd * gmul[j].z + gadd[j].z; v.w = v.w * rstd * gmul[j].w + gadd[j].w;
                xv[r][j] = v;
                v2u w; w.x = pk2(v.x, v.y); w.y = pk2(v.z, v.w);
                *(v2u*)(xf + (size_t)(t0 + r) * D + 4 * lane + 256 * j) = w; }
        }
        float acc[2][20];
#pragma unroll
        for (int r = 0; r < 2; ++r)
#pragma unroll
            for (int q = 0; q < 20; ++q) acc[r][q] = 0.f;
#pragma unroll
        for (int j = 0; j < 4; ++j) {
#pragma unroll
            for (int jj = 0; jj < 4; ++jj) {
                const int idx = (4 * j + jj) * 64 + lane;
#pragma unroll
                for (int q = 0; q < 5; ++q) { const f4 w = wr[q * 1024 + idx];
#pragma unroll
                    for (int r = 0; r < 2; ++r) { const float xe = (jj == 0) ? xv[r][j].x : (jj == 1) ? xv[r][j].y : (jj == 2) ? xv[r][j].z : xv[r][j].w;
                        acc[r][4 * q + 0] += xe * w.x; acc[r][4 * q + 1] += xe * w.y; acc[r][4 * q + 2] += xe * w.z; acc[r][4 * q + 3] += xe * w.w; } }
                asm volatile("" ::: "memory");
            }
        }
        float mine0 = 0.f, mine1 = 0.f;
#pragma unroll
        for (int q = 0; q < 20; ++q) { const float s0 = wave_sum(acc[0][q]), s1 = wave_sum(acc[1][q]); if (lane == q) { mine0 = s0; mine1 = s1; } }
        if (lane < 20) { lgl[(pr * 2 + 0) * 20 + lane] = mine0; lgl[(pr * 2 + 1) * 20 + lane] = mine1; }
    }
    __syncthreads();
    if (tid < TPB) {
        const int t = tb0 + tid;
        float lg[20];
#pragma unroll
        for (int q = 0; q < 20; ++q) lg[q] = lgl[tid * 20 + q];
        float gl[4], gmax = -1e30f; int gi = 0;
#pragma unroll
        for (int j = 0; j < 4; ++j) { gl[j] = lg[j] + b_group[j]; if (gl[j] > gmax) { gmax = gl[j]; gi = j; } }
        float gs = 0.f;
#pragma unroll
        for (int j = 0; j < 4; ++j) gs += expf(gl[j] - gmax);
        const float g_top = 1.0f / gs;
        float el[4], emax = -1e30f;
#pragma unroll
        for (int j = 0; j < 4; ++j) { const float raw = (gi == 0) ? lg[4 + j] : (gi == 1) ? lg[8 + j] : (gi == 2) ? lg[12 + j] : lg[16 + j]; el[j] = raw + b_router[gi * 4 + j]; emax = fmaxf(emax, el[j]); }
        float ep[4], es = 0.f;
#pragma unroll
        for (int j = 0; j < 4; ++j) { ep[j] = expf(el[j] - emax); es += ep[j]; }
#pragma unroll
        for (int j = 0; j < 4; ++j) ep[j] /= es;
        int i1 = 0; float p1 = ep[0];
#pragma unroll
        for (int j = 1; j < 4; ++j) if (ep[j] > p1) { p1 = ep[j]; i1 = j; }
        int i2 = -1; float p2 = -1.f;
#pragma unroll
        for (int j = 0; j < 4; ++j) if (j != i1 && ep[j] > p2) { p2 = ep[j]; i2 = j; }
        const float den = p1 + p2;
        tok_e[t * 2 + 0] = gi * 4 + i1; tok_e[t * 2 + 1] = gi * 4 + i2;
        tok_w[t * 2 + 0] = g_top * (p1 / den); tok_w[t * 2 + 1] = g_top * (p2 / den);
        __hip_atomic_fetch_add(&hist[gi * 4 + i1], 1, __ATOMIC_RELAXED, __HIP_MEMORY_SCOPE_WORKGROUP); __hip_atomic_fetch_add(&hist[gi * 4 + i2], 1, __ATOMIC_RELAXED, __HIP_MEMORY_SCOPE_WORKGROUP);
    }
    __syncthreads();
    if (tid < 16) ((int*)(a.ws + WS_HIST))[blockIdx.x * 16 + tid] = hist[tid];
}
__device__ __forceinline__ void phase_convert_experts(const Args& a, LAS unsigned char* lds) {
    LAS float* tile = (LAS float*)(lds + 98304);
    bf16* wtgu = (bf16*)(a.ws + WS_WTGU); bf16* wtd = (bf16*)(a.ws + WS_WTD);
    for (int job = blockIdx.x; job < 4096 + 2048; job += gridDim.x) {
        if (job < 4096) { const int e = job >> 8, nt = (job >> 4) & 15, kt = job & 15, n0 = nt * 64;
            const int j = n0 >> 8, r = n0 & 255, half = r >> 7, cc = r & 127;
            const float* src = (half ? a.in[17] : a.in[16]) + (size_t)e * 1024 * 512;
            conv_job(src, 512, 128 * j + cc, wtgu + (size_t)e * 1024 * 1024, 1024, n0, kt * 64, tile); }
        else { const int jj = job - 4096, e = jj >> 7, nt = (jj >> 3) & 15, kt = jj & 7;
            conv_job(a.in[18] + (size_t)e * 512 * 1024, 1024, nt * 64, wtd + (size_t)e * 1024 * 512, 512, nt * 64, kt * 64, tile); }
    }
}
__device__ __forceinline__ void phase_scatter(const Args& a, LAS unsigned char* lds) {
    LAS int* base = (LAS int*)lds;
    LAS int* mybase = base + 16;
    LAS int* elist = base + 32;
    LAS int* slots = base + 32 + 512;
    const int* hist = (const int*)(a.ws + WS_HIST); const int* tok_e = (const int*)(a.ws + WS_TOKE);
    int* tok_s = (int*)(a.ws + WS_TOKS); int* meta = (int*)(a.ws + WS_META); int* tile_expert = meta + 64;
    const bf16* xf = (const bf16*)(a.ws + WS_XF); bf16* xs = (bf16*)(a.ws + WS_XS);
    const int tid = tidx(), lane = tid & 63, wave = tid >> 6, G = (int)gridDim.x;
    const int TPB = T / G, tb0 = blockIdx.x * TPB, NA = 2 * TPB;
    if (tid < 16) { int tot = 0, before = 0; for (int i = 0; i < G; ++i) { const int c = hist[i * 16 + tid]; tot += c; if (i < (int)blockIdx.x) before += c; } base[tid] = tot; mybase[tid] = before; }
    __syncthreads();
    if (tid == 0) { int off = 0;
        for (int e = 0; e < 16; ++e) { const int cnt = base[e], nt = (cnt + 255) >> 8;
            if (blockIdx.x == 0) { meta[e] = cnt; meta[16 + e] = off; for (int k = 0; k < nt; ++k) tile_expert[(off >> 8) + k] = e; }
            base[e] = off; off += nt * 256; }
        if (blockIdx.x == 0) { meta[32] = off; meta[33] = off >> 8; } }
    for (int i = tid; i < NA; i += 512) elist[i] = tok_e[tb0 * 2 + i];
    __syncthreads();
    for (int i = tid; i < NA; i += 512) { const int e = elist[i]; int rank = 0; for (int k = 0; k < i; ++k) rank += (elist[k] == e) ? 1 : 0;
        const int slot = base[e] + mybase[e] + rank; slots[i] = slot; tok_s[tb0 * 2 + i] = slot; }
    __syncthreads();
    for (int i = wave; i < NA; i += 8) { const int slot = slots[i], t = tb0 + (i >> 1);
        const v4u* src = (const v4u*)(xf + (size_t)t * D); v4u* dst = (v4u*)(xs + (size_t)slot * D);
        dst[lane] = src[lane]; dst[lane + 64] = src[lane + 64]; }
}
__device__ __forceinline__ void phase_moe1(const Args& a, LAS unsigned char* lds) {
    const int* meta = (const int*)(a.ws + WS_META);
    pg8::Gemm g{(const bf16*)(a.ws + WS_XS), (const bf16*)(a.ws + WS_WTGU), 0, 0, 1024};
    pg8::MoeOrder S; S.init(meta, meta + 64, (int)gridDim.x, (int)blockIdx.x);
    pg8::EpiAct E{(bf16*)(a.ws + WS_ACT)};
    pg8::gemm_phase<pg8::EpiAct, pg8::MoeOrder, true, true>(lds, g, S, E);
}
__device__ __forceinline__ void phase_moe2(const Args& a, LAS unsigned char* lds) {
    const int* meta = (const int*)(a.ws + WS_META);
    pg8::Gemm g{(const bf16*)(a.ws + WS_ACT), (const bf16*)(a.ws + WS_WTD), 0, 0, 512};
    pg8::MoeOrder S; S.init(meta, meta + 64, (int)gridDim.x, (int)blockIdx.x);
    pg8::EpiY E{(bf16*)(a.ws + WS_Y)};
    pg8::gemm_phase<pg8::EpiY, pg8::MoeOrder, true, true>(lds, g, S, E);
}
__device__ __forceinline__ void phase_final(const Args& a, LAS unsigned char* lds) {
    const float* mod = (const float*)(a.ws + WS_MOD); const float* now = a.in[19];
    const bf16* y = (const bf16*)(a.ws + WS_Y); const int* tok_s = (const int*)(a.ws + WS_TOKS); const float* tok_w = (const float*)(a.ws + WS_TOKW);
    float* out = a.out;
    const int tid = tidx(), lane = tid & 63, wave = tid >> 6;
    const int gw = blockIdx.x * 8 + wave, NGW = gridDim.x * 8;
    for (int t = gw; t < T; t += NGW) {
        const int b = t / SEQ, s1 = tok_s[t * 2], s2 = tok_s[t * 2 + 1];
        const float w1 = tok_w[t * 2], w2 = tok_w[t * 2 + 1];
        float4 o[4]; float ss = 0.f;
#pragma unroll
        for (int j = 0; j < 4; ++j) { const int k = 4 * lane + 256 * j;
            const float4 hv = *(const float4*)(out + (size_t)t * D + k), gf = *(const float4*)(mod + (size_t)b * 6144 + 5120 + k);
            const v2u a1 = *(const v2u*)(y + (size_t)s1 * D + k), a2 = *(const v2u*)(y + (size_t)s2 * D + k);
            float4 v;
            v.x = hv.x + gf.x * (w1 * bflo(a1.x) + w2 * bflo(a2.x)); v.y = hv.y + gf.y * (w1 * bfhi(a1.x) + w2 * bfhi(a2.x));
            v.z = hv.z + gf.z * (w1 * bflo(a1.y) + w2 * bflo(a2.y)); v.w = hv.w + gf.w * (w1 * bfhi(a1.y) + w2 * bfhi(a2.y));
            o[j] = v; ss += v.x * v.x + v.y * v.y + v.z * v.z + v.w * v.w; }
        ss = wave_sum(ss);
        const float rstd = rsqrtf(ss * (1.0f / D) + 1e-6f);
#pragma unroll
        for (int j = 0; j < 4; ++j) { const int k = 4 * lane + 256 * j; const float4 nwv = *(const float4*)(now + k);
            *(float4*)(out + (size_t)t * D + k) = make_float4(o[j].x * rstd * nwv.x, o[j].y * rstd * nwv.y, o[j].z * rstd * nwv.z, o[j].w * rstd * nwv.w); }
    }
}


__device__ __forceinline__ float quad_sum(float v) { v += __shfl_xor(v, 1); v += __shfl_xor(v, 2); return v; }
template <int BR>
__device__ __forceinline__ void scan_item(const Args& a, LAS unsigned char* lds, int b, int h, int half) {
    constexpr int TG = 8;
    LAS float* kf = (LAS float*)lds;
    LAS float* qf = kf + TG * 128;
    LAS float* vf = qf + TG * 128;
    LAS float* of = vf + TG * 128;
    LAS float* sc = of + TG * 128;
    bf16* proj = (bf16*)(a.ws + WS_PROJ);
    const float2* rope = (const float2*)(a.ws + WS_ROPE);
    const float* Gd = (const float*)(a.ws + WS_G); const float* Bd = (const float*)(a.ws + WS_BETA); const float* conv_w = a.in[6];
    float* ssq = (float*)(a.ws + WS_SSQ);
    const int tid = tidx(), v = tid >> 2, qd = tid & 3;
    const size_t row0 = (size_t)b * SEQ;
    const int qcol = (BR == 0 ? P_RQ : P_GQ) + h * 128, kcol = (BR == 0 ? P_RK : P_GK) + h * 128, vcol = (BR == 0 ? P_RV : P_GV) + h * 256 + half * 128;
    const float gamma = 1.0f - exp2f(-5.0f - (float)h);
    LAS float* hv = sc + TG * 2;
    float s[32];
#pragma unroll
    for (int d = 0; d < 32; ++d) s[d] = 0.f;
    for (int i = tid; i < 2 * 3 * 128; i += 512) hv[i] = 0.f;
    __syncthreads();
    for (int t0 = 0; t0 < SEQ; t0 += TG) {
        if (BR == 0) {
#pragma unroll
            for (int r = 0; r < 2; ++r) { const int idx = tid + 512 * r, isk = idx >> 9, tt = (idx >> 6) & 7, i = idx & 63, t = t0 + tt;
                const bf16* pr = proj + (row0 + t) * PW + (isk ? kcol : qcol);
                const float x1 = bf2f(pr[i]), x2 = bf2f(pr[i + 64]); const float2 cs = rope[t * 64 + i];
                const float sc_ = isk ? 0.08838834764831845f : 1.0f;
                LAS float* dst = (isk ? kf : qf) + tt * 128;
                dst[i] = (x1 * cs.x - x2 * cs.y) * sc_; dst[i + 64] = (x1 * cs.y + x2 * cs.x) * sc_; }
#pragma unroll
            for (int r = 0; r < 2; ++r) { const int idx = tid + 512 * r, tt = idx >> 7, c = idx & 127;
                vf[tt * 128 + c] = bf2f(proj[(row0 + t0 + tt) * PW + vcol + c]); }
        } else {
            if (tid < 384) {
                const bool isv = tid >= 256; const int u = isv ? tid - 256 : tid;
                const int tt = isv ? (u >> 4) : (u >> 5), part = isv ? (u & 15) : (u & 31), t = t0 + tt;
                const int col = isv ? (vcol + 8 * part) : (part < 16 ? qcol + 8 * part : kcol + 8 * (part - 16));
                const int cch = col - P_GQ;
                float acc[8];
#pragma unroll
                for (int j = 0; j < 8; ++j) acc[j] = 0.f;
#pragma unroll
                for (int i = 0; i < 4; ++i) { const int tr = t - 3 + i;
                    if (isv && tr < t0) {
                        const LAS float* hp = hv + (((t0 / TG) & 1) * 3 + (tr - (t0 - 3))) * 128 + 8 * part;
                        const float4 w0 = *(const float4*)(conv_w + i * 2048 + cch), w1 = *(const float4*)(conv_w + i * 2048 + cch + 4);
                        acc[0] += hp[0] * w0.x; acc[1] += hp[1] * w0.y; acc[2] += hp[2] * w0.z; acc[3] += hp[3] * w0.w;
                        acc[4] += hp[4] * w1.x; acc[5] += hp[5] * w1.y; acc[6] += hp[6] * w1.z; acc[7] += hp[7] * w1.w;
                    } else if (tr >= 0) { const v4u raw = *(const v4u*)(proj + (row0 + tr) * PW + col);
                        if (isv && i == 3 && tt >= TG - 3) { LAS float* hn = hv + ((((t0 / TG) + 1) & 1) * 3 + (tt - (TG - 3))) * 128 + 8 * part;
                            hn[0] = bflo(raw.x); hn[1] = bfhi(raw.x); hn[2] = bflo(raw.y); hn[3] = bfhi(raw.y); hn[4] = bflo(raw.z); hn[5] = bfhi(raw.z); hn[6] = bflo(raw.w); hn[7] = bfhi(raw.w); }
                        const float4 w0 = *(const float4*)(conv_w + i * 2048 + cch), w1 = *(const float4*)(conv_w + i * 2048 + cch + 4);
                        acc[0] += bflo(raw.x) * w0.x; acc[1] += bfhi(raw.x) * w0.y; acc[2] += bflo(raw.y) * w0.z; acc[3] += bfhi(raw.y) * w0.w;
                        acc[4] += bflo(raw.z) * w1.x; acc[5] += bfhi(raw.z) * w1.y; acc[6] += bflo(raw.w) * w1.z; acc[7] += bfhi(raw.w) * w1.w; } }
                float ss = 0.f;
#pragma unroll
                for (int j = 0; j < 8; ++j) { acc[j] = acc[j] * fsigmoid(acc[j]); ss += acc[j] * acc[j]; }
                if (!isv) {
                    ss += __shfl_xor(ss, 1); ss += __shfl_xor(ss, 2); ss += __shfl_xor(ss, 4); ss += __shfl_xor(ss, 8);
                    const float rn = rsqrtf(ss + 1e-6f) * (part < 16 ? 0.08838834764831845f : 1.0f);
                    LAS float* dst = (part < 16 ? qf : kf) + tt * 128 + 8 * (part & 15);
#pragma unroll
                    for (int j = 0; j < 8; ++j) dst[j] = acc[j] * rn;
                } else { LAS float* dst = vf + tt * 128 + 8 * part;
#pragma unroll
                    for (int j = 0; j < 8; ++j) dst[j] = acc[j]; }
            } else if (tid < 384 + TG) { const int tt = tid - 384; const size_t gi = (row0 + t0 + tt) * 4 + h; sc[tt * 2] = expf(Gd[gi]); sc[tt * 2 + 1] = Bd[gi]; }
        }
        __syncthreads();
#pragma unroll 1
        for (int tt = 0; tt < TG; ++tt) {
            const LAS f4* kp = (const LAS f4*)(kf + tt * 128 + 32 * qd); const LAS f4* qp = (const LAS f4*)(qf + tt * 128 + 32 * qd);
            const float vt = vf[tt * 128 + v];
            float o = 0.f;
            if (BR == 0) {
#pragma unroll
                for (int d4 = 0; d4 < 8; ++d4) { const f4 kk = kp[d4], qq = qp[d4];
                    s[4 * d4 + 0] = gamma * s[4 * d4 + 0] + kk.x * vt; o += qq.x * s[4 * d4 + 0];
                    s[4 * d4 + 1] = gamma * s[4 * d4 + 1] + kk.y * vt; o += qq.y * s[4 * d4 + 1];
                    s[4 * d4 + 2] = gamma * s[4 * d4 + 2] + kk.z * vt; o += qq.z * s[4 * d4 + 2];
                    s[4 * d4 + 3] = gamma * s[4 * d4 + 3] + kk.w * vt; o += qq.w * s[4 * d4 + 3]; }
            } else {
                const float al = sc[tt * 2], bt = sc[tt * 2 + 1];
                float dot = 0.f;
#pragma unroll
                for (int d4 = 0; d4 < 8; ++d4) { const f4 kk = kp[d4];
                    s[4 * d4 + 0] *= al; dot += s[4 * d4 + 0] * kk.x; s[4 * d4 + 1] *= al; dot += s[4 * d4 + 1] * kk.y;
                    s[4 * d4 + 2] *= al; dot += s[4 * d4 + 2] * kk.z; s[4 * d4 + 3] *= al; dot += s[4 * d4 + 3] * kk.w; }
                dot = quad_sum(dot);
                const float vn = bt * (vt - dot);
#pragma unroll
                for (int d4 = 0; d4 < 8; ++d4) { const f4 kk = kp[d4], qq = qp[d4];
                    s[4 * d4 + 0] += kk.x * vn; o += s[4 * d4 + 0] * qq.x; s[4 * d4 + 1] += kk.y * vn; o += s[4 * d4 + 1] * qq.y;
                    s[4 * d4 + 2] += kk.z * vn; o += s[4 * d4 + 2] * qq.z; s[4 * d4 + 3] += kk.w * vn; o += s[4 * d4 + 3] * qq.w; }
            }
            o = quad_sum(o);
            if (qd == 0) of[tt * 128 + v] = o;
        }
        __syncthreads();
        if (tid < 128) { const int tt = tid >> 4, c8 = (tid & 15) * 8;
            const LAS float* src = of + tt * 128 + c8; float ss = 0.f;
#pragma unroll
            for (int j = 0; j < 8; ++j) ss += src[j] * src[j];
            v4u w; w.x = pk2(src[0], src[1]); w.y = pk2(src[2], src[3]); w.z = pk2(src[4], src[5]); w.w = pk2(src[6], src[7]);
            *(v4u*)(proj + (row0 + t0 + tt) * PW + vcol + c8) = w;
            ss += __shfl_xor(ss, 1); ss += __shfl_xor(ss, 2); ss += __shfl_xor(ss, 4); ss += __shfl_xor(ss, 8);
            if ((tid & 15) == 0) ssq[(row0 + t0 + tt) * 16 + BR * 8 + h * 2 + half] = ss; }
        __syncthreads();
    }
}
__device__ __forceinline__ void phase_scan_simple(const Args& a, LAS unsigned char* lds) {
    for (int id = blockIdx.x; id < 256; id += gridDim.x) {
        const int br = (id >> 4) & 1, half = (id >> 3) & 1, bh = (id >> 5) * 8 + (id & 7), b = bh >> 2, h = bh & 3;
        if (br == 0) scan_item<0>(a, lds, b, h, half); else scan_item<1>(a, lds, b, h, half);
        __syncthreads();
    }
}
__device__ __forceinline__ void phase_merge(const Args& a, LAS unsigned char* lds) {
    const bf16* proj = (const bf16*)(a.ws + WS_PROJ); const float* ssq = (const float*)(a.ws + WS_SSQ); const float* gnw = a.in[9];
    bf16* merged = (bf16*)(a.ws + WS_MERGED);
    const int tid = tidx(), lane = tid & 63, wave = tid >> 6;
    const int gw = blockIdx.x * 8 + wave, NGW = gridDim.x * 8;
    for (int t = gw; t < T; t += NGW) {
        const int c0 = 16 * lane, h = lane >> 4;
        const float* sq = ssq + (size_t)t * 16;
        const float rr = rsqrtf((sq[h * 2] + sq[h * 2 + 1]) * (1.0f / 256.0f) + 1e-6f), rg = rsqrtf((sq[8 + h * 2] + sq[8 + h * 2 + 1]) * (1.0f / 256.0f) + 1e-6f);
        const bf16* pr = proj + (size_t)t * PW;
#pragma unroll
        for (int part = 0; part < 2; ++part) { const int c = c0 + 8 * part;
            const v4u orv = *(const v4u*)(pr + P_RV + c), ogv = *(const v4u*)(pr + P_GV + c), ga = *(const v4u*)(pr + P_GA + c), gb = *(const v4u*)(pr + P_GB + c);
            const float4 w0 = *(const float4*)(gnw + (c & 255)), w1 = *(const float4*)(gnw + (c & 255) + 4);
            float o[8];
            o[0] = bflo(ga.x) * bflo(orv.x) * rr + bflo(gb.x) * bflo(ogv.x) * rg * w0.x; o[1] = bfhi(ga.x) * bfhi(orv.x) * rr + bfhi(gb.x) * bfhi(ogv.x) * rg * w0.y;
            o[2] = bflo(ga.y) * bflo(orv.y) * rr + bflo(gb.y) * bflo(ogv.y) * rg * w0.z; o[3] = bfhi(ga.y) * bfhi(orv.y) * rr + bfhi(gb.y) * bfhi(ogv.y) * rg * w0.w;
            o[4] = bflo(ga.z) * bflo(orv.z) * rr + bflo(gb.z) * bflo(ogv.z) * rg * w1.x; o[5] = bfhi(ga.z) * bfhi(orv.z) * rr + bfhi(gb.z) * bfhi(ogv.z) * rg * w1.y;
            o[6] = bflo(ga.w) * bflo(orv.w) * rr + bflo(gb.w) * bflo(ogv.w) * rg * w1.z; o[7] = bfhi(ga.w) * bfhi(orv.w) * rr + bfhi(gb.w) * bfhi(ogv.w) * rg * w1.w;
            v4u w; w.x = pk2(o[0], o[1]); w.y = pk2(o[2], o[3]); w.z = pk2(o[4], o[5]); w.w = pk2(o[6], o[7]);
            *(v4u*)(merged + (size_t)t * 1024 + c) = w; }
    }
}

}
namespace {
typedef short s8v __attribute__((ext_vector_type(8)));
typedef short s4v __attribute__((ext_vector_type(4)));
typedef float f16v __attribute__((ext_vector_type(16)));
#define MFMA32(a, b, c) __builtin_amdgcn_mfma_f32_32x32x16_bf16((a), (b), (c), 0, 0, 0)
constexpr int PT128 = 136, PT64 = 72;
constexpr size_t DO_QH = 0, DO_KHT = 32 * MiB, DO_QK = 64 * MiB, DO_TU = 80 * MiB, DO_TW = 96 * MiB;
constexpr size_t WS_VH = WS_MERGED;
constexpr size_t WS_EG = 464 * MiB, WS_EGL = 465 * MiB;

typedef __bf16 bf2v __attribute__((ext_vector_type(2)));
typedef float f2v __attribute__((ext_vector_type(2)));
__device__ __forceinline__ unsigned cvtpk(float lo, float hi) { const f2v v = {lo, hi}; return __builtin_bit_cast(unsigned, __builtin_convertvector(v, bf2v)); }
__device__ __forceinline__ s8v ld_nat(const LAS bf16* base, int pitch, int row, int k0, int hh) { return *(const LAS s8v*)(base + row * pitch + k0 + 8 * hh); }
__device__ __forceinline__ s8v ld_perm(const LAS bf16* base, int pitch, int row, int k0, int hh) {
    const LAS bf16* p = base + row * pitch + k0 + 4 * hh;
    const s4v lo = *(const LAS s4v*)p, hi = *(const LAS s4v*)(p + 8);
    return __builtin_shufflevector(lo, hi, 0, 1, 2, 3, 4, 5, 6, 7);
}
template <int S> __device__ __forceinline__ s8v pack8(const f16v& x) {
    v4u p; p.x = cvtpk(x[8 * S + 0], x[8 * S + 1]); p.y = cvtpk(x[8 * S + 2], x[8 * S + 3]); p.z = cvtpk(x[8 * S + 4], x[8 * S + 5]); p.w = cvtpk(x[8 * S + 6], x[8 * S + 7]);
    return __builtin_bit_cast(s8v, p);
}
__device__ __forceinline__ f16v zero16() { f16v z;
#pragma unroll
    for (int i = 0; i < 16; ++i) z[i] = 0.f; return z; }

__device__ __forceinline__ void conv8(const bf16* proj, size_t rowbase, int tloc, int col, const float* conv_w, int cch, float (&acc)[8]) {
#pragma unroll
    for (int j = 0; j < 8; ++j) acc[j] = 0.f;
#pragma unroll
    for (int i = 0; i < 4; ++i) { const int tr = tloc - 3 + i;
        if (tr >= 0) { const v4u raw = *(const v4u*)(proj + (rowbase + tr) * PW + col);
            const float4 w0 = *(const float4*)(conv_w + i * 2048 + cch), w1 = *(const float4*)(conv_w + i * 2048 + cch + 4);
            acc[0] += bflo(raw.x) * w0.x; acc[1] += bfhi(raw.x) * w0.y; acc[2] += bflo(raw.y) * w0.z; acc[3] += bfhi(raw.y) * w0.w;
            acc[4] += bflo(raw.z) * w1.x; acc[5] += bfhi(raw.z) * w1.y; acc[6] += bflo(raw.w) * w1.z; acc[7] += bfhi(raw.w) * w1.w; } }
}

__device__ __forceinline__ void tile_store_rm(LAS bf16* buf, const f16v& v, int mt, int nt, int r32, int hh) {
#pragma unroll
    for (int rg = 0; rg < 16; ++rg) buf[(32 * mt + (rg & 3) + 8 * (rg >> 2) + 4 * hh) * PT64 + 32 * nt + r32] = (bf16)f2bf(v[rg]);
}
__device__ __forceinline__ void tile_store_tr(LAS bf16* buf, const f16v& v, int mt, int nt, int r32, int hh) {
#pragma unroll
    for (int g4 = 0; g4 < 4; ++g4) { v2u w; w.x = cvtpk(v[4 * g4 + 0], v[4 * g4 + 1]); w.y = cvtpk(v[4 * g4 + 2], v[4 * g4 + 3]); *(LAS v2u*)(buf + (32 * nt + r32) * PT64 + 32 * mt + 8 * g4 + 4 * hh) = w; }
}
__device__ __forceinline__ void phase_gprep(const Args& a, LAS unsigned char* lds) {
    LAS bf16* Kh = (LAS bf16*)lds;
    LAS bf16* Qh = (LAS bf16*)(lds + 17408);
    LAS bf16* Kht = (LAS bf16*)(lds + 34816);
    LAS float* bt = (LAS float*)(lds + 53248);
    LAS float* gc = bt + 64;
    LAS bf16* MB = (LAS bf16*)(lds + 53760);
    constexpr int MSZ = 64 * PT64;
    const bf16* proj = (const bf16*)(a.ws + WS_PROJ);
    const float* Gd = (const float*)(a.ws + WS_G); const float* Bd = (const float*)(a.ws + WS_BETA); const float* conv_w = a.in[6];
    unsigned char* dout = (unsigned char*)a.out;
    bf16* QHg = (bf16*)(dout + DO_QH); bf16* KHTg = (bf16*)(dout + DO_KHT); bf16* QKg = (bf16*)(dout + DO_QK); bf16* TUg = (bf16*)(dout + DO_TU); bf16* TWg = (bf16*)(dout + DO_TW);
    bf16* VHg = (bf16*)(a.ws + WS_VH); float* EGg = (float*)(a.ws + WS_EG); float* EGLg = (float*)(a.ws + WS_EGL);
    const int tid = tidx(), lane = tid & 63, wave = tid >> 6, r32 = lane & 31, hh = lane >> 5;
#pragma unroll 1
    for (int item = blockIdx.x; item < 2048; item += gridDim.x) {
        const int n = item & 31, bh = item >> 5, h = bh & 3, b = bh >> 2;
        const size_t rowb = (size_t)b * SEQ;
        const int tl0 = n * 64;
        for (int i = tid; i < 8 * MSZ / 8; i += 512) ((LAS v4u*)MB)[i] = (v4u){0u, 0u, 0u, 0u};
        if (wave == 0) {
            float g = Gd[(rowb + tl0 + lane) * 4 + h];
#pragma unroll
            for (int o = 1; o < 64; o <<= 1) { const float t = __shfl_up(g, o); if (lane >= o) g += t; }
            const float gl = __shfl(g, 63);
            bt[lane] = Bd[(rowb + tl0 + lane) * 4 + h]; gc[lane] = g;
            EGg[(size_t)item * 64 + lane] = expf(g); EGLg[(size_t)item * 64 + lane] = expf(gl - g);
        }
#pragma unroll 1
        for (int r = 0; r < 4; ++r) {
            const int u = tid + 512 * r, tt = u >> 5, part = u & 31, isk = part >> 4, c8 = 8 * (part & 15);
            const int col = (isk ? P_GK : P_GQ) + h * 128 + c8;
            float acc[8]; conv8(proj, rowb, tl0 + tt, col, conv_w, col - P_GQ, acc);
            float ss = 0.f;
#pragma unroll
            for (int j = 0; j < 8; ++j) { acc[j] = acc[j] * fsigmoid(acc[j]); ss += acc[j] * acc[j]; }
            ss += __shfl_xor(ss, 1); ss += __shfl_xor(ss, 2); ss += __shfl_xor(ss, 4); ss += __shfl_xor(ss, 8);
            const float rn = rsqrtf(ss + 1e-6f) * (isk ? 1.0f : 0.08838834764831845f);
            v4u w; w.x = pk2(acc[0] * rn, acc[1] * rn); w.y = pk2(acc[2] * rn, acc[3] * rn); w.z = pk2(acc[4] * rn, acc[5] * rn); w.w = pk2(acc[6] * rn, acc[7] * rn);
            if (!isk) { *(LAS v4u*)(Qh + tt * PT128 + c8) = w; *(v4u*)(QHg + ((size_t)item * 64 + tt) * 128 + c8) = w; }
            else { *(LAS v4u*)(Kh + tt * PT128 + c8) = w;
                Kht[(c8 + 0) * PT64 + tt] = (bf16)(w.x & 0xffff); Kht[(c8 + 1) * PT64 + tt] = (bf16)(w.x >> 16); Kht[(c8 + 2) * PT64 + tt] = (bf16)(w.y & 0xffff); Kht[(c8 + 3) * PT64 + tt] = (bf16)(w.y >> 16);
                Kht[(c8 + 4) * PT64 + tt] = (bf16)(w.z & 0xffff); Kht[(c8 + 5) * PT64 + tt] = (bf16)(w.z >> 16); Kht[(c8 + 6) * PT64 + tt] = (bf16)(w.w & 0xffff); Kht[(c8 + 7) * PT64 + tt] = (bf16)(w.w >> 16); }
        }
#pragma unroll 1
        for (int r = 0; r < 4; ++r) {
            const int u = tid + 512 * r, tt = u >> 5, c8 = 8 * (u & 31), col = P_GV + h * 256 + c8;
            float acc[8]; conv8(proj, rowb, tl0 + tt, col, conv_w, col - P_GQ, acc);
#pragma unroll
            for (int j = 0; j < 8; ++j) acc[j] = acc[j] * fsigmoid(acc[j]);
            v4u w; w.x = pk2(acc[0], acc[1]); w.y = pk2(acc[2], acc[3]); w.z = pk2(acc[4], acc[5]); w.w = pk2(acc[6], acc[7]);
            *(v4u*)(VHg + (rowb + tl0 + tt) * 1024 + h * 256 + c8) = w;
        }
        __syncthreads();
        f16v X = zero16();
        const int q3 = (wave < 3) ? wave : wave - 3, mt = (q3 >= 1) ? 1 : 0, nt = (q3 == 2) ? 1 : 0;
        if (wave < 3) {
            f16v acc = zero16();
#pragma unroll
            for (int ks = 0; ks < 8; ++ks) acc = MFMA32(ld_nat(Kh, PT128, 32 * mt + r32, 16 * ks, hh), ld_nat(Kh, PT128, 32 * nt + r32, 16 * ks, hh), acc);
            const int bcol = 32 * nt + r32; const float gcb = gc[bcol];
            f16v N_;
#pragma unroll
            for (int rg = 0; rg < 16; ++rg) { const int ar = 32 * mt + (rg & 3) + 8 * (rg >> 2) + 4 * hh;
                N_[rg] = (ar > bcol) ? -bt[ar] * acc[rg] * expf(gc[ar] - gcb) : 0.f; X[rg] = N_[rg] + ((ar == bcol) ? 1.0f : 0.0f); }
            tile_store_rm(MB + 0 * MSZ, N_, mt, nt, r32, hh); tile_store_tr(MB + 1 * MSZ, N_, mt, nt, r32, hh);
            tile_store_rm(MB + 2 * MSZ, X, mt, nt, r32, hh);
        } else if (wave < 6) {
            const int jt = (wave == 5) ? 1 : 0, itile = (wave >= 4) ? 1 : 0;
            f16v acc = zero16();
#pragma unroll
            for (int ks = 0; ks < 8; ++ks) acc = MFMA32(ld_nat(Kh, PT128, 32 * jt + r32, 16 * ks, hh), ld_nat(Qh, PT128, 32 * itile + r32, 16 * ks, hh), acc);
            const int icol = 32 * itile + r32; const float gci = gc[icol];
#pragma unroll
            for (int g4 = 0; g4 < 4; ++g4) { const int j0 = 32 * jt + 8 * g4 + 4 * hh; float v[4];
#pragma unroll
                for (int j = 0; j < 4; ++j) { const int jr = j0 + j; v[j] = (icol >= jr) ? acc[4 * g4 + j] * expf(gci - gc[jr]) : 0.f; }
                v2u w; w.x = pk2(v[0], v[1]); w.y = pk2(v[2], v[3]); *(v2u*)(QKg + ((size_t)item * 64 + icol) * 64 + j0) = w; }
        } else if (wave == 6) {
            for (int i = lane; i < 32 * 4; i += 64) { const int row = i >> 2, c = i & 3; *(v4u*)(QKg + ((size_t)item * 64 + row) * 64 + 32 + 8 * c) = (v4u){0u, 0u, 0u, 0u}; }
        }
#pragma unroll
        for (int r = 0; r < 2; ++r) { const int p = tid + 512 * r, row = p >> 3, c = p & 7;
            *(v4u*)(KHTg + ((size_t)item * 128 + row) * 64 + 8 * c) = *(const LAS v4u*)(Kht + row * PT64 + 8 * c); }
        __syncthreads();
        if (wave >= 3 && wave < 6) {
            f16v acc = zero16();
#pragma unroll
            for (int ks = 0; ks < 4; ++ks) acc = MFMA32(ld_nat(MB + 0 * MSZ, PT64, 32 * mt + r32, 16 * ks, hh), ld_nat(MB + 1 * MSZ, PT64, 32 * nt + r32, 16 * ks, hh), acc);
            tile_store_rm(MB + 3 * MSZ, acc, mt, nt, r32, hh); tile_store_tr(MB + 4 * MSZ, acc, mt, nt, r32, hh);
        }
        __syncthreads();
#pragma unroll 1
        for (int r = 1; r <= 5; ++r) {
            const int so = ((r - 1) & 1) * 3, sn = (r & 1) * 3;
            LAS bf16* Xo = MB + (2 + so) * MSZ; LAS bf16* Po = MB + (3 + so) * MSZ; LAS bf16* Qo = MB + (4 + so) * MSZ;
            LAS bf16* Xn = MB + (2 + sn) * MSZ; LAS bf16* Pn = MB + (3 + sn) * MSZ; LAS bf16* Qn = MB + (4 + sn) * MSZ;
            if (wave < 3) {
#pragma unroll
                for (int ks = 0; ks < 4; ++ks) X = MFMA32(ld_nat(Xo, PT64, 32 * mt + r32, 16 * ks, hh), ld_nat(Qo, PT64, 32 * nt + r32, 16 * ks, hh), X);
                if (r < 5) tile_store_rm(Xn, X, mt, nt, r32, hh);
            } else if (wave < 6 && r < 5) {
                f16v acc = zero16();
#pragma unroll
                for (int ks = 0; ks < 4; ++ks) acc = MFMA32(ld_nat(Po, PT64, 32 * mt + r32, 16 * ks, hh), ld_nat(Qo, PT64, 32 * nt + r32, 16 * ks, hh), acc);
                tile_store_rm(Pn, acc, mt, nt, r32, hh); tile_store_tr(Qn, acc, mt, nt, r32, hh);
            }
            __syncthreads();
        }
        if (wave < 3) {
            const int jcol = 32 * nt + r32; const float bj = bt[jcol], ej = expf(gc[jcol]);
            f16v U_, W_;
#pragma unroll
            for (int rg = 0; rg < 16; ++rg) { U_[rg] = X[rg] * bj; W_[rg] = U_[rg] * ej; }
            tile_store_rm(MB + 0 * MSZ, U_, mt, nt, r32, hh); tile_store_rm(MB + 3 * MSZ, W_, mt, nt, r32, hh);
        }
        __syncthreads();
        { const int row = tid >> 3, c = tid & 7; const size_t go = ((size_t)item * 64 + row) * 64 + 8 * c;
          *(v4u*)(TUg + go) = *(const LAS v4u*)(MB + 0 * MSZ + row * PT64 + 8 * c); *(v4u*)(TWg + go) = *(const LAS v4u*)(MB + 3 * MSZ + row * PT64 + 8 * c); }
        __syncthreads();
    }
}

template <int BR>
__device__ __forceinline__ void scan_mfma_item(const Args& a, LAS unsigned char* lds, int b, int h) {
    LAS bf16* Tu = (LAS bf16*)lds; LAS bf16* Tw = (LAS bf16*)(lds + 9216); LAS bf16* QK = (LAS bf16*)(lds + 18432); LAS bf16* Qh = (LAS bf16*)(lds + 27648);
    LAS bf16* Kht = (LAS bf16*)(lds + 45056); LAS bf16* nW = (LAS bf16*)(lds + 63488);
    LAS bf16* Qd = (LAS bf16*)lds; LAS bf16* Kr = (LAS bf16*)(lds + 17408); LAS bf16* Kdt = (LAS bf16*)(lds + 34816); LAS bf16* Pm = (LAS bf16*)(lds + 53248);
    LAS float* egs = (LAS float*)(lds + 117760); LAS float* egls = egs + 64;
    bf16* proj = (bf16*)(a.ws + WS_PROJ);
    const int tid = tidx(), lane = tid & 63, wave = tid >> 6, r32 = lane & 31, hh = lane >> 5;
    LAS bf16* Vt = (LAS bf16*)(lds + 80896 + wave * 4608);
    const size_t rowb = (size_t)b * SEQ;
    const unsigned char* dout = (const unsigned char*)a.out;
    const bf16* QHg = (const bf16*)(dout + DO_QH); const bf16* KHTg = (const bf16*)(dout + DO_KHT); const bf16* QKg = (const bf16*)(dout + DO_QK);
    const bf16* TUg = (const bf16*)(dout + DO_TU); const bf16* TWg = (const bf16*)(dout + DO_TW);
    const bf16* VHg = (const bf16*)(a.ws + WS_VH); const float* EGg = (const float*)(a.ws + WS_EG); const float* EGLg = (const float*)(a.ws + WS_EGL);
    const float2* rope = (const float2*)(a.ws + WS_ROPE);
    const float lgam = logf(1.0f - exp2f(-5.0f - (float)h));
    f16v S[4];
#pragma unroll
    for (int dt = 0; dt < 4; ++dt) S[dt] = zero16();
#pragma unroll 1
    for (int n = 0; n < 32; ++n) {
        const int tl0 = n * 64, item = (b * 4 + h) * 32 + n;
        if (BR == 1) {
            { const int row = tid >> 3, c = tid & 7; const size_t go = ((size_t)item * 64 + row) * 64 + 8 * c;
              *(LAS v4u*)(Tu + row * PT64 + 8 * c) = *(const v4u*)(TUg + go); *(LAS v4u*)(Tw + row * PT64 + 8 * c) = *(const v4u*)(TWg + go); *(LAS v4u*)(QK + row * PT64 + 8 * c) = *(const v4u*)(QKg + go); }
#pragma unroll
            for (int r = 0; r < 2; ++r) { const int p = tid + 512 * r;
                { const int row = p >> 4, c = p & 15; *(LAS v4u*)(Qh + row * PT128 + 8 * c) = *(const v4u*)(QHg + ((size_t)item * 64 + row) * 128 + 8 * c); }
                { const int row = p >> 3, c = p & 7; *(LAS v4u*)(Kht + row * PT64 + 8 * c) = *(const v4u*)(KHTg + ((size_t)item * 128 + row) * 64 + 8 * c); } }
            if (tid < 64) egs[tid] = EGg[(size_t)item * 64 + tid]; else if (tid < 128) egls[tid - 64] = EGLg[(size_t)item * 64 + tid - 64];
        } else {
#pragma unroll
            for (int r = 0; r < 2; ++r) {
                const int u = tid + 512 * r, tt = u >> 4, isk = (u >> 3) & 1, i0 = 8 * (u & 7), t = tl0 + tt;
                const bf16* pr = proj + (rowb + t) * PW + (isk ? P_RK : P_RQ) + h * 128;
                const v4u x1 = *(const v4u*)(pr + i0), x2 = *(const v4u*)(pr + 64 + i0);
                const float4* rp = (const float4*)(rope + t * 64 + i0);
                const float4 c0 = rp[0], c1 = rp[1], c2 = rp[2], c3 = rp[3];
                const float a1[8] = {bflo(x1.x), bfhi(x1.x), bflo(x1.y), bfhi(x1.y), bflo(x1.z), bfhi(x1.z), bflo(x1.w), bfhi(x1.w)};
                const float a2[8] = {bflo(x2.x), bfhi(x2.x), bflo(x2.y), bfhi(x2.y), bflo(x2.z), bfhi(x2.z), bflo(x2.w), bfhi(x2.w)};
                const float cs[8] = {c0.x, c0.z, c1.x, c1.z, c2.x, c2.z, c3.x, c3.z}, sn[8] = {c0.y, c0.w, c1.y, c1.w, c2.y, c2.w, c3.y, c3.w};
                const float sc = isk ? 0.08838834764831845f : expf((float)(tt + 1) * lgam);
                float o1[8], o2[8];
#pragma unroll
                for (int j = 0; j < 8; ++j) { o1[j] = (a1[j] * cs[j] - a2[j] * sn[j]) * sc; o2[j] = (a1[j] * sn[j] + a2[j] * cs[j]) * sc; }
                v4u w1, w2; w1.x = pk2(o1[0], o1[1]); w1.y = pk2(o1[2], o1[3]); w1.z = pk2(o1[4], o1[5]); w1.w = pk2(o1[6], o1[7]);
                w2.x = pk2(o2[0], o2[1]); w2.y = pk2(o2[2], o2[3]); w2.z = pk2(o2[4], o2[5]); w2.w = pk2(o2[6], o2[7]);
                LAS bf16* dst = (isk ? Kr : Qd) + tt * PT128;
                *(LAS v4u*)(dst + i0) = w1; *(LAS v4u*)(dst + 64 + i0) = w2;
                if (isk) { const float kd = expf((float)(63 - tt) * lgam);
#pragma unroll
                    for (int j = 0; j < 8; ++j) { Kdt[(i0 + j) * PT64 + tt] = (bf16)f2bf(o1[j] * kd); Kdt[(64 + i0 + j) * PT64 + tt] = (bf16)f2bf(o2[j] * kd); } }
            }
        }
        {
            const bf16* vsrc = (BR == 1) ? (VHg + (rowb + tl0 + lane) * 1024 + h * 256 + 32 * wave) : (proj + (rowb + tl0 + lane) * PW + P_RV + h * 256 + 32 * wave);
            const v4u q0 = ((const v4u*)vsrc)[0], q1 = ((const v4u*)vsrc)[1], q2 = ((const v4u*)vsrc)[2], q3 = ((const v4u*)vsrc)[3];
            const unsigned wv[16] = {q0.x, q0.y, q0.z, q0.w, q1.x, q1.y, q1.z, q1.w, q2.x, q2.y, q2.z, q2.w, q3.x, q3.y, q3.z, q3.w};
#pragma unroll
            for (int j = 0; j < 16; ++j) { Vt[(2 * j) * PT64 + lane] = (bf16)(wv[j] & 0xffff); Vt[(2 * j + 1) * PT64 + lane] = (bf16)(wv[j] >> 16); }
        }
        __syncthreads();
        if (BR == 1) {
            const int dt = wave >> 1, itile = wave & 1;
            f16v acc = zero16();
#pragma unroll
            for (int ks = 0; ks < 4; ++ks) acc = MFMA32(ld_nat(Kht, PT64, 32 * dt + r32, 16 * ks, hh), ld_nat(Tw, PT64, 32 * itile + r32, 16 * ks, hh), acc);
            const int icol = 32 * itile + r32;
#pragma unroll
            for (int g4 = 0; g4 < 4; ++g4) { const int d0 = 32 * dt + 8 * g4 + 4 * hh;
                v2u w; w.x = cvtpk(-acc[4 * g4 + 0], -acc[4 * g4 + 1]); w.y = cvtpk(-acc[4 * g4 + 2], -acc[4 * g4 + 3]); *(LAS v2u*)(nW + icol * PT128 + d0) = w; }
        } else if (wave < 3) {
            const int jt = (wave == 2) ? 1 : 0, itile = (wave >= 1) ? 1 : 0;
            f16v acc = zero16();
#pragma unroll
            for (int ks = 0; ks < 8; ++ks) acc = MFMA32(ld_nat(Kr, PT128, 32 * jt + r32, 16 * ks, hh), ld_nat(Qd, PT128, 32 * itile + r32, 16 * ks, hh), acc);
            const int icol = 32 * itile + r32;
#pragma unroll
            for (int g4 = 0; g4 < 4; ++g4) { const int j0 = 32 * jt + 8 * g4 + 4 * hh; float v[4];
#pragma unroll
                for (int j = 0; j < 4; ++j) { const int jr = j0 + j; v[j] = (icol >= jr) ? acc[4 * g4 + j] * expf(-(float)(jr + 1) * lgam) : 0.f; }
                v2u w; w.x = cvtpk(v[0], v[1]); w.y = cvtpk(v[2], v[3]); *(LAS v2u*)(Pm + icol * PT64 + j0) = w; }
        }
        __syncthreads();
        s8v Sp[4][2];
#pragma unroll
        for (int dt = 0; dt < 4; ++dt) { Sp[dt][0] = pack8<0>(S[dt]); Sp[dt][1] = pack8<1>(S[dt]); }
        bf16* orow = proj + (rowb + tl0) * PW + (BR == 1 ? P_GV : P_RV) + h * 256 + 32 * wave + r32;
        if (BR == 1) {
            s8v vb[2][2], vs[2][2];
#pragma unroll
            for (int it = 0; it < 2; ++it) {
                f16v acc = zero16();
#pragma unroll
                for (int ks = 0; ks < 4; ++ks) acc = MFMA32(ld_nat(Tu, PT64, 32 * it + r32, 16 * ks, hh), ld_nat(Vt, PT64, r32, 16 * ks, hh), acc);
#pragma unroll
                for (int dt = 0; dt < 4; ++dt) { acc = MFMA32(ld_perm(nW, PT128, 32 * it + r32, 32 * dt, hh), Sp[dt][0], acc); acc = MFMA32(ld_perm(nW, PT128, 32 * it + r32, 32 * dt + 16, hh), Sp[dt][1], acc); }
                vb[it][0] = pack8<0>(acc); vb[it][1] = pack8<1>(acc);
#pragma unroll
                for (int g4 = 0; g4 < 4; ++g4) { const f4 e = *(const LAS f4*)(egls + 32 * it + 8 * g4 + 4 * hh); acc[4 * g4 + 0] *= e.x; acc[4 * g4 + 1] *= e.y; acc[4 * g4 + 2] *= e.z; acc[4 * g4 + 3] *= e.w; }
                vs[it][0] = pack8<0>(acc); vs[it][1] = pack8<1>(acc);
            }
#pragma unroll
            for (int it = 0; it < 2; ++it) {
                f16v acc = zero16();
#pragma unroll
                for (int dt = 0; dt < 4; ++dt) { acc = MFMA32(ld_perm(Qh, PT128, 32 * it + r32, 32 * dt, hh), Sp[dt][0], acc); acc = MFMA32(ld_perm(Qh, PT128, 32 * it + r32, 32 * dt + 16, hh), Sp[dt][1], acc); }
#pragma unroll
                for (int g4 = 0; g4 < 4; ++g4) { const f4 e = *(const LAS f4*)(egs + 32 * it + 8 * g4 + 4 * hh); acc[4 * g4 + 0] *= e.x; acc[4 * g4 + 1] *= e.y; acc[4 * g4 + 2] *= e.z; acc[4 * g4 + 3] *= e.w; }
#pragma unroll
                for (int jt = 0; jt <= it; ++jt) { acc = MFMA32(ld_perm(QK, PT64, 32 * it + r32, 32 * jt, hh), vb[jt][0], acc); acc = MFMA32(ld_perm(QK, PT64, 32 * it + r32, 32 * jt + 16, hh), vb[jt][1], acc); }
#pragma unroll
                for (int rg = 0; rg < 16; ++rg) { const int row = 32 * it + (rg & 3) + 8 * (rg >> 2) + 4 * hh; orow[(size_t)row * PW] = (bf16)f2bf(acc[rg]); }
            }
            const float egl_ = egs[63];
#pragma unroll
            for (int dt = 0; dt < 4; ++dt) {
#pragma unroll
                for (int i = 0; i < 16; ++i) S[dt][i] *= egl_;
#pragma unroll
                for (int it = 0; it < 2; ++it) { S[dt] = MFMA32(ld_perm(Kht, PT64, 32 * dt + r32, 32 * it, hh), vs[it][0], S[dt]); S[dt] = MFMA32(ld_perm(Kht, PT64, 32 * dt + r32, 32 * it + 16, hh), vs[it][1], S[dt]); }
            }
        } else {
#pragma unroll
            for (int it = 0; it < 2; ++it) {
                f16v acc = zero16();
#pragma unroll
                for (int dt = 0; dt < 4; ++dt) { acc = MFMA32(ld_perm(Qd, PT128, 32 * it + r32, 32 * dt, hh), Sp[dt][0], acc); acc = MFMA32(ld_perm(Qd, PT128, 32 * it + r32, 32 * dt + 16, hh), Sp[dt][1], acc); }
#pragma unroll
                for (int jt = 0; jt <= it; ++jt)
#pragma unroll
                    for (int ks = 0; ks < 2; ++ks) acc = MFMA32(ld_nat(Pm, PT64, 32 * it + r32, 32 * jt + 16 * ks, hh), ld_nat(Vt, PT64, r32, 32 * jt + 16 * ks, hh), acc);
#pragma unroll
                for (int rg = 0; rg < 16; ++rg) { const int row = 32 * it + (rg & 3) + 8 * (rg >> 2) + 4 * hh; orow[(size_t)row * PW] = (bf16)f2bf(acc[rg]); }
            }
            const float g64 = expf(64.0f * lgam);
#pragma unroll
            for (int dt = 0; dt < 4; ++dt) {
#pragma unroll
                for (int i = 0; i < 16; ++i) S[dt][i] *= g64;
#pragma unroll
                for (int ks = 0; ks < 4; ++ks) S[dt] = MFMA32(ld_nat(Kdt, PT64, 32 * dt + r32, 16 * ks, hh), ld_nat(Vt, PT64, r32, 16 * ks, hh), S[dt]);
            }
        }
        __syncthreads();
    }
}
__device__ __forceinline__ void phase_scan_mfma(const Args& a, LAS unsigned char* lds) {
    for (int id = blockIdx.x; id < 128; id += gridDim.x) {
        const int br = id & 1, bh = id >> 1, b = bh >> 2, h = bh & 3;
        if (br == 0) scan_mfma_item<0>(a, lds, b, h); else scan_mfma_item<1>(a, lds, b, h);
    }
}
__device__ __forceinline__ void phase_merge2(const Args& a, LAS unsigned char* lds) {
    const bf16* proj = (const bf16*)(a.ws + WS_PROJ); const float* gnw = a.in[9];
    bf16* merged = (bf16*)(a.ws + WS_MERGED);
    const int tid = tidx(), lane = tid & 63, wave = tid >> 6;
    const int gw = blockIdx.x * 8 + wave, NGW = gridDim.x * 8;
    for (int t = gw; t < T; t += NGW) {
        const int c0 = 16 * lane;
        const bf16* pr = proj + (size_t)t * PW;
        v4u orv[2], ogv[2]; float sr = 0.f, sg = 0.f;
#pragma unroll
        for (int part = 0; part < 2; ++part) { orv[part] = *(const v4u*)(pr + P_RV + c0 + 8 * part); ogv[part] = *(const v4u*)(pr + P_GV + c0 + 8 * part);
            const unsigned ru[4] = {orv[part].x, orv[part].y, orv[part].z, orv[part].w}, gu[4] = {ogv[part].x, ogv[part].y, ogv[part].z, ogv[part].w};
#pragma unroll
            for (int j = 0; j < 4; ++j) { sr += bflo(ru[j]) * bflo(ru[j]) + bfhi(ru[j]) * bfhi(ru[j]); sg += bflo(gu[j]) * bflo(gu[j]) + bfhi(gu[j]) * bfhi(gu[j]); } }
        sr += __shfl_xor(sr, 1); sr += __shfl_xor(sr, 2); sr += __shfl_xor(sr, 4); sr += __shfl_xor(sr, 8);
        sg += __shfl_xor(sg, 1); sg += __shfl_xor(sg, 2); sg += __shfl_xor(sg, 4); sg += __shfl_xor(sg, 8);
        const float rr = rsqrtf(sr * (1.0f / 256.0f) + 1e-6f), rg = rsqrtf(sg * (1.0f / 256.0f) + 1e-6f);
#pragma unroll
        for (int part = 0; part < 2; ++part) { const int c = c0 + 8 * part;
            const v4u ga = *(const v4u*)(pr + P_GA + c), gb = *(const v4u*)(pr + P_GB + c);
            const float4 w0 = *(const float4*)(gnw + (c & 255)), w1 = *(const float4*)(gnw + (c & 255) + 4);
            const v4u ov = orv[part], gv = ogv[part];
            float o[8];
            o[0] = bflo(ga.x) * bflo(ov.x) * rr + bflo(gb.x) * bflo(gv.x) * rg * w0.x; o[1] = bfhi(ga.x) * bfhi(ov.x) * rr + bfhi(gb.x) * bfhi(gv.x) * rg * w0.y;
            o[2] = bflo(ga.y) * bflo(ov.y) * rr + bflo(gb.y) * bflo(gv.y) * rg * w0.z; o[3] = bfhi(ga.y) * bfhi(ov.y) * rr + bfhi(gb.y) * bfhi(gv.y) * rg * w0.w;
            o[4] = bflo(ga.z) * bflo(ov.z) * rr + bflo(gb.z) * bflo(gv.z) * rg * w1.x; o[5] = bfhi(ga.z) * bfhi(ov.z) * rr + bfhi(gb.z) * bfhi(gv.z) * rg * w1.y;
            o[6] = bflo(ga.w) * bflo(ov.w) * rr + bflo(gb.w) * bflo(gv.w) * rg * w1.z; o[7] = bfhi(ga.w) * bfhi(ov.w) * rr + bfhi(gb.w) * bfhi(gv.w) * rg * w1.w;
            v4u w; w.x = pk2(o[0], o[1]); w.y = pk2(o[2], o[3]); w.z = pk2(o[4], o[5]); w.w = pk2(o[6], o[7]);
            *(v4u*)(merged + (size_t)t * 1024 + c) = w; }
    }
}
}
namespace {
template <int MODE> __device__ __forceinline__ void phase_scan_mix(const Args& a, LAS unsigned char* lds) {
    const int id = blockIdx.x;
    if (id < 64) { const int b = id >> 2, h = id & 3; if (MODE == 1) scan_mfma_item<0>(a, lds, b, h); else scan_mfma_item<1>(a, lds, b, h); }
    else if (id < 192) { const int q = id - 64, half = q & 1, bh = q >> 1, b = bh >> 2, h = bh & 3; if (MODE == 1) scan_item<1>(a, lds, b, h, half); else scan_item<0>(a, lds, b, h, half); }
}
template <int PH> __device__ __forceinline__ void run_phase(const Args& a, LAS unsigned char* lds) {
    if (PH == 0) phase_mod(a, lds);
    else if (PH == 1) { phase_norm1(a, lds); __syncthreads(); phase_convert_in(a, lds); }
    else if (PH == 2) phase_inproj(a, lds);
    else if (PH == 3) phase_gprep(a, lds);
    else if (PH == 4) phase_scan_mfma(a, lds);
    else if (PH == 5) phase_merge2(a, lds);
    else if (PH == 6) phase_outproj(a, lds);
    else if (PH == 7) { phase_route(a, lds); __syncthreads(); phase_convert_experts(a, lds); }
    else if (PH == 8) phase_scatter(a, lds);
    else if (PH == 9) phase_moe1(a, lds);
    else if (PH == 10) phase_moe2(a, lds);
    else if (PH == 11) phase_final(a, lds);
    else if (PH == 21) phase_scan_mix<1>(a, lds);
    else if (PH == 22) phase_scan_mix<2>(a, lds);
}
template <int PH> __global__ void __launch_bounds__(512, 2) k_phase(Args a) {
    extern __shared__ __attribute__((aligned(16))) unsigned char smem[];
    run_phase<PH>(a, (LAS unsigned char*)smem);
}
}
namespace {
__global__ void __launch_bounds__(512, 2) k_mega(Args a) {
    extern __shared__ __attribute__((aligned(16))) unsigned char smem[];
    LAS unsigned char* lds = (LAS unsigned char*)smem;
    cg::grid_group grid = cg::this_grid();
    run_phase<0>(a, lds); grid.sync();
    run_phase<1>(a, lds); grid.sync();
    run_phase<2>(a, lds); grid.sync();
    run_phase<3>(a, lds); grid.sync();
    run_phase<4>(a, lds); grid.sync();
    run_phase<5>(a, lds); grid.sync();
    run_phase<6>(a, lds); grid.sync();
    run_phase<7>(a, lds); grid.sync();
    run_phase<8>(a, lds); grid.sync();
    run_phase<9>(a, lds); grid.sync();
    run_phase<10>(a, lds); grid.sync();
    run_phase<11>(a, lds);
}
}
extern "C" void kernel_launch(void* const* d_in, const int* in_sizes, int n_in, void* d_out, int out_size, void* d_ws, size_t ws_size, hipStream_t stream) {
    if (ws_size < 512 * MiB) return;
    static int grid_blocks = 0;
    if (!grid_blocks) {
        int dev = 0, cus = 0, per_cu = 0;
        (void)hipGetDevice(&dev);
        (void)hipDeviceGetAttribute(&cus, hipDeviceAttributeMultiprocessorCount, dev);
        (void)hipFuncSetAttribute((const void*)k_mega, hipFuncAttributeMaxDynamicSharedMemorySize, LDS_BYTES);
        (void)hipOccupancyMaxActiveBlocksPerMultiprocessor(&per_cu, (const void*)k_mega, 512, LDS_BYTES);
        if (per_cu < 1) per_cu = 1;
        grid_blocks = cus * per_cu;
        if (grid_blocks > 256) grid_blocks = 256;
    }
    Args a{};
    for (int i = 0; i < 20; ++i) a.in[i] = (const float*)d_in[i];
    a.out = (float*)d_out; a.ws = (unsigned char*)d_ws;
    void* args[] = {&a};
    (void)hipLaunchCooperativeKernel((const void*)k_mega, dim3(grid_blocks), dim3(512), args, LDS_BYTES, stream);
}
```

```cpp
#include <hip/hip_runtime.h>
#include <hip/hip_cooperative_groups.h>
#include <stdint.h>
namespace cg = cooperative_groups;

#define LAS __attribute__((address_space(3)))
typedef unsigned short bf16;
typedef unsigned v4u __attribute__((ext_vector_type(4)));
typedef unsigned v2u __attribute__((ext_vector_type(2)));
typedef float f4 __attribute__((ext_vector_type(4)));

namespace {
constexpr int D = 1024, NB = 16, SEQ = 2048, T = NB * SEQ, DIN = 8200;
constexpr int NH = 4, DK = 128, DV = 256;
constexpr int C_RQ = 0, C_RK = 512, C_RV = 1024, C_RG = 2048, C_GQ = 3072, C_GK = 3584, C_GV = 4096, C_GZ = 5120,
              C_GA = 6144, C_GB = 6148, C_GTA = 6152, C_GTB = 7176;
constexpr int NE = 16, FF = 512;
constexpr int MAXSLOT = 2 * T + NE * 256;
constexpr int PW = 6144, P_RQ = 0, P_RK = 512, P_RV = 1024, P_GQ = 2048, P_GK = 2560, P_GV = 3072, P_GA = 4096, P_GB = 5120;

constexpr size_t MiB = 1u << 20;
constexpr size_t WS_PROJ = 0;
constexpr size_t WS_MERGED = 384 * MiB;
constexpr size_t WS_WTOUT = 448 * MiB;
constexpr size_t WS_WTGU = 0;
constexpr size_t WS_WTD = 32 * MiB;
constexpr size_t WS_XF = 48 * MiB;
constexpr size_t WS_XS = 112 * MiB;
constexpr size_t WS_ACT = 248 * MiB;
constexpr size_t WS_Y = 316 * MiB;
constexpr size_t WS_CTL = 456 * MiB;
constexpr size_t WS_MOD = 457 * MiB;
constexpr size_t WS_ROPE = 458 * MiB;
constexpr size_t WS_BETA = 459 * MiB;
constexpr size_t WS_G = 459 * MiB + 512 * 1024;
constexpr size_t WS_SSQ = 460 * MiB;
constexpr size_t WS_TOKE = 462 * MiB;
constexpr size_t WS_TOKW = 462 * MiB + 256 * 1024;
constexpr size_t WS_TOKS = 462 * MiB + 512 * 1024;
constexpr size_t WS_HIST = 463 * MiB;
constexpr size_t WS_META = 463 * MiB + 64 * 1024;
constexpr size_t WS_NEED = 464 * MiB;
constexpr size_t DO_XM = 0;
constexpr size_t DO_WTIN = 64 * MiB;
constexpr int LDS_BYTES = 147456;

__device__ __forceinline__ float silu_f(float x) { return x / (1.0f + expf(-x)); }
__device__ __forceinline__ float sigmoid_f(float x) { return 1.0f / (1.0f + expf(-x)); }
__device__ __forceinline__ float fsigmoid(float x) { return __builtin_amdgcn_rcpf(1.0f + __expf(-x)); }
__device__ __forceinline__ float wave_sum(float v) {
#pragma unroll
    for (int o = 32; o >= 1; o >>= 1) v += __shfl_xor(v, o);
    return v;
}
__device__ __forceinline__ unsigned f2bf(float f) { unsigned u = __float_as_uint(f); return (u + 0x7fffu + ((u >> 16) & 1u)) >> 16; }
__device__ __forceinline__ unsigned pk2(float lo, float hi) { return f2bf(lo) | (f2bf(hi) << 16); }
__device__ __forceinline__ float bf2f(unsigned short b) { return __uint_as_float(((unsigned)b) << 16); }
__device__ __forceinline__ float bflo(unsigned w) { return __uint_as_float(w << 16); }
__device__ __forceinline__ float bfhi(unsigned w) { return __uint_as_float(w & 0xffff0000u); }

struct Args { const float* in[20]; float* out; unsigned char* ws; int ph_lo, ph_hi; };
}
namespace pg8 {
#define PG8_LAS __attribute__((address_space(3)))
typedef unsigned short bf16_t;
typedef short bf16x8 __attribute__((ext_vector_type(8)));
typedef float f32x4 __attribute__((ext_vector_type(4)));
typedef unsigned u32x4 __attribute__((ext_vector_type(4)));
constexpr int BM = 256, BK = 64, HALF = 128, HTB = HALF * BK * 2  , STAGE_BYTES = 8 * HTB, NXCD = 8, WGM = 8;

__host__ __device__ __forceinline__ int lds_byte(int r, int c) { const int st = (r >> 4) * 2 + (c >> 5), rr = r & 15, cc = c & 31, ob = rr * 64 + cc * 2; return st * 1024 + (ob ^ (((ob >> 9) & 1) << 5)); }
__host__ __device__ __forceinline__ void stage_rc(int b, int& R, int& C) { const int st = b / 1024, sb = b % 1024, swz = sb ^ (((sb >> 9) & 1) << 5); R = (st >> 1) * 16 + swz / 64; C = (st & 1) * 32 + (swz % 64) / 2; }
__host__ __device__ __forceinline__ int perm32(int rho) { const int n = rho >> 4, i = rho & 15; return 8 * (i >> 2) + 4 * n + (i & 3); }

struct Unit { int pm, pn; };
struct Gemm { const bf16_t* A; const bf16_t* Bt; int M, N, K; };

struct StaticOrder {
    int nM, nN, nwg, G, c;
    __host__ __device__ void init(int M, int N, int G_, int c_) { nM = M / BM; nN = N / BM; nwg = nM * nN; G = G_; c = c_; }
    __host__ __device__ bool next(int i, Unit& u) const {
        const long L = (long)i * G + c; if (L >= nwg) return false;
        int wgid = (int)L; { const int q = nwg / NXCD, r = nwg % NXCD, xcd = wgid % NXCD, off = wgid / NXCD; wgid = (xcd < r ? xcd * (q + 1) : r * (q + 1) + (xcd - r) * q) + off; }
        const int nig = WGM * nN, gid = wgid / nig, fm = gid * WGM, gsz = (nM - fm) < WGM ? (nM - fm) : WGM;
        u.pm = fm + ((wgid % nig) % gsz); u.pn = (wgid % nig) / gsz; return true;
    }
    __device__ __forceinline__ void a_ready(const Unit&) const {}
    __device__ __forceinline__ void done(const Unit&) const {}
};

__device__ __forceinline__ unsigned cvt_pk_bf16(float lo, float hi) { unsigned r; asm volatile("v_cvt_pk_bf16_f32 %0, %1, %2" : "=v"(r) : "v"(lo), "v"(hi)); return r; }
__device__ __forceinline__ float fsig(float x) { return __builtin_amdgcn_rcpf(1.0f + __expf(-x)); }

struct EpiProj {
    static constexpr bool PERM = true, AFTER_DRAIN = false;
    bf16_t* P; int pw;
    __device__ __forceinline__ void operator()(const f32x4 (&acc)[2][2][4][2], const Unit& u, int wr, int wc, int fr, int fq) const {
        const int row0 = u.pm * BM + wr * 64 + fr;
        if (u.pn < 16) {
            const int col0 = u.pn * BM + wc * 32 + 8 * fq;
#pragma unroll
            for (int ai = 0; ai < 2; ++ai)
#pragma unroll
                for (int m = 0; m < 4; ++m) { bf16_t* rowp = P + (size_t)(row0 + ai * HALF + m * 16) * pw + col0;
#pragma unroll
                    for (int bj = 0; bj < 2; ++bj) { const f32x4 v0 = acc[ai][bj][m][0], v1 = acc[ai][bj][m][1];
                        u32x4 w; w.x = cvt_pk_bf16(v0[0], v0[1]); w.y = cvt_pk_bf16(v0[2], v0[3]); w.z = cvt_pk_bf16(v1[0], v1[1]); w.w = cvt_pk_bf16(v1[2], v1[3]);
                        *(u32x4*)(rowp + bj * HALF) = w; } }
        } else {
            const int col0 = 4096 + (u.pn - 16) * 128 + wc * 32 + 8 * fq;
#pragma unroll
            for (int ai = 0; ai < 2; ++ai)
#pragma unroll
                for (int m = 0; m < 4; ++m) { bf16_t* rowp = P + (size_t)(row0 + ai * HALF + m * 16) * pw + col0;
                    float o[8];
#pragma unroll
                    for (int n = 0; n < 2; ++n)
#pragma unroll
                        for (int j = 0; j < 4; ++j) { const float g = acc[ai][0][m][n][j], s = acc[ai][1][m][n][j]; o[n * 4 + j] = g * fsig(g) * fsig(s); }
                    u32x4 w; w.x = cvt_pk_bf16(o[0], o[1]); w.y = cvt_pk_bf16(o[2], o[3]); w.z = cvt_pk_bf16(o[4], o[5]); w.w = cvt_pk_bf16(o[6], o[7]);
                    *(u32x4*)rowp = w; }
        }
    }
};
struct EpiH {
    static constexpr bool PERM = false, AFTER_DRAIN = false;
    const float* x; const float* mod; float* h;
    __device__ __forceinline__ void operator()(const f32x4 (&acc)[2][2][4][2], const Unit& u, int wr, int wc, int fr, int fq) const {
        const int row0 = u.pm * BM + wr * 64 + fr, col0 = u.pn * BM + wc * 32 + 4 * fq;
        const int b = (u.pm * BM) / 2048;
        f32x4 gv[2][2];
#pragma unroll
        for (int bj = 0; bj < 2; ++bj)
#pragma unroll
            for (int n = 0; n < 2; ++n) gv[bj][n] = *(const f32x4*)(mod + (size_t)b * 6144 + 2048 + col0 + bj * HALF + n * 16);
#pragma unroll
        for (int ai = 0; ai < 2; ++ai)
#pragma unroll
            for (int m = 0; m < 4; ++m) { const size_t off = (size_t)(row0 + ai * HALF + m * 16) * 1024 + col0;
#pragma unroll
                for (int bj = 0; bj < 2; ++bj)
#pragma unroll
                    for (int n = 0; n < 2; ++n) { const f32x4 xv = *(const f32x4*)(x + off + bj * HALF + n * 16); *(f32x4*)(h + off + bj * HALF + n * 16) = xv + gv[bj][n] * acc[ai][bj][m][n]; }
                asm volatile("" ::: "memory"); }
    }
};
struct EpiAct {
    static constexpr bool PERM = true, AFTER_DRAIN = false;
    bf16_t* act;
    __device__ __forceinline__ void operator()(const f32x4 (&acc)[2][2][4][2], const Unit& u, int wr, int wc, int fr, int fq) const {
        const int row0 = u.pm * BM + wr * 64 + fr, col0 = (u.pn & 3) * 128 + wc * 32 + 8 * fq;
#pragma unroll
        for (int ai = 0; ai < 2; ++ai)
#pragma unroll
            for (int m = 0; m < 4; ++m) { bf16_t* rowp = act + (size_t)(row0 + ai * HALF + m * 16) * 512 + col0;
                float o[8];
#pragma unroll
                for (int n = 0; n < 2; ++n)
#pragma unroll
                    for (int j = 0; j < 4; ++j) { const float g = acc[ai][0][m][n][j], up = acc[ai][1][m][n][j]; o[n * 4 + j] = g * fsig(g) * up; }
                u32x4 w; w.x = cvt_pk_bf16(o[0], o[1]); w.y = cvt_pk_bf16(o[2], o[3]); w.z = cvt_pk_bf16(o[4], o[5]); w.w = cvt_pk_bf16(o[6], o[7]);
                *(u32x4*)rowp = w; }
    }
};
struct EpiY {
    static constexpr bool PERM = true, AFTER_DRAIN = false;
    bf16_t* y;
    __device__ __forceinline__ void operator()(const f32x4 (&acc)[2][2][4][2], const Unit& u, int wr, int wc, int fr, int fq) const {
        const int row0 = u.pm * BM + wr * 64 + fr, col0 = (u.pn & 3) * BM + wc * 32 + 8 * fq;
#pragma unroll
        for (int ai = 0; ai < 2; ++ai)
#pragma unroll
            for (int m = 0; m < 4; ++m) { bf16_t* rowp = y + (size_t)(row0 + ai * HALF + m * 16) * 1024 + col0;
#pragma unroll
                for (int bj = 0; bj < 2; ++bj) { const f32x4 v0 = acc[ai][bj][m][0], v1 = acc[ai][bj][m][1];
                    u32x4 w; w.x = cvt_pk_bf16(v0[0], v0[1]); w.y = cvt_pk_bf16(v0[2], v0[3]); w.z = cvt_pk_bf16(v1[0], v1[1]); w.w = cvt_pk_bf16(v1[2], v1[3]);
                    *(u32x4*)(rowp + bj * HALF) = w; } }
    }
};
struct MoeOrder {
    const int* tile_expert; int nwg, G, c;
    __device__ void init(const int* meta, const int* te, int G_, int c_) { tile_expert = te; nwg = meta[33] * 4; G = G_; c = c_; }
    __device__ bool next(int i, Unit& u) const {
        const long L = (long)i * G + c; if (L >= nwg) return false;
        int wgid = (int)L; { const int q = nwg / NXCD, r = nwg % NXCD, xcd = wgid % NXCD, off = wgid / NXCD; wgid = (xcd < r ? xcd * (q + 1) : r * (q + 1) + (xcd - r) * q) + off; }
        u.pm = wgid >> 2; u.pn = tile_expert[u.pm] * 4 + (wgid & 3); return true;
    }
    __device__ __forceinline__ void a_ready(const Unit&) const {}
    __device__ __forceinline__ void done(const Unit&) const {}
};
template <class Epi, class Sched, bool ALIGN_EPI = false, bool SP2 = false>
__device__ __forceinline__ void gemm_phase(PG8_LAS unsigned char* lds, const Gemm g, const Sched& S, const Epi& E) {
    const int tid = threadIdx.x, wid = __builtin_amdgcn_readfirstlane(tid >> 6), lane = tid & 63, wr = wid >> 2, wc = wid & 3, fr = lane & 15, fq = lane >> 4;
    const int K = g.K, nt = K / BK;
    unsigned voffA[2], voffB[2];
#pragma unroll
    for (int i = 0; i < 2; ++i) { int R, C; stage_rc(tid * 16 + i * 8192, R, C); const int Rb = Epi::PERM ? ((R & ~31) + perm32(R & 31)) : R;
        voffA[i] = (unsigned)(R * K + C) * 2u; voffB[i] = (unsigned)(Rb * K + C) * 2u; }
    const size_t kstep = (size_t)(BK * 2);
    const size_t hstep = (size_t)HALF * K * 2;
    const size_t tstep = 2 * hstep;
    const unsigned ldsw = (unsigned)wid * 1024u;
    const int aoff = lds_byte(wr * 64 + fr, fq * 8), boff = lds_byte(wc * 32 + fr, fq * 8);
#define PG8_SA(b, h) (((b) * 2 + (h)) * HTB)
#define PG8_SB(b, h) ((4 + (b) * 2 + (h)) * HTB)
#define PG8_STAGE(bufoff, gbase, voff) do { _Pragma("unroll") for (int _i = 0; _i < 2; ++_i) \
        __builtin_amdgcn_global_load_lds((const unsigned*)((const char*)(gbase) + (voff)[_i]), (PG8_LAS unsigned*)(lds + (bufoff) + ldsw + _i * 8192), 16, 0, 0); } while (0)
#define PG8_LDA(dst, b, h) do { _Pragma("unroll") for (int m = 0; m < 4; ++m) _Pragma("unroll") for (int k = 0; k < 2; ++k) dst[m][k] = *(const PG8_LAS bf16x8*)(lds + PG8_SA(b, h) + aoff + m * 2048 + k * 1024); } while (0)
#define PG8_LDB(dst, b, h) do { _Pragma("unroll") for (int n = 0; n < 2; ++n) _Pragma("unroll") for (int k = 0; k < 2; ++k) dst[n][k] = *(const PG8_LAS bf16x8*)(lds + PG8_SB(b, h) + boff + n * 2048 + k * 1024); } while (0)
#define PG8_MMA(ai, bj, At, Bt) do { __builtin_amdgcn_s_setprio(1); _Pragma("unroll") for (int m = 0; m < 4; ++m) _Pragma("unroll") for (int n = 0; n < 2; ++n) _Pragma("unroll") for (int k = 0; k < 2; ++k) \
        acc[ai][bj][m][n] = __builtin_amdgcn_mfma_f32_16x16x32_bf16(Bt[n][k], At[m][k], acc[ai][bj][m][n], 0, 0, 0); __builtin_amdgcn_s_setprio(0); } while (0)
#define PG8_WAIT_V(n) asm volatile("s_waitcnt vmcnt(" #n ")" ::: "memory")
#define PG8_WAIT_L(n) asm volatile("s_waitcnt lgkmcnt(" #n ")" ::: "memory")
#define PG8_BAR __builtin_amdgcn_s_barrier()
#define PG8_SCHED __builtin_amdgcn_sched_barrier(0)
    Unit cur, nxt; int ui = 0;
    if (!S.next(0, cur)) return;
    f32x4 acc[2][2][4][2];
#pragma unroll
    for (int a = 0; a < 2; ++a)
#pragma unroll
        for (int b = 0; b < 2; ++b)
#pragma unroll
            for (int m = 0; m < 4; ++m)
#pragma unroll
                for (int n = 0; n < 2; ++n) acc[a][b][m][n] = (f32x4){0.f, 0.f, 0.f, 0.f};
    bf16x8 At[4][2], B0[2][2], B1[2][2];
    const char* cA = (const char*)g.A + (size_t)cur.pm * tstep; const char* cB = (const char*)g.Bt + (size_t)cur.pn * tstep;
    S.a_ready(cur);
    if constexpr (SP2) {
        PG8_STAGE(PG8_SB(0, 0), cB, voffB); PG8_STAGE(PG8_SB(0, 1), cB + hstep, voffB); PG8_STAGE(PG8_SA(0, 0), cA, voffA); PG8_STAGE(PG8_SA(0, 1), cA + hstep, voffA);
        if (wr == 1) PG8_BAR;
        PG8_WAIT_V(2); PG8_BAR;
        PG8_STAGE(PG8_SB(1, 0), cB + kstep, voffB); PG8_STAGE(PG8_SA(1, 0), cA + kstep, voffA); PG8_STAGE(PG8_SB(1, 1), cB + hstep + kstep, voffB);
        PG8_WAIT_V(6); PG8_BAR;
    } else {
        PG8_STAGE(PG8_SB(0, 0), cB, voffB); PG8_STAGE(PG8_SA(0, 0), cA, voffA); PG8_STAGE(PG8_SB(0, 1), cB + hstep, voffB); PG8_STAGE(PG8_SA(0, 1), cA + hstep, voffA);
        if (wr == 1) PG8_BAR;
        PG8_WAIT_V(4); PG8_BAR;
        PG8_STAGE(PG8_SB(1, 0), cB + kstep, voffB); PG8_STAGE(PG8_SA(1, 0), cA + kstep, voffA); PG8_STAGE(PG8_SB(1, 1), cB + hstep + kstep, voffB);
        PG8_WAIT_V(6); PG8_BAR;
    }
    for (;;) {
        const bool has_next = S.next(ui + 1, nxt);
        const char* nA = has_next ? (const char*)g.A + (size_t)nxt.pm * tstep : cA; const char* nB = has_next ? (const char*)g.Bt + (size_t)nxt.pn * tstep : cB;
        for (int t = 0; t < nt; t += 2) {
            const bool last = (t == nt - 2);
            const char* a1 = cA + (size_t)(t + 1) * kstep;
            const char* a2 = last ? nA : cA + (size_t)(t + 2) * kstep; const char* b2 = last ? nB : cB + (size_t)(t + 2) * kstep;
            const char* a3 = a2 + kstep; const char* b3 = b2 + kstep;
            if (last && has_next) S.a_ready(nxt);
            if constexpr (SP2) {
            PG8_LDB(B0, 0, 0); PG8_LDB(B1, 0, 1); PG8_SCHED; PG8_LDA(At, 0, 0); PG8_STAGE(PG8_SA(1, 1), a1 + hstep, voffA);
            PG8_WAIT_V(8); PG8_WAIT_L(0); PG8_BAR; PG8_MMA(0, 0, At, B0); PG8_MMA(0, 1, At, B1); PG8_BAR; PG8_SCHED;
            PG8_LDA(At, 0, 1); PG8_STAGE(PG8_SB(0, 0), b2, voffB); PG8_STAGE(PG8_SB(0, 1), b2 + hstep, voffB); PG8_STAGE(PG8_SA(0, 0), a2, voffA);
            PG8_WAIT_V(8); PG8_WAIT_L(0); PG8_BAR; PG8_MMA(1, 0, At, B0); PG8_MMA(1, 1, At, B1); PG8_BAR; PG8_SCHED;
            PG8_LDB(B0, 1, 0); PG8_LDB(B1, 1, 1); PG8_SCHED; PG8_LDA(At, 1, 0); PG8_STAGE(PG8_SA(0, 1), a2 + hstep, voffA);
            PG8_WAIT_V(8); PG8_WAIT_L(0); PG8_BAR; PG8_MMA(0, 0, At, B0); PG8_MMA(0, 1, At, B1); PG8_BAR; PG8_SCHED;
            PG8_LDA(At, 1, 1); PG8_STAGE(PG8_SB(1, 0), b3, voffB); PG8_STAGE(PG8_SB(1, 1), b3 + hstep, voffB); PG8_STAGE(PG8_SA(1, 0), a3, voffA);
            PG8_WAIT_V(8); PG8_WAIT_L(0); PG8_BAR; PG8_MMA(1, 0, At, B0); PG8_MMA(1, 1, At, B1); PG8_BAR; PG8_SCHED;
            } else {
            PG8_LDB(B0, 0, 0); PG8_SCHED; PG8_LDA(At, 0, 0); PG8_STAGE(PG8_SA(1, 1), a1 + hstep, voffA);
            PG8_WAIT_L(8); PG8_BAR; PG8_WAIT_L(0); PG8_MMA(0, 0, At, B0); PG8_BAR; PG8_SCHED;
            PG8_LDB(B1, 0, 1); PG8_STAGE(PG8_SB(0, 0), b2, voffB);
            PG8_BAR; PG8_WAIT_L(0); PG8_MMA(0, 1, At, B1); PG8_BAR;
            PG8_LDA(At, 0, 1); PG8_STAGE(PG8_SA(0, 0), a2, voffA);
            PG8_BAR; PG8_WAIT_L(0); PG8_MMA(1, 0, At, B0); PG8_BAR; PG8_SCHED;
            PG8_STAGE(PG8_SB(0, 1), b2 + hstep, voffB);
            PG8_WAIT_V(6); PG8_BAR; PG8_MMA(1, 1, At, B1); PG8_BAR;
            PG8_LDB(B0, 1, 0); PG8_SCHED; PG8_LDA(At, 1, 0); PG8_STAGE(PG8_SA(0, 1), a2 + hstep, voffA);
            PG8_WAIT_L(8); PG8_BAR; PG8_WAIT_L(0); PG8_MMA(0, 0, At, B0); PG8_BAR; PG8_SCHED;
            PG8_LDB(B1, 1, 1); PG8_STAGE(PG8_SB(1, 0), b3, voffB);
            PG8_BAR; PG8_WAIT_L(0); PG8_MMA(0, 1, At, B1); PG8_BAR;
            PG8_LDA(At, 1, 1); PG8_STAGE(PG8_SA(1, 0), a3, voffA);
            PG8_BAR; PG8_WAIT_L(0); PG8_MMA(1, 0, At, B0); PG8_BAR; PG8_SCHED;
            PG8_STAGE(PG8_SB(1, 1), b3 + hstep, voffB);
            PG8_WAIT_V(6); PG8_BAR; PG8_MMA(1, 1, At, B1); PG8_BAR;
            }
        }
        if constexpr (ALIGN_EPI) { if (wr == 0) PG8_BAR; }
        if constexpr (!Epi::AFTER_DRAIN) { E(acc, cur, wr, wc, fr, fq); S.done(cur); }
        if (!has_next) break;
#pragma unroll
        for (int a = 0; a < 2; ++a)
#pragma unroll
            for (int b = 0; b < 2; ++b)
#pragma unroll
                for (int m = 0; m < 4; ++m)
#pragma unroll
                    for (int n = 0; n < 2; ++n) acc[a][b][m][n] = (f32x4){0.f, 0.f, 0.f, 0.f};
        cur = nxt; cA = nA; cB = nB; ++ui;
        if constexpr (ALIGN_EPI) { if (wr == 1) PG8_BAR; }
    }
    PG8_WAIT_V(0);
    if constexpr (!ALIGN_EPI) { if (wr == 0) PG8_BAR; }
    PG8_BAR;
    if constexpr (Epi::AFTER_DRAIN) { E.fused(acc, cur, wr, wc, fr, fq, lds, wid, lane); S.done(cur); }
#undef PG8_SA
#undef PG8_SB
#undef PG8_STAGE
#undef PG8_LDA
#undef PG8_LDB
#undef PG8_MMA
#undef PG8_WAIT_V
#undef PG8_WAIT_L
#undef PG8_BAR
#undef PG8_SCHED
}
}
namespace {
__device__ __forceinline__ int tidx() { int t = threadIdx.x; asm volatile("" : "+v"(t)); return t; }
__device__ __forceinline__ void phase_mod(const Args& a, LAS unsigned char* lds) {
    LAS float* sc = (LAS float*)lds;
    LAS float* part = (LAS float*)(lds + 65536);
    const float* c = a.in[1]; const float* mw = a.in[2]; const float* mb = a.in[3];
    float* mod = (float*)(a.ws + WS_MOD);
    const int tid = tidx();
    for (int i = tid; i < 16 * 1024; i += 512) sc[i] = silu_f(c[i]);
    __syncthreads();
    const int kg = tid >> 5, cj = tid & 31;
    for (int cgp = blockIdx.x; cgp < 256; cgp += gridDim.x) {
        const int j0 = cgp * 24;
        float acc[16];
#pragma unroll
        for (int b = 0; b < 16; ++b) acc[b] = 0.f;
        if (cj < 24) {
            for (int kk = 0; kk < 64; kk += 4) {
                const int k = kg * 64 + kk;
                const float w0 = mw[(size_t)(k + 0) * 6144 + j0 + cj], w1 = mw[(size_t)(k + 1) * 6144 + j0 + cj], w2 = mw[(size_t)(k + 2) * 6144 + j0 + cj], w3 = mw[(size_t)(k + 3) * 6144 + j0 + cj];
#pragma unroll
                for (int b = 0; b < 16; ++b) { const f4 s = *(const LAS f4*)(sc + b * 1024 + k); acc[b] += s.x * w0 + s.y * w1 + s.z * w2 + s.w * w3; }
            }
        }
#pragma unroll
        for (int b = 0; b < 16; ++b) part[(kg * 16 + b) * 32 + cj] = acc[b];
        __syncthreads();
        if (tid < 384) { const int b = tid / 24, cc = tid % 24; float s = mb[j0 + cc];
            for (int g2 = 0; g2 < 16; ++g2) s += part[(g2 * 16 + b) * 32 + cc];
            mod[b * 6144 + j0 + cc] = s; }
        __syncthreads();
    }
}

__device__ __forceinline__ void phase_norm1(const Args& a, LAS unsigned char* lds) {
    LAS f4* wgA = (LAS f4*)lds;
    LAS f4* wgB = (LAS f4*)(lds + 16384);
    const float* x = a.in[0]; const float* nw = a.in[4]; const float* w_in = a.in[5]; const float* a_log = a.in[7]; const float* dt_bias = a.in[8];
    const float* mod = (const float*)(a.ws + WS_MOD);
    bf16* xm = (bf16*)((unsigned char*)a.out + DO_XM);
    float* Gd = (float*)(a.ws + WS_G); float* Bd = (float*)(a.ws + WS_BETA);
    const int tid = tidx(), lane = tid & 63, wave = tid >> 6;
    for (int k = tid; k < 1024; k += 512) { const int idx = (4 * (k >> 8) + (k & 3)) * 64 + ((k & 255) >> 2);
        wgA[idx] = *(const f4*)(w_in + (size_t)k * DIN + C_GA); wgB[idx] = *(const f4*)(w_in + (size_t)k * DIN + C_GB); }
    __syncthreads();
    const int gw = blockIdx.x * 8 + wave, NGW = gridDim.x * 8;
    for (int grp = gw; grp < T / 2; grp += NGW) {
        const int t0 = grp * 2, b = t0 / SEQ;
        float4 gmul[4], gadd[4];
#pragma unroll
        for (int j = 0; j < 4; ++j) { const int k = 4 * lane + 256 * j;
            const float4 wv = *(const float4*)(nw + k), sc = *(const float4*)(mod + (size_t)b * 6144 + 1024 + k), sh = *(const float4*)(mod + (size_t)b * 6144 + k);
            gmul[j] = make_float4(wv.x * (1.f + sc.x), wv.y * (1.f + sc.y), wv.z * (1.f + sc.z), wv.w * (1.f + sc.w)); gadd[j] = sh; }
        float4 xv[2][4];
#pragma unroll
        for (int r = 0; r < 2; ++r) {
            float ss = 0.f;
#pragma unroll
            for (int j = 0; j < 4; ++j) { xv[r][j] = *(const float4*)(x + (size_t)(t0 + r) * D + 4 * lane + 256 * j); ss += xv[r][j].x * xv[r][j].x + xv[r][j].y * xv[r][j].y + xv[r][j].z * xv[r][j].z + xv[r][j].w * xv[r][j].w; }
            ss = wave_sum(ss);
            const float rstd = rsqrtf(ss * (1.0f / D) + 1e-6f);
#pragma unroll
            for (int j = 0; j < 4; ++j) { float4 v = xv[r][j];
                v.x = v.x * rstd * gmul[j].x + gadd[j].x; v.y = v.y * rstd * gmul[j].y + gadd[j].y; v.z = v.z * rstd * gmul[j].z + gadd[j].z; v.w = v.w * rstd * gmul[j].w + gadd[j].w;
                xv[r][j] = v;
                v2u w; w.x = pk2(v.x, v.y); w.y = pk2(v.z, v.w);
                *(v2u*)(xm + (size_t)(t0 + r) * D + 4 * lane + 256 * j) = w; }
        }
        float acc[2][8];
#pragma unroll
        for (int r = 0; r < 2; ++r)
#pragma unroll
            for (int q = 0; q < 8; ++q) acc[r][q] = 0.f;
#pragma unroll
        for (int j = 0; j < 4; ++j) {
#pragma unroll
            for (int jj = 0; jj < 4; ++jj) {
                const f4 wa = wgA[(4 * j + jj) * 64 + lane], wb = wgB[(4 * j + jj) * 64 + lane];
#pragma unroll
                for (int r = 0; r < 2; ++r) { const float xe = (jj == 0) ? xv[r][j].x : (jj == 1) ? xv[r][j].y : (jj == 2) ? xv[r][j].z : xv[r][j].w;
                    acc[r][0] += xe * wa.x; acc[r][1] += xe * wa.y; acc[r][2] += xe * wa.z; acc[r][3] += xe * wa.w;
                    acc[r][4] += xe * wb.x; acc[r][5] += xe * wb.y; acc[r][6] += xe * wb.z; acc[r][7] += xe * wb.w; }
            }
            asm volatile("" ::: "memory");
        }
        float mine = 0.f;
#pragma unroll
        for (int r = 0; r < 2; ++r)
#pragma unroll
            for (int q = 0; q < 8; ++q) { const float s = wave_sum(acc[r][q]); if (lane == r * 8 + q) mine = s; }
        if (lane < 16) { const int r = lane >> 3, q = lane & 7, t = t0 + r;
            if (q < 4) { const float z = mine + dt_bias[q]; const float sp = (z > 20.f) ? z : log1pf(expf(z)); Gd[t * 4 + q] = -expf(a_log[q]) * sp; }
            else Bd[t * 4 + (q - 4)] = sigmoid_f(mine); }
    }
}

__device__ __forceinline__ void conv_job(const float* src, int ldsrc, int srccol, bf16* dst, int ldd, int n0, int k0, LAS float* tile) {
    const int tid = tidx();
#pragma unroll
    for (int i = 0; i < 2; ++i) { const int kk = (tid >> 4) + 32 * i, c4 = (tid & 15) * 4;
        const float4 v = *(const float4*)(src + (size_t)(k0 + kk) * ldsrc + srccol + c4);
        tile[kk * 65 + c4 + 0] = v.x; tile[kk * 65 + c4 + 1] = v.y; tile[kk * 65 + c4 + 2] = v.z; tile[kk * 65 + c4 + 3] = v.w; }
    __syncthreads();
    { const int n = tid >> 3, kc = (tid & 7) * 8;
        v4u w; w.x = pk2(tile[(kc + 0) * 65 + n], tile[(kc + 1) * 65 + n]); w.y = pk2(tile[(kc + 2) * 65 + n], tile[(kc + 3) * 65 + n]);
        w.z = pk2(tile[(kc + 4) * 65 + n], tile[(kc + 5) * 65 + n]); w.w = pk2(tile[(kc + 6) * 65 + n], tile[(kc + 7) * 65 + n]);
        *(v4u*)(dst + (size_t)(n0 + n) * ldd + k0 + kc) = w; }
    __syncthreads();
}
__device__ __forceinline__ int win_srccol(int n0) {
    if (n0 < 512) return C_RQ + n0;
    if (n0 < 1024) return C_RK + (n0 - 512);
    if (n0 < 2048) return C_RV + (n0 - 1024);
    if (n0 < 4096) return C_GQ + (n0 - 2048);
    const int j = (n0 - 4096) >> 8, r = (n0 - 4096) & 255, half = r >> 7, cc = r & 127;
    if (j < 8) return (half ? C_GTA : C_RG) + 128 * j + cc;
    return (half ? C_GTB : C_GZ) + 128 * (j - 8) + cc;
}
__device__ __forceinline__ void phase_convert_in(const Args& a, LAS unsigned char* lds) {
    LAS float* tile = (LAS float*)(lds + 32768);
    bf16* wtin = (bf16*)((unsigned char*)a.out + DO_WTIN); bf16* wtout = (bf16*)(a.ws + WS_WTOUT);
    for (int job = blockIdx.x; job < 2048 + 256; job += gridDim.x) {
        if (job < 2048) { const int nt = job >> 4, kt = job & 15; conv_job(a.in[5], DIN, win_srccol(nt * 64), wtin, 1024, nt * 64, kt * 64, tile); }
        else { const int jj = job - 2048, nt = jj >> 4, kt = jj & 15; conv_job(a.in[10], 1024, nt * 64, wtout, 1024, nt * 64, kt * 64, tile); }
    }
    float2* rope = (float2*)(a.ws + WS_ROPE);
    for (int i = blockIdx.x * 512 + tidx(); i < SEQ * 64; i += gridDim.x * 512) {
        const int t = i >> 6, fi = i & 63;
        const double inv = exp(-((double)fi / 64.0) * 9.210340371976184), ang = (double)t * inv;
        rope[i] = make_float2((float)cos(ang), (float)sin(ang));
    }
}
__device__ __forceinline__ void phase_inproj(const Args& a, LAS unsigned char* lds) {
    pg8::Gemm g{(const bf16*)((unsigned char*)a.out + DO_XM), (const bf16*)((unsigned char*)a.out + DO_WTIN), T, 8192, 1024};
    pg8::StaticOrder S; S.init(T, 8192, (int)gridDim.x, (int)blockIdx.x);
    pg8::EpiProj E{(bf16*)(a.ws + WS_PROJ), PW};
    pg8::gemm_phase<pg8::EpiProj, pg8::StaticOrder, true, true>(lds, g, S, E);
}


__device__ __forceinline__ void phase_outproj(const Args& a, LAS unsigned char* lds) {
    pg8::Gemm g{(const bf16*)(a.ws + WS_MERGED), (const bf16*)(a.ws + WS_WTOUT), T, 1024, 1024};
    pg8::StaticOrder S; S.init(T, 1024, (int)gridDim.x, (int)blockIdx.x);
    pg8::EpiH E{a.in[0], (const float*)(a.ws + WS_MOD), a.out};
    pg8::gemm_phase<pg8::EpiH, pg8::StaticOrder, true, true>(lds, g, S, E);
}

__device__ __forceinline__ void phase_route(const Args& a, LAS unsigned char* lds) {
    LAS f4* wr = (LAS f4*)lds;
    LAS int* hist = (LAS int*)(lds + 5 * 16384);
    LAS float* lgl = (LAS float*)(lds + 5 * 16384 + 256);
    const float* h = a.out; const float* nw = a.in[11]; const float* w_group = a.in[12]; const float* b_group = a.in[13]; const float* w_router = a.in[14]; const float* b_router = a.in[15];
    const float* mod = (const float*)(a.ws + WS_MOD);
    bf16* xf = (bf16*)(a.ws + WS_XF);
    int* tok_e = (int*)(a.ws + WS_TOKE); float* tok_w = (float*)(a.ws + WS_TOKW);
    const int tid = tidx(), lane = tid & 63, wave = tid >> 6;
    for (int k = tid; k < 1024; k += 512) { const int idx = (4 * (k >> 8) + (k & 3)) * 64 + ((k & 255) >> 2);
        wr[idx] = *(const f4*)(w_group + (size_t)k * 4);
#pragma unroll
        for (int q = 0; q < 4; ++q) wr[(q + 1) * 1024 + idx] = *(const f4*)(w_router + (size_t)k * 16 + 4 * q); }
    if (tid < 16) hist[tid] = 0;
    __syncthreads();
    const int TPB = T / (int)gridDim.x, tb0 = blockIdx.x * TPB;
#pragma unroll 1
    for (int pr = wave; pr < TPB / 2; pr += 8) {
        const int t0 = tb0 + pr * 2, b = t0 / SEQ;
        float4 gmul[4], gadd[4];
#pragma unroll
        for (int j = 0; j < 4; ++j) { const int k = 4 * lane + 256 * j;
            const float4 wv = *(const float4*)(nw + k), sc = *(const float4*)(mod + (size_t)b * 6144 + 4096 + k), sh = *(const float4*)(mod + (size_t)b * 6144 + 3072 + k);
            gmul[j] = make_float4(wv.x * (1.f + sc.x), wv.y * (1.f + sc.y), wv.z * (1.f + sc.z), wv.w * (1.f + sc.w)); gadd[j] = sh; }
        float4 xv[2][4];
#pragma unroll
        for (int r = 0; r < 2; ++r) {
            float ss = 0.f;
#pragma unroll
            for (int j = 0; j < 4; ++j) { xv[r][j] = *(const float4*)(h + (size_t)(t0 + r) * D + 4 * lane + 256 * j); ss += xv[r][j].x * xv[r][j].x + xv[r][j].y * xv[r][j].y + xv[r][j].z * xv[r][j].z + xv[r][j].w * xv[r][j].w; }
            ss = wave_sum(ss);
            const float rstd = rsqrtf(ss * (1.0f / D) + 1e-6f);
#pragma unroll
            for (int j = 0; j < 4; ++j) { float4 v = xv[r][j];
                v.x = v.x * rstd * gmul[j].x + gadd[j].x; v.y = v.y * rstd * gmul[j].y + gadd[j].y; v.z = v.z * rstd * gmul[j].z + gadd[j].z; v.w = v.w * rstd * gmul[j].w + gadd[j].w;
                xv[r][j] = v;
                v2u w; w.x = pk2(v.x, v.y); w.y = pk2(v.z, v.w);
                *(v2u*)(xf + (size_t)(t0 + r) * D + 4 * lane + 256 * j) = w; }
        }
        float acc[2][20];
#pragma unroll
        for (int r = 0; r < 2; ++r)
#pragma unroll
            for (int q = 0; q < 20; ++q) acc[r][q] = 0.f;
#pragma unroll
        for (int j = 0; j < 4; ++j) {
#pragma unroll
            for (int jj = 0; jj < 4; ++jj) {
                const int idx = (4 * j + jj) * 64 + lane;
#pragma unroll
                for (int q = 0; q < 5; ++q) { const f4 w = wr[q * 1024 + idx];
#pragma unroll
                    for (int r = 0; r < 2; ++r) { const float xe = (jj == 0) ? xv[r][j].x : (jj == 1) ? xv[r][j].y : (jj == 2) ? xv[r][j].z : xv[r][j].w;
                        acc[r][4 * q + 0] += xe * w.x; acc[r][4 * q + 1] += xe * w.y; acc[r][4 * q + 2] += xe * w.z; acc[r][4 * q + 3] += xe * w.w; } }
                asm volatile("" ::: "memory");
            }
        }
        float mine0 = 0.f, mine1 = 0.f;
#pragma unroll
        for (int q = 0; q < 20; ++q) { const float s0 = wave_sum(acc[0][q]), s1 = wave_sum(acc[1][q]); if (lane == q) { mine0 = s0; mine1 = s1; } }
        if (lane < 20) { lgl[(pr * 2 + 0) * 20 + lane] = mine0; lgl[(pr * 2 + 1) * 20 + lane] = mine1; }
    }
    __syncthreads();
    if (tid < TPB) {
        const int t = tb0 + tid;
        float lg[20];
#pragma unroll
        for (int q = 0; q < 20; ++q) lg[q] = lgl[tid * 20 + q];
        float gl[4], gmax = -1e30f; int gi = 0;
#pragma unroll
        for (int j = 0; j < 4; ++j) { gl[j] = lg[j] + b_group[j]; if (gl[j] > gmax) { gmax = gl[j]; gi = j; } }
        float gs = 0.f;
#pragma unroll
        for (int j = 0; j < 4; ++j) gs += expf(gl[j] - gmax);
        const float g_top = 1.0f / gs;
        float el[4], emax = -1e30f;
#pragma unroll
        for (int j = 0; j < 4; ++j) { const float raw = (gi == 0) ? lg[4 + j] : (gi == 1) ? lg[8 + j] : (gi == 2) ? lg[12 + j] : lg[16 + j]; el[j] = raw + b_router[gi * 4 + j]; emax = fmaxf(emax, el[j]); }
        float ep[4], es = 0.f;
#pragma unroll
        for (int j = 0; j < 4; ++j) { ep[j] = expf(el[j] - emax); es += ep[j]; }
#pragma unroll
        for (int j = 0; j < 4; ++j) ep[j] /= es;
        int i1 = 0; float p1 = ep[0];
#pragma unroll
        for (int j = 1; j < 4; ++j) if (ep[j] > p1) { p1 = ep[j]; i1 = j; }
        int i2 = -1; float p2 = -1.f;
#pragma unroll
        for (int j = 0; j < 4; ++j) if (j != i1 && ep[j] > p2) { p2 = ep[j]; i2 = j; }
        const float den = p1 + p2;
        tok_e[t * 2 + 0] = gi * 4 + i1; tok_e[t * 2 + 1] = gi * 4 + i2;
        tok_w[t * 2 + 0] = g_top * (p1 / den); tok_w[t * 2 + 1] = g_top * (p2 / den);
        __hip_atomic_fetch_add(&hist[gi * 4 + i1], 1, __ATOMIC_RELAXED, __HIP_MEMORY_SCOPE_WORKGROUP); __hip_atomic_fetch_add(&hist[gi * 4 + i2], 1, __ATOMIC_RELAXED, __HIP_MEMORY_SCOPE_WORKGROUP);
    }
    __syncthreads();
    if (tid < 16) ((int*)(a.ws + WS_HIST))[blockIdx.x * 16 + tid] = hist[tid];
}
__device__ __forceinline__ void phase_convert_experts(const Args& a, LAS unsigned char* lds) {
    LAS float* tile = (LAS float*)(lds + 98304);
    bf16* wtgu = (bf16*)(a.ws + WS_WTGU); bf16* wtd = (bf16*)(a.ws + WS_WTD);
    for (int job = blockIdx.x; job < 4096 + 2048; job += gridDim.x) {
        if (job < 4096) { const int e = job >> 8, nt = (job >> 4) & 15, kt = job & 15, n0 = nt * 64;
            const int j = n0 >> 8, r = n0 & 255, half = r >> 7, cc = r & 127;
            const float* src = (half ? a.in[17] : a.in[16]) + (size_t)e * 1024 * 512;
            conv_job(src, 512, 128 * j + cc, wtgu + (size_t)e * 1024 * 1024, 1024, n0, kt * 64, tile); }
        else { const int jj = job - 4096, e = jj >> 7, nt = (jj >> 3) & 15, kt = jj & 7;
            conv_job(a.in[18] + (size_t)e * 512 * 1024, 1024, nt * 64, wtd + (size_t)e * 1024 * 512, 512, nt * 64, kt * 64, tile); }
    }
}
__device__ __forceinline__ void phase_scatter(const Args& a, LAS unsigned char* lds) {
    LAS int* base = (LAS int*)lds;
    LAS int* mybase = base + 16;
    LAS int* elist = base + 32;
    LAS int* slots = base + 32 + 512;
    const int* hist = (const int*)(a.ws + WS_HIST); const int* tok_e = (const int*)(a.ws + WS_TOKE);
    int* tok_s = (int*)(a.ws + WS_TOKS); int* meta = (int*)(a.ws + WS_META); int* tile_expert = meta + 64;
    const bf16* xf = (const bf16*)(a.ws + WS_XF); bf16* xs = (bf16*)(a.ws + WS_XS);
    const int tid = tidx(), lane = tid & 63, wave = tid >> 6, G = (int)gridDim.x;
    const int TPB = T / G, tb0 = blockIdx.x * TPB, NA = 2 * TPB;
    if (tid < 16) { int tot = 0, before = 0; for (int i = 0; i < G; ++i) { const int c = hist[i * 16 + tid]; tot += c; if (i < (int)blockIdx.x) before += c; } base[tid] = tot; mybase[tid] = before; }
    __syncthreads();
    if (tid == 0) { int off = 0;
        for (int e = 0; e < 16; ++e) { const int cnt = base[e], nt = (cnt + 255) >> 8;
            if (blockIdx.x == 0) { meta[e] = cnt; meta[16 + e] = off; for (int k = 0; k < nt; ++k) tile_expert[(off >> 8) + k] = e; }
            base[e] = off; off += nt * 256; }
        if (blockIdx.x == 0) { meta[32] = off; meta[33] = off >> 8; } }
    for (int i = tid; i < NA; i += 512) elist[i] = tok_e[tb0 * 2 + i];
    __syncthreads();
    for (int i = tid; i < NA; i += 512) { const int e = elist[i]; int rank = 0; for (int k = 0; k < i; ++k) rank += (elist[k] == e) ? 1 : 0;
        const int slot = base[e] + mybase[e] + rank; slots[i] = slot; tok_s[tb0 * 2 + i] = slot; }
    __syncthreads();
    for (int i = wave; i < NA; i += 8) { const int slot = slots[i], t = tb0 + (i >> 1);
        const v4u* src = (const v4u*)(xf + (size_t)t * D); v4u* dst = (v4u*)(xs + (size_t)slot * D);
        dst[lane] = src[lane]; dst[lane + 64] = src[lane + 64]; }
}
__device__ __forceinline__ void phase_moe1(const Args& a, LAS unsigned char* lds) {
    const int* meta = (const int*)(a.ws + WS_META);
    pg8::Gemm g{(const bf16*)(a.ws + WS_XS), (const bf16*)(a.ws + WS_WTGU), 0, 0, 1024};
    pg8::MoeOrder S; S.init(meta, meta + 64, (int)gridDim.x, (int)blockIdx.x);
    pg8::EpiAct E{(bf16*)(a.ws + WS_ACT)};
    pg8::gemm_phase<pg8::EpiAct, pg8::MoeOrder, true, true>(lds, g, S, E);
}
__device__ __forceinline__ void phase_moe2(const Args& a, LAS unsigned char* lds) {
    const int* meta = (const int*)(a.ws + WS_META);
    pg8::Gemm g{(const bf16*)(a.ws + WS_ACT), (const bf16*)(a.ws + WS_WTD), 0, 0, 512};
    pg8::MoeOrder S; S.init(meta, meta + 64, (int)gridDim.x, (int)blockIdx.x);
    pg8::EpiY E{(bf16*)(a.ws + WS_Y)};
    pg8::gemm_phase<pg8::EpiY, pg8::MoeOrder, true, true>(lds, g, S, E);
}
__device__ __forceinline__ void phase_final(const Args& a, LAS unsigned char* lds) {
    const float* mod = (const float*)(a.ws + WS_MOD); const float* now = a.in[19];
    const bf16* y = (const bf16*)(a.ws + WS_Y); const int* tok_s = (const int*)(a.ws + WS_TOKS); const float* tok_w = (const float*)(a.ws + WS_TOKW);
    float* out = a.out;
    const int tid = tidx(), lane = tid & 63, wave = tid >> 6;
    const int gw = blockIdx.x * 8 + wave, NGW = gridDim.x * 8;
    for (int t = gw; t < T; t += NGW) {
        const int b = t / SEQ, s1 = tok_s[t * 2], s2 = tok_s[t * 2 + 1];
        const float w1 = tok_w[t * 2], w2 = tok_w[t * 2 + 1];
        float4 o[4]; float ss = 0.f;
#pragma unroll
        for (int j = 0; j < 4; ++j) { const int k = 4 * lane + 256 * j;
            const float4 hv = *(const float4*)(out + (size_t)t * D + k), gf = *(const float4*)(mod + (size_t)b * 6144 + 5120 + k);
            const v2u a1 = *(const v2u*)(y + (size_t)s1 * D + k), a2 = *(const v2u*)(y + (size_t)s2 * D + k);
            float4 v;
            v.x = hv.x + gf.x * (w1 * bflo(a1.x) + w2 * bflo(a2.x)); v.y = hv.y + gf.y * (w1 * bfhi(a1.x) + w2 * bfhi(a2.x));
            v.z = hv.z + gf.z * (w1 * bflo(a1.y) + w2 * bflo(a2.y)); v.w = hv.w + gf.w * (w1 * bfhi(a1.y) + w2 * bfhi(a2.y));
            o[j] = v; ss += v.x * v.x + v.y * v.y + v.z * v.z + v.w * v.w; }
        ss = wave_sum(ss);
        const float rstd = rsqrtf(ss * (1.0f / D) + 1e-6f);
#pragma unroll
        for (int j = 0; j < 4; ++j) { const int k = 4 * lane + 256 * j; const float4 nwv = *(const float4*)(now + k);
            *(float4*)(out + (size_t)t * D + k) = make_float4(o[j].x * rstd * nwv.x, o[j].y * rstd * nwv.y, o[j].z * rstd * nwv.z, o[j].w * rstd * nwv.w); }
    }
}


__device__ __forceinline__ float quad_sum(float v) { v += __shfl_xor(v, 1); v += __shfl_xor(v, 2); return v; }
template <int BR>
__device__ __forceinline__ void scan_item(const Args& a, LAS unsigned char* lds, int b, int h, int half) {
    constexpr int TG = 8;
    LAS float* kf = (LAS float*)lds;
    LAS float* qf = kf + TG * 128;
    LAS float* vf = qf + TG * 128;
    LAS float* of = vf + TG * 128;
    LAS float* sc = of + TG * 128;
    bf16* proj = (bf16*)(a.ws + WS_PROJ);
    const float2* rope = (const float2*)(a.ws + WS_ROPE);
    const float* Gd = (const float*)(a.ws + WS_G); const float* Bd = (const float*)(a.ws + WS_BETA); const float* conv_w = a.in[6];
    float* ssq = (float*)(a.ws + WS_SSQ);
    const int tid = tidx(), v = tid >> 2, qd = tid & 3;
    const size_t row0 = (size_t)b * SEQ;
    const int qcol = (BR == 0 ? P_RQ : P_GQ) + h * 128, kcol = (BR == 0 ? P_RK : P_GK) + h * 128, vcol = (BR == 0 ? P_RV : P_GV) + h * 256 + half * 128;
    const float gamma = 1.0f - exp2f(-5.0f - (float)h);
    LAS float* hv = sc + TG * 2;
    float s[32];
#pragma unroll
    for (int d = 0; d < 32; ++d) s[d] = 0.f;
    for (int i = tid; i < 2 * 3 * 128; i += 512) hv[i] = 0.f;
    __syncthreads();
    for (int t0 = 0; t0 < SEQ; t0 += TG) {
        if (BR == 0) {
#pragma unroll
            for (int r = 0; r < 2; ++r) { const int idx = tid + 512 * r, isk = idx >> 9, tt = (idx >> 6) & 7, i = idx & 63, t = t0 + tt;
                const bf16* pr = proj + (row0 + t) * PW + (isk ? kcol : qcol);
                const float x1 = bf2f(pr[i]), x2 = bf2f(pr[i + 64]); const float2 cs = rope[t * 64 + i];
                const float sc_ = isk ? 0.08838834764831845f : 1.0f;
                LAS float* dst = (isk ? kf : qf) + tt * 128;
                dst[i] = (x1 * cs.x - x2 * cs.y) * sc_; dst[i + 64] = (x1 * cs.y + x2 * cs.x) * sc_; }
#pragma unroll
            for (int r = 0; r < 2; ++r) { const int idx = tid + 512 * r, tt = idx >> 7, c = idx & 127;
                vf[tt * 128 + c] = bf2f(proj[(row0 + t0 + tt) * PW + vcol + c]); }
        } else {
            if (tid < 384) {
                const bool isv = tid >= 256; const int u = isv ? tid - 256 : tid;
                const int tt = isv ? (u >> 4) : (u >> 5), part = isv ? (u & 15) : (u & 31), t = t0 + tt;
                const int col = isv ? (vcol + 8 * part) : (part < 16 ? qcol + 8 * part : kcol + 8 * (part - 16));
                const int cch = col - P_GQ;
                float acc[8];
#pragma unroll
                for (int j = 0; j < 8; ++j) acc[j] = 0.f;
#pragma unroll
                for (int i = 0; i < 4; ++i) { const int tr = t - 3 + i;
                    if (isv && tr < t0) {
                        const LAS float* hp = hv + (((t0 / TG) & 1) * 3 + (tr - (t0 - 3))) * 128 + 8 * part;
                        const float4 w0 = *(const float4*)(conv_w + i * 2048 + cch), w1 = *(const float4*)(conv_w + i * 2048 + cch + 4);
                        acc[0] += hp[0] * w0.x; acc[1] += hp[1] * w0.y; acc[2] += hp[2] * w0.z; acc[3] += hp[3] * w0.w;
                        acc[4] += hp[4] * w1.x; acc[5] += hp[5] * w1.y; acc[6] += hp[6] * w1.z; acc[7] += hp[7] * w1.w;
                    } else if (tr >= 0) { const v4u raw = *(const v4u*)(proj + (row0 + tr) * PW + col);
                        if (isv && i == 3 && tt >= TG - 3) { LAS float* hn = hv + ((((t0 / TG) + 1) & 1) * 3 + (tt - (TG - 3))) * 128 + 8 * part;
                            hn[0] = bflo(raw.x); hn[1] = bfhi(raw.x); hn[2] = bflo(raw.y); hn[3] = bfhi(raw.y); hn[4] = bflo(raw.z); hn[5] = bfhi(raw.z); hn[6] = bflo(raw.w); hn[7] = bfhi(raw.w); }
                        const float4 w0 = *(const float4*)(conv_w + i * 2048 + cch), w1 = *(const float4*)(conv_w + i * 2048 + cch + 4);
                        acc[0] += bflo(raw.x) * w0.x; acc[1] += bfhi(raw.x) * w0.y; acc[2] += bflo(raw.y) * w0.z; acc[3] += bfhi(raw.y) * w0.w;
                        acc[4] += bflo(raw.z) * w1.x; acc[5] += bfhi(raw.z) * w1.y; acc[6] += bflo(raw.w) * w1.z; acc[7] += bfhi(raw.w) * w1.w; } }
                float ss = 0.f;
#pragma unroll
                for (int j = 0; j < 8; ++j) { acc[j] = acc[j] * fsigmoid(acc[j]); ss += acc[j] * acc[j]; }
                if (!isv) {
                    ss += __shfl_xor(ss, 1); ss += __shfl_xor(ss, 2); ss += __shfl_xor(ss, 4); ss += __shfl_xor(ss, 8);
                    const float rn = rsqrtf(ss + 1e-6f) * (part < 16 ? 0.08838834764831845f : 1.0f);
                    LAS float* dst = (part < 16 ? qf : kf) + tt * 128 + 8 * (part & 15);
#pragma unroll
                    for (int j = 0; j < 8; ++j) dst[j] = acc[j] * rn;
                } else { LAS float* dst = vf + tt * 128 + 8 * part;
#pragma unroll
                    for (int j = 0; j < 8; ++j) dst[j] = acc[j]; }
            } else if (tid < 384 + TG) { const int tt = tid - 384; const size_t gi = (row0 + t0 + tt) * 4 + h; sc[tt * 2] = expf(Gd[gi]); sc[tt * 2 + 1] = Bd[gi]; }
        }
        __syncthreads();
#pragma unroll 1
        for (int tt = 0; tt < TG; ++tt) {
            const LAS f4* kp = (const LAS f4*)(kf + tt * 128 + 32 * qd); const LAS f4* qp = (const LAS f4*)(qf + tt * 128 + 32 * qd);
            const float vt = vf[tt * 128 + v];
            float o = 0.f;
            if (BR == 0) {
#pragma unroll
                for (int d4 = 0; d4 < 8; ++d4) { const f4 kk = kp[d4], qq = qp[d4];
                    s[4 * d4 + 0] = gamma * s[4 * d4 + 0] + kk.x * vt; o += qq.x * s[4 * d4 + 0];
                    s[4 * d4 + 1] = gamma * s[4 * d4 + 1] + kk.y * vt; o += qq.y * s[4 * d4 + 1];
                    s[4 * d4 + 2] = gamma * s[4 * d4 + 2] + kk.z * vt; o += qq.z * s[4 * d4 + 2];
                    s[4 * d4 + 3] = gamma * s[4 * d4 + 3] + kk.w * vt; o += qq.w * s[4 * d4 + 3]; }
            } else {
                const float al = sc[tt * 2], bt = sc[tt * 2 + 1];
                float dot = 0.f;
#pragma unroll
                for (int d4 = 0; d4 < 8; ++d4) { const f4 kk = kp[d4];
                    s[4 * d4 + 0] *= al; dot += s[4 * d4 + 0] * kk.x; s[4 * d4 + 1] *= al; dot += s[4 * d4 + 1] * kk.y;
                    s[4 * d4 + 2] *= al; dot += s[4 * d4 + 2] * kk.z; s[4 * d4 + 3] *= al; dot += s[4 * d4 + 3] * kk.w; }
                dot = quad_sum(dot);
                const float vn = bt * (vt - dot);
#pragma unroll
                for (int d4 = 0; d4 < 8; ++d4) { const f4 kk = kp[d4], qq = qp[d4];
                    s[4 * d4 + 0] += kk.x * vn; o += s[4 * d4 + 0] * qq.x; s[4 * d4 + 1] += kk.y * vn; o += s[4 * d4 + 1] * qq.y;
                    s[4 * d4 + 2] += kk.z * vn; o += s[4 * d4 + 2] * qq.z; s[4 * d4 + 3] += kk.w * vn; o += s[4 * d4 + 3] * qq.w; }
            }
            o = quad_sum(o);
            if (qd == 0) of[tt * 128 + v] = o;
        }
        __syncthreads();
        if (tid < 128) { const int tt = tid >> 4, c8 = (tid & 15) * 8;
            const LAS float* src = of + tt * 128 + c8; float ss = 0.f;
#pragma unroll
            for (int j = 0; j < 8; ++j) ss += src[j] * src[j];
            v4u w; w.x = pk2(src[0], src[1]); w.y = pk2(src[2], src[3]); w.z = pk2(src[4], src[5]); w.w = pk2(src[6], src[7]);
            *(v4u*)(proj + (row0 + t0 + tt) * PW + vcol + c8) = w;
            ss += __shfl_xor(ss, 1); ss += __shfl_xor(ss, 2); ss += __shfl_xor(ss, 4); ss += __shfl_xor(ss, 8);
            if ((tid & 15) == 0) ssq[(row0 + t0 + tt) * 16 + BR * 8 + h * 2 + half] = ss; }
        __syncthreads();
    }
}
__device__ __forceinline__ void phase_scan_simple(const Args& a, LAS unsigned char* lds) {
    for (int id = blockIdx.x; id < 256; id += gridDim.x) {
        const int br = (id >> 4) & 1, half = (id >> 3) & 1, bh = (id >> 5) * 8 + (id & 7), b = bh >> 2, h = bh & 3;
        if (br == 0) scan_item<0>(a, lds, b, h, half); else scan_item<1>(a, lds, b, h, half);
        __syncthreads();
    }
}
__device__ __forceinline__ void phase_merge(const Args& a, LAS unsigned char* lds) {
    const bf16* proj = (const bf16*)(a.ws + WS_PROJ); const float* ssq = (const float*)(a.ws + WS_SSQ); const float* gnw = a.in[9];
    bf16* merged = (bf16*)(a.ws + WS_MERGED);
    const int tid = tidx(), lane = tid & 63, wave = tid >> 6;
    const int gw = blockIdx.x * 8 + wave, NGW = gridDim.x * 8;
    for (int t = gw; t < T; t += NGW) {
        const int c0 = 16 * lane, h = lane >> 4;
        const float* sq = ssq + (size_t)t * 16;
        const float rr = rsqrtf((sq[h * 2] + sq[h * 2 + 1]) * (1.0f / 256.0f) + 1e-6f), rg = rsqrtf((sq[8 + h * 2] + sq[8 + h * 2 + 1]) * (1.0f / 256.0f) + 1e-6f);
        const bf16* pr = proj + (size_t)t * PW;
#pragma unroll
        for (int part = 0; part < 2; ++part) { const int c = c0 + 8 * part;
            const v4u orv = *(const v4u*)(pr + P_RV + c), ogv = *(const v4u*)(pr + P_GV + c), ga = *(const v4u*)(pr + P_GA + c), gb = *(const v4u*)(pr + P_GB + c);
            const float4 w0 = *(const float4*)(gnw + (c & 255)), w1 = *(const float4*)(gnw + (c & 255) + 4);
            float o[8];
            o[0] = bflo(ga.x) * bflo(orv.x) * rr + bflo(gb.x) * bflo(ogv.x) * rg * w0.x; o[1] = bfhi(ga.x) * bfhi(orv.x) * rr + bfhi(gb.x) * bfhi(ogv.x) * rg * w0.y;
            o[2] = bflo(ga.y) * bflo(orv.y) * rr + bflo(gb.y) * bflo(ogv.y) * rg * w0.z; o[3] = bfhi(ga.y) * bfhi(orv.y) * rr + bfhi(gb.y) * bfhi(ogv.y) * rg * w0.w;
            o[4] = bflo(ga.z) * bflo(orv.z) * rr + bflo(gb.z) * bflo(ogv.z) * rg * w1.x; o[5] = bfhi(ga.z) * bfhi(orv.z) * rr + bfhi(gb.z) * bfhi(ogv.z) * rg * w1.y;
            o[6] = bflo(ga.w) * bflo(orv.w) * rr + bflo(gb.w) * bflo(ogv.w) * rg * w1.z; o[7] = bfhi(ga.w) * bfhi(orv.w) * rr + bfhi(gb.w) * bfhi(ogv.w) * rg * w1.w;
            v4u w; w.x = pk2(o[0], o[1]); w.y = pk2(o[2], o[3]); w.z = pk2(o[4], o[5]); w.w = pk2(o[6], o[7]);
            *(v4u*)(merged + (size_t)t * 1024 + c) = w; }
    }
}

}
namespace {
typedef short s8v __attribute__((ext_vector_type(8)));
typedef short s4v __attribute__((ext_vector_type(4)));
typedef float f16v __attribute__((ext_vector_type(16)));
#define MFMA32(a, b, c) __builtin_amdgcn_mfma_f32_32x32x16_bf16((a), (b), (c), 0, 0, 0)
constexpr int PT128 = 136, PT64 = 72;
constexpr size_t DO_QH = 0, DO_KHT = 32 * MiB, DO_QK = 64 * MiB, DO_TU = 80 * MiB, DO_TW = 96 * MiB;
constexpr size_t WS_VH = WS_MERGED;
constexpr size_t WS_EG = 464 * MiB, WS_EGL = 465 * MiB;

typedef __bf16 bf2v __attribute__((ext_vector_type(2)));
typedef float f2v __attribute__((ext_vector_type(2)));
__device__ __forceinline__ unsigned cvtpk(float lo, float hi) { const f2v v = {lo, hi}; return __builtin_bit_cast(unsigned, __builtin_convertvector(v, bf2v)); }
__device__ __forceinline__ s8v ld_nat(const LAS bf16* base, int pitch, int row, int k0, int hh) { return *(const LAS s8v*)(base + row * pitch + k0 + 8 * hh); }
__device__ __forceinline__ s8v ld_perm(const LAS bf16* base, int pitch, int row, int k0, int hh) {
    const LAS bf16* p = base + row * pitch + k0 + 4 * hh;
    const s4v lo = *(const LAS s4v*)p, hi = *(const LAS s4v*)(p + 8);
    return __builtin_shufflevector(lo, hi, 0, 1, 2, 3, 4, 5, 6, 7);
}
template <int S> __device__ __forceinline__ s8v pack8(const f16v& x) {
    v4u p; p.x = cvtpk(x[8 * S + 0], x[8 * S + 1]); p.y = cvtpk(x[8 * S + 2], x[8 * S + 3]); p.z = cvtpk(x[8 * S + 4], x[8 * S + 5]); p.w = cvtpk(x[8 * S + 6], x[8 * S + 7]);
    return __builtin_bit_cast(s8v, p);
}
__device__ __forceinline__ f16v zero16() { f16v z;
#pragma unroll
    for (int i = 0; i < 16; ++i) z[i] = 0.f; return z; }

__device__ __forceinline__ void conv8(const bf16* proj, size_t rowbase, int tloc, int col, const float* conv_w, int cch, float (&acc)[8]) {
#pragma unroll
    for (int j = 0; j < 8; ++j) acc[j] = 0.f;
#pragma unroll
    for (int i = 0; i < 4; ++i) { const int tr = tloc - 3 + i;
        if (tr >= 0) { const v4u raw = *(const v4u*)(proj + (rowbase + tr) * PW + col);
            const float4 w0 = *(const float4*)(conv_w + i * 2048 + cch), w1 = *(const float4*)(conv_w + i * 2048 + cch + 4);
            acc[0] += bflo(raw.x) * w0.x; acc[1] += bfhi(raw.x) * w0.y; acc[2] += bflo(raw.y) * w0.z; acc[3] += bfhi(raw.y) * w0.w;
            acc[4] += bflo(raw.z) * w1.x; acc[5] += bfhi(raw.z) * w1.y; acc[6] += bflo(raw.w) * w1.z; acc[7] += bfhi(raw.w) * w1.w; } }
}

__device__ __forceinline__ void tile_store_rm(LAS bf16* buf, const f16v& v, int mt, int nt, int r32, int hh) {
#pragma unroll
    for (int rg = 0; rg < 16; ++rg) buf[(32 * mt + (rg & 3) + 8 * (rg >> 2) + 4 * hh) * PT64 + 32 * nt + r32] = (bf16)f2bf(v[rg]);
}
__device__ __forceinline__ void tile_store_tr(LAS bf16* buf, const f16v& v, int mt, int nt, int r32, int hh) {
#pragma unroll
    for (int g4 = 0; g4 < 4; ++g4) { v2u w; w.x = cvtpk(v[4 * g4 + 0], v[4 * g4 + 1]); w.y = cvtpk(v[4 * g4 + 2], v[4 * g4 + 3]); *(LAS v2u*)(buf + (32 * nt + r32) * PT64 + 32 * mt + 8 * g4 + 4 * hh) = w; }
}
__device__ __forceinline__ void phase_gprep(const Args& a, LAS unsigned char* lds) {
    LAS bf16* Kh = (LAS bf16*)lds;
    LAS bf16* Qh = (LAS bf16*)(lds + 17408);
    LAS bf16* Kht = (LAS bf16*)(lds + 34816);
    LAS float* bt = (LAS float*)(lds + 53248);
    LAS float* gc = bt + 64;
    LAS bf16* MB = (LAS bf16*)(lds + 53760);
    constexpr int MSZ = 64 * PT64;
    const bf16* proj = (const bf16*)(a.ws + WS_PROJ);
    const float* Gd = (const float*)(a.ws + WS_G); const float* Bd = (const float*)(a.ws + WS_BETA); const float* conv_w = a.in[6];
    unsigned char* dout = (unsigned char*)a.out;
    bf16* QHg = (bf16*)(dout + DO_QH); bf16* KHTg = (bf16*)(dout + DO_KHT); bf16* QKg = (bf16*)(dout + DO_QK); bf16* TUg = (bf16*)(dout + DO_TU); bf16* TWg = (bf16*)(dout + DO_TW);
    bf16* VHg = (bf16*)(a.ws + WS_VH); float* EGg = (float*)(a.ws + WS_EG); float* EGLg = (float*)(a.ws + WS_EGL);
    const int tid = tidx(), lane = tid & 63, wave = tid >> 6, r32 = lane & 31, hh = lane >> 5;
#pragma unroll 1
    for (int item = blockIdx.x; item < 2048; item += gridDim.x) {
        const int n = item & 31, bh = item >> 5, h = bh & 3, b = bh >> 2;
        const size_t rowb = (size_t)b * SEQ;
        const int tl0 = n * 64;
        for (int i = tid; i < 8 * MSZ / 8; i += 512) ((LAS v4u*)MB)[i] = (v4u){0u, 0u, 0u, 0u};
        if (wave == 0) {
            float g = Gd[(rowb + tl0 + lane) * 4 + h];
#pragma unroll
            for (int o = 1; o < 64; o <<= 1) { const float t = __shfl_up(g, o); if (lane >= o) g += t; }
            const float gl = __shfl(g, 63);
            bt[lane] = Bd[(rowb + tl0 + lane) * 4 + h]; gc[lane] = g;
            EGg[(size_t)item * 64 + lane] = expf(g); EGLg[(size_t)item * 64 + lane] = expf(gl - g);
        }
#pragma unroll 1
        for (int r = 0; r < 4; ++r) {
            const int u = tid + 512 * r, tt = u >> 5, part = u & 31, isk = part >> 4, c8 = 8 * (part & 15);
            const int col = (isk ? P_GK : P_GQ) + h * 128 + c8;
            float acc[8]; conv8(proj, rowb, tl0 + tt, col, conv_w, col - P_GQ, acc);
            float ss = 0.f;
#pragma unroll
            for (int j = 0; j < 8; ++j) { acc[j] = acc[j] * fsigmoid(acc[j]); ss += acc[j] * acc[j]; }
            ss += __shfl_xor(ss, 1); ss += __shfl_xor(ss, 2); ss += __shfl_xor(ss, 4); ss += __shfl_xor(ss, 8);
            const float rn = rsqrtf(ss + 1e-6f) * (isk ? 1.0f : 0.08838834764831845f);
            v4u w; w.x = pk2(acc[0] * rn, acc[1] * rn); w.y = pk2(acc[2] * rn, acc[3] * rn); w.z = pk2(acc[4] * rn, acc[5] * rn); w.w = pk2(acc[6] * rn, acc[7] * rn);
            if (!isk) { *(LAS v4u*)(Qh + tt * PT128 + c8) = w; *(v4u*)(QHg + ((size_t)item * 64 + tt) * 128 + c8) = w; }
            else { *(LAS v4u*)(Kh + tt * PT128 + c8) = w;
                Kht[(c8 + 0) * PT64 + tt] = (bf16)(w.x & 0xffff); Kht[(c8 + 1) * PT64 + tt] = (bf16)(w.x >> 16); Kht[(c8 + 2) * PT64 + tt] = (bf16)(w.y & 0xffff); Kht[(c8 + 3) * PT64 + tt] = (bf16)(w.y >> 16);
                Kht[(c8 + 4) * PT64 + tt] = (bf16)(w.z & 0xffff); Kht[(c8 + 5) * PT64 + tt] = (bf16)(w.z >> 16); Kht[(c8 + 6) * PT64 + tt] = (bf16)(w.w & 0xffff); Kht[(c8 + 7) * PT64 + tt] = (bf16)(w.w >> 16); }
        }
#pragma unroll 1
        for (int r = 0; r < 4; ++r) {
            const int u = tid + 512 * r, tt = u >> 5, c8 = 8 * (u & 31), col = P_GV + h * 256 + c8;
            float acc[8]; conv8(proj, rowb, tl0 + tt, col, conv_w, col - P_GQ, acc);
#pragma unroll
            for (int j = 0; j < 8; ++j) acc[j] = acc[j] * fsigmoid(acc[j]);
            v4u w; w.x = pk2(acc[0], acc[1]); w.y = pk2(acc[2], acc[3]); w.z = pk2(acc[4], acc[5]); w.w = pk2(acc[6], acc[7]);
            *(v4u*)(VHg + (rowb + tl0 + tt) * 1024 + h * 256 + c8) = w;
        }
        __syncthreads();
        f16v X = zero16();
        const int q3 = (wave < 3) ? wave : wave - 3, mt = (q3 >= 1) ? 1 : 0, nt = (q3 == 2) ? 1 : 0;
        if (wave < 3) {
            f16v acc = zero16();
#pragma unroll
            for (int ks = 0; ks < 8; ++ks) acc = MFMA32(ld_nat(Kh, PT128, 32 * mt + r32, 16 * ks, hh), ld_nat(Kh, PT128, 32 * nt + r32, 16 * ks, hh), acc);
            const int bcol = 32 * nt + r32; const float gcb = gc[bcol];
            f16v N_;
#pragma unroll
            for (int rg = 0; rg < 16; ++rg) { const int ar = 32 * mt + (rg & 3) + 8 * (rg >> 2) + 4 * hh;
                N_[rg] = (ar > bcol) ? -bt[ar] * acc[rg] * expf(gc[ar] - gcb) : 0.f; X[rg] = N_[rg] + ((ar == bcol) ? 1.0f : 0.0f); }
            tile_store_rm(MB + 0 * MSZ, N_, mt, nt, r32, hh); tile_store_tr(MB + 1 * MSZ, N_, mt, nt, r32, hh);
            tile_store_rm(MB + 2 * MSZ, X, mt, nt, r32, hh);
        } else if (wave < 6) {
            const int jt = (wave == 5) ? 1 : 0, itile = (wave >= 4) ? 1 : 0;
            f16v acc = zero16();
#pragma unroll
            for (int ks = 0; ks < 8; ++ks) acc = MFMA32(ld_nat(Kh, PT128, 32 * jt + r32, 16 * ks, hh), ld_nat(Qh, PT128, 32 * itile + r32, 16 * ks, hh), acc);
            const int icol = 32 * itile + r32; const float gci = gc[icol];
#pragma unroll
            for (int g4 = 0; g4 < 4; ++g4) { const int j0 = 32 * jt + 8 * g4 + 4 * hh; float v[4];
#pragma unroll
                for (int j = 0; j < 4; ++j) { const int jr = j0 + j; v[j] = (icol >= jr) ? acc[4 * g4 + j] * expf(gci - gc[jr]) : 0.f; }
                v2u w; w.x = pk2(v[0], v[1]); w.y = pk2(v[2], v[3]); *(v2u*)(QKg + ((size_t)item * 64 + icol) * 64 + j0) = w; }
        } else if (wave == 6) {
            for (int i = lane; i < 32 * 4; i += 64) { const int row = i >> 2, c = i & 3; *(v4u*)(QKg + ((size_t)item * 64 + row) * 64 + 32 + 8 * c) = (v4u){0u, 0u, 0u, 0u}; }
        }
#pragma unroll
        for (int r = 0; r < 2; ++r) { const int p = tid + 512 * r, row = p >> 3, c = p & 7;
            *(v4u*)(KHTg + ((size_t)item * 128 + row) * 64 + 8 * c) = *(const LAS v4u*)(Kht + row * PT64 + 8 * c); }
        __syncthreads();
        if (wave >= 3 && wave < 6) {
            f16v acc = zero16();
#pragma unroll
            for (int ks = 0; ks < 4; ++ks) acc = MFMA32(ld_nat(MB + 0 * MSZ, PT64, 32 * mt + r32, 16 * ks, hh), ld_nat(MB + 1 * MSZ, PT64, 32 * nt + r32, 16 * ks, hh), acc);
            tile_store_rm(MB + 3 * MSZ, acc, mt, nt, r32, hh); tile_store_tr(MB + 4 * MSZ, acc, mt, nt, r32, hh);
        }
        __syncthreads();
#pragma unroll 1
        for (int r = 1; r <= 5; ++r) {
            const int so = ((r - 1) & 1) * 3, sn = (r & 1) * 3;
            LAS bf16* Xo = MB + (2 + so) * MSZ; LAS bf16* Po = MB + (3 + so) * MSZ; LAS bf16* Qo = MB + (4 + so) * MSZ;
            LAS bf16* Xn = MB + (2 + sn) * MSZ; LAS bf16* Pn = MB + (3 + sn) * MSZ; LAS bf16* Qn = MB + (4 + sn) * MSZ;
            if (wave < 3) {
#pragma unroll
                for (int ks = 0; ks < 4; ++ks) X = MFMA32(ld_nat(Xo, PT64, 32 * mt + r32, 16 * ks, hh), ld_nat(Qo, PT64, 32 * nt + r32, 16 * ks, hh), X);
                if (r < 5) tile_store_rm(Xn, X, mt, nt, r32, hh);
            } else if (wave < 6 && r < 5) {
                f16v acc = zero16();
#pragma unroll
                for (int ks = 0; ks < 4; ++ks) acc = MFMA32(ld_nat(Po, PT64, 32 * mt + r32, 16 * ks, hh), ld_nat(Qo, PT64, 32 * nt + r32, 16 * ks, hh), acc);
                tile_store_rm(Pn, acc, mt, nt, r32, hh); tile_store_tr(Qn, acc, mt, nt, r32, hh);
            }
            __syncthreads();
        }
        if (wave < 3) {
            const int jcol = 32 * nt + r32; const float bj = bt[jcol], ej = expf(gc[jcol]);
            f16v U_, W_;
#pragma unroll
            for (int rg = 0; rg < 16; ++rg) { U_[rg] = X[rg] * bj; W_[rg] = U_[rg] * ej; }
            tile_store_rm(MB + 0 * MSZ, U_, mt, nt, r32, hh); tile_store_rm(MB + 3 * MSZ, W_, mt, nt, r32, hh);
        }
        __syncthreads();
        { const int row = tid >> 3, c = tid & 7; const size_t go = ((size_t)item * 64 + row) * 64 + 8 * c;
          *(v4u*)(TUg + go) = *(const LAS v4u*)(MB + 0 * MSZ + row * PT64 + 8 * c); *(v4u*)(TWg + go) = *(const LAS v4u*)(MB + 3 * MSZ + row * PT64 + 8 * c); }
        __syncthreads();
    }
}

template <int BR>
__device__ __forceinline__ void scan_mfma_item(const Args& a, LAS unsigned char* lds, int b, int h) {
    LAS bf16* Tu = (LAS bf16*)lds; LAS bf16* Tw = (LAS bf16*)(lds + 9216); LAS bf16* QK = (LAS bf16*)(lds + 18432); LAS bf16* Qh = (LAS bf16*)(lds + 27648);
    LAS bf16* Kht = (LAS bf16*)(lds + 45056); LAS bf16* nW = (LAS bf16*)(lds + 63488);
    LAS bf16* Qd = (LAS bf16*)lds; LAS bf16* Kr = (LAS bf16*)(lds + 17408); LAS bf16* Kdt = (LAS bf16*)(lds + 34816); LAS bf16* Pm = (LAS bf16*)(lds + 53248);
    LAS float* egs = (LAS float*)(lds + 117760); LAS float* egls = egs + 64;
    bf16* proj = (bf16*)(a.ws + WS_PROJ);
    const int tid = tidx(), lane = tid & 63, wave = tid >> 6, r32 = lane & 31, hh = lane >> 5;
    LAS bf16* Vt = (LAS bf16*)(lds + 80896 + wave * 4608);
    const size_t rowb = (size_t)b * SEQ;
    const unsigned char* dout = (const unsigned char*)a.out;
    const bf16* QHg = (const bf16*)(dout + DO_QH); const bf16* KHTg = (const bf16*)(dout + DO_KHT); const bf16* QKg = (const bf16*)(dout + DO_QK);
    const bf16* TUg = (const bf16*)(dout + DO_TU); const bf16* TWg = (const bf16*)(dout + DO_TW);
    const bf16* VHg = (const bf16*)(a.ws + WS_VH); const float* EGg = (const float*)(a.ws + WS_EG); const float* EGLg = (const float*)(a.ws + WS_EGL);
    const float2* rope = (const float2*)(a.ws + WS_ROPE);
    const float lgam = logf(1.0f - exp2f(-5.0f - (float)h));
    f16v S[4];
#pragma unroll
    for (int dt = 0; dt < 4; ++dt) S[dt] = zero16();
#pragma unroll 1
    for (int n = 0; n < 32; ++n) {
        const int tl0 = n * 64, item = (b * 4 + h) * 32 + n;
        if (BR == 1) {
            { const int row = tid >> 3, c = tid & 7; const size_t go = ((size_t)item * 64 + row) * 64 + 8 * c;
              *(LAS v4u*)(Tu + row * PT64 + 8 * c) = *(const v4u*)(TUg + go); *(LAS v4u*)(Tw + row * PT64 + 8 * c) = *(const v4u*)(TWg + go); *(LAS v4u*)(QK + row * PT64 + 8 * c) = *(const v4u*)(QKg + go); }
#pragma unroll
            for (int r = 0; r < 2; ++r) { const int p = tid + 512 * r;
                { const int row = p >> 4, c = p & 15; *(LAS v4u*)(Qh + row * PT128 + 8 * c) = *(const v4u*)(QHg + ((size_t)item * 64 + row) * 128 + 8 * c); }
                { const int row = p >> 3, c = p & 7; *(LAS v4u*)(Kht + row * PT64 + 8 * c) = *(const v4u*)(KHTg + ((size_t)item * 128 + row) * 64 + 8 * c); } }
            if (tid < 64) egs[tid] = EGg[(size_t)item * 64 + tid]; else if (tid < 128) egls[tid - 64] = EGLg[(size_t)item * 64 + tid - 64];
        } else {
#pragma unroll
            for (int r = 0; r < 2; ++r) {
                const int u = tid + 512 * r, tt = u >> 4, isk = (u >> 3) & 1, i0 = 8 * (u & 7), t = tl0 + tt;
                const bf16* pr = proj + (rowb + t) * PW + (isk ? P_RK : P_RQ) + h * 128;
                const v4u x1 = *(const v4u*)(pr + i0), x2 = *(const v4u*)(pr + 64 + i0);
                const float4* rp = (const float4*)(rope + t * 64 + i0);
                const float4 c0 = rp[0], c1 = rp[1], c2 = rp[2], c3 = rp[3];
                const float a1[8] = {bflo(x1.x), bfhi(x1.x), bflo(x1.y), bfhi(x1.y), bflo(x1.z), bfhi(x1.z), bflo(x1.w), bfhi(x1.w)};
                const float a2[8] = {bflo(x2.x), bfhi(x2.x), bflo(x2.y), bfhi(x2.y), bflo(x2.z), bfhi(x2.z), bflo(x2.w), bfhi(x2.w)};
                const float cs[8] = {c0.x, c0.z, c1.x, c1.z, c2.x, c2.z, c3.x, c3.z}, sn[8] = {c0.y, c0.w, c1.y, c1.w, c2.y, c2.w, c3.y, c3.w};
                const float sc = isk ? 0.08838834764831845f : expf((float)(tt + 1) * lgam);
                float o1[8], o2[8];
#pragma unroll
                for (int j = 0; j < 8; ++j) { o1[j] = (a1[j] * cs[j] - a2[j] * sn[j]) * sc; o2[j] = (a1[j] * sn[j] + a2[j] * cs[j]) * sc; }
                v4u w1, w2; w1.x = pk2(o1[0], o1[1]); w1.y = pk2(o1[2], o1[3]); w1.z = pk2(o1[4], o1[5]); w1.w = pk2(o1[6], o1[7]);
                w2.x = pk2(o2[0], o2[1]); w2.y = pk2(o2[2], o2[3]); w2.z = pk2(o2[4], o2[5]); w2.w = pk2(o2[6], o2[7]);
                LAS bf16* dst = (isk ? Kr : Qd) + tt * PT128;
                *(LAS v4u*)(dst + i0) = w1; *(LAS v4u*)(dst + 64 + i0) = w2;
                if (isk) { const float kd = expf((float)(63 - tt) * lgam);
#pragma unroll
                    for (int j = 0; j < 8; ++j) { Kdt[(i0 + j) * PT64 + tt] = (bf16)f2bf(o1[j] * kd); Kdt[(64 + i0 + j) * PT64 + tt] = (bf16)f2bf(o2[j] * kd); } }
            }
        }
        {
            const bf16* vsrc = (BR == 1) ? (VHg + (rowb + tl0 + lane) * 1024 + h * 256 + 32 * wave) : (proj + (rowb + tl0 + lane) * PW + P_RV + h * 256 + 32 * wave);
            const v4u q0 = ((const v4u*)vsrc)[0], q1 = ((const v4u*)vsrc)[1], q2 = ((const v4u*)vsrc)[2], q3 = ((const v4u*)vsrc)[3];
            const unsigned wv[16] = {q0.x, q0.y, q0.z, q0.w, q1.x, q1.y, q1.z, q1.w, q2.x, q2.y, q2.z, q2.w, q3.x, q3.y, q3.z, q3.w};
#pragma unroll
            for (int j = 0; j < 16; ++j) { Vt[(2 * j) * PT64 + lane] = (bf16)(wv[j] & 0xffff); Vt[(2 * j + 1) * PT64 + lane] = (bf16)(wv[j] >> 16); }
        }
        __syncthreads();
        if (BR == 1) {
            const int dt = wave >> 1, itile = wave & 1;
            f16v acc = zero16();
#pragma unroll
            for (int ks = 0; ks < 4; ++ks) acc = MFMA32(ld_nat(Kht, PT64, 32 * dt + r32, 16 * ks, hh), ld_nat(Tw, PT64, 32 * itile + r32, 16 * ks, hh), acc);
            const int icol = 32 * itile + r32;
#pragma unroll
            for (int g4 = 0; g4 < 4; ++g4) { const int d0 = 32 * dt + 8 * g4 + 4 * hh;
                v2u w; w.x = cvtpk(-acc[4 * g4 + 0], -acc[4 * g4 + 1]); w.y = cvtpk(-acc[4 * g4 + 2], -acc[4 * g4 + 3]); *(LAS v2u*)(nW + icol * PT128 + d0) = w; }
        } else if (wave < 3) {
            const int jt = (wave == 2) ? 1 : 0, itile = (wave >= 1) ? 1 : 0;
            f16v acc = zero16();
#pragma unroll
            for (int ks = 0; ks < 8; ++ks) acc = MFMA32(ld_nat(Kr, PT128, 32 * jt + r32, 16 * ks, hh), ld_nat(Qd, PT128, 32 * itile + r32, 16 * ks, hh), acc);
            const int icol = 32 * itile + r32;
#pragma unroll
            for (int g4 = 0; g4 < 4; ++g4) { const int j0 = 32 * jt + 8 * g4 + 4 * hh; float v[4];
#pragma unroll
                for (int j = 0; j < 4; ++j) { const int jr = j0 + j; v[j] = (icol >= jr) ? acc[4 * g4 + j] * expf(-(float)(jr + 1) * lgam) : 0.f; }
                v2u w; w.x = cvtpk(v[0], v[1]); w.y = cvtpk(v[2], v[3]); *(LAS v2u*)(Pm + icol * PT64 + j0) = w; }
        }
        __syncthreads();
        s8v Sp[4][2];
#pragma unroll
        for (int dt = 0; dt < 4; ++dt) { Sp[dt][0] = pack8<0>(S[dt]); Sp[dt][1] = pack8<1>(S[dt]); }
        bf16* orow = proj + (rowb + tl0) * PW + (BR == 1 ? P_GV : P_RV) + h * 256 + 32 * wave + r32;
        if (BR == 1) {
            s8v vb[2][2], vs[2][2];
#pragma unroll
            for (int it = 0; it < 2; ++it) {
                f16v acc = zero16();
#pragma unroll
                for (int ks = 0; ks < 4; ++ks) acc = MFMA32(ld_nat(Tu, PT64, 32 * it + r32, 16 * ks, hh), ld_nat(Vt, PT64, r32, 16 * ks, hh), acc);
#pragma unroll
                for (int dt = 0; dt < 4; ++dt) { acc = MFMA32(ld_perm(nW, PT128, 32 * it + r32, 32 * dt, hh), Sp[dt][0], acc); acc = MFMA32(ld_perm(nW, PT128, 32 * it + r32, 32 * dt + 16, hh), Sp[dt][1], acc); }
                vb[it][0] = pack8<0>(acc); vb[it][1] = pack8<1>(acc);
#pragma unroll
                for (int g4 = 0; g4 < 4; ++g4) { const f4 e = *(const LAS f4*)(egls + 32 * it + 8 * g4 + 4 * hh); acc[4 * g4 + 0] *= e.x; acc[4 * g4 + 1] *= e.y; acc[4 * g4 + 2] *= e.z; acc[4 * g4 + 3] *= e.w; }
                vs[it][0] = pack8<0>(acc); vs[it][1] = pack8<1>(acc);
            }
#pragma unroll
            for (int it = 0; it < 2; ++it) {
                f16v acc = zero16();
#pragma unroll
                for (int dt = 0; dt < 4; ++dt) { acc = MFMA32(ld_perm(Qh, PT128, 32 * it + r32, 32 * dt, hh), Sp[dt][0], acc); acc = MFMA32(ld_perm(Qh, PT128, 32 * it + r32, 32 * dt + 16, hh), Sp[dt][1], acc); }
#pragma unroll
                for (int g4 = 0; g4 < 4; ++g4) { const f4 e = *(const LAS f4*)(egs + 32 * it + 8 * g4 + 4 * hh); acc[4 * g4 + 0] *= e.x; acc[4 * g4 + 1] *= e.y; acc[4 * g4 + 2] *= e.z; acc[4 * g4 + 3] *= e.w; }
#pragma unroll
                for (int jt = 0; jt <= it; ++jt) { acc = MFMA32(ld_perm(QK, PT64, 32 * it + r32, 32 * jt, hh), vb[jt][0], acc); acc = MFMA32(ld_perm(QK, PT64, 32 * it + r32, 32 * jt + 16, hh), vb[jt][1], acc); }
#pragma unroll
                for (int rg = 0; rg < 16; ++rg) { const int row = 32 * it + (rg & 3) + 8 * (rg >> 2) + 4 * hh; orow[(size_t)row * PW] = (bf16)f2bf(acc[rg]); }
            }
            const float egl_ = egs[63];
#pragma unroll
            for (int dt = 0; dt < 4; ++dt) {
#pragma unroll
                for (int i = 0; i < 16; ++i) S[dt][i] *= egl_;
#pragma unroll
                for (int it = 0; it < 2; ++it) { S[dt] = MFMA32(ld_perm(Kht, PT64, 32 * dt + r32, 32 * it, hh), vs[it][0], S[dt]); S[dt] = MFMA32(ld_perm(Kht, PT64, 32 * dt + r32, 32 * it + 16, hh), vs[it][1], S[dt]); }
            }
        } else {
#pragma unroll
            for (int it = 0; it < 2; ++it) {
                f16v acc = zero16();
#pragma unroll
                for (int dt = 0; dt < 4; ++dt) { acc = MFMA32(ld_perm(Qd, PT128, 32 * it + r32, 32 * dt, hh), Sp[dt][0], acc); acc = MFMA32(ld_perm(Qd, PT128, 32 * it + r32, 32 * dt + 16, hh), Sp[dt][1], acc); }
#pragma unroll
                for (int jt = 0; jt <= it; ++jt)
#pragma unroll
                    for (int ks = 0; ks < 2; ++ks) acc = MFMA32(ld_nat(Pm, PT64, 32 * it + r32, 32 * jt + 16 * ks, hh), ld_nat(Vt, PT64, r32, 32 * jt + 16 * ks, hh), acc);
#pragma unroll
                for (int rg = 0; rg < 16; ++rg) { const int row = 32 * it + (rg & 3) + 8 * (rg >> 2) + 4 * hh; orow[(size_t)row * PW] = (bf16)f2bf(acc[rg]); }
            }
            const float g64 = expf(64.0f * lgam);
#pragma unroll
            for (int dt = 0; dt < 4; ++dt) {
#pragma unroll
                for (int i = 0; i < 16; ++i) S[dt][i] *= g64;
#pragma unroll
                for (int ks = 0; ks < 4; ++ks) S[dt] = MFMA32(ld_nat(Kdt, PT64, 32 * dt + r32, 16 * ks, hh), ld_nat(Vt, PT64, r32, 16 * ks, hh), S[dt]);
            }
        }
        __syncthreads();
    }
}
__device__ __forceinline__ void phase_scan_mfma(const Args& a, LAS unsigned char* lds) {
    for (int id = blockIdx.x; id < 128; id += gridDim.x) {
        const int br = id & 1, bh = id >> 1, b = bh >> 2, h = bh & 3;
        if (br == 0) scan_mfma_item<0>(a, lds, b, h); else scan_mfma_item<1>(a, lds, b, h);
    }
}
__device__ __forceinline__ void phase_merge2(const Args& a, LAS unsigned char* lds) {
    const bf16* proj = (const bf16*)(a.ws + WS_PROJ); const float* gnw = a.in[9];
    bf16* merged = (bf16*)(a.ws + WS_MERGED);
    const int tid = tidx(), lane = tid & 63, wave = tid >> 6;
    const int gw = blockIdx.x * 8 + wave, NGW = gridDim.x * 8;
    for (int t = gw; t < T; t += NGW) {
        const int c0 = 16 * lane;
        const bf16* pr = proj + (size_t)t * PW;
        v4u orv[2], ogv[2]; float sr = 0.f, sg = 0.f;
#pragma unroll
        for (int part = 0; part < 2; ++part) { orv[part] = *(const v4u*)(pr + P_RV + c0 + 8 * part); ogv[part] = *(const v4u*)(pr + P_GV + c0 + 8 * part);
            const unsigned ru[4] = {orv[part].x, orv[part].y, orv[part].z, orv[part].w}, gu[4] = {ogv[part].x, ogv[part].y, ogv[part].z, ogv[part].w};
#pragma unroll
            for (int j = 0; j < 4; ++j) { sr += bflo(ru[j]) * bflo(ru[j]) + bfhi(ru[j]) * bfhi(ru[j]); sg += bflo(gu[j]) * bflo(gu[j]) + bfhi(gu[j]) * bfhi(gu[j]); } }
        sr += __shfl_xor(sr, 1); sr += __shfl_xor(sr, 2); sr += __shfl_xor(sr, 4); sr += __shfl_xor(sr, 8);
        sg += __shfl_xor(sg, 1); sg += __shfl_xor(sg, 2); sg += __shfl_xor(sg, 4); sg += __shfl_xor(sg, 8);
        const float rr = rsqrtf(sr * (1.0f / 256.0f) + 1e-6f), rg = rsqrtf(sg * (1.0f / 256.0f) + 1e-6f);
#pragma unroll
        for (int part = 0; part < 2; ++part) { const int c = c0 + 8 * part;
            const v4u ga = *(const v4u*)(pr + P_GA + c), gb = *(const v4u*)(pr + P_GB + c);
            const float4 w0 = *(const float4*)(gnw + (c & 255)), w1 = *(const float4*)(gnw + (c & 255) + 4);
            const v4u ov = orv[part], gv = ogv[part];
            float o[8];
            o[0] = bflo(ga.x) * bflo(ov.x) * rr + bflo(gb.x) * bflo(gv.x) * rg * w0.x; o[1] = bfhi(ga.x) * bfhi(ov.x) * rr + bfhi(gb.x) * bfhi(gv.x) * rg * w0.y;
            o[2] = bflo(ga.y) * bflo(ov.y) * rr + bflo(gb.y) * bflo(gv.y) * rg * w0.z; o[3] = bfhi(ga.y) * bfhi(ov.y) * rr + bfhi(gb.y) * bfhi(gv.y) * rg * w0.w;
            o[4] = bflo(ga.z) * bflo(ov.z) * rr + bflo(gb.z) * bflo(gv.z) * rg * w1.x; o[5] = bfhi(ga.z) * bfhi(ov.z) * rr + bfhi(gb.z) * bfhi(gv.z) * rg * w1.y;
            o[6] = bflo(ga.w) * bflo(ov.w) * rr + bflo(gb.w) * bflo(gv.w) * rg * w1.z; o[7] = bfhi(ga.w) * bfhi(ov.w) * rr + bfhi(gb.w) * bfhi(gv.w) * rg * w1.w;
            v4u w; w.x = pk2(o[0], o[1]); w.y = pk2(o[2], o[3]); w.z = pk2(o[4], o[5]); w.w = pk2(o[6], o[7]);
            *(v4u*)(merged + (size_t)t * 1024 + c) = w; }
    }
}
}
namespace {
template <int MODE> __device__ __forceinline__ void phase_scan_mix(const Args& a, LAS unsigned char* lds) {
    const int id = blockIdx.x;
    if (id < 64) { const int b = id >> 2, h = id & 3; if (MODE == 1) scan_mfma_item<0>(a, lds, b, h); else scan_mfma_item<1>(a, lds, b, h); }
    else if (id < 192) { const int q = id - 64, half = q & 1, bh = q >> 1, b = bh >> 2, h = bh & 3; if (MODE == 1) scan_item<1>(a, lds, b, h, half); else scan_item<0>(a, lds, b, h, half); }
}
template <int PH> __device__ __forceinline__ void run_phase(const Args& a, LAS unsigned char* lds) {
    if (PH == 0) phase_mod(a, lds);
    else if (PH == 1) { phase_norm1(a, lds); __syncthreads(); phase_convert_in(a, lds); }
    else if (PH == 2) phase_inproj(a, lds);
    else if (PH == 3) phase_gprep(a, lds);
    else if (PH == 4) phase_scan_mfma(a, lds);
    else if (PH == 5) phase_merge2(a, lds);
    else if (PH == 6) phase_outproj(a, lds);
    else if (PH == 7) { phase_route(a, lds); __syncthreads(); phase_convert_experts(a, lds); }
    else if (PH == 8) phase_scatter(a, lds);
    else if (PH == 9) phase_moe1(a, lds);
    else if (PH == 10) phase_moe2(a, lds);
    else if (PH == 11) phase_final(a, lds);
    else if (PH == 21) phase_scan_mix<1>(a, lds);
    else if (PH == 22) phase_scan_mix<2>(a, lds);
}
template <int PH> __global__ void __launch_bounds__(512, 2) k_phase(Args a) {
    extern __shared__ __attribute__((aligned(16))) unsigned char smem[];
    run_phase<PH>(a, (LAS unsigned char*)smem);
}
}
namespace {
#define XB_TMO      128
#define XB_XCNT(j)  (256  + 64 * (j))
#define XB_XSUB(j)  (1280 + 64 * (j))
#define XB_XGEN(j)  (2304 + 64 * (j))
#define XB_TOP      3328
#define XB_TOPGEN   3392
#define XCD_BAR_WORDS 3456
#define XB_SPIN_CAP (1u << 18)

__device__ __forceinline__ unsigned xb_ld(unsigned* p)              { return __hip_atomic_load(p, __ATOMIC_RELAXED, __HIP_MEMORY_SCOPE_AGENT); }
__device__ __forceinline__ unsigned xb_add(unsigned* p, unsigned v) { return __hip_atomic_fetch_add(p, v, __ATOMIC_RELAXED, __HIP_MEMORY_SCOPE_AGENT); }
__device__ __forceinline__ unsigned xb_xcc_id() { return (unsigned)__builtin_amdgcn_s_getreg((3 << 11) | 20) & 0xFu; }
#define XB_SPIN(cond, bar) do { unsigned _sp = 0; while (cond) { __builtin_amdgcn_s_sleep(1); \
    if ((++_sp & 255u) == 0u) { if (xb_ld(&(bar)[XB_TMO])) break; if (_sp > XB_SPIN_CAP) { atomicAdd(&(bar)[XB_TMO], 1u); break; } } } } while (0)

struct XcdBarrier {
    unsigned* bar; unsigned x;
    volatile LAS unsigned* st;
};

__device__ __forceinline__ XcdBarrier xcd_barrier_post(unsigned* bar, volatile LAS unsigned* st) {
    XcdBarrier b; b.bar = bar; b.x = xb_xcc_id(); b.st = st;
    if (threadIdx.x == 0) (void)xb_add(&bar[XB_XCNT(b.x)], 1u);
    return b;
}
__device__ __forceinline__ void xcd_barrier_complete(unsigned* bar, unsigned x, unsigned& nloc, unsigned& nx) {
    const unsigned G = gridDim.x * gridDim.y * gridDim.z;
    unsigned sum, cnt, mine, sp = 0u;
    for (;;) {
        sum = 0u; cnt = 0u; mine = 0u;
#pragma unroll
        for (unsigned j = 0; j < 16; ++j) { const unsigned c = xb_ld(&bar[XB_XCNT(j)]); sum += c; cnt += (c > 0u) ? 1u : 0u; mine = (j == x) ? c : mine; }
        if (sum == G) break;
        __builtin_amdgcn_s_sleep(1);
        if ((++sp & 255u) == 0u) { if (xb_ld(&bar[XB_TMO])) break; if (sp > XB_SPIN_CAP) { atomicAdd(&bar[XB_TMO], 1u); break; } }
    }
    nloc = mine > 0u ? mine : 1u; nx = cnt > 0u ? cnt : 1u;
}

__device__ __forceinline__ void xcd_barrier(const XcdBarrier& b) {
    asm volatile("s_waitcnt vmcnt(0)" ::: "memory");
    __syncthreads();
    if (threadIdx.x == 0) {
        unsigned* bar = b.bar;
        __builtin_amdgcn_s_waitcnt(0);
        unsigned nloc = b.st[0], nx = b.st[1];
        if (nloc == 0u) { xcd_barrier_complete(bar, b.x, nloc, nx); b.st[0] = nloc; b.st[1] = nx; }
        const unsigned old = xb_add(&bar[XB_XSUB(b.x)], 1u);
        const unsigned gen = old / nloc;
        if (old + 1u == (gen + 1u) * nloc) {
            __builtin_amdgcn_fence(__ATOMIC_RELEASE, "agent");
            asm volatile("s_waitcnt vmcnt(0)" ::: "memory");
            const unsigned og = xb_add(&bar[XB_TOP], 1u);
            const unsigned tg = og / nx;
            if (og + 1u == (tg + 1u) * nx) xb_add(&bar[XB_TOPGEN], 1u);
            else XB_SPIN(xb_ld(&bar[XB_TOPGEN]) == tg, bar);
            __builtin_amdgcn_fence(__ATOMIC_ACQUIRE, "agent");
            xb_add(&bar[XB_XGEN(b.x)], 1u);
            asm volatile("s_waitcnt vmcnt(0)" ::: "memory");
        } else {
            XB_SPIN(xb_ld(&bar[XB_XGEN(b.x)]) == gen, bar);
            __builtin_amdgcn_fence(__ATOMIC_ACQUIRE, "agent");
            asm volatile("s_waitcnt vmcnt(0)" ::: "memory");
        }
    }
    __syncthreads();
}

constexpr int LDS_BAR_OFF = LDS_BYTES - 16;
__global__ void __launch_bounds__(512, 2) k_mega(Args a) {
    extern __shared__ __attribute__((aligned(16))) unsigned char smem[];
    LAS unsigned char* lds = (LAS unsigned char*)smem;
    cg::grid_group grid = cg::this_grid();
    if (threadIdx.x == 0) *(LAS v4u*)(lds + LDS_BAR_OFF) = (v4u){0u, 0u, 0u, 0u};
    __syncthreads();
    XcdBarrier bar = xcd_barrier_post((unsigned*)(a.ws + WS_CTL), (volatile LAS unsigned*)(lds + LDS_BAR_OFF));
    run_phase<0>(a, lds); grid.sync();
    run_phase<1>(a, lds); xcd_barrier(bar);
    run_phase<2>(a, lds); xcd_barrier(bar);
    run_phase<3>(a, lds); xcd_barrier(bar);
    run_phase<4>(a, lds); xcd_barrier(bar);
    run_phase<5>(a, lds); xcd_barrier(bar);
    run_phase<6>(a, lds); xcd_barrier(bar);
    run_phase<7>(a, lds); xcd_barrier(bar);
    run_phase<8>(a, lds); xcd_barrier(bar);
    run_phase<9>(a, lds); xcd_barrier(bar);
    run_phase<10>(a, lds); xcd_barrier(bar);
    run_phase<11>(a, lds);
}
}
extern "C" void kernel_launch(void* const* d_in, const int* in_sizes, int n_in, void* d_out, int out_size, void* d_ws, size_t ws_size, hipStream_t stream) {
    if (ws_size < 512 * MiB) return;
    static int grid_blocks = 0;
    if (!grid_blocks) {
        int dev = 0, cus = 0, per_cu = 0;
        (void)hipGetDevice(&dev);
        (void)hipDeviceGetAttribute(&cus, hipDeviceAttributeMultiprocessorCount, dev);
        (void)hipFuncSetAttribute((const void*)k_mega, hipFuncAttributeMaxDynamicSharedMemorySize, LDS_BYTES);
        (void)hipOccupancyMaxActiveBlocksPerMultiprocessor(&per_cu, (const void*)k_mega, 512, LDS_BYTES);
        if (per_cu < 1) per_cu = 1;
        grid_blocks = cus * per_cu;
        if (grid_blocks > 256) grid_blocks = 256;
    }
    (void)hipMemsetAsync((unsigned char*)d_ws + WS_CTL, 0, XCD_BAR_WORDS * 4, stream);
    Args a{};
    for (int i = 0; i < 20; ++i) a.in[i] = (const float*)d_in[i];
    a.out = (float*)d_out; a.ws = (unsigned char*)d_ws;
    void* args[] = {&a};
    (void)hipLaunchCooperativeKernel((const void*)k_mega, dim3(grid_blocks), dim3(512), args, LDS_BYTES, stream);
}
```

```cpp
#include <hip/hip_runtime.h>
#include <hip/hip_cooperative_groups.h>
#include <stdint.h>
namespace cg = cooperative_groups;

#define LAS __attribute__((address_space(3)))
typedef unsigned short bf16;
typedef unsigned v4u __attribute__((ext_vector_type(4)));
typedef unsigned v2u __attribute__((ext_vector_type(2)));
typedef float f4 __attribute__((ext_vector_type(4)));

namespace {
constexpr int D = 1024, NB = 16, SEQ = 2048, T = NB * SEQ, DIN = 8200;
constexpr int NH = 4, DK = 128, DV = 256;
constexpr int C_RQ = 0, C_RK = 512, C_RV = 1024, C_RG = 2048, C_GQ = 3072, C_GK = 3584, C_GV = 4096, C_GZ = 5120,
              C_GA = 6144, C_GB = 6148, C_GTA = 6152, C_GTB = 7176;
constexpr int NE = 16, FF = 512;
constexpr int MAXSLOT = 2 * T + NE * 256;
constexpr int PW = 6144, P_RQ = 0, P_RK = 512, P_RV = 1024, P_GQ = 2048, P_GK = 2560, P_GV = 3072, P_GA = 4096, P_GB = 5120;

constexpr size_t MiB = 1u << 20;
constexpr size_t WS_PROJ = 0;
constexpr size_t WS_MERGED = 384 * MiB;
constexpr size_t WS_WTOUT = 448 * MiB;
constexpr size_t WS_CTL = 450 * MiB;
constexpr size_t WS_MOD = 450 * MiB + 64 * 1024;
constexpr size_t WS_ROPE = 451 * MiB;
constexpr size_t WS_BETA = 452 * MiB;
constexpr size_t WS_G = 452 * MiB + 512 * 1024;
constexpr size_t WS_TOKE = 453 * MiB;
constexpr size_t WS_TOKW = 453 * MiB + 256 * 1024;
constexpr size_t WS_TOKS = 453 * MiB + 512 * 1024;
constexpr size_t WS_HIST = 453 * MiB + 768 * 1024;
constexpr size_t WS_META = 453 * MiB + 832 * 1024;
constexpr size_t WS_SSQ = 455 * MiB;
constexpr size_t WS_WTGU = 456 * MiB;
constexpr size_t WS_WTD = 488 * MiB;
constexpr size_t WS_XF = 0;
constexpr size_t WS_XS = 64 * MiB;
constexpr size_t WS_ACT = 200 * MiB;
constexpr size_t WS_Y = 268 * MiB;
constexpr size_t WS_NEED = 504 * MiB;
constexpr size_t DO_XM = 0;
constexpr size_t DO_WTIN = 64 * MiB;
constexpr int LDS_BYTES = 147456;

__device__ __forceinline__ float silu_f(float x) { return x / (1.0f + expf(-x)); }
__device__ __forceinline__ float sigmoid_f(float x) { return 1.0f / (1.0f + expf(-x)); }
__device__ __forceinline__ float fsigmoid(float x) { return __builtin_amdgcn_rcpf(1.0f + __expf(-x)); }
template <int CTRL> __device__ __forceinline__ float dpp_mov(float v) { return __builtin_bit_cast(float, __builtin_amdgcn_update_dpp(0, __builtin_bit_cast(int, v), CTRL, 0xF, 0xF, false)); }
__device__ __forceinline__ float row_sum16(float v) {
    v += dpp_mov<0xB1>(v);
    v += dpp_mov<0x4E>(v);
    v += dpp_mov<0x141>(v);
    v += dpp_mov<0x140>(v);
    return v;
}
__device__ __forceinline__ float wave_sum(float v) { v = row_sum16(v); v += __shfl_xor(v, 16); v += __shfl_xor(v, 32); return v; }
typedef __bf16 bf2v_ __attribute__((ext_vector_type(2)));
typedef float f2v_ __attribute__((ext_vector_type(2)));
__device__ __forceinline__ unsigned pkh(float lo, float hi) { const f2v_ v = {lo, hi}; return __builtin_bit_cast(unsigned, __builtin_convertvector(v, bf2v_)); }
__device__ __forceinline__ unsigned f2bf(float f) { unsigned u = __float_as_uint(f); return (u + 0x7fffu + ((u >> 16) & 1u)) >> 16; }
__device__ __forceinline__ unsigned pk2(float lo, float hi) { return f2bf(lo) | (f2bf(hi) << 16); }
__device__ __forceinline__ float bf2f(unsigned short b) { return __uint_as_float(((unsigned)b) << 16); }
__device__ __forceinline__ float bflo(unsigned w) { return __uint_as_float(w << 16); }
__device__ __forceinline__ float bfhi(unsigned w) { return __uint_as_float(w & 0xffff0000u); }

struct Args { const float* in[20]; float* out; unsigned char* ws; int ph_lo, ph_hi; };
}
namespace pg8 {
#define PG8_LAS __attribute__((address_space(3)))
typedef unsigned short bf16_t;
typedef short bf16x8 __attribute__((ext_vector_type(8)));
typedef float f32x4 __attribute__((ext_vector_type(4)));
typedef unsigned u32x4 __attribute__((ext_vector_type(4)));
constexpr int BM = 256, BK = 64, HALF = 128, HTB = HALF * BK * 2  , STAGE_BYTES = 8 * HTB, NXCD = 8, WGM = 8;

__host__ __device__ __forceinline__ int lds_byte(int r, int c) { const int st = (r >> 4) * 2 + (c >> 5), rr = r & 15, cc = c & 31, ob = rr * 64 + cc * 2; return st * 1024 + (ob ^ (((ob >> 9) & 1) << 5)); }
__host__ __device__ __forceinline__ void stage_rc(int b, int& R, int& C) { const int st = b / 1024, sb = b % 1024, swz = sb ^ (((sb >> 9) & 1) << 5); R = (st >> 1) * 16 + swz / 64; C = (st & 1) * 32 + (swz % 64) / 2; }
__host__ __device__ __forceinline__ int perm32(int rho) { const int n = rho >> 4, i = rho & 15; return 8 * (i >> 2) + 4 * n + (i & 3); }

struct Unit { int pm, pn; };
struct Gemm { const bf16_t* A; const bf16_t* Bt; int M, N, K; };

struct StaticOrder {
    int nM, nN, nwg, G, c;
    __host__ __device__ void init(int M, int N, int G_, int c_) { nM = M / BM; nN = N / BM; nwg = nM * nN; G = G_; c = c_; }
    __host__ __device__ bool next(int i, Unit& u) const {
        const long L = (long)i * G + c; if (L >= nwg) return false;
        int wgid = (int)L; { const int q = nwg / NXCD, r = nwg % NXCD, xcd = wgid % NXCD, off = wgid / NXCD; wgid = (xcd < r ? xcd * (q + 1) : r * (q + 1) + (xcd - r) * q) + off; }
        const int nig = WGM * nN, gid = wgid / nig, fm = gid * WGM, gsz = (nM - fm) < WGM ? (nM - fm) : WGM;
        u.pm = fm + ((wgid % nig) % gsz); u.pn = (wgid % nig) / gsz; return true;
    }
    __device__ __forceinline__ void a_ready(const Unit&) const {}
    __device__ __forceinline__ void done(const Unit&) const {}
};

__device__ __forceinline__ unsigned cvt_pk_bf16(float lo, float hi) { unsigned r; asm volatile("v_cvt_pk_bf16_f32 %0, %1, %2" : "=v"(r) : "v"(lo), "v"(hi)); return r; }
__device__ __forceinline__ float fsig(float x) { return __builtin_amdgcn_rcpf(1.0f + __expf(-x)); }

struct EpiProj {
    static constexpr bool PERM = true, AFTER_DRAIN = false;
    bf16_t* P; int pw;
    __device__ __forceinline__ void operator()(const f32x4 (&acc)[2][2][4][2], const Unit& u, int wr, int wc, int fr, int fq) const {
        const int row0 = u.pm * BM + wr * 64 + fr;
        if (u.pn < 16) {
            const int col0 = u.pn * BM + wc * 32 + 8 * fq;
#pragma unroll
            for (int ai = 0; ai < 2; ++ai)
#pragma unroll
                for (int m = 0; m < 4; ++m) { bf16_t* rowp = P + (size_t)(row0 + ai * HALF + m * 16) * pw + col0;
#pragma unroll
                    for (int bj = 0; bj < 2; ++bj) { const f32x4 v0 = acc[ai][bj][m][0], v1 = acc[ai][bj][m][1];
                        u32x4 w; w.x = cvt_pk_bf16(v0[0], v0[1]); w.y = cvt_pk_bf16(v0[2], v0[3]); w.z = cvt_pk_bf16(v1[0], v1[1]); w.w = cvt_pk_bf16(v1[2], v1[3]);
                        *(u32x4*)(rowp + bj * HALF) = w; } }
        } else {
            const int col0 = 4096 + (u.pn - 16) * 128 + wc * 32 + 8 * fq;
#pragma unroll
            for (int ai = 0; ai < 2; ++ai)
#pragma unroll
                for (int m = 0; m < 4; ++m) { bf16_t* rowp = P + (size_t)(row0 + ai * HALF + m * 16) * pw + col0;
                    float o[8];
#pragma unroll
                    for (int n = 0; n < 2; ++n)
#pragma unroll
                        for (int j = 0; j < 4; ++j) { const float g = acc[ai][0][m][n][j], s = acc[ai][1][m][n][j]; o[n * 4 + j] = g * fsig(g) * fsig(s); }
                    u32x4 w; w.x = cvt_pk_bf16(o[0], o[1]); w.y = cvt_pk_bf16(o[2], o[3]); w.z = cvt_pk_bf16(o[4], o[5]); w.w = cvt_pk_bf16(o[6], o[7]);
                    *(u32x4*)rowp = w; }
        }
    }
};
struct EpiH {
    static constexpr bool PERM = false, AFTER_DRAIN = false;
    const float* x; const float* mod; float* h;
    __device__ __forceinline__ void operator()(const f32x4 (&acc)[2][2][4][2], const Unit& u, int wr, int wc, int fr, int fq) const {
        const int row0 = u.pm * BM + wr * 64 + fr, col0 = u.pn * BM + wc * 32 + 4 * fq;
        const int b = (u.pm * BM) / 2048;
        f32x4 gv[2][2];
#pragma unroll
        for (int bj = 0; bj < 2; ++bj)
#pragma unroll
            for (int n = 0; n < 2; ++n) gv[bj][n] = *(const f32x4*)(mod + (size_t)b * 6144 + 2048 + col0 + bj * HALF + n * 16);
#pragma unroll
        for (int ai = 0; ai < 2; ++ai)
#pragma unroll
            for (int m = 0; m < 4; ++m) { const size_t off = (size_t)(row0 + ai * HALF + m * 16) * 1024 + col0;
#pragma unroll
                for (int bj = 0; bj < 2; ++bj)
#pragma unroll
                    for (int n = 0; n < 2; ++n) { const f32x4 xv = *(const f32x4*)(x + off + bj * HALF + n * 16); *(f32x4*)(h + off + bj * HALF + n * 16) = xv + gv[bj][n] * acc[ai][bj][m][n]; }
                asm volatile("" ::: "memory"); }
    }
};
struct EpiAct {
    static constexpr bool PERM = true, AFTER_DRAIN = false;
    bf16_t* act;
    __device__ __forceinline__ void operator()(const f32x4 (&acc)[2][2][4][2], const Unit& u, int wr, int wc, int fr, int fq) const {
        const int row0 = u.pm * BM + wr * 64 + fr, col0 = (u.pn & 3) * 128 + wc * 32 + 8 * fq;
#pragma unroll
        for (int ai = 0; ai < 2; ++ai)
#pragma unroll
            for (int m = 0; m < 4; ++m) { bf16_t* rowp = act + (size_t)(row0 + ai * HALF + m * 16) * 512 + col0;
                float o[8];
#pragma unroll
                for (int n = 0; n < 2; ++n)
#pragma unroll
                    for (int j = 0; j < 4; ++j) { const float g = acc[ai][0][m][n][j], up = acc[ai][1][m][n][j]; o[n * 4 + j] = g * fsig(g) * up; }
                u32x4 w; w.x = cvt_pk_bf16(o[0], o[1]); w.y = cvt_pk_bf16(o[2], o[3]); w.z = cvt_pk_bf16(o[4], o[5]); w.w = cvt_pk_bf16(o[6], o[7]);
                *(u32x4*)rowp = w; }
    }
};
struct EpiY {
    static constexpr bool PERM = true, AFTER_DRAIN = false;
    bf16_t* y;
    __device__ __forceinline__ void operator()(const f32x4 (&acc)[2][2][4][2], const Unit& u, int wr, int wc, int fr, int fq) const {
        const int row0 = u.pm * BM + wr * 64 + fr, col0 = (u.pn & 3) * BM + wc * 32 + 8 * fq;
#pragma unroll
        for (int ai = 0; ai < 2; ++ai)
#pragma unroll
            for (int m = 0; m < 4; ++m) { bf16_t* rowp = y + (size_t)(row0 + ai * HALF + m * 16) * 1024 + col0;
#pragma unroll
                for (int bj = 0; bj < 2; ++bj) { const f32x4 v0 = acc[ai][bj][m][0], v1 = acc[ai][bj][m][1];
                    u32x4 w; w.x = cvt_pk_bf16(v0[0], v0[1]); w.y = cvt_pk_bf16(v0[2], v0[3]); w.z = cvt_pk_bf16(v1[0], v1[1]); w.w = cvt_pk_bf16(v1[2], v1[3]);
                    *(u32x4*)(rowp + bj * HALF) = w; } }
    }
};
struct MoeOrder {
    const int* tile_expert; int nwg, G, c;
    __device__ void init(const int* meta, const int* te, int G_, int c_) { tile_expert = te; nwg = meta[33] * 4; G = G_; c = c_; }
    __device__ bool next(int i, Unit& u) const {
        const long L = (long)i * G + c; if (L >= nwg) return false;
        int wgid = (int)L; { const int q = nwg / NXCD, r = nwg % NXCD, xcd = wgid % NXCD, off = wgid / NXCD; wgid = (xcd < r ? xcd * (q + 1) : r * (q + 1) + (xcd - r) * q) + off; }
        u.pm = wgid >> 2; u.pn = tile_expert[u.pm] * 4 + (wgid & 3); return true;
    }
    __device__ __forceinline__ void a_ready(const Unit&) const {}
    __device__ __forceinline__ void done(const Unit&) const {}
};
template <class Epi, class Sched, bool ALIGN_EPI = false, bool SP2 = false>
__device__ __forceinline__ void gemm_phase(PG8_LAS unsigned char* lds, const Gemm g, const Sched& S, const Epi& E) {
    const int tid = threadIdx.x, wid = __builtin_amdgcn_readfirstlane(tid >> 6), lane = tid & 63, wr = wid >> 2, wc = wid & 3, fr = lane & 15, fq = lane >> 4;
    const int K = g.K, nt = K / BK;
    unsigned voffA[2], voffB[2];
#pragma unroll
    for (int i = 0; i < 2; ++i) { int R, C; stage_rc(tid * 16 + i * 8192, R, C); const int Rb = Epi::PERM ? ((R & ~31) + perm32(R & 31)) : R;
        voffA[i] = (unsigned)(R * K + C) * 2u; voffB[i] = (unsigned)(Rb * K + C) * 2u; }
    const size_t kstep = (size_t)(BK * 2);
    const size_t hstep = (size_t)HALF * K * 2;
    const size_t tstep = 2 * hstep;
    const unsigned ldsw = (unsigned)wid * 1024u;
    const int aoff = lds_byte(wr * 64 + fr, fq * 8), boff = lds_byte(wc * 32 + fr, fq * 8);
#define PG8_SA(b, h) (((b) * 2 + (h)) * HTB)
#define PG8_SB(b, h) ((4 + (b) * 2 + (h)) * HTB)
#define PG8_STAGE(bufoff, gbase, voff) do { _Pragma("unroll") for (int _i = 0; _i < 2; ++_i) \
        __builtin_amdgcn_global_load_lds((const unsigned*)((const char*)(gbase) + (voff)[_i]), (PG8_LAS unsigned*)(lds + (bufoff) + ldsw + _i * 8192), 16, 0, 0); } while (0)
#define PG8_LDA(dst, b, h) do { _Pragma("unroll") for (int m = 0; m < 4; ++m) _Pragma("unroll") for (int k = 0; k < 2; ++k) dst[m][k] = *(const PG8_LAS bf16x8*)(lds + PG8_SA(b, h) + aoff + m * 2048 + k * 1024); } while (0)
#define PG8_LDB(dst, b, h) do { _Pragma("unroll") for (int n = 0; n < 2; ++n) _Pragma("unroll") for (int k = 0; k < 2; ++k) dst[n][k] = *(const PG8_LAS bf16x8*)(lds + PG8_SB(b, h) + boff + n * 2048 + k * 1024); } while (0)
#define PG8_MMA(ai, bj, At, Bt) do { __builtin_amdgcn_s_setprio(1); _Pragma("unroll") for (int m = 0; m < 4; ++m) _Pragma("unroll") for (int n = 0; n < 2; ++n) _Pragma("unroll") for (int k = 0; k < 2; ++k) \
        acc[ai][bj][m][n] = __builtin_amdgcn_mfma_f32_16x16x32_bf16(Bt[n][k], At[m][k], acc[ai][bj][m][n], 0, 0, 0); __builtin_amdgcn_s_setprio(0); } while (0)
#define PG8_WAIT_V(n) asm volatile("s_waitcnt vmcnt(" #n ")" ::: "memory")
#define PG8_WAIT_L(n) asm volatile("s_waitcnt lgkmcnt(" #n ")" ::: "memory")
#define PG8_BAR __builtin_amdgcn_s_barrier()
#define PG8_SCHED __builtin_amdgcn_sched_barrier(0)
    Unit cur, nxt; int ui = 0;
    if (!S.next(0, cur)) return;
    f32x4 acc[2][2][4][2];
#pragma unroll
    for (int a = 0; a < 2; ++a)
#pragma unroll
        for (int b = 0; b < 2; ++b)
#pragma unroll
            for (int m = 0; m < 4; ++m)
#pragma unroll
                for (int n = 0; n < 2; ++n) acc[a][b][m][n] = (f32x4){0.f, 0.f, 0.f, 0.f};
    bf16x8 At[4][2], B0[2][2], B1[2][2];
    const char* cA = (const char*)g.A + (size_t)cur.pm * tstep; const char* cB = (const char*)g.Bt + (size_t)cur.pn * tstep;
    S.a_ready(cur);
    if constexpr (SP2) {
        PG8_STAGE(PG8_SB(0, 0), cB, voffB); PG8_STAGE(PG8_SB(0, 1), cB + hstep, voffB); PG8_STAGE(PG8_SA(0, 0), cA, voffA); PG8_STAGE(PG8_SA(0, 1), cA + hstep, voffA);
        if (wr == 1) PG8_BAR;
        PG8_WAIT_V(2); PG8_BAR;
        PG8_STAGE(PG8_SB(1, 0), cB + kstep, voffB); PG8_STAGE(PG8_SA(1, 0), cA + kstep, voffA); PG8_STAGE(PG8_SB(1, 1), cB + hstep + kstep, voffB);
        PG8_WAIT_V(6); PG8_BAR;
    } else {
        PG8_STAGE(PG8_SB(0, 0), cB, voffB); PG8_STAGE(PG8_SA(0, 0), cA, voffA); PG8_STAGE(PG8_SB(0, 1), cB + hstep, voffB); PG8_STAGE(PG8_SA(0, 1), cA + hstep, voffA);
        if (wr == 1) PG8_BAR;
        PG8_WAIT_V(4); PG8_BAR;
        PG8_STAGE(PG8_SB(1, 0), cB + kstep, voffB); PG8_STAGE(PG8_SA(1, 0), cA + kstep, voffA); PG8_STAGE(PG8_SB(1, 1), cB + hstep + kstep, voffB);
        PG8_WAIT_V(6); PG8_BAR;
    }
    for (;;) {
        const bool has_next = S.next(ui + 1, nxt);
        const char* nA = has_next ? (const char*)g.A + (size_t)nxt.pm * tstep : cA; const char* nB = has_next ? (const char*)g.Bt + (size_t)nxt.pn * tstep : cB;
        for (int t = 0; t < nt; t += 2) {
            const bool last = (t == nt - 2);
            const char* a1 = cA + (size_t)(t + 1) * kstep;
            const char* a2 = last ? nA : cA + (size_t)(t + 2) * kstep; const char* b2 = last ? nB : cB + (size_t)(t + 2) * kstep;
            const char* a3 = a2 + kstep; const char* b3 = b2 + kstep;
            if (last && has_next) S.a_ready(nxt);
            if constexpr (SP2) {
            PG8_LDB(B0, 0, 0); PG8_LDB(B1, 0, 1); PG8_SCHED; PG8_LDA(At, 0, 0); PG8_STAGE(PG8_SA(1, 1), a1 + hstep, voffA);
            PG8_WAIT_V(8); PG8_WAIT_L(0); PG8_BAR; PG8_MMA(0, 0, At, B0); PG8_MMA(0, 1, At, B1); PG8_BAR; PG8_SCHED;
            PG8_LDA(At, 0, 1); PG8_STAGE(PG8_SB(0, 0), b2, voffB); PG8_STAGE(PG8_SB(0, 1), b2 + hstep, voffB); PG8_STAGE(PG8_SA(0, 0), a2, voffA);
            PG8_WAIT_V(8); PG8_WAIT_L(0); PG8_BAR; PG8_MMA(1, 0, At, B0); PG8_MMA(1, 1, At, B1); PG8_BAR; PG8_SCHED;
            PG8_LDB(B0, 1, 0); PG8_LDB(B1, 1, 1); PG8_SCHED; PG8_LDA(At, 1, 0); PG8_STAGE(PG8_SA(0, 1), a2 + hstep, voffA);
            PG8_WAIT_V(8); PG8_WAIT_L(0); PG8_BAR; PG8_MMA(0, 0, At, B0); PG8_MMA(0, 1, At, B1); PG8_BAR; PG8_SCHED;
            PG8_LDA(At, 1, 1); PG8_STAGE(PG8_SB(1, 0), b3, voffB); PG8_STAGE(PG8_SB(1, 1), b3 + hstep, voffB); PG8_STAGE(PG8_SA(1, 0), a3, voffA);
            PG8_WAIT_V(8); PG8_WAIT_L(0); PG8_BAR; PG8_MMA(1, 0, At, B0); PG8_MMA(1, 1, At, B1); PG8_BAR; PG8_SCHED;
            } else {
            PG8_LDB(B0, 0, 0); PG8_SCHED; PG8_LDA(At, 0, 0); PG8_STAGE(PG8_SA(1, 1), a1 + hstep, voffA);
            PG8_WAIT_L(8); PG8_BAR; PG8_WAIT_L(0); PG8_MMA(0, 0, At, B0); PG8_BAR; PG8_SCHED;
            PG8_LDB(B1, 0, 1); PG8_STAGE(PG8_SB(0, 0), b2, voffB);
            PG8_BAR; PG8_WAIT_L(0); PG8_MMA(0, 1, At, B1); PG8_BAR;
            PG8_LDA(At, 0, 1); PG8_STAGE(PG8_SA(0, 0), a2, voffA);
            PG8_BAR; PG8_WAIT_L(0); PG8_MMA(1, 0, At, B0); PG8_BAR; PG8_SCHED;
            PG8_STAGE(PG8_SB(0, 1), b2 + hstep, voffB);
            PG8_WAIT_V(6); PG8_BAR; PG8_MMA(1, 1, At, B1); PG8_BAR;
            PG8_LDB(B0, 1, 0); PG8_SCHED; PG8_LDA(At, 1, 0); PG8_STAGE(PG8_SA(0, 1), a2 + hstep, voffA);
            PG8_WAIT_L(8); PG8_BAR; PG8_WAIT_L(0); PG8_MMA(0, 0, At, B0); PG8_BAR; PG8_SCHED;
            PG8_LDB(B1, 1, 1); PG8_STAGE(PG8_SB(1, 0), b3, voffB);
            PG8_BAR; PG8_WAIT_L(0); PG8_MMA(0, 1, At, B1); PG8_BAR;
            PG8_LDA(At, 1, 1); PG8_STAGE(PG8_SA(1, 0), a3, voffA);
            PG8_BAR; PG8_WAIT_L(0); PG8_MMA(1, 0, At, B0); PG8_BAR; PG8_SCHED;
            PG8_STAGE(PG8_SB(1, 1), b3 + hstep, voffB);
            PG8_WAIT_V(6); PG8_BAR; PG8_MMA(1, 1, At, B1); PG8_BAR;
            }
        }
        if constexpr (ALIGN_EPI) { if (wr == 0) PG8_BAR; }
        if constexpr (!Epi::AFTER_DRAIN) { E(acc, cur, wr, wc, fr, fq); S.done(cur); }
        if (!has_next) break;
#pragma unroll
        for (int a = 0; a < 2; ++a)
#pragma unroll
            for (int b = 0; b < 2; ++b)
#pragma unroll
                for (int m = 0; m < 4; ++m)
#pragma unroll
                    for (int n = 0; n < 2; ++n) acc[a][b][m][n] = (f32x4){0.f, 0.f, 0.f, 0.f};
        cur = nxt; cA = nA; cB = nB; ++ui;
        if constexpr (ALIGN_EPI) { if (wr == 1) PG8_BAR; }
    }
    PG8_WAIT_V(0);
    if constexpr (!ALIGN_EPI) { if (wr == 0) PG8_BAR; }
    PG8_BAR;
    if constexpr (Epi::AFTER_DRAIN) { E.fused(acc, cur, wr, wc, fr, fq, lds, wid, lane); S.done(cur); }
#undef PG8_SA
#undef PG8_SB
#undef PG8_STAGE
#undef PG8_LDA
#undef PG8_LDB
#undef PG8_MMA
#undef PG8_WAIT_V
#undef PG8_WAIT_L
#undef PG8_BAR
#undef PG8_SCHED
}
}
namespace {
__device__ __forceinline__ int tidx() { int t = threadIdx.x; asm volatile("" : "+v"(t)); return t; }
__device__ __forceinline__ void phase_mod(const Args& a, LAS unsigned char* lds) {
    LAS float* sc = (LAS float*)lds;
    LAS float* part = (LAS float*)(lds + 65536);
    const float* c = a.in[1]; const float* mw = a.in[2]; const float* mb = a.in[3];
    float* mod = (float*)(a.ws + WS_MOD);
    const int tid = tidx();
    for (int i = tid; i < 16 * 1024; i += 512) sc[i] = silu_f(c[i]);
    __syncthreads();
    const int kg = tid >> 5, cj = tid & 31;
    for (int cgp = blockIdx.x; cgp < 256; cgp += gridDim.x) {
        const int j0 = cgp * 24;
        float acc[16];
#pragma unroll
        for (int b = 0; b < 16; ++b) acc[b] = 0.f;
        if (cj < 24) {
            for (int kk = 0; kk < 64; kk += 4) {
                const int k = kg * 64 + kk;
                const float w0 = mw[(size_t)(k + 0) * 6144 + j0 + cj], w1 = mw[(size_t)(k + 1) * 6144 + j0 + cj], w2 = mw[(size_t)(k + 2) * 6144 + j0 + cj], w3 = mw[(size_t)(k + 3) * 6144 + j0 + cj];
#pragma unroll
                for (int b = 0; b < 16; ++b) { const f4 s = *(const LAS f4*)(sc + b * 1024 + k); acc[b] += s.x * w0 + s.y * w1 + s.z * w2 + s.w * w3; }
            }
        }
#pragma unroll
        for (int b = 0; b < 16; ++b) part[(kg * 16 + b) * 32 + cj] = acc[b];
        __syncthreads();
        if (tid < 384) { const int b = tid / 24, cc = tid % 24; float s = mb[j0 + cc];
            for (int g2 = 0; g2 < 16; ++g2) s += part[(g2 * 16 + b) * 32 + cc];
            mod[b * 6144 + j0 + cc] = s; }
        __syncthreads();
    }
}

__device__ __forceinline__ void phase_norm1(const Args& a, LAS unsigned char* lds) {
    LAS f4* wgA = (LAS f4*)lds;
    LAS f4* wgB = (LAS f4*)(lds + 16384);
    const float* x = a.in[0]; const float* nw = a.in[4]; const float* w_in = a.in[5]; const float* a_log = a.in[7]; const float* dt_bias = a.in[8];
    const float* mod = (const float*)(a.ws + WS_MOD);
    bf16* xm = (bf16*)((unsigned char*)a.out + DO_XM);
    float* Gd = (float*)(a.ws + WS_G); float* Bd = (float*)(a.ws + WS_BETA);
    const int tid = tidx(), lane = tid & 63, wave = tid >> 6;
    for (int k = tid; k < 1024; k += 512) { const int idx = (4 * (k >> 8) + (k & 3)) * 64 + ((k & 255) >> 2);
        wgA[idx] = *(const f4*)(w_in + (size_t)k * DIN + C_GA); wgB[idx] = *(const f4*)(w_in + (size_t)k * DIN + C_GB); }
    __syncthreads();
    const int gw = blockIdx.x * 8 + wave, NGW = gridDim.x * 8;
    for (int grp = gw; grp < T / 2; grp += NGW) {
        const int t0 = grp * 2, b = t0 / SEQ;
        float4 gmul[4], gadd[4];
#pragma unroll
        for (int j = 0; j < 4; ++j) { const int k = 4 * lane + 256 * j;
            const float4 wv = *(const float4*)(nw + k), sc = *(const float4*)(mod + (size_t)b * 6144 + 1024 + k), sh = *(const float4*)(mod + (size_t)b * 6144 + k);
            gmul[j] = make_float4(wv.x * (1.f + sc.x), wv.y * (1.f + sc.y), wv.z * (1.f + sc.z), wv.w * (1.f + sc.w)); gadd[j] = sh; }
        float4 xv[2][4];
#pragma unroll
        for (int r = 0; r < 2; ++r) {
            float ss = 0.f;
#pragma unroll
            for (int j = 0; j < 4; ++j) { xv[r][j] = *(const float4*)(x + (size_t)(t0 + r) * D + 4 * lane + 256 * j); ss += xv[r][j].x * xv[r][j].x + xv[r][j].y * xv[r][j].y + xv[r][j].z * xv[r][j].z + xv[r][j].w * xv[r][j].w; }
            ss = wave_sum(ss);
            const float rstd = rsqrtf(ss * (1.0f / D) + 1e-6f);
#pragma unroll
            for (int j = 0; j < 4; ++j) { float4 v = xv[r][j];
                v.x = v.x * rstd * gmul[j].x + gadd[j].x; v.y = v.y * rstd * gmul[j].y + gadd[j].y; v.z = v.z * rstd * gmul[j].z + gadd[j].z; v.w = v.w * rstd * gmul[j].w + gadd[j].w;
                xv[r][j] = v;
                v2u w; w.x = pkh(v.x, v.y); w.y = pkh(v.z, v.w);
                *(v2u*)(xm + (size_t)(t0 + r) * D + 4 * lane + 256 * j) = w; }
        }
        float acc[2][8];
#pragma unroll
        for (int r = 0; r < 2; ++r)
#pragma unroll
            for (int q = 0; q < 8; ++q) acc[r][q] = 0.f;
#pragma unroll
        for (int j = 0; j < 4; ++j) {
#pragma unroll
            for (int jj = 0; jj < 4; ++jj) {
                const f4 wa = wgA[(4 * j + jj) * 64 + lane], wb = wgB[(4 * j + jj) * 64 + lane];
#pragma unroll
                for (int r = 0; r < 2; ++r) { const float xe = (jj == 0) ? xv[r][j].x : (jj == 1) ? xv[r][j].y : (jj == 2) ? xv[r][j].z : xv[r][j].w;
                    acc[r][0] += xe * wa.x; acc[r][1] += xe * wa.y; acc[r][2] += xe * wa.z; acc[r][3] += xe * wa.w;
                    acc[r][4] += xe * wb.x; acc[r][5] += xe * wb.y; acc[r][6] += xe * wb.z; acc[r][7] += xe * wb.w; }
            }
            asm volatile("" ::: "memory");
        }
        float mine = 0.f;
#pragma unroll
        for (int r = 0; r < 2; ++r)
#pragma unroll
            for (int q = 0; q < 8; ++q) { const float s = row_sum16(acc[r][q]); if ((lane & 15) == r * 8 + q) mine = s; }
        mine += __shfl_xor(mine, 16); mine += __shfl_xor(mine, 32);
        if (lane < 16) { const int r = lane >> 3, q = lane & 7, t = t0 + r;
            if (q < 4) { const float z = mine + dt_bias[q]; const float sp = (z > 20.f) ? z : log1pf(expf(z)); Gd[t * 4 + q] = -expf(a_log[q]) * sp; }
            else Bd[t * 4 + (q - 4)] = sigmoid_f(mine); }
    }
}

struct CJob { const float* src; bf16* dst; int ldsrc, ldd; };
__device__ __forceinline__ void cjob_load(const CJob& j, int lane, f4 (&v)[8]) {
#pragma unroll
    for (int i = 0; i < 8; ++i) v[i] = *(const f4*)(j.src + (size_t)(4 * i + (lane >> 4)) * j.ldsrc + 4 * (lane & 15));
}
__device__ __forceinline__ void cjob_store(const CJob& j, int lane, const f4 (&v)[8], LAS float* tile) {
#pragma unroll
    for (int i = 0; i < 8; ++i) { LAS float* tp = tile + (4 * i + (lane >> 4)) * 65 + 4 * (lane & 15); tp[0] = v[i][0]; tp[1] = v[i][1]; tp[2] = v[i][2]; tp[3] = v[i][3]; }
    asm volatile("s_waitcnt lgkmcnt(0)" ::: "memory");
    unsigned w[16];
#pragma unroll
    for (int q = 0; q < 16; ++q) w[q] = pkh(tile[(2 * q) * 65 + lane], tile[(2 * q + 1) * 65 + lane]);
    bf16* dp = j.dst + (size_t)lane * j.ldd;
#pragma unroll
    for (int q = 0; q < 4; ++q) { v4u o; o.x = w[4 * q]; o.y = w[4 * q + 1]; o.z = w[4 * q + 2]; o.w = w[4 * q + 3]; *(v4u*)(dp + 8 * q) = o; }
    asm volatile("s_waitcnt lgkmcnt(0)" ::: "memory");
}
__device__ __forceinline__ int win_srccol(int n0) {
    if (n0 < 512) return C_RQ + n0;
    if (n0 < 1024) return C_RK + (n0 - 512);
    if (n0 < 2048) return C_RV + (n0 - 1024);
    if (n0 < 4096) return C_GQ + (n0 - 2048);
    const int j = (n0 - 4096) >> 8, r = (n0 - 4096) & 255, half = r >> 7, cc = r & 127;
    if (j < 8) return (half ? C_GTA : C_RG) + 128 * j + cc;
    return (half ? C_GTB : C_GZ) + 128 * (j - 8) + cc;
}
__device__ __forceinline__ CJob cjob_in(const Args& a, int job) {
    CJob j;
    if (job < 4096) { const int nt = job >> 5, kt = job & 31; j.src = a.in[5] + (size_t)(kt * 32) * DIN + win_srccol(nt * 64); j.ldsrc = DIN; j.dst = (bf16*)((unsigned char*)a.out + DO_WTIN) + (size_t)(nt * 64) * 1024 + kt * 32; j.ldd = 1024; }
    else { const int jj = job - 4096, nt = jj >> 5, kt = jj & 31; j.src = a.in[10] + (size_t)(kt * 32) * 1024 + nt * 64; j.ldsrc = 1024; j.dst = (bf16*)(a.ws + WS_WTOUT) + (size_t)(nt * 64) * 1024 + kt * 32; j.ldd = 1024; }
    return j;
}
__device__ __forceinline__ void phase_convert_in(const Args& a, LAS unsigned char* lds) {
    const int tid = tidx(), lane = tid & 63, wave = tid >> 6;
    LAS float* tile = (LAS float*)(lds + 32768 + wave * 8448);
    const int NJ = 4096 + 512, stride = gridDim.x * 8;
    int job = blockIdx.x * 8 + wave;
    f4 va[8], vb[8];
    if (job < NJ) { CJob j = cjob_in(a, job); cjob_load(j, lane, va); }
#pragma unroll 1
    for (; job < NJ; job += 2 * stride) {
        const CJob j0 = cjob_in(a, job);
        if (job + stride < NJ) { CJob j1 = cjob_in(a, job + stride); cjob_load(j1, lane, vb); }
        cjob_store(j0, lane, va, tile);
        if (job + stride < NJ) { const CJob j1 = cjob_in(a, job + stride);
            if (job + 2 * stride < NJ) { CJob j2 = cjob_in(a, job + 2 * stride); cjob_load(j2, lane, va); }
            cjob_store(j1, lane, vb, tile); }
    }
    float2* rope = (float2*)(a.ws + WS_ROPE);
    for (int i = blockIdx.x * 512 + tidx(); i < SEQ * 64; i += gridDim.x * 512) {
        const int t = i >> 6, fi = i & 63;
        const double inv = exp(-((double)fi / 64.0) * 9.210340371976184), ang = (double)t * inv;
        rope[i] = make_float2((float)cos(ang), (float)sin(ang));
    }
}
__device__ __forceinline__ void phase_inproj(const Args& a, LAS unsigned char* lds) {
    pg8::Gemm g{(const bf16*)((unsigned char*)a.out + DO_XM), (const bf16*)((unsigned char*)a.out + DO_WTIN), T, 8192, 1024};
    pg8::StaticOrder S; S.init(T, 8192, (int)gridDim.x, (int)blockIdx.x);
    pg8::EpiProj E{(bf16*)(a.ws + WS_PROJ), PW};
    pg8::gemm_phase<pg8::EpiProj, pg8::StaticOrder, true, true>(lds, g, S, E);
}


__device__ __forceinline__ void phase_outproj(const Args& a, LAS unsigned char* lds) {
    pg8::Gemm g{(const bf16*)(a.ws + WS_MERGED), (const bf16*)(a.ws + WS_WTOUT), T, 1024, 1024};
    pg8::StaticOrder S; S.init(T, 1024, (int)gridDim.x, (int)blockIdx.x);
    pg8::EpiH E{a.in[0], (const float*)(a.ws + WS_MOD), a.out};
    pg8::gemm_phase<pg8::EpiH, pg8::StaticOrder, true, true>(lds, g, S, E);
}

__device__ __forceinline__ void phase_route(const Args& a, LAS unsigned char* lds) {
    LAS f4* wr = (LAS f4*)lds;
    LAS int* hist = (LAS int*)(lds + 5 * 16384);
    LAS float* lgl = (LAS float*)(lds + 5 * 16384 + 256);
    const float* h = a.out; const float* nw = a.in[11]; const float* w_group = a.in[12]; const float* b_group = a.in[13]; const float* w_router = a.in[14]; const float* b_router = a.in[15];
    const float* mod = (const float*)(a.ws + WS_MOD);
    bf16* xf = (bf16*)(a.ws + WS_XF);
    int* tok_e = (int*)(a.ws + WS_TOKE); float* tok_w = (float*)(a.ws + WS_TOKW);
    const int tid = tidx(), lane = tid & 63, wave = tid >> 6;
    for (int k = tid; k < 1024; k += 512) { const int idx = (4 * (k >> 8) + (k & 3)) * 64 + ((k & 255) >> 2);
        wr[idx] = *(const f4*)(w_group + (size_t)k * 4);
#pragma unroll
        for (int q = 0; q < 4; ++q) wr[(q + 1) * 1024 + idx] = *(const f4*)(w_router + (size_t)k * 16 + 4 * q); }
    if (tid < 16) hist[tid] = 0;
    __syncthreads();
    const int TPB = T / (int)gridDim.x, tb0 = blockIdx.x * TPB;
#pragma unroll 1
    for (int pr = wave; pr < TPB / 2; pr += 8) {
        const int t0 = tb0 + pr * 2, b = t0 / SEQ;
        float4 gmul[4], gadd[4];
#pragma unroll
        for (int j = 0; j < 4; ++j) { const int k = 4 * lane + 256 * j;
            const float4 wv = *(const float4*)(nw + k), sc = *(const float4*)(mod + (size_t)b * 6144 + 4096 + k), sh = *(const float4*)(mod + (size_t)b * 6144 + 3072 + k);
            gmul[j] = make_float4(wv.x * (1.f + sc.x), wv.y * (1.f + sc.y), wv.z * (1.f + sc.z), wv.w * (1.f + sc.w)); gadd[j] = sh; }
        float4 xv[2][4];
#pragma unroll
        for (int r = 0; r < 2; ++r) {
            float ss = 0.f;
#pragma unroll
            for (int j = 0; j < 4; ++j) { xv[r][j] = *(const float4*)(h + (size_t)(t0 + r) * D + 4 * lane + 256 * j); ss += xv[r][j].x * xv[r][j].x + xv[r][j].y * xv[r][j].y + xv[r][j].z * xv[r][j].z + xv[r][j].w * xv[r][j].w; }
            ss = wave_sum(ss);
            const float rstd = rsqrtf(ss * (1.0f / D) + 1e-6f);
#pragma unroll
            for (int j = 0; j < 4; ++j) { float4 v = xv[r][j];
                v.x = v.x * rstd * gmul[j].x + gadd[j].x; v.y = v.y * rstd * gmul[j].y + gadd[j].y; v.z = v.z * rstd * gmul[j].z + gadd[j].z; v.w = v.w * rstd * gmul[j].w + gadd[j].w;
                xv[r][j] = v;
                v2u w; w.x = pkh(v.x, v.y); w.y = pkh(v.z, v.w);
                *(v2u*)(xf + (size_t)(t0 + r) * D + 4 * lane + 256 * j) = w; }
        }
        float acc[2][20];
#pragma unroll
        for (int r = 0; r < 2; ++r)
#pragma unroll
            for (int q = 0; q < 20; ++q) acc[r][q] = 0.f;
#pragma unroll
        for (int j = 0; j < 4; ++j) {
#pragma unroll
            for (int jj = 0; jj < 4; ++jj) {
                const int idx = (4 * j + jj) * 64 + lane;
#pragma unroll
                for (int q = 0; q < 5; ++q) { const f4 w = wr[q * 1024 + idx];
#pragma unroll
                    for (int r = 0; r < 2; ++r) { const float xe = (jj == 0) ? xv[r][j].x : (jj == 1) ? xv[r][j].y : (jj == 2) ? xv[r][j].z : xv[r][j].w;
                        acc[r][4 * q + 0] += xe * w.x; acc[r][4 * q + 1] += xe * w.y; acc[r][4 * q + 2] += xe * w.z; acc[r][4 * q + 3] += xe * w.w; } }
                asm volatile("" ::: "memory");
            }
        }
        float m0 = 0.f, m1 = 0.f, m2 = 0.f;
#pragma unroll
        for (int v = 0; v < 40; ++v) { const float s = row_sum16(acc[v / 20][v % 20]);
            if (v < 16) { if ((lane & 15) == v) m0 = s; } else if (v < 32) { if ((lane & 15) == v - 16) m1 = s; } else { if ((lane & 15) == v - 32) m2 = s; } }
        m0 += __shfl_xor(m0, 16); m0 += __shfl_xor(m0, 32); m1 += __shfl_xor(m1, 16); m1 += __shfl_xor(m1, 32); m2 += __shfl_xor(m2, 16); m2 += __shfl_xor(m2, 32);
        if (lane < 16) { lgl[pr * 40 + lane] = m0; lgl[pr * 40 + 16 + lane] = m1; if (lane < 8) lgl[pr * 40 + 32 + lane] = m2; }
    }
    __syncthreads();
    if (tid < TPB) {
        const int t = tb0 + tid;
        float lg[20];
#pragma unroll
        for (int q = 0; q < 20; ++q) lg[q] = lgl[tid * 20 + q];
        float gl[4], gmax = -1e30f; int gi = 0;
#pragma unroll
        for (int j = 0; j < 4; ++j) { gl[j] = lg[j] + b_group[j]; if (gl[j] > gmax) { gmax = gl[j]; gi = j; } }
        float gs = 0.f;
#pragma unroll
        for (int j = 0; j < 4; ++j) gs += expf(gl[j] - gmax);
        const float g_top = 1.0f / gs;
        float el[4], emax = -1e30f;
#pragma unroll
        for (int j = 0; j < 4; ++j) { const float raw = (gi == 0) ? lg[4 + j] : (gi == 1) ? lg[8 + j] : (gi == 2) ? lg[12 + j] : lg[16 + j]; el[j] = raw + b_router[gi * 4 + j]; emax = fmaxf(emax, el[j]); }
        float ep[4], es = 0.f;
#pragma unroll
        for (int j = 0; j < 4; ++j) { ep[j] = expf(el[j] - emax); es += ep[j]; }
#pragma unroll
        for (int j = 0; j < 4; ++j) ep[j] /= es;
        int i1 = 0; float p1 = ep[0];
#pragma unroll
        for (int j = 1; j < 4; ++j) if (ep[j] > p1) { p1 = ep[j]; i1 = j; }
        int i2 = -1; float p2 = -1.f;
#pragma unroll
        for (int j = 0; j < 4; ++j) if (j != i1 && ep[j] > p2) { p2 = ep[j]; i2 = j; }
        const float den = p1 + p2;
        tok_e[t * 2 + 0] = gi * 4 + i1; tok_e[t * 2 + 1] = gi * 4 + i2;
        tok_w[t * 2 + 0] = g_top * (p1 / den); tok_w[t * 2 + 1] = g_top * (p2 / den);
        __hip_atomic_fetch_add(&hist[gi * 4 + i1], 1, __ATOMIC_RELAXED, __HIP_MEMORY_SCOPE_WORKGROUP); __hip_atomic_fetch_add(&hist[gi * 4 + i2], 1, __ATOMIC_RELAXED, __HIP_MEMORY_SCOPE_WORKGROUP);
    }
    __syncthreads();
    if (tid < 16) ((int*)(a.ws + WS_HIST))[blockIdx.x * 16 + tid] = hist[tid];
}
__device__ __forceinline__ CJob cjob_ex(const Args& a, int job) {
    CJob j;
    if (job < 8192) { const int e = job >> 9, nt = (job >> 5) & 15, kt = job & 31, n0 = nt * 64;
        const int jt = n0 >> 8, r = n0 & 255, half = r >> 7, cc = r & 127;
        j.src = (half ? a.in[17] : a.in[16]) + (size_t)e * 1024 * 512 + (size_t)(kt * 32) * 512 + 128 * jt + cc; j.ldsrc = 512;
        j.dst = (bf16*)(a.ws + WS_WTGU) + (size_t)e * 1024 * 1024 + (size_t)n0 * 1024 + kt * 32; j.ldd = 1024; }
    else { const int jj = job - 8192, e = jj >> 8, nt = (jj >> 4) & 15, kt = jj & 15;
        j.src = a.in[18] + (size_t)e * 512 * 1024 + (size_t)(kt * 32) * 1024 + nt * 64; j.ldsrc = 1024;
        j.dst = (bf16*)(a.ws + WS_WTD) + (size_t)e * 1024 * 512 + (size_t)(nt * 64) * 512 + kt * 32; j.ldd = 512; }
    return j;
}
__device__ __forceinline__ void convert_experts_part(const Args& a, LAS unsigned char* lds, int part, int nparts) {
    const int tid = tidx(), lane = tid & 63, wave = tid >> 6;
    LAS float* tile = (LAS float*)(lds + 32768 + wave * 8448);
    const int NJ = 8192 + 4096, stride = nparts * 8;
    int job = part * 8 + wave;
    f4 va[8], vb[8];
    if (job < NJ) { CJob j = cjob_ex(a, job); cjob_load(j, lane, va); }
#pragma unroll 1
    for (; job < NJ; job += 2 * stride) {
        const CJob j0 = cjob_ex(a, job);
        if (job + stride < NJ) { CJob j1 = cjob_ex(a, job + stride); cjob_load(j1, lane, vb); }
        cjob_store(j0, lane, va, tile);
        if (job + stride < NJ) { const CJob j1 = cjob_ex(a, job + stride);
            if (job + 2 * stride < NJ) { CJob j2 = cjob_ex(a, job + 2 * stride); cjob_load(j2, lane, va); }
            cjob_store(j1, lane, vb, tile); }
    }
}
__device__ __forceinline__ void phase_scatter(const Args& a, LAS unsigned char* lds) {
    LAS int* base = (LAS int*)lds;
    LAS int* mybase = base + 16;
    LAS int* elist = base + 32;
    LAS int* slots = base + 32 + 512;
    const int* hist = (const int*)(a.ws + WS_HIST); const int* tok_e = (const int*)(a.ws + WS_TOKE);
    int* tok_s = (int*)(a.ws + WS_TOKS); int* meta = (int*)(a.ws + WS_META); int* tile_expert = meta + 64;
    const bf16* xf = (const bf16*)(a.ws + WS_XF); bf16* xs = (bf16*)(a.ws + WS_XS);
    const int tid = tidx(), lane = tid & 63, wave = tid >> 6, G = (int)gridDim.x;
    const int TPB = T / G, tb0 = blockIdx.x * TPB, NA = 2 * TPB;
    if (tid < 16) { int tot = 0, before = 0; for (int i = 0; i < G; ++i) { const int c = hist[i * 16 + tid]; tot += c; if (i < (int)blockIdx.x) before += c; } base[tid] = tot; mybase[tid] = before; }
    __syncthreads();
    if (tid == 0) { int off = 0;
        for (int e = 0; e < 16; ++e) { const int cnt = base[e], nt = (cnt + 255) >> 8;
            if (blockIdx.x == 0) { meta[e] = cnt; meta[16 + e] = off; for (int k = 0; k < nt; ++k) tile_expert[(off >> 8) + k] = e; }
            base[e] = off; off += nt * 256; }
        if (blockIdx.x == 0) { meta[32] = off; meta[33] = off >> 8; } }
    for (int i = tid; i < NA; i += 512) elist[i] = tok_e[tb0 * 2 + i];
    __syncthreads();
    for (int i = tid; i < NA; i += 512) { const int e = elist[i]; int rank = 0; for (int k = 0; k < i; ++k) rank += (elist[k] == e) ? 1 : 0;
        const int slot = base[e] + mybase[e] + rank; slots[i] = slot; tok_s[tb0 * 2 + i] = slot; }
    __syncthreads();
    for (int i = wave; i < NA; i += 8) { const int slot = slots[i], t = tb0 + (i >> 1);
        const v4u* src = (const v4u*)(xf + (size_t)t * D); v4u* dst = (v4u*)(xs + (size_t)slot * D);
        dst[lane] = src[lane]; dst[lane + 64] = src[lane + 64]; }
}
__device__ __forceinline__ void phase_moe1(const Args& a, LAS unsigned char* lds) {
    const int* meta = (const int*)(a.ws + WS_META);
    pg8::Gemm g{(const bf16*)(a.ws + WS_XS), (const bf16*)(a.ws + WS_WTGU), 0, 0, 1024};
    pg8::MoeOrder S; S.init(meta, meta + 64, (int)gridDim.x, (int)blockIdx.x);
    pg8::EpiAct E{(bf16*)(a.ws + WS_ACT)};
    pg8::gemm_phase<pg8::EpiAct, pg8::MoeOrder, true, true>(lds, g, S, E);
}
__device__ __forceinline__ void phase_moe2(const Args& a, LAS unsigned char* lds) {
    const int* meta = (const int*)(a.ws + WS_META);
    pg8::Gemm g{(const bf16*)(a.ws + WS_ACT), (const bf16*)(a.ws + WS_WTD), 0, 0, 512};
    pg8::MoeOrder S; S.init(meta, meta + 64, (int)gridDim.x, (int)blockIdx.x);
    pg8::EpiY E{(bf16*)(a.ws + WS_Y)};
    pg8::gemm_phase<pg8::EpiY, pg8::MoeOrder, true, true>(lds, g, S, E);
}
__device__ __forceinline__ void phase_final(const Args& a, LAS unsigned char* lds) {
    const float* mod = (const float*)(a.ws + WS_MOD); const float* now = a.in[19];
    const bf16* y = (const bf16*)(a.ws + WS_Y); const int* tok_s = (const int*)(a.ws + WS_TOKS); const float* tok_w = (const float*)(a.ws + WS_TOKW);
    float* out = a.out;
    const int tid = tidx(), lane = tid & 63, wave = tid >> 6;
    const int gw = blockIdx.x * 8 + wave, NGW = gridDim.x * 8;
    for (int t = gw; t < T; t += NGW) {
        const int b = t / SEQ, s1 = tok_s[t * 2], s2 = tok_s[t * 2 + 1];
        const float w1 = tok_w[t * 2], w2 = tok_w[t * 2 + 1];
        float4 o[4]; float ss = 0.f;
#pragma unroll
        for (int j = 0; j < 4; ++j) { const int k = 4 * lane + 256 * j;
            const float4 hv = *(const float4*)(out + (size_t)t * D + k), gf = *(const float4*)(mod + (size_t)b * 6144 + 5120 + k);
            const v2u a1 = *(const v2u*)(y + (size_t)s1 * D + k), a2 = *(const v2u*)(y + (size_t)s2 * D + k);
            float4 v;
            v.x = hv.x + gf.x * (w1 * bflo(a1.x) + w2 * bflo(a2.x)); v.y = hv.y + gf.y * (w1 * bfhi(a1.x) + w2 * bfhi(a2.x));
            v.z = hv.z + gf.z * (w1 * bflo(a1.y) + w2 * bflo(a2.y)); v.w = hv.w + gf.w * (w1 * bfhi(a1.y) + w2 * bfhi(a2.y));
            o[j] = v; ss += v.x * v.x + v.y * v.y + v.z * v.z + v.w * v.w; }
        ss = wave_sum(ss);
        const float rstd = rsqrtf(ss * (1.0f / D) + 1e-6f);
#pragma unroll
        for (int j = 0; j < 4; ++j) { const int k = 4 * lane + 256 * j; const float4 nwv = *(const float4*)(now + k);
            *(float4*)(out + (size_t)t * D + k) = make_float4(o[j].x * rstd * nwv.x, o[j].y * rstd * nwv.y, o[j].z * rstd * nwv.z, o[j].w * rstd * nwv.w); }
    }
}


__device__ __forceinline__ float quad_sum(float v) { v += __shfl_xor(v, 1); v += __shfl_xor(v, 2); return v; }
template <int BR>
__device__ __forceinline__ void scan_item(const Args& a, LAS unsigned char* lds, int b, int h, int half) {
    constexpr int TG = 8;
    LAS float* kf = (LAS float*)lds;
    LAS float* qf = kf + TG * 128;
    LAS float* vf = qf + TG * 128;
    LAS float* of = vf + TG * 128;
    LAS float* sc = of + TG * 128;
    bf16* proj = (bf16*)(a.ws + WS_PROJ);
    const float2* rope = (const float2*)(a.ws + WS_ROPE);
    const float* Gd = (const float*)(a.ws + WS_G); const float* Bd = (const float*)(a.ws + WS_BETA); const float* conv_w = a.in[6];
    float* ssq = (float*)(a.ws + WS_SSQ);
    const int tid = tidx(), v = tid >> 2, qd = tid & 3;
    const size_t row0 = (size_t)b * SEQ;
    const int qcol = (BR == 0 ? P_RQ : P_GQ) + h * 128, kcol = (BR == 0 ? P_RK : P_GK) + h * 128, vcol = (BR == 0 ? P_RV : P_GV) + h * 256 + half * 128;
    const float gamma = 1.0f - exp2f(-5.0f - (float)h);
    LAS float* hv = sc + TG * 2;
    float s[32];
#pragma unroll
    for (int d = 0; d < 32; ++d) s[d] = 0.f;
    for (int i = tid; i < 2 * 3 * 128; i += 512) hv[i] = 0.f;
    __syncthreads();
    for (int t0 = 0; t0 < SEQ; t0 += TG) {
        if (BR == 0) {
#pragma unroll
            for (int r = 0; r < 2; ++r) { const int idx = tid + 512 * r, isk = idx >> 9, tt = (idx >> 6) & 7, i = idx & 63, t = t0 + tt;
                const bf16* pr = proj + (row0 + t) * PW + (isk ? kcol : qcol);
                const float x1 = bf2f(pr[i]), x2 = bf2f(pr[i + 64]); const float2 cs = rope[t * 64 + i];
                const float sc_ = isk ? 0.08838834764831845f : 1.0f;
                LAS float* dst = (isk ? kf : qf) + tt * 128;
                dst[i] = (x1 * cs.x - x2 * cs.y) * sc_; dst[i + 64] = (x1 * cs.y + x2 * cs.x) * sc_; }
#pragma unroll
            for (int r = 0; r < 2; ++r) { const int idx = tid + 512 * r, tt = idx >> 7, c = idx & 127;
                vf[tt * 128 + c] = bf2f(proj[(row0 + t0 + tt) * PW + vcol + c]); }
        } else {
            if (tid < 384) {
                const bool isv = tid >= 256; const int u = isv ? tid - 256 : tid;
                const int tt = isv ? (u >> 4) : (u >> 5), part = isv ? (u & 15) : (u & 31), t = t0 + tt;
                const int col = isv ? (vcol + 8 * part) : (part < 16 ? qcol + 8 * part : kcol + 8 * (part - 16));
                const int cch = col - P_GQ;
                float acc[8];
#pragma unroll
                for (int j = 0; j < 8; ++j) acc[j] = 0.f;
#pragma unroll
                for (int i = 0; i < 4; ++i) { const int tr = t - 3 + i;
                    if (isv && tr < t0) {
                        const LAS float* hp = hv + (((t0 / TG) & 1) * 3 + (tr - (t0 - 3))) * 128 + 8 * part;
                        const float4 w0 = *(const float4*)(conv_w + i * 2048 + cch), w1 = *(const float4*)(conv_w + i * 2048 + cch + 4);
                        acc[0] += hp[0] * w0.x; acc[1] += hp[1] * w0.y; acc[2] += hp[2] * w0.z; acc[3] += hp[3] * w0.w;
                        acc[4] += hp[4] * w1.x; acc[5] += hp[5] * w1.y; acc[6] += hp[6] * w1.z; acc[7] += hp[7] * w1.w;
                    } else if (tr >= 0) { const v4u raw = *(const v4u*)(proj + (row0 + tr) * PW + col);
                        if (isv && i == 3 && tt >= TG - 3) { LAS float* hn = hv + ((((t0 / TG) + 1) & 1) * 3 + (tt - (TG - 3))) * 128 + 8 * part;
                            hn[0] = bflo(raw.x); hn[1] = bfhi(raw.x); hn[2] = bflo(raw.y); hn[3] = bfhi(raw.y); hn[4] = bflo(raw.z); hn[5] = bfhi(raw.z); hn[6] = bflo(raw.w); hn[7] = bfhi(raw.w); }
                        const float4 w0 = *(const float4*)(conv_w + i * 2048 + cch), w1 = *(const float4*)(conv_w + i * 2048 + cch + 4);
                        acc[0] += bflo(raw.x) * w0.x; acc[1] += bfhi(raw.x) * w0.y; acc[2] += bflo(raw.y) * w0.z; acc[3] += bfhi(raw.y) * w0.w;
                        acc[4] += bflo(raw.z) * w1.x; acc[5] += bfhi(raw.z) * w1.y; acc[6] += bflo(raw.w) * w1.z; acc[7] += bfhi(raw.w) * w1.w; } }
                float ss = 0.f;
#pragma unroll
                for (int j = 0; j < 8; ++j) { acc[j] = acc[j] * fsigmoid(acc[j]); ss += acc[j] * acc[j]; }
                if (!isv) {
                    ss += __shfl_xor(ss, 1); ss += __shfl_xor(ss, 2); ss += __shfl_xor(ss, 4); ss += __shfl_xor(ss, 8);
                    const float rn = rsqrtf(ss + 1e-6f) * (part < 16 ? 0.08838834764831845f : 1.0f);
                    LAS float* dst = (part < 16 ? qf : kf) + tt * 128 + 8 * (part & 15);
#pragma unroll
                    for (int j = 0; j < 8; ++j) dst[j] = acc[j] * rn;
                } else { LAS float* dst = vf + tt * 128 + 8 * part;
#pragma unroll
                    for (int j = 0; j < 8; ++j) dst[j] = acc[j]; }
            } else if (tid < 384 + TG) { const int tt = tid - 384; const size_t gi = (row0 + t0 + tt) * 4 + h; sc[tt * 2] = expf(Gd[gi]); sc[tt * 2 + 1] = Bd[gi]; }
        }
        __syncthreads();
#pragma unroll 1
        for (int tt = 0; tt < TG; ++tt) {
            const LAS f4* kp = (const LAS f4*)(kf + tt * 128 + 32 * qd); const LAS f4* qp = (const LAS f4*)(qf + tt * 128 + 32 * qd);
            const float vt = vf[tt * 128 + v];
            float o = 0.f;
            if (BR == 0) {
#pragma unroll
                for (int d4 = 0; d4 < 8; ++d4) { const f4 kk = kp[d4], qq = qp[d4];
                    s[4 * d4 + 0] = gamma * s[4 * d4 + 0] + kk.x * vt; o += qq.x * s[4 * d4 + 0];
                    s[4 * d4 + 1] = gamma * s[4 * d4 + 1] + kk.y * vt; o += qq.y * s[4 * d4 + 1];
                    s[4 * d4 + 2] = gamma * s[4 * d4 + 2] + kk.z * vt; o += qq.z * s[4 * d4 + 2];
                    s[4 * d4 + 3] = gamma * s[4 * d4 + 3] + kk.w * vt; o += qq.w * s[4 * d4 + 3]; }
            } else {
                const float al = sc[tt * 2], bt = sc[tt * 2 + 1];
                float dot = 0.f;
#pragma unroll
                for (int d4 = 0; d4 < 8; ++d4) { const f4 kk = kp[d4];
                    s[4 * d4 + 0] *= al; dot += s[4 * d4 + 0] * kk.x; s[4 * d4 + 1] *= al; dot += s[4 * d4 + 1] * kk.y;
                    s[4 * d4 + 2] *= al; dot += s[4 * d4 + 2] * kk.z; s[4 * d4 + 3] *= al; dot += s[4 * d4 + 3] * kk.w; }
                dot = quad_sum(dot);
                const float vn = bt * (vt - dot);
#pragma unroll
                for (int d4 = 0; d4 < 8; ++d4) { const f4 kk = kp[d4], qq = qp[d4];
                    s[4 * d4 + 0] += kk.x * vn; o += s[4 * d4 + 0] * qq.x; s[4 * d4 + 1] += kk.y * vn; o += s[4 * d4 + 1] * qq.y;
                    s[4 * d4 + 2] += kk.z * vn; o += s[4 * d4 + 2] * qq.z; s[4 * d4 + 3] += kk.w * vn; o += s[4 * d4 + 3] * qq.w; }
            }
            o = quad_sum(o);
            if (qd == 0) of[tt * 128 + v] = o;
        }
        __syncthreads();
        if (tid < 128) { const int tt = tid >> 4, c8 = (tid & 15) * 8;
            const LAS float* src = of + tt * 128 + c8; float ss = 0.f;
#pragma unroll
            for (int j = 0; j < 8; ++j) ss += src[j] * src[j];
            v4u w; w.x = pkh(src[0], src[1]); w.y = pkh(src[2], src[3]); w.z = pkh(src[4], src[5]); w.w = pkh(src[6], src[7]);
            *(v4u*)(proj + (row0 + t0 + tt) * PW + vcol + c8) = w;
            ss += __shfl_xor(ss, 1); ss += __shfl_xor(ss, 2); ss += __shfl_xor(ss, 4); ss += __shfl_xor(ss, 8);
            if ((tid & 15) == 0) ssq[(row0 + t0 + tt) * 16 + BR * 8 + h * 2 + half] = ss; }
        __syncthreads();
    }
}
__device__ __forceinline__ void phase_scan_simple(const Args& a, LAS unsigned char* lds) {
    for (int id = blockIdx.x; id < 256; id += gridDim.x) {
        const int br = (id >> 4) & 1, half = (id >> 3) & 1, bh = (id >> 5) * 8 + (id & 7), b = bh >> 2, h = bh & 3;
        if (br == 0) scan_item<0>(a, lds, b, h, half); else scan_item<1>(a, lds, b, h, half);
        __syncthreads();
    }
}
__device__ __forceinline__ void phase_merge(const Args& a, LAS unsigned char* lds) {
    const bf16* proj = (const bf16*)(a.ws + WS_PROJ); const float* ssq = (const float*)(a.ws + WS_SSQ); const float* gnw = a.in[9];
    bf16* merged = (bf16*)(a.ws + WS_MERGED);
    const int tid = tidx(), lane = tid & 63, wave = tid >> 6;
    const int gw = blockIdx.x * 8 + wave, NGW = gridDim.x * 8;
    for (int t = gw; t < T; t += NGW) {
        const int c0 = 16 * lane, h = lane >> 4;
        const float* sq = ssq + (size_t)t * 16;
        const float rr = rsqrtf((sq[h * 2] + sq[h * 2 + 1]) * (1.0f / 256.0f) + 1e-6f), rg = rsqrtf((sq[8 + h * 2] + sq[8 + h * 2 + 1]) * (1.0f / 256.0f) + 1e-6f);
        const bf16* pr = proj + (size_t)t * PW;
#pragma unroll
        for (int part = 0; part < 2; ++part) { const int c = c0 + 8 * part;
            const v4u orv = *(const v4u*)(pr + P_RV + c), ogv = *(const v4u*)(pr + P_GV + c), ga = *(const v4u*)(pr + P_GA + c), gb = *(const v4u*)(pr + P_GB + c);
            const float4 w0 = *(const float4*)(gnw + (c & 255)), w1 = *(const float4*)(gnw + (c & 255) + 4);
            float o[8];
            o[0] = bflo(ga.x) * bflo(orv.x) * rr + bflo(gb.x) * bflo(ogv.x) * rg * w0.x; o[1] = bfhi(ga.x) * bfhi(orv.x) * rr + bfhi(gb.x) * bfhi(ogv.x) * rg * w0.y;
            o[2] = bflo(ga.y) * bflo(orv.y) * rr + bflo(gb.y) * bflo(ogv.y) * rg * w0.z; o[3] = bfhi(ga.y) * bfhi(orv.y) * rr + bfhi(gb.y) * bfhi(ogv.y) * rg * w0.w;
            o[4] = bflo(ga.z) * bflo(orv.z) * rr + bflo(gb.z) * bflo(ogv.z) * rg * w1.x; o[5] = bfhi(ga.z) * bfhi(orv.z) * rr + bfhi(gb.z) * bfhi(ogv.z) * rg * w1.y;
            o[6] = bflo(ga.w) * bflo(orv.w) * rr + bflo(gb.w) * bflo(ogv.w) * rg * w1.z; o[7] = bfhi(ga.w) * bfhi(orv.w) * rr + bfhi(gb.w) * bfhi(ogv.w) * rg * w1.w;
            v4u w; w.x = pkh(o[0], o[1]); w.y = pkh(o[2], o[3]); w.z = pkh(o[4], o[5]); w.w = pkh(o[6], o[7]);
            *(v4u*)(merged + (size_t)t * 1024 + c) = w; }
    }
}

}
namespace {
typedef short s8v __attribute__((ext_vector_type(8)));
typedef short s4v __attribute__((ext_vector_type(4)));
typedef float f16v __attribute__((ext_vector_type(16)));
#define MFMA32(a, b, c) __builtin_amdgcn_mfma_f32_32x32x16_bf16((a), (b), (c), 0, 0, 0)
constexpr int PT128 = 136, PT64 = 72;
constexpr size_t DO_QH = 0, DO_KHT = 32 * MiB, DO_QK = 64 * MiB, DO_TU = 80 * MiB, DO_TW = 96 * MiB;
constexpr size_t WS_VH = WS_MERGED;
constexpr size_t WS_EG = 454 * MiB, WS_EGL = 454 * MiB + 512 * 1024;

typedef __bf16 bf2v __attribute__((ext_vector_type(2)));
typedef float f2v __attribute__((ext_vector_type(2)));
__device__ __forceinline__ unsigned cvtpk(float lo, float hi) { const f2v v = {lo, hi}; return __builtin_bit_cast(unsigned, __builtin_convertvector(v, bf2v)); }
__device__ __forceinline__ s8v ld_nat(const LAS bf16* base, int pitch, int row, int k0, int hh) { return *(const LAS s8v*)(base + row * pitch + k0 + 8 * hh); }
__device__ __forceinline__ s8v ld_perm(const LAS bf16* base, int pitch, int row, int k0, int hh) {
    const LAS bf16* p = base + row * pitch + k0 + 4 * hh;
    const s4v lo = *(const LAS s4v*)p, hi = *(const LAS s4v*)(p + 8);
    return __builtin_shufflevector(lo, hi, 0, 1, 2, 3, 4, 5, 6, 7);
}
template <int S> __device__ __forceinline__ s8v pack8(const f16v& x) {
    v4u p; p.x = cvtpk(x[8 * S + 0], x[8 * S + 1]); p.y = cvtpk(x[8 * S + 2], x[8 * S + 3]); p.z = cvtpk(x[8 * S + 4], x[8 * S + 5]); p.w = cvtpk(x[8 * S + 6], x[8 * S + 7]);
    return __builtin_bit_cast(s8v, p);
}
__device__ __forceinline__ f16v zero16() { f16v z;
#pragma unroll
    for (int i = 0; i < 16; ++i) z[i] = 0.f; return z; }

__device__ __forceinline__ void conv8(const bf16* proj, size_t rowbase, int tloc, int col, const float* conv_w, int cch, float (&acc)[8]) {
#pragma unroll
    for (int j = 0; j < 8; ++j) acc[j] = 0.f;
#pragma unroll
    for (int i = 0; i < 4; ++i) { const int tr = tloc - 3 + i;
        if (tr >= 0) { const v4u raw = *(const v4u*)(proj + (rowbase + tr) * PW + col);
            const float4 w0 = *(const float4*)(conv_w + i * 2048 + cch), w1 = *(const float4*)(conv_w + i * 2048 + cch + 4);
            acc[0] += bflo(raw.x) * w0.x; acc[1] += bfhi(raw.x) * w0.y; acc[2] += bflo(raw.y) * w0.z; acc[3] += bfhi(raw.y) * w0.w;
            acc[4] += bflo(raw.z) * w1.x; acc[5] += bfhi(raw.z) * w1.y; acc[6] += bflo(raw.w) * w1.z; acc[7] += bfhi(raw.w) * w1.w; } }
}

__device__ __forceinline__ void tile_store_rm(LAS bf16* buf, const f16v& v, int mt, int nt, int r32, int hh) {
#pragma unroll
    for (int rg = 0; rg < 16; ++rg) buf[(32 * mt + (rg & 3) + 8 * (rg >> 2) + 4 * hh) * PT64 + 32 * nt + r32] = (bf16)f2bf(v[rg]);
}
__device__ __forceinline__ void tile_store_tr(LAS bf16* buf, const f16v& v, int mt, int nt, int r32, int hh) {
#pragma unroll
    for (int g4 = 0; g4 < 4; ++g4) { v2u w; w.x = cvtpk(v[4 * g4 + 0], v[4 * g4 + 1]); w.y = cvtpk(v[4 * g4 + 2], v[4 * g4 + 3]); *(LAS v2u*)(buf + (32 * nt + r32) * PT64 + 32 * mt + 8 * g4 + 4 * hh) = w; }
}
__device__ __forceinline__ void phase_gprep(const Args& a, LAS unsigned char* lds) {
    LAS bf16* Kh = (LAS bf16*)lds;
    LAS bf16* Qh = (LAS bf16*)(lds + 17408);
    LAS bf16* Kht = (LAS bf16*)(lds + 34816);
    LAS float* bt = (LAS float*)(lds + 53248);
    LAS float* gc = bt + 64;
    LAS bf16* MB = (LAS bf16*)(lds + 53760);
    constexpr int MSZ = 64 * PT64;
    const bf16* proj = (const bf16*)(a.ws + WS_PROJ);
    const float* Gd = (const float*)(a.ws + WS_G); const float* Bd = (const float*)(a.ws + WS_BETA); const float* conv_w = a.in[6];
    unsigned char* dout = (unsigned char*)a.out;
    bf16* QHg = (bf16*)(dout + DO_QH); bf16* KHTg = (bf16*)(dout + DO_KHT); bf16* QKg = (bf16*)(dout + DO_QK); bf16* TUg = (bf16*)(dout + DO_TU); bf16* TWg = (bf16*)(dout + DO_TW);
    bf16* VHg = (bf16*)(a.ws + WS_VH); float* EGg = (float*)(a.ws + WS_EG); float* EGLg = (float*)(a.ws + WS_EGL);
    const int tid = tidx(), lane = tid & 63, wave = tid >> 6, r32 = lane & 31, hh = lane >> 5;
    for (int i = tid; i < 8 * MSZ / 8; i += 512) ((LAS v4u*)MB)[i] = (v4u){0u, 0u, 0u, 0u};
    const int cg = tid & 31, run = tid >> 5, isk = cg >> 4, c8qk = 8 * (cg & 15), tt0 = run * 4;
    const int h0 = (blockIdx.x >> 5) & 3;
    const int colqk = (isk ? P_GK : P_GQ) + h0 * 128 + c8qk, colv = P_GV + h0 * 256 + 8 * cg;
    LAS f4* wtab = (LAS f4*)(lds + 127488);
    if (tid < 256) { const int which = tid >> 7, i = (tid >> 5) & 3, g = tid & 31;
        const int col = which ? (P_GV + h0 * 256 + 8 * g) : (((g >> 4) ? P_GK : P_GQ) + h0 * 128 + 8 * (g & 15));
        wtab[((which * 4 + i) * 32 + g) * 2 + 0] = *(const f4*)(conv_w + i * 2048 + col - P_GQ); wtab[((which * 4 + i) * 32 + g) * 2 + 1] = *(const f4*)(conv_w + i * 2048 + col - P_GQ + 4); }
    __syncthreads();
    v4u rq[7], rv[7];
    { const int it0 = blockIdx.x, n0_ = it0 & 31, b0_ = it0 >> 7;
#pragma unroll
      for (int i = 0; i < 7; ++i) { const int tr = n0_ * 64 + tt0 - 3 + i;
          if (tr >= 0 && it0 < 2048) { rq[i] = *(const v4u*)(proj + ((size_t)b0_ * SEQ + tr) * PW + colqk); rv[i] = *(const v4u*)(proj + ((size_t)b0_ * SEQ + tr) * PW + colv); }
          else { rq[i] = (v4u){0u, 0u, 0u, 0u}; rv[i] = (v4u){0u, 0u, 0u, 0u}; } } }
#pragma unroll 1
    for (int item = blockIdx.x; item < 2048; item += gridDim.x) {
        const int n = item & 31, bh = item >> 5, h = bh & 3, b = bh >> 2;
        const size_t rowb = (size_t)b * SEQ;
        const int tl0 = n * 64;
        if (wave == 0) {
            float g = Gd[(rowb + tl0 + lane) * 4 + h];
#pragma unroll
            for (int o = 1; o < 64; o <<= 1) { const float t = __shfl_up(g, o); if (lane >= o) g += t; }
            const float gl = __shfl(g, 63);
            bt[lane] = Bd[(rowb + tl0 + lane) * 4 + h]; gc[lane] = g;
            EGg[(size_t)item * 64 + lane] = expf(g); EGLg[(size_t)item * 64 + lane] = expf(gl - g);
        }
        {
#pragma unroll
            for (int j = 0; j < 4; ++j) {
                const int tt = tt0 + j;
                float acc[8];
#pragma unroll
                for (int c = 0; c < 8; ++c) acc[c] = 0.f;
#pragma unroll
                for (int i = 0; i < 4; ++i) { const v4u raw = rq[j + i]; const f4 w0 = wtab[((0 * 4 + i) * 32 + cg) * 2], w1 = wtab[((0 * 4 + i) * 32 + cg) * 2 + 1];
                    acc[0] += bflo(raw.x) * w0.x; acc[1] += bfhi(raw.x) * w0.y; acc[2] += bflo(raw.y) * w0.z; acc[3] += bfhi(raw.y) * w0.w;
                    acc[4] += bflo(raw.z) * w1.x; acc[5] += bfhi(raw.z) * w1.y; acc[6] += bflo(raw.w) * w1.z; acc[7] += bfhi(raw.w) * w1.w; }
                float ss = 0.f;
#pragma unroll
                for (int c = 0; c < 8; ++c) { acc[c] = acc[c] * fsigmoid(acc[c]); ss += acc[c] * acc[c]; }
                ss += __shfl_xor(ss, 1); ss += __shfl_xor(ss, 2); ss += __shfl_xor(ss, 4); ss += __shfl_xor(ss, 8);
                const float rn = rsqrtf(ss + 1e-6f) * (isk ? 1.0f : 0.08838834764831845f);
                v4u w; w.x = pkh(acc[0] * rn, acc[1] * rn); w.y = pkh(acc[2] * rn, acc[3] * rn); w.z = pkh(acc[4] * rn, acc[5] * rn); w.w = pkh(acc[6] * rn, acc[7] * rn);
                if (!isk) { *(LAS v4u*)(Qh + tt * PT128 + c8qk) = w; *(v4u*)(QHg + ((size_t)item * 64 + tt) * 128 + c8qk) = w; }
                else *(LAS v4u*)(Kh + tt * PT128 + c8qk) = w;
#pragma unroll
                for (int c = 0; c < 8; ++c) acc[c] = 0.f;
#pragma unroll
                for (int i = 0; i < 4; ++i) { const v4u raw = rv[j + i]; const f4 w0 = wtab[((1 * 4 + i) * 32 + cg) * 2], w1 = wtab[((1 * 4 + i) * 32 + cg) * 2 + 1];
                    acc[0] += bflo(raw.x) * w0.x; acc[1] += bfhi(raw.x) * w0.y; acc[2] += bflo(raw.y) * w0.z; acc[3] += bfhi(raw.y) * w0.w;
                    acc[4] += bflo(raw.z) * w1.x; acc[5] += bfhi(raw.z) * w1.y; acc[6] += bflo(raw.w) * w1.z; acc[7] += bfhi(raw.w) * w1.w; }
#pragma unroll
                for (int c = 0; c < 8; ++c) acc[c] = acc[c] * fsigmoid(acc[c]);
                v4u wvv; wvv.x = pkh(acc[0], acc[1]); wvv.y = pkh(acc[2], acc[3]); wvv.z = pkh(acc[4], acc[5]); wvv.w = pkh(acc[6], acc[7]);
                *(v4u*)(VHg + (rowb + tl0 + tt) * 1024 + h * 256 + 8 * cg) = wvv;
            }
            { const int itn = item + (int)gridDim.x, nn = itn & 31, bn = itn >> 7;
#pragma unroll
              for (int i = 0; i < 7; ++i) { const int tr = nn * 64 + tt0 - 3 + i;
                  if (tr >= 0 && itn < 2048) { rq[i] = *(const v4u*)(proj + ((size_t)bn * SEQ + tr) * PW + colqk); rv[i] = *(const v4u*)(proj + ((size_t)bn * SEQ + tr) * PW + colv); }
                  else { rq[i] = (v4u){0u, 0u, 0u, 0u}; rv[i] = (v4u){0u, 0u, 0u, 0u}; } } }
        }
        __syncthreads();
        f16v X = zero16();
        const int q3 = (wave < 3) ? wave : wave - 3, mt = (q3 >= 1) ? 1 : 0, nt = (q3 == 2) ? 1 : 0;
        if (wave < 3) {
            f16v acc = zero16();
#pragma unroll
            for (int ks = 0; ks < 8; ++ks) acc = MFMA32(ld_nat(Kh, PT128, 32 * mt + r32, 16 * ks, hh), ld_nat(Kh, PT128, 32 * nt + r32, 16 * ks, hh), acc);
            const int bcol = 32 * nt + r32; const float gcb = gc[bcol];
            f16v N_;
#pragma unroll
            for (int rg = 0; rg < 16; ++rg) { const int ar = 32 * mt + (rg & 3) + 8 * (rg >> 2) + 4 * hh;
                N_[rg] = (ar > bcol) ? -bt[ar] * acc[rg] * expf(gc[ar] - gcb) : 0.f; X[rg] = N_[rg] + ((ar == bcol) ? 1.0f : 0.0f); }
            tile_store_rm(MB + 0 * MSZ, N_, mt, nt, r32, hh); tile_store_tr(MB + 1 * MSZ, N_, mt, nt, r32, hh);
            tile_store_rm(MB + 2 * MSZ, X, mt, nt, r32, hh);
        } else if (wave < 6) {
            const int jt = (wave == 5) ? 1 : 0, itile = (wave >= 4) ? 1 : 0;
            f16v acc = zero16();
#pragma unroll
            for (int ks = 0; ks < 8; ++ks) acc = MFMA32(ld_nat(Kh, PT128, 32 * jt + r32, 16 * ks, hh), ld_nat(Qh, PT128, 32 * itile + r32, 16 * ks, hh), acc);
            const int icol = 32 * itile + r32; const float gci = gc[icol];
#pragma unroll
            for (int g4 = 0; g4 < 4; ++g4) { const int j0 = 32 * jt + 8 * g4 + 4 * hh; float v[4];
#pragma unroll
                for (int j = 0; j < 4; ++j) { const int jr = j0 + j; v[j] = (icol >= jr) ? acc[4 * g4 + j] * expf(gci - gc[jr]) : 0.f; }
                v2u w; w.x = pkh(v[0], v[1]); w.y = pkh(v[2], v[3]); *(v2u*)(QKg + ((size_t)item * 64 + icol) * 64 + j0) = w; }
        } else if (wave == 6) {
            for (int i = lane; i < 32 * 4; i += 64) { const int row = i >> 2, c = i & 3; *(v4u*)(QKg + ((size_t)item * 64 + row) * 64 + 32 + 8 * c) = (v4u){0u, 0u, 0u, 0u}; }
        }
#pragma unroll
        for (int r = 0; r < 2; ++r) { const int p = tid + 512 * r, d = p & 127, tg = p >> 7;
            const LAS bf16* kp = Kh + (8 * tg) * PT128 + d;
            v4u w; w.x = (unsigned)kp[0] | ((unsigned)kp[PT128] << 16); w.y = (unsigned)kp[2 * PT128] | ((unsigned)kp[3 * PT128] << 16);
            w.z = (unsigned)kp[4 * PT128] | ((unsigned)kp[5 * PT128] << 16); w.w = (unsigned)kp[6 * PT128] | ((unsigned)kp[7 * PT128] << 16);
            *(v4u*)(KHTg + ((size_t)item * 128 + d) * 64 + 8 * tg) = w; }
        __syncthreads();
        if (wave >= 3 && wave < 6) {
            f16v acc = zero16();
#pragma unroll
            for (int ks = 0; ks < 4; ++ks) acc = MFMA32(ld_nat(MB + 0 * MSZ, PT64, 32 * mt + r32, 16 * ks, hh), ld_nat(MB + 1 * MSZ, PT64, 32 * nt + r32, 16 * ks, hh), acc);
            tile_store_rm(MB + 3 * MSZ, acc, mt, nt, r32, hh); tile_store_tr(MB + 4 * MSZ, acc, mt, nt, r32, hh);
        }
        __syncthreads();
#pragma unroll 1
        for (int r = 1; r <= 5; ++r) {
            const int so = ((r - 1) & 1) * 3, sn = (r & 1) * 3;
            LAS bf16* Xo = MB + (2 + so) * MSZ; LAS bf16* Po = MB + (3 + so) * MSZ; LAS bf16* Qo = MB + (4 + so) * MSZ;
            LAS bf16* Xn = MB + (2 + sn) * MSZ; LAS bf16* Pn = MB + (3 + sn) * MSZ; LAS bf16* Qn = MB + (4 + sn) * MSZ;
            if (wave < 3) {
#pragma unroll
                for (int ks = 0; ks < 4; ++ks) X = MFMA32(ld_nat(Xo, PT64, 32 * mt + r32, 16 * ks, hh), ld_nat(Qo, PT64, 32 * nt + r32, 16 * ks, hh), X);
                if (r < 5) tile_store_rm(Xn, X, mt, nt, r32, hh);
            } else if (wave < 6 && r < 5) {
                f16v acc = zero16();
#pragma unroll
                for (int ks = 0; ks < 4; ++ks) acc = MFMA32(ld_nat(Po, PT64, 32 * mt + r32, 16 * ks, hh), ld_nat(Qo, PT64, 32 * nt + r32, 16 * ks, hh), acc);
                tile_store_rm(Pn, acc, mt, nt, r32, hh); tile_store_tr(Qn, acc, mt, nt, r32, hh);
            }
            __syncthreads();
        }
        if (wave < 3) {
            const int jcol = 32 * nt + r32; const float bj = bt[jcol], ej = expf(gc[jcol]);
            f16v U_, W_;
#pragma unroll
            for (int rg = 0; rg < 16; ++rg) { U_[rg] = X[rg] * bj; W_[rg] = U_[rg] * ej; }
            tile_store_rm(MB + 0 * MSZ, U_, mt, nt, r32, hh); tile_store_rm(MB + 3 * MSZ, W_, mt, nt, r32, hh);
        }
        __syncthreads();
        { const int row = tid >> 3, c = tid & 7; const size_t go = ((size_t)item * 64 + row) * 64 + 8 * c;
          *(v4u*)(TUg + go) = *(const LAS v4u*)(MB + 0 * MSZ + row * PT64 + 8 * c); *(v4u*)(TWg + go) = *(const LAS v4u*)(MB + 3 * MSZ + row * PT64 + 8 * c); }
        __syncthreads();
    }
}

template <int BR>
__device__ __forceinline__ void scan_mfma_item(const Args& a, LAS unsigned char* lds, int b, int h) {
    LAS bf16* Tu = (LAS bf16*)lds; LAS bf16* Tw = (LAS bf16*)(lds + 9216); LAS bf16* QK = (LAS bf16*)(lds + 18432); LAS bf16* Qh = (LAS bf16*)(lds + 27648);
    LAS bf16* Kht = (LAS bf16*)(lds + 45056); LAS bf16* nW = (LAS bf16*)(lds + 63488);
    LAS bf16* Qd = (LAS bf16*)lds; LAS bf16* Kr = (LAS bf16*)(lds + 17408); LAS bf16* Kdt = (LAS bf16*)(lds + 34816); LAS bf16* Pm = (LAS bf16*)(lds + 53248);
    LAS float* egs = (LAS float*)(lds + 117760); LAS float* egls = egs + 64;
    bf16* proj = (bf16*)(a.ws + WS_PROJ);
    const int tid = tidx(), lane = tid & 63, wave = tid >> 6, r32 = lane & 31, hh = lane >> 5;
    LAS bf16* Vt = (LAS bf16*)(lds + 80896 + wave * 4608);
    const size_t rowb = (size_t)b * SEQ;
    const unsigned char* dout = (const unsigned char*)a.out;
    const bf16* QHg = (const bf16*)(dout + DO_QH); const bf16* KHTg = (const bf16*)(dout + DO_KHT); const bf16* QKg = (const bf16*)(dout + DO_QK);
    const bf16* TUg = (const bf16*)(dout + DO_TU); const bf16* TWg = (const bf16*)(dout + DO_TW);
    const bf16* VHg = (const bf16*)(a.ws + WS_VH); const float* EGg = (const float*)(a.ws + WS_EG); const float* EGLg = (const float*)(a.ws + WS_EGL);
    const float2* rope = (const float2*)(a.ws + WS_ROPE);
    const float lgam = logf(1.0f - exp2f(-5.0f - (float)h));
    LAS float* kdt = egs + 128;
    if (BR == 0 && tid < 64) kdt[tid] = expf((float)(63 - tid) * lgam);
    f16v S[4];
#pragma unroll
    for (int dt = 0; dt < 4; ++dt) S[dt] = zero16();
#pragma unroll 1
    for (int n = 0; n < 32; ++n) {
        const int tl0 = n * 64, item = (b * 4 + h) * 32 + n;
        if (BR == 1) {
            { const int row = tid >> 3, c = tid & 7; const size_t go = ((size_t)item * 64 + row) * 64 + 8 * c;
              *(LAS v4u*)(Tu + row * PT64 + 8 * c) = *(const v4u*)(TUg + go); *(LAS v4u*)(Tw + row * PT64 + 8 * c) = *(const v4u*)(TWg + go); *(LAS v4u*)(QK + row * PT64 + 8 * c) = *(const v4u*)(QKg + go); }
#pragma unroll
            for (int r = 0; r < 2; ++r) { const int p = tid + 512 * r;
                { const int row = p >> 4, c = p & 15; *(LAS v4u*)(Qh + row * PT128 + 8 * c) = *(const v4u*)(QHg + ((size_t)item * 64 + row) * 128 + 8 * c); }
                { const int row = p >> 3, c = p & 7; *(LAS v4u*)(Kht + row * PT64 + 8 * c) = *(const v4u*)(KHTg + ((size_t)item * 128 + row) * 64 + 8 * c); } }
            if (tid < 64) egs[tid] = EGg[(size_t)item * 64 + tid]; else if (tid < 128) egls[tid - 64] = EGLg[(size_t)item * 64 + tid - 64];
        } else {
#pragma unroll
            for (int r = 0; r < 2; ++r) {
                const int u = tid + 512 * r, tt = u >> 4, isk = (u >> 3) & 1, i0 = 8 * (u & 7), t = tl0 + tt;
                const bf16* pr = proj + (rowb + t) * PW + (isk ? P_RK : P_RQ) + h * 128;
                const v4u x1 = *(const v4u*)(pr + i0), x2 = *(const v4u*)(pr + 64 + i0);
                const float4* rp = (const float4*)(rope + t * 64 + i0);
                const float4 c0 = rp[0], c1 = rp[1], c2 = rp[2], c3 = rp[3];
                const float a1[8] = {bflo(x1.x), bfhi(x1.x), bflo(x1.y), bfhi(x1.y), bflo(x1.z), bfhi(x1.z), bflo(x1.w), bfhi(x1.w)};
                const float a2[8] = {bflo(x2.x), bfhi(x2.x), bflo(x2.y), bfhi(x2.y), bflo(x2.z), bfhi(x2.z), bflo(x2.w), bfhi(x2.w)};
                const float cs[8] = {c0.x, c0.z, c1.x, c1.z, c2.x, c2.z, c3.x, c3.z}, sn[8] = {c0.y, c0.w, c1.y, c1.w, c2.y, c2.w, c3.y, c3.w};
                const float sc = isk ? 0.08838834764831845f : expf((float)(tt + 1) * lgam);
                float o1[8], o2[8];
#pragma unroll
                for (int j = 0; j < 8; ++j) { o1[j] = (a1[j] * cs[j] - a2[j] * sn[j]) * sc; o2[j] = (a1[j] * sn[j] + a2[j] * cs[j]) * sc; }
                v4u w1, w2; w1.x = pkh(o1[0], o1[1]); w1.y = pkh(o1[2], o1[3]); w1.z = pkh(o1[4], o1[5]); w1.w = pkh(o1[6], o1[7]);
                w2.x = pkh(o2[0], o2[1]); w2.y = pkh(o2[2], o2[3]); w2.z = pkh(o2[4], o2[5]); w2.w = pkh(o2[6], o2[7]);
                LAS bf16* dst = (isk ? Kr : Qd) + tt * PT128;
                *(LAS v4u*)(dst + i0) = w1; *(LAS v4u*)(dst + 64 + i0) = w2;
            }
        }
        {
            const bf16* vsrc = (BR == 1) ? (VHg + (rowb + tl0 + lane) * 1024 + h * 256 + 32 * wave) : (proj + (rowb + tl0 + lane) * PW + P_RV + h * 256 + 32 * wave);
            const v4u q0 = ((const v4u*)vsrc)[0], q1 = ((const v4u*)vsrc)[1], q2 = ((const v4u*)vsrc)[2], q3 = ((const v4u*)vsrc)[3];
            const unsigned wv[16] = {q0.x, q0.y, q0.z, q0.w, q1.x, q1.y, q1.z, q1.w, q2.x, q2.y, q2.z, q2.w, q3.x, q3.y, q3.z, q3.w};
#pragma unroll
            for (int j = 0; j < 16; ++j) { Vt[(2 * j) * PT64 + lane] = (bf16)(wv[j] & 0xffff); Vt[(2 * j + 1) * PT64 + lane] = (bf16)(wv[j] >> 16); }
        }
        __syncthreads();
        if (BR == 1) {
            const int dt = wave >> 1, itile = wave & 1;
            f16v acc = zero16();
#pragma unroll
            for (int ks = 0; ks < 4; ++ks) acc = MFMA32(ld_nat(Kht, PT64, 32 * dt + r32, 16 * ks, hh), ld_nat(Tw, PT64, 32 * itile + r32, 16 * ks, hh), acc);
            const int icol = 32 * itile + r32;
#pragma unroll
            for (int g4 = 0; g4 < 4; ++g4) { const int d0 = 32 * dt + 8 * g4 + 4 * hh;
                v2u w; w.x = cvtpk(-acc[4 * g4 + 0], -acc[4 * g4 + 1]); w.y = cvtpk(-acc[4 * g4 + 2], -acc[4 * g4 + 3]); *(LAS v2u*)(nW + icol * PT128 + d0) = w; }
        } else {
#pragma unroll
            for (int r = 0; r < 2; ++r) { const int p = tid + 512 * r, d = p & 127, tg = p >> 7;
                const LAS bf16* kp = Kr + (8 * tg) * PT128 + d;
                float kv[8];
#pragma unroll
                for (int i = 0; i < 8; ++i) kv[i] = bf2f(kp[i * PT128]) * kdt[8 * tg + i];
                v4u w; w.x = cvtpk(kv[0], kv[1]); w.y = cvtpk(kv[2], kv[3]); w.z = cvtpk(kv[4], kv[5]); w.w = cvtpk(kv[6], kv[7]);
                *(LAS v4u*)(Kdt + d * PT64 + 8 * tg) = w; }
        }
        if (BR == 0 && wave < 3) {
            const int jt = (wave == 2) ? 1 : 0, itile = (wave >= 1) ? 1 : 0;
            f16v acc = zero16();
#pragma unroll
            for (int ks = 0; ks < 8; ++ks) acc = MFMA32(ld_nat(Kr, PT128, 32 * jt + r32, 16 * ks, hh), ld_nat(Qd, PT128, 32 * itile + r32, 16 * ks, hh), acc);
            const int icol = 32 * itile + r32;
#pragma unroll
            for (int g4 = 0; g4 < 4; ++g4) { const int j0 = 32 * jt + 8 * g4 + 4 * hh; float v[4];
#pragma unroll
                for (int j = 0; j < 4; ++j) { const int jr = j0 + j; v[j] = (icol >= jr) ? acc[4 * g4 + j] * expf(-(float)(jr + 1) * lgam) : 0.f; }
                v2u w; w.x = cvtpk(v[0], v[1]); w.y = cvtpk(v[2], v[3]); *(LAS v2u*)(Pm + icol * PT64 + j0) = w; }
        }
        __syncthreads();
        s8v Sp[4][2];
#pragma unroll
        for (int dt = 0; dt < 4; ++dt) { Sp[dt][0] = pack8<0>(S[dt]); Sp[dt][1] = pack8<1>(S[dt]); }
        bf16* orow = proj + (rowb + tl0) * PW + (BR == 1 ? P_GV : P_RV) + h * 256 + 32 * wave + r32;
        if (BR == 1) {
            s8v vb[2][2], vs[2][2];
#pragma unroll
            for (int it = 0; it < 2; ++it) {
                f16v acc = zero16();
#pragma unroll
                for (int ks = 0; ks < 4; ++ks) acc = MFMA32(ld_nat(Tu, PT64, 32 * it + r32, 16 * ks, hh), ld_nat(Vt, PT64, r32, 16 * ks, hh), acc);
#pragma unroll
                for (int dt = 0; dt < 4; ++dt) { acc = MFMA32(ld_perm(nW, PT128, 32 * it + r32, 32 * dt, hh), Sp[dt][0], acc); acc = MFMA32(ld_perm(nW, PT128, 32 * it + r32, 32 * dt + 16, hh), Sp[dt][1], acc); }
                vb[it][0] = pack8<0>(acc); vb[it][1] = pack8<1>(acc);
#pragma unroll
                for (int g4 = 0; g4 < 4; ++g4) { const f4 e = *(const LAS f4*)(egls + 32 * it + 8 * g4 + 4 * hh); acc[4 * g4 + 0] *= e.x; acc[4 * g4 + 1] *= e.y; acc[4 * g4 + 2] *= e.z; acc[4 * g4 + 3] *= e.w; }
                vs[it][0] = pack8<0>(acc); vs[it][1] = pack8<1>(acc);
            }
#pragma unroll
            for (int it = 0; it < 2; ++it) {
                f16v acc = zero16();
#pragma unroll
                for (int dt = 0; dt < 4; ++dt) { acc = MFMA32(ld_perm(Qh, PT128, 32 * it + r32, 32 * dt, hh), Sp[dt][0], acc); acc = MFMA32(ld_perm(Qh, PT128, 32 * it + r32, 32 * dt + 16, hh), Sp[dt][1], acc); }
#pragma unroll
                for (int g4 = 0; g4 < 4; ++g4) { const f4 e = *(const LAS f4*)(egs + 32 * it + 8 * g4 + 4 * hh); acc[4 * g4 + 0] *= e.x; acc[4 * g4 + 1] *= e.y; acc[4 * g4 + 2] *= e.z; acc[4 * g4 + 3] *= e.w; }
#pragma unroll
                for (int jt = 0; jt <= it; ++jt) { acc = MFMA32(ld_perm(QK, PT64, 32 * it + r32, 32 * jt, hh), vb[jt][0], acc); acc = MFMA32(ld_perm(QK, PT64, 32 * it + r32, 32 * jt + 16, hh), vb[jt][1], acc); }
#pragma unroll
                for (int rg = 0; rg < 16; ++rg) { const int row = 32 * it + (rg & 3) + 8 * (rg >> 2) + 4 * hh; orow[(size_t)row * PW] = (bf16)f2bf(acc[rg]); }
            }
            const float egl_ = egs[63];
#pragma unroll
            for (int dt = 0; dt < 4; ++dt) {
#pragma unroll
                for (int i = 0; i < 16; ++i) S[dt][i] *= egl_;
#pragma unroll
                for (int it = 0; it < 2; ++it) { S[dt] = MFMA32(ld_perm(Kht, PT64, 32 * dt + r32, 32 * it, hh), vs[it][0], S[dt]); S[dt] = MFMA32(ld_perm(Kht, PT64, 32 * dt + r32, 32 * it + 16, hh), vs[it][1], S[dt]); }
            }
        } else {
#pragma unroll
            for (int it = 0; it < 2; ++it) {
                f16v acc = zero16();
#pragma unroll
                for (int dt = 0; dt < 4; ++dt) { acc = MFMA32(ld_perm(Qd, PT128, 32 * it + r32, 32 * dt, hh), Sp[dt][0], acc); acc = MFMA32(ld_perm(Qd, PT128, 32 * it + r32, 32 * dt + 16, hh), Sp[dt][1], acc); }
#pragma unroll
                for (int jt = 0; jt <= it; ++jt)
#pragma unroll
                    for (int ks = 0; ks < 2; ++ks) acc = MFMA32(ld_nat(Pm, PT64, 32 * it + r32, 32 * jt + 16 * ks, hh), ld_nat(Vt, PT64, r32, 32 * jt + 16 * ks, hh), acc);
#pragma unroll
                for (int rg = 0; rg < 16; ++rg) { const int row = 32 * it + (rg & 3) + 8 * (rg >> 2) + 4 * hh; orow[(size_t)row * PW] = (bf16)f2bf(acc[rg]); }
            }
            const float g64 = expf(64.0f * lgam);
#pragma unroll
            for (int dt = 0; dt < 4; ++dt) {
#pragma unroll
                for (int i = 0; i < 16; ++i) S[dt][i] *= g64;
#pragma unroll
                for (int ks = 0; ks < 4; ++ks) S[dt] = MFMA32(ld_nat(Kdt, PT64, 32 * dt + r32, 16 * ks, hh), ld_nat(Vt, PT64, r32, 16 * ks, hh), S[dt]);
            }
        }
        __syncthreads();
    }
}
__device__ __forceinline__ void phase_scan_mfma(const Args& a, LAS unsigned char* lds) {
    if (gridDim.x >= 256 && blockIdx.x >= 128) { convert_experts_part(a, lds, (int)blockIdx.x - 128, (int)gridDim.x - 128); return; }
    for (int id = blockIdx.x; id < 128; id += gridDim.x) {
        const int br = id & 1, bh = id >> 1, b = bh >> 2, h = bh & 3;
        if (br == 0) scan_mfma_item<0>(a, lds, b, h); else scan_mfma_item<1>(a, lds, b, h);
    }
    if (gridDim.x < 256) convert_experts_part(a, lds, (int)blockIdx.x, (int)gridDim.x);
}
__device__ __forceinline__ void phase_merge2(const Args& a, LAS unsigned char* lds) {
    const bf16* proj = (const bf16*)(a.ws + WS_PROJ); const float* gnw = a.in[9];
    bf16* merged = (bf16*)(a.ws + WS_MERGED);
    const int tid = tidx(), lane = tid & 63, wave = tid >> 6;
    const int gw = blockIdx.x * 8 + wave, NGW = gridDim.x * 8;
    for (int t = gw; t < T; t += NGW) {
        const int c0 = 16 * lane;
        const bf16* pr = proj + (size_t)t * PW;
        v4u orv[2], ogv[2]; float sr = 0.f, sg = 0.f;
#pragma unroll
        for (int part = 0; part < 2; ++part) { orv[part] = *(const v4u*)(pr + P_RV + c0 + 8 * part); ogv[part] = *(const v4u*)(pr + P_GV + c0 + 8 * part);
            const unsigned ru[4] = {orv[part].x, orv[part].y, orv[part].z, orv[part].w}, gu[4] = {ogv[part].x, ogv[part].y, ogv[part].z, ogv[part].w};
#pragma unroll
            for (int j = 0; j < 4; ++j) { sr += bflo(ru[j]) * bflo(ru[j]) + bfhi(ru[j]) * bfhi(ru[j]); sg += bflo(gu[j]) * bflo(gu[j]) + bfhi(gu[j]) * bfhi(gu[j]); } }
        sr += __shfl_xor(sr, 1); sr += __shfl_xor(sr, 2); sr += __shfl_xor(sr, 4); sr += __shfl_xor(sr, 8);
        sg += __shfl_xor(sg, 1); sg += __shfl_xor(sg, 2); sg += __shfl_xor(sg, 4); sg += __shfl_xor(sg, 8);
        const float rr = rsqrtf(sr * (1.0f / 256.0f) + 1e-6f), rg = rsqrtf(sg * (1.0f / 256.0f) + 1e-6f);
#pragma unroll
        for (int part = 0; part < 2; ++part) { const int c = c0 + 8 * part;
            const v4u ga = *(const v4u*)(pr + P_GA + c), gb = *(const v4u*)(pr + P_GB + c);
            const float4 w0 = *(const float4*)(gnw + (c & 255)), w1 = *(const float4*)(gnw + (c & 255) + 4);
            const v4u ov = orv[part], gv = ogv[part];
            float o[8];
            o[0] = bflo(ga.x) * bflo(ov.x) * rr + bflo(gb.x) * bflo(gv.x) * rg * w0.x; o[1] = bfhi(ga.x) * bfhi(ov.x) * rr + bfhi(gb.x) * bfhi(gv.x) * rg * w0.y;
            o[2] = bflo(ga.y) * bflo(ov.y) * rr + bflo(gb.y) * bflo(gv.y) * rg * w0.z; o[3] = bfhi(ga.y) * bfhi(ov.y) * rr + bfhi(gb.y) * bfhi(gv.y) * rg * w0.w;
            o[4] = bflo(ga.z) * bflo(ov.z) * rr + bflo(gb.z) * bflo(gv.z) * rg * w1.x; o[5] = bfhi(ga.z) * bfhi(ov.z) * rr + bfhi(gb.z) * bfhi(gv.z) * rg * w1.y;
            o[6] = bflo(ga.w) * bflo(ov.w) * rr + bflo(gb.w) * bflo(gv.w) * rg * w1.z; o[7] = bfhi(ga.w) * bfhi(ov.w) * rr + bfhi(gb.w) * bfhi(gv.w) * rg * w1.w;
            v4u w; w.x = pkh(o[0], o[1]); w.y = pkh(o[2], o[3]); w.z = pkh(o[4], o[5]); w.w = pkh(o[6], o[7]);
            *(v4u*)(merged + (size_t)t * 1024 + c) = w; }
    }
}
}
namespace {
template <int MODE> __device__ __forceinline__ void phase_scan_mix(const Args& a, LAS unsigned char* lds) {
    const int id = blockIdx.x;
    if (id < 64) { const int b = id >> 2, h = id & 3; if (MODE == 1) scan_mfma_item<0>(a, lds, b, h); else scan_mfma_item<1>(a, lds, b, h); }
    else if (id < 192) { const int q = id - 64, half = q & 1, bh = q >> 1, b = bh >> 2, h = bh & 3; if (MODE == 1) scan_item<1>(a, lds, b, h, half); else scan_item<0>(a, lds, b, h, half); }
}
template <int PH> __device__ __forceinline__ void run_phase(const Args& a, LAS unsigned char* lds) {
    if (PH == 0) { phase_mod(a, lds); __syncthreads(); phase_convert_in(a, lds); }
    else if (PH == 1) phase_norm1(a, lds);
    else if (PH == 2) phase_inproj(a, lds);
    else if (PH == 3) phase_gprep(a, lds);
    else if (PH == 4) phase_scan_mfma(a, lds);
    else if (PH == 5) phase_merge2(a, lds);
    else if (PH == 6) phase_outproj(a, lds);
    else if (PH == 7) phase_route(a, lds);
    else if (PH == 8) phase_scatter(a, lds);
    else if (PH == 9) phase_moe1(a, lds);
    else if (PH == 10) phase_moe2(a, lds);
    else if (PH == 11) phase_final(a, lds);
    else if (PH == 21) phase_scan_mix<1>(a, lds);
    else if (PH == 22) phase_scan_mix<2>(a, lds);
}
template <int PH> __global__ void __launch_bounds__(512, 2) k_phase(Args a) {
    extern __shared__ __attribute__((aligned(16))) unsigned char smem[];
    run_phase<PH>(a, (LAS unsigned char*)smem);
}
}
namespace {
#define XB_TMO      128
#define XB_XCNT(j)  (256  + 64 * (j))
#define XB_XSUB(j)  (1280 + 64 * (j))
#define XB_XGEN(j)  (2304 + 64 * (j))
#define XB_TOP      3328
#define XB_TOPGEN   3392
#define XCD_BAR_WORDS 3456
#define XB_SPIN_CAP (1u << 18)

__device__ __forceinline__ unsigned xb_ld(unsigned* p)              { return __hip_atomic_load(p, __ATOMIC_RELAXED, __HIP_MEMORY_SCOPE_AGENT); }
__device__ __forceinline__ unsigned xb_add(unsigned* p, unsigned v) { return __hip_atomic_fetch_add(p, v, __ATOMIC_RELAXED, __HIP_MEMORY_SCOPE_AGENT); }
__device__ __forceinline__ unsigned xb_xcc_id() { return (unsigned)__builtin_amdgcn_s_getreg((3 << 11) | 20) & 0xFu; }
#define XB_SPIN(cond, bar) do { unsigned _sp = 0; while (cond) { __builtin_amdgcn_s_sleep(1); \
    if ((++_sp & 255u) == 0u) { if (xb_ld(&(bar)[XB_TMO])) break; if (_sp > XB_SPIN_CAP) { atomicAdd(&(bar)[XB_TMO], 1u); break; } } } } while (0)

struct XcdBarrier {
    unsigned* bar; unsigned x;
    volatile LAS unsigned* st;
};

__device__ __forceinline__ XcdBarrier xcd_barrier_post(unsigned* bar, volatile LAS unsigned* st) {
    XcdBarrier b; b.bar = bar; b.x = xb_xcc_id(); b.st = st;
    if (threadIdx.x == 0) (void)xb_add(&bar[XB_XCNT(b.x)], 1u);
    return b;
}
__device__ __forceinline__ void xcd_barrier_complete(unsigned* bar, unsigned x, unsigned& nloc, unsigned& nx) {
    const unsigned G = gridDim.x * gridDim.y * gridDim.z;
    unsigned sum, cnt, mine, sp = 0u;
    for (;;) {
        sum = 0u; cnt = 0u; mine = 0u;
#pragma unroll
        for (unsigned j = 0; j < 16; ++j) { const unsigned c = xb_ld(&bar[XB_XCNT(j)]); sum += c; cnt += (c > 0u) ? 1u : 0u; mine = (j == x) ? c : mine; }
        if (sum == G) break;
        __builtin_amdgcn_s_sleep(1);
        if ((++sp & 255u) == 0u) { if (xb_ld(&bar[XB_TMO])) break; if (sp > XB_SPIN_CAP) { atomicAdd(&bar[XB_TMO], 1u); break; } }
    }
    nloc = mine > 0u ? mine : 1u; nx = cnt > 0u ? cnt : 1u;
}

__device__ __forceinline__ void xcd_barrier(const XcdBarrier& b) {
    asm volatile("s_waitcnt vmcnt(0)" ::: "memory");
    __syncthreads();
    if (threadIdx.x == 0) {
        unsigned* bar = b.bar;
        __builtin_amdgcn_s_waitcnt(0);
        unsigned nloc = b.st[0], nx = b.st[1];
        if (nloc == 0u) { xcd_barrier_complete(bar, b.x, nloc, nx); b.st[0] = nloc; b.st[1] = nx; }
        const unsigned old = xb_add(&bar[XB_XSUB(b.x)], 1u);
        const unsigned gen = old / nloc;
        if (old + 1u == (gen + 1u) * nloc) {
            __builtin_amdgcn_fence(__ATOMIC_RELEASE, "agent");
            asm volatile("s_waitcnt vmcnt(0)" ::: "memory");
            const unsigned og = xb_add(&bar[XB_TOP], 1u);
            const unsigned tg = og / nx;
            if (og + 1u == (tg + 1u) * nx) xb_add(&bar[XB_TOPGEN], 1u);
            else XB_SPIN(xb_ld(&bar[XB_TOPGEN]) == tg, bar);
            __builtin_amdgcn_fence(__ATOMIC_ACQUIRE, "agent");
            xb_add(&bar[XB_XGEN(b.x)], 1u);
            asm volatile("s_waitcnt vmcnt(0)" ::: "memory");
        } else {
            XB_SPIN(xb_ld(&bar[XB_XGEN(b.x)]) == gen, bar);
            __builtin_amdgcn_fence(__ATOMIC_ACQUIRE, "agent");
            asm volatile("s_waitcnt vmcnt(0)" ::: "memory");
        }
    }
    __syncthreads();
}

constexpr int LDS_BAR_OFF = LDS_BYTES - 16;
__global__ void __launch_bounds__(512, 2) k_mega(Args a) {
    extern __shared__ __attribute__((aligned(16))) unsigned char smem[];
    LAS unsigned char* lds = (LAS unsigned char*)smem;
    cg::grid_group grid = cg::this_grid();
    if (threadIdx.x == 0) *(LAS v4u*)(lds + LDS_BAR_OFF) = (v4u){0u, 0u, 0u, 0u};
    __syncthreads();
    XcdBarrier bar = xcd_barrier_post((unsigned*)(a.ws + WS_CTL), (volatile LAS unsigned*)(lds + LDS_BAR_OFF));
    run_phase<0>(a, lds); grid.sync();
    run_phase<1>(a, lds); xcd_barrier(bar);
    run_phase<2>(a, lds); xcd_barrier(bar);
    run_phase<3>(a, lds); xcd_barrier(bar);
    run_phase<4>(a, lds); xcd_barrier(bar);
    run_phase<5>(a, lds); xcd_barrier(bar);
    run_phase<6>(a, lds); xcd_barrier(bar);
    run_phase<7>(a, lds); xcd_barrier(bar);
    run_phase<8>(a, lds); xcd_barrier(bar);
    run_phase<9>(a, lds); xcd_barrier(bar);
    run_phase<10>(a, lds); xcd_barrier(bar);
    run_phase<11>(a, lds);
}
}
extern "C" void kernel_launch(void* const* d_in, const int* in_sizes, int n_in, void* d_out, int out_size, void* d_ws, size_t ws_size, hipStream_t stream) {
    if (ws_size < 512 * MiB) return;
    static int grid_blocks = 0;
    if (!grid_blocks) {
        int dev = 0, cus = 0, per_cu = 0;
        (void)hipGetDevice(&dev);
        (void)hipDeviceGetAttribute(&cus, hipDeviceAttributeMultiprocessorCount, dev);
        (void)hipFuncSetAttribute((const void*)k_mega, hipFuncAttributeMaxDynamicSharedMemorySize, LDS_BYTES);
        (void)hipOccupancyMaxActiveBlocksPerMultiprocessor(&per_cu, (const void*)k_mega, 512, LDS_BYTES);
        if (per_cu < 1) per_cu = 1;
        grid_blocks = cus * per_cu;
        if (grid_blocks > 256) grid_blocks = 256;
    }
    (void)hipMemsetAsync((unsigned char*)d_ws + WS_CTL, 0, XCD_BAR_WORDS * 4, stream);
    Args a{};
    for (int i = 0; i < 20; ++i) a.in[i] = (const float*)d_in[i];
    a.out = (float*)d_out; a.ws = (unsigned char*)d_ws;
    void* args[] = {&a};
    (void)hipLaunchCooperativeKernel((const void*)k_mega, dim3(grid_blocks), dim3(512), args, LDS_BYTES, stream);
}
```

```cpp
#include <hip/hip_runtime.h>
#include <hip/hip_cooperative_groups.h>
#include <stdint.h>
namespace cg = cooperative_groups;

#define LAS __attribute__((address_space(3)))
typedef unsigned short bf16;
typedef unsigned v4u __attribute__((ext_vector_type(4)));
typedef unsigned v2u __attribute__((ext_vector_type(2)));
typedef float f4 __attribute__((ext_vector_type(4)));

namespace {
constexpr int D = 1024, NB = 16, SEQ = 2048, T = NB * SEQ, DIN = 8200;
constexpr int NH = 4, DK = 128, DV = 256;
constexpr int C_RQ = 0, C_RK = 512, C_RV = 1024, C_RG = 2048, C_GQ = 3072, C_GK = 3584, C_GV = 4096, C_GZ = 5120,
              C_GA = 6144, C_GB = 6148, C_GTA = 6152, C_GTB = 7176;
constexpr int NE = 16, FF = 512;
constexpr int MAXSLOT = 2 * T + NE * 256;
constexpr int PW = 6144, P_RQ = 0, P_RK = 512, P_RV = 1024, P_GQ = 2048, P_GK = 2560, P_GV = 3072, P_GA = 4096, P_GB = 5120;

constexpr size_t MiB = 1u << 20;
constexpr size_t WS_PROJ = 0;
constexpr size_t WS_MERGED = 384 * MiB;
constexpr size_t WS_WTOUT = 448 * MiB;
constexpr size_t WS_CTL = 450 * MiB;
constexpr size_t WS_MOD = 450 * MiB + 64 * 1024;
constexpr size_t WS_ROPE = 451 * MiB;
constexpr size_t WS_BETA = 452 * MiB;
constexpr size_t WS_G = 452 * MiB + 512 * 1024;
constexpr size_t WS_TOKE = 453 * MiB;
constexpr size_t WS_TOKW = 453 * MiB + 256 * 1024;
constexpr size_t WS_TOKS = 453 * MiB + 512 * 1024;
constexpr size_t WS_HIST = 453 * MiB + 768 * 1024;
constexpr size_t WS_META = 453 * MiB + 832 * 1024;
constexpr size_t WS_SSQ = 455 * MiB;
constexpr size_t WS_SLOTTOK = 455 * MiB;
constexpr size_t WS_WTGU = 456 * MiB;
constexpr size_t WS_WTD = 488 * MiB;
constexpr size_t WS_XF = 0;
constexpr size_t WS_XS = 64 * MiB;
constexpr size_t WS_ACT = 200 * MiB;
constexpr size_t WS_Y = 268 * MiB;
constexpr size_t WS_NEED = 504 * MiB;
constexpr size_t DO_XM = 0;
constexpr size_t DO_WTIN = 64 * MiB;
constexpr int LDS_BYTES = 147456;

__device__ __forceinline__ float silu_f(float x) { return x / (1.0f + expf(-x)); }
__device__ __forceinline__ float sigmoid_f(float x) { return 1.0f / (1.0f + expf(-x)); }
__device__ __forceinline__ float fsigmoid(float x) { return __builtin_amdgcn_rcpf(1.0f + __expf(-x)); }
template <int CTRL> __device__ __forceinline__ float dpp_mov(float v) { return __builtin_bit_cast(float, __builtin_amdgcn_update_dpp(0, __builtin_bit_cast(int, v), CTRL, 0xF, 0xF, false)); }
__device__ __forceinline__ float row_sum16(float v) {
    v += dpp_mov<0xB1>(v);
    v += dpp_mov<0x4E>(v);
    v += dpp_mov<0x141>(v);
    v += dpp_mov<0x140>(v);
    return v;
}
__device__ __forceinline__ float wave_sum(float v) { v = row_sum16(v); v += __shfl_xor(v, 16); v += __shfl_xor(v, 32); return v; }
typedef __bf16 bf2v_ __attribute__((ext_vector_type(2)));
typedef float f2v_ __attribute__((ext_vector_type(2)));
__device__ __forceinline__ unsigned pkh(float lo, float hi) { const f2v_ v = {lo, hi}; return __builtin_bit_cast(unsigned, __builtin_convertvector(v, bf2v_)); }
__device__ __forceinline__ unsigned f2bf(float f) { unsigned u = __float_as_uint(f); return (u + 0x7fffu + ((u >> 16) & 1u)) >> 16; }
__device__ __forceinline__ unsigned pk2(float lo, float hi) { return f2bf(lo) | (f2bf(hi) << 16); }
__device__ __forceinline__ float bf2f(unsigned short b) { return __uint_as_float(((unsigned)b) << 16); }
__device__ __forceinline__ float bflo(unsigned w) { return __uint_as_float(w << 16); }
__device__ __forceinline__ float bfhi(unsigned w) { return __uint_as_float(w & 0xffff0000u); }

struct Args { const float* in[20]; float* out; unsigned char* ws; int ph_lo, ph_hi; };
}
namespace pg8 {
#define PG8_LAS __attribute__((address_space(3)))
typedef unsigned short bf16_t;
typedef short bf16x8 __attribute__((ext_vector_type(8)));
typedef float f32x4 __attribute__((ext_vector_type(4)));
typedef unsigned u32x4 __attribute__((ext_vector_type(4)));
constexpr int BM = 256, BK = 64, HALF = 128, HTB = HALF * BK * 2  , STAGE_BYTES = 8 * HTB, NXCD = 8, WGM = 8;

__host__ __device__ __forceinline__ int lds_byte(int r, int c) { const int st = (r >> 4) * 2 + (c >> 5), rr = r & 15, cc = c & 31, ob = rr * 64 + cc * 2; return st * 1024 + (ob ^ (((ob >> 9) & 1) << 5)); }
__host__ __device__ __forceinline__ void stage_rc(int b, int& R, int& C) { const int st = b / 1024, sb = b % 1024, swz = sb ^ (((sb >> 9) & 1) << 5); R = (st >> 1) * 16 + swz / 64; C = (st & 1) * 32 + (swz % 64) / 2; }
__host__ __device__ __forceinline__ int perm32(int rho) { const int n = rho >> 4, i = rho & 15; return 8 * (i >> 2) + 4 * n + (i & 3); }

struct Unit { int pm, pn; };
struct Gemm { const bf16_t* A; const bf16_t* Bt; int M, N, K; };

struct StaticOrder {
    int nM, nN, nwg, G, c;
    __host__ __device__ void init(int M, int N, int G_, int c_) { nM = M / BM; nN = N / BM; nwg = nM * nN; G = G_; c = c_; }
    __host__ __device__ bool next(int i, Unit& u) const {
        const long L = (long)i * G + c; if (L >= nwg) return false;
        int wgid = (int)L; { const int q = nwg / NXCD, r = nwg % NXCD, xcd = wgid % NXCD, off = wgid / NXCD; wgid = (xcd < r ? xcd * (q + 1) : r * (q + 1) + (xcd - r) * q) + off; }
        const int nig = WGM * nN, gid = wgid / nig, fm = gid * WGM, gsz = (nM - fm) < WGM ? (nM - fm) : WGM;
        u.pm = fm + ((wgid % nig) % gsz); u.pn = (wgid % nig) / gsz; return true;
    }
    __device__ __forceinline__ void a_ready(const Unit&) const {}
    __device__ __forceinline__ void done(const Unit&) const {}
};

__device__ __forceinline__ unsigned cvt_pk_bf16(float lo, float hi) { unsigned r; asm volatile("v_cvt_pk_bf16_f32 %0, %1, %2" : "=v"(r) : "v"(lo), "v"(hi)); return r; }
__device__ __forceinline__ float fsig(float x) { return __builtin_amdgcn_rcpf(1.0f + __expf(-x)); }

struct EpiProj {
    static constexpr bool PERM = true, AFTER_DRAIN = false;
    bf16_t* P; int pw; const float* rope;
    __device__ __forceinline__ void operator()(const f32x4 (&acc)[2][2][4][2], const Unit& u, int wr, int wc, int fr, int fq) const {
        const int row0 = u.pm * BM + wr * 64 + fr;
        if (u.pn < 4) {
            const int isk = u.pn >> 1, head = 2 * (u.pn & 1) + (wc >> 1), i0 = 32 * (wc & 1) + 8 * fq;
            const float lgam = __logf(1.0f - exp2f(-5.0f - (float)head));
            bf16_t* base = P + (isk ? 512 : 0) + head * 128 + i0;
#pragma unroll
            for (int ai = 0; ai < 2; ++ai)
#pragma unroll
                for (int m = 0; m < 4; ++m) { const int row = row0 + ai * HALF + m * 16, tl = row & 2047;
                    const f32x4* rp = (const f32x4*)(rope + (size_t)(tl * 64 + i0) * 2);
                    const f32x4 c0 = rp[0], c1 = rp[1], c2 = rp[2], c3 = rp[3];
                    const float cs[8] = {c0[0], c0[2], c1[0], c1[2], c2[0], c2[2], c3[0], c3[2]}, sn[8] = {c0[1], c0[3], c1[1], c1[3], c2[1], c2[3], c3[1], c3[3]};
                    const float sc = isk ? 0.08838834764831845f : __expf((float)((tl & 63) + 1) * lgam);
                    float o1[8], o2[8];
#pragma unroll
                    for (int n = 0; n < 2; ++n)
#pragma unroll
                        for (int j = 0; j < 4; ++j) { const float x1 = acc[ai][0][m][n][j], x2 = acc[ai][1][m][n][j]; const int q = 4 * n + j;
                            o1[q] = (x1 * cs[q] - x2 * sn[q]) * sc; o2[q] = (x1 * sn[q] + x2 * cs[q]) * sc; }
                    u32x4 w1, w2; w1.x = cvt_pk_bf16(o1[0], o1[1]); w1.y = cvt_pk_bf16(o1[2], o1[3]); w1.z = cvt_pk_bf16(o1[4], o1[5]); w1.w = cvt_pk_bf16(o1[6], o1[7]);
                    w2.x = cvt_pk_bf16(o2[0], o2[1]); w2.y = cvt_pk_bf16(o2[2], o2[3]); w2.z = cvt_pk_bf16(o2[4], o2[5]); w2.w = cvt_pk_bf16(o2[6], o2[7]);
                    bf16_t* rowp = base + (size_t)row * pw;
                    *(u32x4*)rowp = w1; *(u32x4*)(rowp + 64) = w2; }
        } else if (u.pn < 16) {
            const int col0 = u.pn * BM + wc * 32 + 8 * fq;
#pragma unroll
            for (int ai = 0; ai < 2; ++ai)
#pragma unroll
                for (int m = 0; m < 4; ++m) { bf16_t* rowp = P + (size_t)(row0 + ai * HALF + m * 16) * pw + col0;
#pragma unroll
                    for (int bj = 0; bj < 2; ++bj) { const f32x4 v0 = acc[ai][bj][m][0], v1 = acc[ai][bj][m][1];
                        u32x4 w; w.x = cvt_pk_bf16(v0[0], v0[1]); w.y = cvt_pk_bf16(v0[2], v0[3]); w.z = cvt_pk_bf16(v1[0], v1[1]); w.w = cvt_pk_bf16(v1[2], v1[3]);
                        *(u32x4*)(rowp + bj * HALF) = w; } }
        } else {
            const int col0 = 4096 + (u.pn - 16) * 128 + wc * 32 + 8 * fq;
#pragma unroll
            for (int ai = 0; ai < 2; ++ai)
#pragma unroll
                for (int m = 0; m < 4; ++m) { bf16_t* rowp = P + (size_t)(row0 + ai * HALF + m * 16) * pw + col0;
                    float o[8];
#pragma unroll
                    for (int n = 0; n < 2; ++n)
#pragma unroll
                        for (int j = 0; j < 4; ++j) { const float g = acc[ai][0][m][n][j], s = acc[ai][1][m][n][j]; o[n * 4 + j] = g * fsig(g) * fsig(s); }
                    u32x4 w; w.x = cvt_pk_bf16(o[0], o[1]); w.y = cvt_pk_bf16(o[2], o[3]); w.z = cvt_pk_bf16(o[4], o[5]); w.w = cvt_pk_bf16(o[6], o[7]);
                    *(u32x4*)rowp = w; }
        }
    }
};
struct EpiH {
    static constexpr bool PERM = false, AFTER_DRAIN = false;
    const float* x; const float* mod; float* h;
    __device__ __forceinline__ void operator()(const f32x4 (&acc)[2][2][4][2], const Unit& u, int wr, int wc, int fr, int fq) const {
        const int row0 = u.pm * BM + wr * 64 + fr, col0 = u.pn * BM + wc * 32 + 4 * fq;
        const int b = (u.pm * BM) / 2048;
        f32x4 gv[2][2];
#pragma unroll
        for (int bj = 0; bj < 2; ++bj)
#pragma unroll
            for (int n = 0; n < 2; ++n) gv[bj][n] = *(const f32x4*)(mod + (size_t)b * 6144 + 2048 + col0 + bj * HALF + n * 16);
#pragma unroll
        for (int ai = 0; ai < 2; ++ai)
#pragma unroll
            for (int mp = 0; mp < 2; ++mp) {
                f32x4 xv[2][2][2];
#pragma unroll
                for (int mm = 0; mm < 2; ++mm) { const size_t off = (size_t)(row0 + ai * HALF + (2 * mp + mm) * 16) * 1024 + col0;
#pragma unroll
                    for (int bj = 0; bj < 2; ++bj)
#pragma unroll
                        for (int n = 0; n < 2; ++n) xv[mm][bj][n] = *(const f32x4*)(x + off + bj * HALF + n * 16); }
#pragma unroll
                for (int mm = 0; mm < 2; ++mm) { const size_t off = (size_t)(row0 + ai * HALF + (2 * mp + mm) * 16) * 1024 + col0;
#pragma unroll
                    for (int bj = 0; bj < 2; ++bj)
#pragma unroll
                        for (int n = 0; n < 2; ++n) *(f32x4*)(h + off + bj * HALF + n * 16) = xv[mm][bj][n] + gv[bj][n] * acc[ai][bj][2 * mp + mm][n]; }
                asm volatile("" ::: "memory"); }
    }
};
struct EpiAct {
    static constexpr bool PERM = true, AFTER_DRAIN = false;
    bf16_t* act;
    __device__ __forceinline__ void operator()(const f32x4 (&acc)[2][2][4][2], const Unit& u, int wr, int wc, int fr, int fq) const {
        const int row0 = u.pm * BM + wr * 64 + fr, col0 = (u.pn & 3) * 128 + wc * 32 + 8 * fq;
#pragma unroll
        for (int ai = 0; ai < 2; ++ai)
#pragma unroll
            for (int m = 0; m < 4; ++m) { bf16_t* rowp = act + (size_t)(row0 + ai * HALF + m * 16) * 512 + col0;
                float o[8];
#pragma unroll
                for (int n = 0; n < 2; ++n)
#pragma unroll
                    for (int j = 0; j < 4; ++j) { const float g = acc[ai][0][m][n][j], up = acc[ai][1][m][n][j]; o[n * 4 + j] = g * fsig(g) * up; }
                u32x4 w; w.x = cvt_pk_bf16(o[0], o[1]); w.y = cvt_pk_bf16(o[2], o[3]); w.z = cvt_pk_bf16(o[4], o[5]); w.w = cvt_pk_bf16(o[6], o[7]);
                *(u32x4*)rowp = w; }
    }
};
struct EpiY {
    static constexpr bool PERM = true, AFTER_DRAIN = false;
    bf16_t* y;
    __device__ __forceinline__ void operator()(const f32x4 (&acc)[2][2][4][2], const Unit& u, int wr, int wc, int fr, int fq) const {
        const int row0 = u.pm * BM + wr * 64 + fr, col0 = (u.pn & 3) * BM + wc * 32 + 8 * fq;
#pragma unroll
        for (int ai = 0; ai < 2; ++ai)
#pragma unroll
            for (int m = 0; m < 4; ++m) { bf16_t* rowp = y + (size_t)(row0 + ai * HALF + m * 16) * 1024 + col0;
#pragma unroll
                for (int bj = 0; bj < 2; ++bj) { const f32x4 v0 = acc[ai][bj][m][0], v1 = acc[ai][bj][m][1];
                    u32x4 w; w.x = cvt_pk_bf16(v0[0], v0[1]); w.y = cvt_pk_bf16(v0[2], v0[3]); w.z = cvt_pk_bf16(v1[0], v1[1]); w.w = cvt_pk_bf16(v1[2], v1[3]);
                    *(u32x4*)(rowp + bj * HALF) = w; } }
    }
};
struct MoeOrder {
    const int* tile_expert; int nwg, G, c;
    __device__ void init(const int* meta, const int* te, int G_, int c_) { tile_expert = te; nwg = meta[33] * 4; G = G_; c = c_; }
    __device__ bool next(int i, Unit& u) const {
        const long L = (long)i * G + c; if (L >= nwg) return false;
        int wgid = (int)L; { const int q = nwg / NXCD, r = nwg % NXCD, xcd = wgid % NXCD, off = wgid / NXCD; wgid = (xcd < r ? xcd * (q + 1) : r * (q + 1) + (xcd - r) * q) + off; }
        u.pm = wgid >> 2; u.pn = tile_expert[u.pm] * 4 + (wgid & 3); return true;
    }
    __device__ __forceinline__ void a_ready(const Unit&) const {}
    __device__ __forceinline__ void done(const Unit&) const {}
};
struct NoGather { static constexpr bool ON = false; const int* slot_tok; };
struct RowGather { static constexpr bool ON = true; const int* slot_tok; };
template <class Epi, class Sched, bool ALIGN_EPI = false, bool SP2 = false, class AG = NoGather>
__device__ __forceinline__ void gemm_phase(PG8_LAS unsigned char* lds, const Gemm g, const Sched& S, const Epi& E, const AG ag = AG{nullptr}) {
    int tid = threadIdx.x; asm volatile("" : "+v"(tid));
    const int wid = __builtin_amdgcn_readfirstlane(tid >> 6), lane = tid & 63, wr = wid >> 2, wc = wid & 3, fr = lane & 15, fq = lane >> 4;
    const int K = g.K, nt = K / BK;
    unsigned voffA[2], voffB[2]; int rowA[2], colA[2];
#pragma unroll
    for (int i = 0; i < 2; ++i) { int R, C; stage_rc(tid * 16 + i * 8192, R, C); const int Rb = Epi::PERM ? ((R & ~31) + perm32(R & 31)) : R;
        voffA[i] = (unsigned)(R * K + C) * 2u; voffB[i] = (unsigned)(Rb * K + C) * 2u; rowA[i] = R; colA[i] = C; }
    unsigned gC[2][2] = {{0u, 0u}, {0u, 0u}}, gN[2][2] = {{0u, 0u}, {0u, 0u}};
    const size_t kstep = (size_t)(BK * 2);
    const size_t hstep = (size_t)HALF * K * 2;
    const size_t tstep = 2 * hstep;
    const unsigned ldsw = (unsigned)wid * 1024u;
    const int aoff = lds_byte(wr * 64 + fr, fq * 8), boff = lds_byte(wc * 32 + fr, fq * 8);
#define PG8_SA(b, h) (((b) * 2 + (h)) * HTB)
#define PG8_SB(b, h) ((4 + (b) * 2 + (h)) * HTB)
#define PG8_STAGE(bufoff, gbase, voff) do { _Pragma("unroll") for (int _i = 0; _i < 2; ++_i) \
        __builtin_amdgcn_global_load_lds((const unsigned*)((const char*)(gbase) + (voff)[_i]), (PG8_LAS unsigned*)(lds + (bufoff) + ldsw + _i * 8192), 16, 0, 0); } while (0)
#define PG8_STAGE_A(bufoff, H, KOFF, NEXT) do { _Pragma("unroll") for (int _i = 0; _i < 2; ++_i) { const char* _p; \
        if constexpr (AG::ON) _p = (const char*)g.A + ((NEXT) ? gN[H][_i] : gC[H][_i]) + (KOFF); else _p = ((NEXT) ? nA : cA) + (size_t)(H) * hstep + voffA[_i] + (KOFF); \
        __builtin_amdgcn_global_load_lds((const unsigned*)_p, (PG8_LAS unsigned*)(lds + (bufoff) + ldsw + _i * 8192), 16, 0, 0); } } while (0)
#define PG8_GATHER(dst, U) do { if constexpr (AG::ON) { _Pragma("unroll") for (int _h = 0; _h < 2; ++_h) _Pragma("unroll") for (int _i = 0; _i < 2; ++_i) { \
        int _t = ag.slot_tok[(U).pm * BM + _h * HALF + rowA[_i]]; _t = _t < 0 ? 0 : _t; dst[_h][_i] = (unsigned)(_t * K + colA[_i]) * 2u; } } } while (0)
#define PG8_LDA(dst, b, h) do { _Pragma("unroll") for (int m = 0; m < 4; ++m) _Pragma("unroll") for (int k = 0; k < 2; ++k) dst[m][k] = *(const PG8_LAS bf16x8*)(lds + PG8_SA(b, h) + aoff + m * 2048 + k * 1024); } while (0)
#define PG8_LDB(dst, b, h) do { _Pragma("unroll") for (int n = 0; n < 2; ++n) _Pragma("unroll") for (int k = 0; k < 2; ++k) dst[n][k] = *(const PG8_LAS bf16x8*)(lds + PG8_SB(b, h) + boff + n * 2048 + k * 1024); } while (0)
#define PG8_MMA(ai, bj, At, Bt) do { __builtin_amdgcn_s_setprio(1); _Pragma("unroll") for (int m = 0; m < 4; ++m) _Pragma("unroll") for (int n = 0; n < 2; ++n) _Pragma("unroll") for (int k = 0; k < 2; ++k) \
        acc[ai][bj][m][n] = __builtin_amdgcn_mfma_f32_16x16x32_bf16(Bt[n][k], At[m][k], acc[ai][bj][m][n], 0, 0, 0); __builtin_amdgcn_s_setprio(0); } while (0)
#define PG8_WAIT_V(n) asm volatile("s_waitcnt vmcnt(" #n ")" ::: "memory")
#define PG8_WAIT_L(n) asm volatile("s_waitcnt lgkmcnt(" #n ")" ::: "memory")
#define PG8_BAR __builtin_amdgcn_s_barrier()
#define PG8_SCHED __builtin_amdgcn_sched_barrier(0)
    Unit cur, nxt; int ui = 0;
    if (!S.next(0, cur)) return;
    f32x4 acc[2][2][4][2];
#pragma unroll
    for (int a = 0; a < 2; ++a)
#pragma unroll
        for (int b = 0; b < 2; ++b)
#pragma unroll
            for (int m = 0; m < 4; ++m)
#pragma unroll
                for (int n = 0; n < 2; ++n) acc[a][b][m][n] = (f32x4){0.f, 0.f, 0.f, 0.f};
    bf16x8 At[4][2], B0[2][2], B1[2][2];
    const char* cA = (const char*)g.A + (size_t)cur.pm * tstep; const char* cB = (const char*)g.Bt + (size_t)cur.pn * tstep;
    S.a_ready(cur);
    PG8_GATHER(gC, cur);
    { const char* nA = cA; (void)nA;
    if constexpr (SP2) {
        PG8_STAGE(PG8_SB(0, 0), cB, voffB); PG8_STAGE(PG8_SB(0, 1), cB + hstep, voffB); PG8_STAGE_A(PG8_SA(0, 0), 0, 0, false); PG8_STAGE_A(PG8_SA(0, 1), 1, 0, false);
        if (wr == 1) PG8_BAR;
        PG8_WAIT_V(2); PG8_BAR;
        PG8_STAGE(PG8_SB(1, 0), cB + kstep, voffB); PG8_STAGE_A(PG8_SA(1, 0), 0, kstep, false); PG8_STAGE(PG8_SB(1, 1), cB + hstep + kstep, voffB);
        PG8_WAIT_V(6); PG8_BAR;
    } else {
        PG8_STAGE(PG8_SB(0, 0), cB, voffB); PG8_STAGE_A(PG8_SA(0, 0), 0, 0, false); PG8_STAGE(PG8_SB(0, 1), cB + hstep, voffB); PG8_STAGE_A(PG8_SA(0, 1), 1, 0, false);
        if (wr == 1) PG8_BAR;
        PG8_WAIT_V(4); PG8_BAR;
        PG8_STAGE(PG8_SB(1, 0), cB + kstep, voffB); PG8_STAGE_A(PG8_SA(1, 0), 0, kstep, false); PG8_STAGE(PG8_SB(1, 1), cB + hstep + kstep, voffB);
        PG8_WAIT_V(6); PG8_BAR;
    }
    }
    for (;;) {
        const bool has_next = S.next(ui + 1, nxt);
        const char* nA = has_next ? (const char*)g.A + (size_t)nxt.pm * tstep : cA; const char* nB = has_next ? (const char*)g.Bt + (size_t)nxt.pn * tstep : cB;
        if constexpr (AG::ON) { if (has_next) { PG8_GATHER(gN, nxt); } else { gN[0][0] = gC[0][0]; gN[0][1] = gC[0][1]; gN[1][0] = gC[1][0]; gN[1][1] = gC[1][1]; } }
        for (int t = 0; t < nt; t += 2) {
            const bool last = (t == nt - 2);
            const char* a1 = cA + (size_t)(t + 1) * kstep;
            const char* a2 = last ? nA : cA + (size_t)(t + 2) * kstep; const char* b2 = last ? nB : cB + (size_t)(t + 2) * kstep;
            const char* a3 = a2 + kstep; const char* b3 = b2 + kstep;
            const size_t k1 = (size_t)(t + 1) * kstep, k2 = last ? (size_t)0 : (size_t)(t + 2) * kstep, k3 = k2 + kstep; (void)a1; (void)a2; (void)a3;
            if (last && has_next) S.a_ready(nxt);
            if constexpr (SP2) {
            PG8_LDB(B0, 0, 0); PG8_LDB(B1, 0, 1); PG8_SCHED; PG8_LDA(At, 0, 0); PG8_STAGE_A(PG8_SA(1, 1), 1, k1, false);
            PG8_WAIT_V(8); PG8_WAIT_L(0); PG8_BAR; PG8_MMA(0, 0, At, B0); PG8_MMA(0, 1, At, B1); PG8_BAR; PG8_SCHED;
            PG8_LDA(At, 0, 1); PG8_STAGE(PG8_SB(0, 0), b2, voffB); PG8_STAGE(PG8_SB(0, 1), b2 + hstep, voffB); PG8_STAGE_A(PG8_SA(0, 0), 0, k2, last);
            PG8_WAIT_V(8); PG8_WAIT_L(0); PG8_BAR; PG8_MMA(1, 0, At, B0); PG8_MMA(1, 1, At, B1); PG8_BAR; PG8_SCHED;
            PG8_LDB(B0, 1, 0); PG8_LDB(B1, 1, 1); PG8_SCHED; PG8_LDA(At, 1, 0); PG8_STAGE_A(PG8_SA(0, 1), 1, k2, last);
            PG8_WAIT_V(8); PG8_WAIT_L(0); PG8_BAR; PG8_MMA(0, 0, At, B0); PG8_MMA(0, 1, At, B1); PG8_BAR; PG8_SCHED;
            PG8_LDA(At, 1, 1); PG8_STAGE(PG8_SB(1, 0), b3, voffB); PG8_STAGE(PG8_SB(1, 1), b3 + hstep, voffB); PG8_STAGE_A(PG8_SA(1, 0), 0, k3, last);
            PG8_WAIT_V(8); PG8_WAIT_L(0); PG8_BAR; PG8_MMA(1, 0, At, B0); PG8_MMA(1, 1, At, B1); PG8_BAR; PG8_SCHED;
            } else {
            PG8_LDB(B0, 0, 0); PG8_SCHED; PG8_LDA(At, 0, 0); PG8_STAGE_A(PG8_SA(1, 1), 1, k1, false);
            PG8_WAIT_L(8); PG8_BAR; PG8_WAIT_L(0); PG8_MMA(0, 0, At, B0); PG8_BAR; PG8_SCHED;
            PG8_LDB(B1, 0, 1); PG8_STAGE(PG8_SB(0, 0), b2, voffB);
            PG8_BAR; PG8_WAIT_L(0); PG8_MMA(0, 1, At, B1); PG8_BAR;
            PG8_LDA(At, 0, 1); PG8_STAGE_A(PG8_SA(0, 0), 0, k2, last);
            PG8_BAR; PG8_WAIT_L(0); PG8_MMA(1, 0, At, B0); PG8_BAR; PG8_SCHED;
            PG8_STAGE(PG8_SB(0, 1), b2 + hstep, voffB);
            PG8_WAIT_V(6); PG8_BAR; PG8_MMA(1, 1, At, B1); PG8_BAR;
            PG8_LDB(B0, 1, 0); PG8_SCHED; PG8_LDA(At, 1, 0); PG8_STAGE_A(PG8_SA(0, 1), 1, k2, last);
            PG8_WAIT_L(8); PG8_BAR; PG8_WAIT_L(0); PG8_MMA(0, 0, At, B0); PG8_BAR; PG8_SCHED;
            PG8_LDB(B1, 1, 1); PG8_STAGE(PG8_SB(1, 0), b3, voffB);
            PG8_BAR; PG8_WAIT_L(0); PG8_MMA(0, 1, At, B1); PG8_BAR;
            PG8_LDA(At, 1, 1); PG8_STAGE_A(PG8_SA(1, 0), 0, k3, last);
            PG8_BAR; PG8_WAIT_L(0); PG8_MMA(1, 0, At, B0); PG8_BAR; PG8_SCHED;
            PG8_STAGE(PG8_SB(1, 1), b3 + hstep, voffB);
            PG8_WAIT_V(6); PG8_BAR; PG8_MMA(1, 1, At, B1); PG8_BAR;
            }
        }
        if constexpr (ALIGN_EPI) { if (wr == 0) PG8_BAR; }
        if constexpr (!Epi::AFTER_DRAIN) { E(acc, cur, wr, wc, fr, fq); S.done(cur); }
        if (!has_next) break;
#pragma unroll
        for (int a = 0; a < 2; ++a)
#pragma unroll
            for (int b = 0; b < 2; ++b)
#pragma unroll
                for (int m = 0; m < 4; ++m)
#pragma unroll
                    for (int n = 0; n < 2; ++n) acc[a][b][m][n] = (f32x4){0.f, 0.f, 0.f, 0.f};
        cur = nxt; cA = nA; cB = nB; ++ui;
        if constexpr (AG::ON) { gC[0][0] = gN[0][0]; gC[0][1] = gN[0][1]; gC[1][0] = gN[1][0]; gC[1][1] = gN[1][1]; }
        if constexpr (ALIGN_EPI) { if (wr == 1) PG8_BAR; }
    }
    PG8_WAIT_V(0);
    if constexpr (!ALIGN_EPI) { if (wr == 0) PG8_BAR; }
    PG8_BAR;
    if constexpr (Epi::AFTER_DRAIN) { E.fused(acc, cur, wr, wc, fr, fq, lds, wid, lane); S.done(cur); }
#undef PG8_SA
#undef PG8_SB
#undef PG8_STAGE
#undef PG8_STAGE_A
#undef PG8_GATHER
#undef PG8_LDA
#undef PG8_LDB
#undef PG8_MMA
#undef PG8_WAIT_V
#undef PG8_WAIT_L
#undef PG8_BAR
#undef PG8_SCHED
}
}
namespace {
__device__ __forceinline__ int tidx() { int t = threadIdx.x; asm volatile("" : "+v"(t)); return t; }
__device__ __forceinline__ void phase_mod_part(const Args& a, LAS unsigned char* lds, int part, int nparts) {
    LAS float* sc = (LAS float*)lds;
    LAS float* part_s = (LAS float*)(lds + 65536);
    const float* c = a.in[1]; const float* mw = a.in[2]; const float* mb = a.in[3];
    float* mod = (float*)(a.ws + WS_MOD);
    const int tid = tidx(), lane = tid & 63, wave = tid >> 6;
    for (int i = tid; i < 16 * 1024; i += 512) sc[i] = silu_f(c[i]);
    __syncthreads();
    for (int cgp = part; cgp < 96; cgp += nparts) {
        const int j0 = cgp * 64;
        float acc[16];
#pragma unroll
        for (int b = 0; b < 16; ++b) acc[b] = 0.f;
        const float* wp = mw + (size_t)(wave * 128) * 6144 + j0 + lane;
#pragma unroll 2
        for (int kk = 0; kk < 128; kk += 8) {
            float w[8];
#pragma unroll
            for (int i = 0; i < 8; ++i) w[i] = wp[(size_t)(kk + i) * 6144];
#pragma unroll
            for (int b = 0; b < 16; ++b) { const f4 s0 = *(const LAS f4*)(sc + b * 1024 + wave * 128 + kk), s1 = *(const LAS f4*)(sc + b * 1024 + wave * 128 + kk + 4);
                acc[b] += s0.x * w[0] + s0.y * w[1] + s0.z * w[2] + s0.w * w[3] + s1.x * w[4] + s1.y * w[5] + s1.z * w[6] + s1.w * w[7]; }
        }
#pragma unroll
        for (int b = 0; b < 16; ++b) part_s[(wave * 16 + b) * 64 + lane] = acc[b];
        __syncthreads();
        for (int q = tid; q < 1024; q += 512) { const int b = q >> 6, cc = q & 63; float sum = mb[j0 + cc];
#pragma unroll
            for (int w8 = 0; w8 < 8; ++w8) sum += part_s[(w8 * 16 + b) * 64 + cc];
            mod[b * 6144 + j0 + cc] = sum; }
        __syncthreads();
    }
}

__device__ __forceinline__ void phase_norm1(const Args& a, LAS unsigned char* lds) {
    LAS f4* wgA = (LAS f4*)lds;
    LAS f4* wgB = (LAS f4*)(lds + 16384);
    const float* x = a.in[0]; const float* nw = a.in[4]; const float* w_in = a.in[5]; const float* a_log = a.in[7]; const float* dt_bias = a.in[8];
    const float* mod = (const float*)(a.ws + WS_MOD);
    bf16* xm = (bf16*)((unsigned char*)a.out + DO_XM);
    float* Gd = (float*)(a.ws + WS_G); float* Bd = (float*)(a.ws + WS_BETA);
    const int tid = tidx(), lane = tid & 63, wave = tid >> 6;
    for (int k = tid; k < 1024; k += 512) { const int idx = (4 * (k >> 8) + (k & 3)) * 64 + ((k & 255) >> 2);
        wgA[idx] = *(const f4*)(w_in + (size_t)k * DIN + C_GA); wgB[idx] = *(const f4*)(w_in + (size_t)k * DIN + C_GB); }
    __syncthreads();
    const int gw = blockIdx.x * 8 + wave, NGW = gridDim.x * 8;
    float4 xnx[2][4];
#pragma unroll
    for (int r = 0; r < 2; ++r)
#pragma unroll
        for (int j = 0; j < 4; ++j) xnx[r][j] = (gw < T / 2) ? *(const float4*)(x + (size_t)(gw * 2 + r) * D + 4 * lane + 256 * j) : make_float4(0.f, 0.f, 0.f, 0.f);
#pragma unroll 1
    for (int grp = gw; grp < T / 2; grp += NGW) {
        const int t0 = grp * 2, b = t0 / SEQ;
        float4 xv[2][4];
#pragma unroll
        for (int r = 0; r < 2; ++r)
#pragma unroll
            for (int j = 0; j < 4; ++j) xv[r][j] = xnx[r][j];
        if (grp + NGW < T / 2) {
#pragma unroll
            for (int r = 0; r < 2; ++r)
#pragma unroll
                for (int j = 0; j < 4; ++j) xnx[r][j] = *(const float4*)(x + (size_t)((grp + NGW) * 2 + r) * D + 4 * lane + 256 * j);
        }
        float4 gmul[4], gadd[4];
#pragma unroll
        for (int j = 0; j < 4; ++j) { const int k = 4 * lane + 256 * j;
            const float4 wv = *(const float4*)(nw + k), sc = *(const float4*)(mod + (size_t)b * 6144 + 1024 + k), sh = *(const float4*)(mod + (size_t)b * 6144 + k);
            gmul[j] = make_float4(wv.x * (1.f + sc.x), wv.y * (1.f + sc.y), wv.z * (1.f + sc.z), wv.w * (1.f + sc.w)); gadd[j] = sh; }
#pragma unroll
        for (int r = 0; r < 2; ++r) {
            float ss = 0.f;
#pragma unroll
            for (int j = 0; j < 4; ++j) ss += xv[r][j].x * xv[r][j].x + xv[r][j].y * xv[r][j].y + xv[r][j].z * xv[r][j].z + xv[r][j].w * xv[r][j].w;
            ss = wave_sum(ss);
            const float rstd = rsqrtf(ss * (1.0f / D) + 1e-6f);
#pragma unroll
            for (int j = 0; j < 4; ++j) { float4 v = xv[r][j];
                v.x = v.x * rstd * gmul[j].x + gadd[j].x; v.y = v.y * rstd * gmul[j].y + gadd[j].y; v.z = v.z * rstd * gmul[j].z + gadd[j].z; v.w = v.w * rstd * gmul[j].w + gadd[j].w;
                xv[r][j] = v;
                v2u w; w.x = pkh(v.x, v.y); w.y = pkh(v.z, v.w);
                *(v2u*)(xm + (size_t)(t0 + r) * D + 4 * lane + 256 * j) = w; }
        }
        float acc[2][8];
#pragma unroll
        for (int r = 0; r < 2; ++r)
#pragma unroll
            for (int q = 0; q < 8; ++q) acc[r][q] = 0.f;
#pragma unroll
        for (int j = 0; j < 4; ++j) {
#pragma unroll
            for (int jj = 0; jj < 4; ++jj) {
                const f4 wa = wgA[(4 * j + jj) * 64 + lane], wb = wgB[(4 * j + jj) * 64 + lane];
#pragma unroll
                for (int r = 0; r < 2; ++r) { const float xe = (jj == 0) ? xv[r][j].x : (jj == 1) ? xv[r][j].y : (jj == 2) ? xv[r][j].z : xv[r][j].w;
                    acc[r][0] += xe * wa.x; acc[r][1] += xe * wa.y; acc[r][2] += xe * wa.z; acc[r][3] += xe * wa.w;
                    acc[r][4] += xe * wb.x; acc[r][5] += xe * wb.y; acc[r][6] += xe * wb.z; acc[r][7] += xe * wb.w; }
            }
            asm volatile("" ::: "memory");
        }
        float mine = 0.f;
#pragma unroll
        for (int r = 0; r < 2; ++r)
#pragma unroll
            for (int q = 0; q < 8; ++q) { const float s = row_sum16(acc[r][q]); if ((lane & 15) == r * 8 + q) mine = s; }
        mine += __shfl_xor(mine, 16); mine += __shfl_xor(mine, 32);
        if (lane < 16) { const int r = lane >> 3, q = lane & 7, t = t0 + r;
            if (q < 4) { const float z = mine + dt_bias[q]; const float sp = (z > 20.f) ? z : log1pf(expf(z)); Gd[t * 4 + q] = -expf(a_log[q]) * sp; }
            else Bd[t * 4 + (q - 4)] = sigmoid_f(mine); }
    }
}

struct CJob { const float* src; bf16* dst; int ldsrc, ldd; };
__device__ __forceinline__ void cjob_load(const CJob& j, int lane, f4 (&v)[16]) {
#pragma unroll
    for (int i = 0; i < 16; ++i) v[i] = *(const f4*)(j.src + (size_t)(4 * i + (lane >> 4)) * j.ldsrc + 4 * (lane & 15));
}
__device__ __forceinline__ void cjob_store(const CJob& j, int lane, const f4 (&v)[16], LAS float* tile) {
#pragma unroll
    for (int hf = 0; hf < 2; ++hf) {
#pragma unroll
        for (int i = 0; i < 8; ++i) { LAS float* tp = tile + (4 * i + (lane >> 4)) * 65 + 4 * (lane & 15); const f4 x = v[8 * hf + i]; tp[0] = x[0]; tp[1] = x[1]; tp[2] = x[2]; tp[3] = x[3]; }
        asm volatile("s_waitcnt lgkmcnt(0)" ::: "memory");
        unsigned w[16];
#pragma unroll
        for (int q = 0; q < 16; ++q) w[q] = pkh(tile[(2 * q) * 65 + lane], tile[(2 * q + 1) * 65 + lane]);
        bf16* dp = j.dst + (size_t)lane * j.ldd + 32 * hf;
#pragma unroll
        for (int q = 0; q < 4; ++q) { v4u o; o.x = w[4 * q]; o.y = w[4 * q + 1]; o.z = w[4 * q + 2]; o.w = w[4 * q + 3]; *(v4u*)(dp + 8 * q) = o; }
        asm volatile("s_waitcnt lgkmcnt(0)" ::: "memory");
    }
}
__device__ __forceinline__ int win_srccol(int n0) {
    if (n0 < 1024) { const int base = (n0 < 512) ? C_RQ : C_RK, r = n0 & 511, tile = r >> 8, q = (r & 255) >> 6;
        return base + tile * 256 + (q & 1) * 128 + (q >> 1) * 64; }
    if (n0 < 2048) return C_RV + (n0 - 1024);
    if (n0 < 4096) return C_GQ + (n0 - 2048);
    const int j = (n0 - 4096) >> 8, r = (n0 - 4096) & 255, half = r >> 7, cc = r & 127;
    if (j < 8) return (half ? C_GTA : C_RG) + 128 * j + cc;
    return (half ? C_GTB : C_GZ) + 128 * (j - 8) + cc;
}
__device__ __forceinline__ CJob cjob_in(const Args& a, int job) {
    CJob j;
    if (job < 2048) { const int nt = job >> 4, kt = job & 15; j.src = a.in[5] + (size_t)(kt * 64) * DIN + win_srccol(nt * 64); j.ldsrc = DIN; j.dst = (bf16*)((unsigned char*)a.out + DO_WTIN) + (size_t)(nt * 64) * 1024 + kt * 64; j.ldd = 1024; }
    else { const int jj = job - 2048, nt = jj >> 4, kt = jj & 15; j.src = a.in[10] + (size_t)(kt * 64) * 1024 + nt * 64; j.ldsrc = 1024; j.dst = (bf16*)(a.ws + WS_WTOUT) + (size_t)(nt * 64) * 1024 + kt * 64; j.ldd = 1024; }
    return j;
}
__device__ __forceinline__ void phase_rope_part(const Args& a, int part, int nparts) {
    const int tid = tidx();
    float2* rope = (float2*)(a.ws + WS_ROPE);
    for (int i = part * 512 + tid; i < SEQ * 64; i += nparts * 512) {
        const int t = i >> 6, fi = i & 63;
        const double inv = exp(-((double)fi / 64.0) * 9.210340371976184), ang = (double)t * inv;
        rope[i] = make_float2((float)cos(ang), (float)sin(ang));
    }
}
__device__ __forceinline__ void phase_inproj(const Args& a, LAS unsigned char* lds) {
    pg8::Gemm g{(const bf16*)((unsigned char*)a.out + DO_XM), (const bf16*)((unsigned char*)a.out + DO_WTIN), T, 8192, 1024};
    pg8::StaticOrder S; S.init(T, 8192, (int)gridDim.x, (int)blockIdx.x);
    pg8::EpiProj E{(bf16*)(a.ws + WS_PROJ), PW, (const float*)(a.ws + WS_ROPE)};
    pg8::gemm_phase<pg8::EpiProj, pg8::StaticOrder, true, true>(lds, g, S, E);
}


__device__ __forceinline__ void phase_outproj(const Args& a, LAS unsigned char* lds) {
    pg8::Gemm g{(const bf16*)(a.ws + WS_MERGED), (const bf16*)(a.ws + WS_WTOUT), T, 1024, 1024};
    pg8::StaticOrder S; S.init(T, 1024, (int)gridDim.x, (int)blockIdx.x);
    pg8::EpiH E{a.in[0], (const float*)(a.ws + WS_MOD), a.out};
    pg8::gemm_phase<pg8::EpiH, pg8::StaticOrder, false, true>(lds, g, S, E);
}

__device__ __forceinline__ void phase_route(const Args& a, LAS unsigned char* lds) {
    LAS f4* wr = (LAS f4*)lds;
    LAS int* hist = (LAS int*)(lds + 5 * 16384);
    LAS float* lgl = (LAS float*)(lds + 5 * 16384 + 256);
    const float* h = a.out; const float* nw = a.in[11]; const float* w_group = a.in[12]; const float* b_group = a.in[13]; const float* w_router = a.in[14]; const float* b_router = a.in[15];
    const float* mod = (const float*)(a.ws + WS_MOD);
    bf16* xf = (bf16*)(a.ws + WS_XF);
    int* tok_e = (int*)(a.ws + WS_TOKE); float* tok_w = (float*)(a.ws + WS_TOKW);
    const int tid = tidx(), lane = tid & 63, wave = tid >> 6;
    for (int k = tid; k < 1024; k += 512) { const int idx = (4 * (k >> 8) + (k & 3)) * 64 + ((k & 255) >> 2);
        wr[idx] = *(const f4*)(w_group + (size_t)k * 4);
#pragma unroll
        for (int q = 0; q < 4; ++q) wr[(q + 1) * 1024 + idx] = *(const f4*)(w_router + (size_t)k * 16 + 4 * q); }
    if (tid < 16) hist[tid] = 0;
    __syncthreads();
    const int TPB = T / (int)gridDim.x, tb0 = blockIdx.x * TPB;
    float4 xnx[2][4];
#pragma unroll
    for (int r = 0; r < 2; ++r)
#pragma unroll
        for (int j = 0; j < 4; ++j) xnx[r][j] = *(const float4*)(h + (size_t)(tb0 + wave * 2 + r) * D + 4 * lane + 256 * j);
#pragma unroll 1
    for (int pr = wave; pr < TPB / 2; pr += 8) {
        const int t0 = tb0 + pr * 2, b = t0 / SEQ;
        float4 xv[2][4];
#pragma unroll
        for (int r = 0; r < 2; ++r)
#pragma unroll
            for (int j = 0; j < 4; ++j) xv[r][j] = xnx[r][j];
        { const int prn = (pr + 8 < TPB / 2) ? pr + 8 : pr;
#pragma unroll
          for (int r = 0; r < 2; ++r)
#pragma unroll
            for (int j = 0; j < 4; ++j) xnx[r][j] = *(const float4*)(h + (size_t)(tb0 + prn * 2 + r) * D + 4 * lane + 256 * j); }
        float4 gmul[4], gadd[4];
#pragma unroll
        for (int j = 0; j < 4; ++j) { const int k = 4 * lane + 256 * j;
            const float4 wv = *(const float4*)(nw + k), sc = *(const float4*)(mod + (size_t)b * 6144 + 4096 + k), sh = *(const float4*)(mod + (size_t)b * 6144 + 3072 + k);
            gmul[j] = make_float4(wv.x * (1.f + sc.x), wv.y * (1.f + sc.y), wv.z * (1.f + sc.z), wv.w * (1.f + sc.w)); gadd[j] = sh; }
#pragma unroll
        for (int r = 0; r < 2; ++r) {
            float ss = 0.f;
#pragma unroll
            for (int j = 0; j < 4; ++j) { ss += xv[r][j].x * xv[r][j].x + xv[r][j].y * xv[r][j].y + xv[r][j].z * xv[r][j].z + xv[r][j].w * xv[r][j].w; }
            ss = wave_sum(ss);
            const float rstd = rsqrtf(ss * (1.0f / D) + 1e-6f);
#pragma unroll
            for (int j = 0; j < 4; ++j) { float4 v = xv[r][j];
                v.x = v.x * rstd * gmul[j].x + gadd[j].x; v.y = v.y * rstd * gmul[j].y + gadd[j].y; v.z = v.z * rstd * gmul[j].z + gadd[j].z; v.w = v.w * rstd * gmul[j].w + gadd[j].w;
                xv[r][j] = v;
                v2u w; w.x = pkh(v.x, v.y); w.y = pkh(v.z, v.w);
                *(v2u*)(xf + (size_t)(t0 + r) * D + 4 * lane + 256 * j) = w; }
        }
        float acc[2][20];
#pragma unroll
        for (int r = 0; r < 2; ++r)
#pragma unroll
            for (int q = 0; q < 20; ++q) acc[r][q] = 0.f;
#pragma unroll
        for (int j = 0; j < 4; ++j) {
#pragma unroll
            for (int jj = 0; jj < 4; ++jj) {
                const int idx = (4 * j + jj) * 64 + lane;
#pragma unroll
                for (int q = 0; q < 5; ++q) { const f4 w = wr[q * 1024 + idx];
#pragma unroll
                    for (int r = 0; r < 2; ++r) { const float xe = (jj == 0) ? xv[r][j].x : (jj == 1) ? xv[r][j].y : (jj == 2) ? xv[r][j].z : xv[r][j].w;
                        acc[r][4 * q + 0] += xe * w.x; acc[r][4 * q + 1] += xe * w.y; acc[r][4 * q + 2] += xe * w.z; acc[r][4 * q + 3] += xe * w.w; } }
                asm volatile("" ::: "memory");
            }
        }
        float m0 = 0.f, m1 = 0.f, m2 = 0.f;
#pragma unroll
        for (int v = 0; v < 40; ++v) { const float s = row_sum16(acc[v / 20][v % 20]);
            if (v < 16) { if ((lane & 15) == v) m0 = s; } else if (v < 32) { if ((lane & 15) == v - 16) m1 = s; } else { if ((lane & 15) == v - 32) m2 = s; } }
        m0 += __shfl_xor(m0, 16); m0 += __shfl_xor(m0, 32); m1 += __shfl_xor(m1, 16); m1 += __shfl_xor(m1, 32); m2 += __shfl_xor(m2, 16); m2 += __shfl_xor(m2, 32);
        if (lane < 16) { lgl[pr * 40 + lane] = m0; lgl[pr * 40 + 16 + lane] = m1; if (lane < 8) lgl[pr * 40 + 32 + lane] = m2; }
    }
    __syncthreads();
    if (tid < TPB) {
        const int t = tb0 + tid;
        float lg[20];
#pragma unroll
        for (int q = 0; q < 20; ++q) lg[q] = lgl[tid * 20 + q];
        float gl[4], gmax = -1e30f; int gi = 0;
#pragma unroll
        for (int j = 0; j < 4; ++j) { gl[j] = lg[j] + b_group[j]; if (gl[j] > gmax) { gmax = gl[j]; gi = j; } }
        float gs = 0.f;
#pragma unroll
        for (int j = 0; j < 4; ++j) gs += expf(gl[j] - gmax);
        const float g_top = 1.0f / gs;
        float el[4], emax = -1e30f;
#pragma unroll
        for (int j = 0; j < 4; ++j) { const float raw = (gi == 0) ? lg[4 + j] : (gi == 1) ? lg[8 + j] : (gi == 2) ? lg[12 + j] : lg[16 + j]; el[j] = raw + b_router[gi * 4 + j]; emax = fmaxf(emax, el[j]); }
        float ep[4], es = 0.f;
#pragma unroll
        for (int j = 0; j < 4; ++j) { ep[j] = expf(el[j] - emax); es += ep[j]; }
#pragma unroll
        for (int j = 0; j < 4; ++j) ep[j] /= es;
        int i1 = 0; float p1 = ep[0];
#pragma unroll
        for (int j = 1; j < 4; ++j) if (ep[j] > p1) { p1 = ep[j]; i1 = j; }
        int i2 = -1; float p2 = -1.f;
#pragma unroll
        for (int j = 0; j < 4; ++j) if (j != i1 && ep[j] > p2) { p2 = ep[j]; i2 = j; }
        const float den = p1 + p2;
        tok_e[t * 2 + 0] = gi * 4 + i1; tok_e[t * 2 + 1] = gi * 4 + i2;
        tok_w[t * 2 + 0] = g_top * (p1 / den); tok_w[t * 2 + 1] = g_top * (p2 / den);
        __hip_atomic_fetch_add(&hist[gi * 4 + i1], 1, __ATOMIC_RELAXED, __HIP_MEMORY_SCOPE_WORKGROUP); __hip_atomic_fetch_add(&hist[gi * 4 + i2], 1, __ATOMIC_RELAXED, __HIP_MEMORY_SCOPE_WORKGROUP);
    }
    __syncthreads();
    if (tid < 16) ((int*)(a.ws + WS_HIST))[blockIdx.x * 16 + tid] = hist[tid];
}
__device__ __forceinline__ CJob cjob_ex(const Args& a, int job) {
    CJob j;
    if (job < 4096) { const int e = job >> 8, nt = (job >> 4) & 15, kt = job & 15, n0 = nt * 64;
        const int jt = n0 >> 8, r = n0 & 255, half = r >> 7, cc = r & 127;
        j.src = (half ? a.in[17] : a.in[16]) + (size_t)e * 1024 * 512 + (size_t)(kt * 64) * 512 + 128 * jt + cc; j.ldsrc = 512;
        j.dst = (bf16*)(a.ws + WS_WTGU) + (size_t)e * 1024 * 1024 + (size_t)n0 * 1024 + kt * 64; j.ldd = 1024; }
    else { const int jj = job - 4096, e = jj >> 7, nt = (jj >> 3) & 15, kt = jj & 7;
        j.src = a.in[18] + (size_t)e * 512 * 1024 + (size_t)(kt * 64) * 1024 + nt * 64; j.ldsrc = 1024;
        j.dst = (bf16*)(a.ws + WS_WTD) + (size_t)e * 1024 * 512 + (size_t)(nt * 64) * 512 + kt * 64; j.ldd = 512; }
    return j;
}
constexpr int NJ_IN = 2048 + 256;
__device__ __forceinline__ void phase_convert_all(const Args& a, LAS unsigned char* lds) {
    const int tid = tidx(), lane = tid & 63, wave = tid >> 6;
    LAS float* tile = (LAS float*)(lds + 32768 + wave * 8448);
    int j0, j1;
    if (gridDim.x == 256) { if (blockIdx.x < 96) { j0 = (int)blockIdx.x * 6; j1 = j0 + 6; } else { const int q = (int)blockIdx.x - 96; j0 = 576 + q * 10 + (q < 128 ? q : 128); j1 = j0 + 10 + (q < 128 ? 1 : 0); } }
    else { const int per = (NJ_IN + (int)gridDim.x - 1) / (int)gridDim.x; j0 = (int)blockIdx.x * per; j1 = j0 + per < NJ_IN ? j0 + per : NJ_IN; }
    f4 va[16], vb[16];
    int job = j0 + wave;
    if (job < j1) { const CJob j = cjob_in(a, job); cjob_load(j, lane, va); }
#pragma unroll 1
    for (; job < j1; job += 16) {
        if (job + 8 < j1) { const CJob j = cjob_in(a, job + 8); cjob_load(j, lane, vb); }
        { const CJob j = cjob_in(a, job); cjob_store(j, lane, va, tile); }
        if (job + 8 < j1) {
            if (job + 16 < j1) { const CJob j = cjob_in(a, job + 16); cjob_load(j, lane, va); }
            const CJob j = cjob_in(a, job + 8); cjob_store(j, lane, vb, tile); }
    }
}
__device__ __forceinline__ void phase_scatter(const Args& a, LAS unsigned char* lds) {
    LAS int* base = (LAS int*)lds;
    LAS int* mybase = base + 16;
    LAS int* elist = base + 32;
    LAS int* slots = base + 32 + 512;
    const int* hist = (const int*)(a.ws + WS_HIST); const int* tok_e = (const int*)(a.ws + WS_TOKE);
    int* tok_s = (int*)(a.ws + WS_TOKS); int* meta = (int*)(a.ws + WS_META); int* tile_expert = meta + 64;
    int* slot_tok = (int*)(a.ws + WS_SLOTTOK);
    const int tid = tidx(), lane = tid & 63, wave = tid >> 6, G = (int)gridDim.x;
    const int TPB = T / G, tb0 = blockIdx.x * TPB, NA = 2 * TPB;
    if (tid < 32) base[tid] = 0;
    __syncthreads();
    for (int q = tid; q < G * 2; q += 512) {
        const int i = q >> 1, e0 = 8 * (q & 1);
        const int4 h0 = *(const int4*)(hist + i * 16 + e0), h1 = *(const int4*)(hist + i * 16 + e0 + 4);
        const int hv[8] = {h0.x, h0.y, h0.z, h0.w, h1.x, h1.y, h1.z, h1.w};
#pragma unroll
        for (int j = 0; j < 8; ++j) { __hip_atomic_fetch_add(&base[e0 + j], hv[j], __ATOMIC_RELAXED, __HIP_MEMORY_SCOPE_WORKGROUP);
            if (i < (int)blockIdx.x) __hip_atomic_fetch_add(&mybase[e0 + j], hv[j], __ATOMIC_RELAXED, __HIP_MEMORY_SCOPE_WORKGROUP); }
    }
    __syncthreads();
    if (tid == 0) { int off = 0;
        for (int e = 0; e < 16; ++e) { const int cnt = base[e], nt = (cnt + 255) >> 8;
            if (blockIdx.x == 0) { meta[e] = cnt; meta[16 + e] = off; for (int k = 0; k < nt; ++k) tile_expert[(off >> 8) + k] = e; }
            base[e] = off; off += nt * 256; }
        if (blockIdx.x == 0) { meta[32] = off; meta[33] = off >> 8; } }
    if (blockIdx.x == 0) {
        __syncthreads();
        for (int e = 0; e < 16; ++e) { const int cnt = meta[e], b0 = base[e], pe = ((cnt + 255) >> 8) << 8; for (int i = cnt + tid; i < pe; i += 512) slot_tok[b0 + i] = -1; } }
    for (int i = tid; i < NA; i += 512) elist[i] = tok_e[tb0 * 2 + i];
    __syncthreads();
    for (int i = tid; i < NA; i += 512) { const int e = elist[i]; int rank = 0; for (int k = 0; k < i; ++k) rank += (elist[k] == e) ? 1 : 0;
        const int slot = base[e] + mybase[e] + rank; slots[i] = slot; tok_s[tb0 * 2 + i] = slot; slot_tok[slot] = tb0 + (i >> 1); }
    (void)lane; (void)wave;
}
__device__ __forceinline__ void phase_moe1(const Args& a, LAS unsigned char* lds) {
    const int* meta = (const int*)(a.ws + WS_META);
    pg8::Gemm g{(const bf16*)(a.ws + WS_XF), (const bf16*)(a.ws + WS_WTGU), 0, 0, 1024};
    pg8::MoeOrder S; S.init(meta, meta + 64, (int)gridDim.x, (int)blockIdx.x);
    pg8::EpiAct E{(bf16*)(a.ws + WS_ACT)};
    pg8::gemm_phase<pg8::EpiAct, pg8::MoeOrder, true, true, pg8::RowGather>(lds, g, S, E, pg8::RowGather{(const int*)(a.ws + WS_SLOTTOK)});
}
__device__ __forceinline__ void phase_moe2(const Args& a, LAS unsigned char* lds) {
    const int* meta = (const int*)(a.ws + WS_META);
    pg8::Gemm g{(const bf16*)(a.ws + WS_ACT), (const bf16*)(a.ws + WS_WTD), 0, 0, 512};
    pg8::MoeOrder S; S.init(meta, meta + 64, (int)gridDim.x, (int)blockIdx.x);
    pg8::EpiY E{(bf16*)(a.ws + WS_Y)};
    pg8::gemm_phase<pg8::EpiY, pg8::MoeOrder, true, true>(lds, g, S, E);
}
__device__ __forceinline__ void phase_final(const Args& a, LAS unsigned char* lds) {
    const float* mod = (const float*)(a.ws + WS_MOD); const float* now = a.in[19];
    const bf16* y = (const bf16*)(a.ws + WS_Y); const int* tok_s = (const int*)(a.ws + WS_TOKS); const float* tok_w = (const float*)(a.ws + WS_TOKW);
    float* out = a.out;
    const int tid = tidx(), lane = tid & 63, wave = tid >> 6;
    const int gw = blockIdx.x * 8 + wave, NGW = gridDim.x * 8;
    const int tlast = gw + ((T - 1 - gw) / NGW) * NGW;
    int2 sl1 = *(const int2*)(tok_s + 2 * gw); float2 wl1 = *(const float2*)(tok_w + 2 * gw);
    const int t1_ = gw + NGW <= tlast ? gw + NGW : tlast;
    int2 sl2 = *(const int2*)(tok_s + 2 * t1_); float2 wl2 = *(const float2*)(tok_w + 2 * t1_);
    float4 hn[4]; v2u y1n[4], y2n[4];
#pragma unroll
    for (int j = 0; j < 4; ++j) { const int k = 4 * lane + 256 * j; hn[j] = *(const float4*)(out + (size_t)gw * D + k);
        y1n[j] = *(const v2u*)(y + (size_t)sl1.x * D + k); y2n[j] = *(const v2u*)(y + (size_t)sl1.y * D + k); }
#pragma unroll 1
    for (int t = gw; t < T; t += NGW) {
        const int b = t / SEQ;
        const float w1 = wl1.x, w2 = wl1.y;
        float4 hv[4]; v2u a1[4], a2[4];
#pragma unroll
        for (int j = 0; j < 4; ++j) { hv[j] = hn[j]; a1[j] = y1n[j]; a2[j] = y2n[j]; }
        const int tn = t + NGW <= tlast ? t + NGW : tlast, tn2 = t + 2 * NGW <= tlast ? t + 2 * NGW : tlast;
        sl1 = sl2; wl1 = wl2;
#pragma unroll
        for (int j = 0; j < 4; ++j) { const int k = 4 * lane + 256 * j; hn[j] = *(const float4*)(out + (size_t)tn * D + k);
            y1n[j] = *(const v2u*)(y + (size_t)sl1.x * D + k); y2n[j] = *(const v2u*)(y + (size_t)sl1.y * D + k); }
        sl2 = *(const int2*)(tok_s + 2 * tn2); wl2 = *(const float2*)(tok_w + 2 * tn2);
        float4 o[4]; float ss = 0.f;
#pragma unroll
        for (int j = 0; j < 4; ++j) { const int k = 4 * lane + 256 * j;
            const float4 gf = *(const float4*)(mod + (size_t)b * 6144 + 5120 + k);
            float4 v;
            v.x = hv[j].x + gf.x * (w1 * bflo(a1[j].x) + w2 * bflo(a2[j].x)); v.y = hv[j].y + gf.y * (w1 * bfhi(a1[j].x) + w2 * bfhi(a2[j].x));
            v.z = hv[j].z + gf.z * (w1 * bflo(a1[j].y) + w2 * bflo(a2[j].y)); v.w = hv[j].w + gf.w * (w1 * bfhi(a1[j].y) + w2 * bfhi(a2[j].y));
            o[j] = v; ss += v.x * v.x + v.y * v.y + v.z * v.z + v.w * v.w; }
        ss = wave_sum(ss);
        const float rstd = rsqrtf(ss * (1.0f / D) + 1e-6f);
#pragma unroll
        for (int j = 0; j < 4; ++j) { const int k = 4 * lane + 256 * j; const float4 nwv = *(const float4*)(now + k);
            *(float4*)(out + (size_t)t * D + k) = make_float4(o[j].x * rstd * nwv.x, o[j].y * rstd * nwv.y, o[j].z * rstd * nwv.z, o[j].w * rstd * nwv.w); }
    }
}


__device__ __forceinline__ float quad_sum(float v) { v += __shfl_xor(v, 1); v += __shfl_xor(v, 2); return v; }
template <int BR>
__device__ __forceinline__ void scan_item(const Args& a, LAS unsigned char* lds, int b, int h, int half) {
    constexpr int TG = 8;
    LAS float* kf = (LAS float*)lds;
    LAS float* qf = kf + TG * 128;
    LAS float* vf = qf + TG * 128;
    LAS float* of = vf + TG * 128;
    LAS float* sc = of + TG * 128;
    bf16* proj = (bf16*)(a.ws + WS_PROJ);
    const float2* rope = (const float2*)(a.ws + WS_ROPE);
    const float* Gd = (const float*)(a.ws + WS_G); const float* Bd = (const float*)(a.ws + WS_BETA); const float* conv_w = a.in[6];
    float* ssq = (float*)(a.ws + WS_SSQ);
    const int tid = tidx(), v = tid >> 2, qd = tid & 3;
    const size_t row0 = (size_t)b * SEQ;
    const int qcol = (BR == 0 ? P_RQ : P_GQ) + h * 128, kcol = (BR == 0 ? P_RK : P_GK) + h * 128, vcol = (BR == 0 ? P_RV : P_GV) + h * 256 + half * 128;
    const float gamma = 1.0f - exp2f(-5.0f - (float)h);
    LAS float* hv = sc + TG * 2;
    float s[32];
#pragma unroll
    for (int d = 0; d < 32; ++d) s[d] = 0.f;
    for (int i = tid; i < 2 * 3 * 128; i += 512) hv[i] = 0.f;
    __syncthreads();
    for (int t0 = 0; t0 < SEQ; t0 += TG) {
        if (BR == 0) {
#pragma unroll
            for (int r = 0; r < 2; ++r) { const int idx = tid + 512 * r, isk = idx >> 9, tt = (idx >> 6) & 7, i = idx & 63, t = t0 + tt;
                const bf16* pr = proj + (row0 + t) * PW + (isk ? kcol : qcol);
                const float x1 = bf2f(pr[i]), x2 = bf2f(pr[i + 64]); const float2 cs = rope[t * 64 + i];
                const float sc_ = isk ? 0.08838834764831845f : 1.0f;
                LAS float* dst = (isk ? kf : qf) + tt * 128;
                dst[i] = (x1 * cs.x - x2 * cs.y) * sc_; dst[i + 64] = (x1 * cs.y + x2 * cs.x) * sc_; }
#pragma unroll
            for (int r = 0; r < 2; ++r) { const int idx = tid + 512 * r, tt = idx >> 7, c = idx & 127;
                vf[tt * 128 + c] = bf2f(proj[(row0 + t0 + tt) * PW + vcol + c]); }
        } else {
            if (tid < 384) {
                const bool isv = tid >= 256; const int u = isv ? tid - 256 : tid;
                const int tt = isv ? (u >> 4) : (u >> 5), part = isv ? (u & 15) : (u & 31), t = t0 + tt;
                const int col = isv ? (vcol + 8 * part) : (part < 16 ? qcol + 8 * part : kcol + 8 * (part - 16));
                const int cch = col - P_GQ;
                float acc[8];
#pragma unroll
                for (int j = 0; j < 8; ++j) acc[j] = 0.f;
#pragma unroll
                for (int i = 0; i < 4; ++i) { const int tr = t - 3 + i;
                    if (isv && tr < t0) {
                        const LAS float* hp = hv + (((t0 / TG) & 1) * 3 + (tr - (t0 - 3))) * 128 + 8 * part;
                        const float4 w0 = *(const float4*)(conv_w + i * 2048 + cch), w1 = *(const float4*)(conv_w + i * 2048 + cch + 4);
                        acc[0] += hp[0] * w0.x; acc[1] += hp[1] * w0.y; acc[2] += hp[2] * w0.z; acc[3] += hp[3] * w0.w;
                        acc[4] += hp[4] * w1.x; acc[5] += hp[5] * w1.y; acc[6] += hp[6] * w1.z; acc[7] += hp[7] * w1.w;
                    } else if (tr >= 0) { const v4u raw = *(const v4u*)(proj + (row0 + tr) * PW + col);
                        if (isv && i == 3 && tt >= TG - 3) { LAS float* hn = hv + ((((t0 / TG) + 1) & 1) * 3 + (tt - (TG - 3))) * 128 + 8 * part;
                            hn[0] = bflo(raw.x); hn[1] = bfhi(raw.x); hn[2] = bflo(raw.y); hn[3] = bfhi(raw.y); hn[4] = bflo(raw.z); hn[5] = bfhi(raw.z); hn[6] = bflo(raw.w); hn[7] = bfhi(raw.w); }
                        const float4 w0 = *(const float4*)(conv_w + i * 2048 + cch), w1 = *(const float4*)(conv_w + i * 2048 + cch + 4);
                        acc[0] += bflo(raw.x) * w0.x; acc[1] += bfhi(raw.x) * w0.y; acc[2] += bflo(raw.y) * w0.z; acc[3] += bfhi(raw.y) * w0.w;
                        acc[4] += bflo(raw.z) * w1.x; acc[5] += bfhi(raw.z) * w1.y; acc[6] += bflo(raw.w) * w1.z; acc[7] += bfhi(raw.w) * w1.w; } }
                float ss = 0.f;
#pragma unroll
                for (int j = 0; j < 8; ++j) { acc[j] = acc[j] * fsigmoid(acc[j]); ss += acc[j] * acc[j]; }
                if (!isv) {
                    ss += __shfl_xor(ss, 1); ss += __shfl_xor(ss, 2); ss += __shfl_xor(ss, 4); ss += __shfl_xor(ss, 8);
                    const float rn = rsqrtf(ss + 1e-6f) * (part < 16 ? 0.08838834764831845f : 1.0f);
                    LAS float* dst = (part < 16 ? qf : kf) + tt * 128 + 8 * (part & 15);
#pragma unroll
                    for (int j = 0; j < 8; ++j) dst[j] = acc[j] * rn;
                } else { LAS float* dst = vf + tt * 128 + 8 * part;
#pragma unroll
                    for (int j = 0; j < 8; ++j) dst[j] = acc[j]; }
            } else if (tid < 384 + TG) { const int tt = tid - 384; const size_t gi = (row0 + t0 + tt) * 4 + h; sc[tt * 2] = expf(Gd[gi]); sc[tt * 2 + 1] = Bd[gi]; }
        }
        __syncthreads();
#pragma unroll 1
        for (int tt = 0; tt < TG; ++tt) {
            const LAS f4* kp = (const LAS f4*)(kf + tt * 128 + 32 * qd); const LAS f4* qp = (const LAS f4*)(qf + tt * 128 + 32 * qd);
            const float vt = vf[tt * 128 + v];
            float o = 0.f;
            if (BR == 0) {
#pragma unroll
                for (int d4 = 0; d4 < 8; ++d4) { const f4 kk = kp[d4], qq = qp[d4];
                    s[4 * d4 + 0] = gamma * s[4 * d4 + 0] + kk.x * vt; o += qq.x * s[4 * d4 + 0];
                    s[4 * d4 + 1] = gamma * s[4 * d4 + 1] + kk.y * vt; o += qq.y * s[4 * d4 + 1];
                    s[4 * d4 + 2] = gamma * s[4 * d4 + 2] + kk.z * vt; o += qq.z * s[4 * d4 + 2];
                    s[4 * d4 + 3] = gamma * s[4 * d4 + 3] + kk.w * vt; o += qq.w * s[4 * d4 + 3]; }
            } else {
                const float al = sc[tt * 2], bt = sc[tt * 2 + 1];
                float dot = 0.f;
#pragma unroll
                for (int d4 = 0; d4 < 8; ++d4) { const f4 kk = kp[d4];
                    s[4 * d4 + 0] *= al; dot += s[4 * d4 + 0] * kk.x; s[4 * d4 + 1] *= al; dot += s[4 * d4 + 1] * kk.y;
                    s[4 * d4 + 2] *= al; dot += s[4 * d4 + 2] * kk.z; s[4 * d4 + 3] *= al; dot += s[4 * d4 + 3] * kk.w; }
                dot = quad_sum(dot);
                const float vn = bt * (vt - dot);
#pragma unroll
                for (int d4 = 0; d4 < 8; ++d4) { const f4 kk = kp[d4], qq = qp[d4];
                    s[4 * d4 + 0] += kk.x * vn; o += s[4 * d4 + 0] * qq.x; s[4 * d4 + 1] += kk.y * vn; o += s[4 * d4 + 1] * qq.y;
                    s[4 * d4 + 2] += kk.z * vn; o += s[4 * d4 + 2] * qq.z; s[4 * d4 + 3] += kk.w * vn; o += s[4 * d4 + 3] * qq.w; }
            }
            o = quad_sum(o);
            if (qd == 0) of[tt * 128 + v] = o;
        }
        __syncthreads();
        if (tid < 128) { const int tt = tid >> 4, c8 = (tid & 15) * 8;
            const LAS float* src = of + tt * 128 + c8; float ss = 0.f;
#pragma unroll
            for (int j = 0; j < 8; ++j) ss += src[j] * src[j];
            v4u w; w.x = pkh(src[0], src[1]); w.y = pkh(src[2], src[3]); w.z = pkh(src[4], src[5]); w.w = pkh(src[6], src[7]);
            *(v4u*)(proj + (row0 + t0 + tt) * PW + vcol + c8) = w;
            ss += __shfl_xor(ss, 1); ss += __shfl_xor(ss, 2); ss += __shfl_xor(ss, 4); ss += __shfl_xor(ss, 8);
            if ((tid & 15) == 0) ssq[(row0 + t0 + tt) * 16 + BR * 8 + h * 2 + half] = ss; }
        __syncthreads();
    }
}
__device__ __forceinline__ void phase_scan_simple(const Args& a, LAS unsigned char* lds) {
    for (int id = blockIdx.x; id < 256; id += gridDim.x) {
        const int br = (id >> 4) & 1, half = (id >> 3) & 1, bh = (id >> 5) * 8 + (id & 7), b = bh >> 2, h = bh & 3;
        if (br == 0) scan_item<0>(a, lds, b, h, half); else scan_item<1>(a, lds, b, h, half);
        __syncthreads();
    }
}
__device__ __forceinline__ void phase_merge(const Args& a, LAS unsigned char* lds) {
    const bf16* proj = (const bf16*)(a.ws + WS_PROJ); const float* ssq = (const float*)(a.ws + WS_SSQ); const float* gnw = a.in[9];
    bf16* merged = (bf16*)(a.ws + WS_MERGED);
    const int tid = tidx(), lane = tid & 63, wave = tid >> 6;
    const int gw = blockIdx.x * 8 + wave, NGW = gridDim.x * 8;
    for (int t = gw; t < T; t += NGW) {
        const int c0 = 16 * lane, h = lane >> 4;
        const float* sq = ssq + (size_t)t * 16;
        const float rr = rsqrtf((sq[h * 2] + sq[h * 2 + 1]) * (1.0f / 256.0f) + 1e-6f), rg = rsqrtf((sq[8 + h * 2] + sq[8 + h * 2 + 1]) * (1.0f / 256.0f) + 1e-6f);
        const bf16* pr = proj + (size_t)t * PW;
#pragma unroll
        for (int part = 0; part < 2; ++part) { const int c = c0 + 8 * part;
            const v4u orv = *(const v4u*)(pr + P_RV + c), ogv = *(const v4u*)(pr + P_GV + c), ga = *(const v4u*)(pr + P_GA + c), gb = *(const v4u*)(pr + P_GB + c);
            const float4 w0 = *(const float4*)(gnw + (c & 255)), w1 = *(const float4*)(gnw + (c & 255) + 4);
            float o[8];
            o[0] = bflo(ga.x) * bflo(orv.x) * rr + bflo(gb.x) * bflo(ogv.x) * rg * w0.x; o[1] = bfhi(ga.x) * bfhi(orv.x) * rr + bfhi(gb.x) * bfhi(ogv.x) * rg * w0.y;
            o[2] = bflo(ga.y) * bflo(orv.y) * rr + bflo(gb.y) * bflo(ogv.y) * rg * w0.z; o[3] = bfhi(ga.y) * bfhi(orv.y) * rr + bfhi(gb.y) * bfhi(ogv.y) * rg * w0.w;
            o[4] = bflo(ga.z) * bflo(orv.z) * rr + bflo(gb.z) * bflo(ogv.z) * rg * w1.x; o[5] = bfhi(ga.z) * bfhi(orv.z) * rr + bfhi(gb.z) * bfhi(ogv.z) * rg * w1.y;
            o[6] = bflo(ga.w) * bflo(orv.w) * rr + bflo(gb.w) * bflo(ogv.w) * rg * w1.z; o[7] = bfhi(ga.w) * bfhi(orv.w) * rr + bfhi(gb.w) * bfhi(ogv.w) * rg * w1.w;
            v4u w; w.x = pkh(o[0], o[1]); w.y = pkh(o[2], o[3]); w.z = pkh(o[4], o[5]); w.w = pkh(o[6], o[7]);
            *(v4u*)(merged + (size_t)t * 1024 + c) = w; }
    }
}

}
namespace {
typedef short s8v __attribute__((ext_vector_type(8)));
typedef short s4v __attribute__((ext_vector_type(4)));
typedef float f16v __attribute__((ext_vector_type(16)));
#define MFMA32(a, b, c) __builtin_amdgcn_mfma_f32_32x32x16_bf16((a), (b), (c), 0, 0, 0)
#define LDS_BARRIER() do { asm volatile("s_waitcnt lgkmcnt(0)" ::: "memory"); __builtin_amdgcn_s_barrier(); asm volatile("" ::: "memory"); } while (0)
constexpr int PT128 = 136, PT64 = 72;
constexpr size_t DO_QH = 0, DO_KHT = 32 * MiB, DO_QK = 64 * MiB, DO_TU = 80 * MiB, DO_TW = 96 * MiB;
constexpr size_t WS_VH = WS_MERGED;
constexpr size_t WS_EG = 454 * MiB, WS_EGL = 454 * MiB + 512 * 1024;

typedef __bf16 bf2v __attribute__((ext_vector_type(2)));
typedef float f2v __attribute__((ext_vector_type(2)));
__device__ __forceinline__ unsigned cvtpk(float lo, float hi) { const f2v v = {lo, hi}; return __builtin_bit_cast(unsigned, __builtin_convertvector(v, bf2v)); }
__device__ __forceinline__ s8v ld_nat(const LAS bf16* base, int pitch, int row, int k0, int hh) { return *(const LAS s8v*)(base + row * pitch + k0 + 8 * hh); }
__device__ __forceinline__ s8v ld_perm(const LAS bf16* base, int pitch, int row, int k0, int hh) {
    const LAS bf16* p = base + row * pitch + k0 + 4 * hh;
    const s4v lo = *(const LAS s4v*)p, hi = *(const LAS s4v*)(p + 8);
    return __builtin_shufflevector(lo, hi, 0, 1, 2, 3, 4, 5, 6, 7);
}
template <int S> __device__ __forceinline__ s8v pack8(const f16v& x) {
    v4u p; p.x = cvtpk(x[8 * S + 0], x[8 * S + 1]); p.y = cvtpk(x[8 * S + 2], x[8 * S + 3]); p.z = cvtpk(x[8 * S + 4], x[8 * S + 5]); p.w = cvtpk(x[8 * S + 6], x[8 * S + 7]);
    return __builtin_bit_cast(s8v, p);
}
__device__ __forceinline__ f16v zero16() { f16v z;
#pragma unroll
    for (int i = 0; i < 16; ++i) z[i] = 0.f; return z; }

__device__ __forceinline__ void conv8(const bf16* proj, size_t rowbase, int tloc, int col, const float* conv_w, int cch, float (&acc)[8]) {
#pragma unroll
    for (int j = 0; j < 8; ++j) acc[j] = 0.f;
#pragma unroll
    for (int i = 0; i < 4; ++i) { const int tr = tloc - 3 + i;
        if (tr >= 0) { const v4u raw = *(const v4u*)(proj + (rowbase + tr) * PW + col);
            const float4 w0 = *(const float4*)(conv_w + i * 2048 + cch), w1 = *(const float4*)(conv_w + i * 2048 + cch + 4);
            acc[0] += bflo(raw.x) * w0.x; acc[1] += bfhi(raw.x) * w0.y; acc[2] += bflo(raw.y) * w0.z; acc[3] += bfhi(raw.y) * w0.w;
            acc[4] += bflo(raw.z) * w1.x; acc[5] += bfhi(raw.z) * w1.y; acc[6] += bflo(raw.w) * w1.z; acc[7] += bfhi(raw.w) * w1.w; } }
}

__device__ __forceinline__ void tile_store_rm(LAS bf16* buf, const f16v& v, int mt, int nt, int r32, int hh) {
#pragma unroll
    for (int rg = 0; rg < 16; ++rg) buf[(32 * mt + (rg & 3) + 8 * (rg >> 2) + 4 * hh) * PT64 + 32 * nt + r32] = (bf16)f2bf(v[rg]);
}
__device__ __forceinline__ void tile_store_tr(LAS bf16* buf, const f16v& v, int mt, int nt, int r32, int hh) {
#pragma unroll
    for (int g4 = 0; g4 < 4; ++g4) { v2u w; w.x = cvtpk(v[4 * g4 + 0], v[4 * g4 + 1]); w.y = cvtpk(v[4 * g4 + 2], v[4 * g4 + 3]); *(LAS v2u*)(buf + (32 * nt + r32) * PT64 + 32 * mt + 8 * g4 + 4 * hh) = w; }
}
__device__ __forceinline__ void phase_gprep(const Args& a, LAS unsigned char* lds) {
    LAS bf16* Kh = (LAS bf16*)lds;
    LAS bf16* Qh = (LAS bf16*)(lds + 17408);
    LAS bf16* Kht = (LAS bf16*)(lds + 34816);
    LAS float* bt = (LAS float*)(lds + 53248);
    LAS float* gc = bt + 64;
    LAS bf16* MB = (LAS bf16*)(lds + 53760);
    constexpr int MSZ = 64 * PT64;
    const bf16* proj = (const bf16*)(a.ws + WS_PROJ);
    const float* Gd = (const float*)(a.ws + WS_G); const float* Bd = (const float*)(a.ws + WS_BETA); const float* conv_w = a.in[6];
    unsigned char* dout = (unsigned char*)a.out;
    bf16* QHg = (bf16*)(dout + DO_QH); bf16* KHTg = (bf16*)(dout + DO_KHT); bf16* QKg = (bf16*)(dout + DO_QK); bf16* TUg = (bf16*)(dout + DO_TU); bf16* TWg = (bf16*)(dout + DO_TW);
    bf16* VHg = (bf16*)(a.ws + WS_VH); float* EGg = (float*)(a.ws + WS_EG); float* EGLg = (float*)(a.ws + WS_EGL);
    const int tid = tidx(), lane = tid & 63, wave = tid >> 6, r32 = lane & 31, hh = lane >> 5;
    for (int i = tid; i < 8 * MSZ / 8; i += 512) ((LAS v4u*)MB)[i] = (v4u){0u, 0u, 0u, 0u};
    const int cg = tid & 31, run = tid >> 5, isk = cg >> 4, c8qk = 8 * (cg & 15), tt0 = run * 4;
    const int h0 = (blockIdx.x >> 5) & 3;
    const int colqk = (isk ? P_GK : P_GQ) + h0 * 128 + c8qk, colv = P_GV + h0 * 256 + 8 * cg;
    LAS f4* wtab = (LAS f4*)(lds + 127488);
    if (tid < 256) { const int which = tid >> 7, i = (tid >> 5) & 3, g = tid & 31;
        const int col = which ? (P_GV + h0 * 256 + 8 * g) : (((g >> 4) ? P_GK : P_GQ) + h0 * 128 + 8 * (g & 15));
        wtab[((which * 4 + i) * 32 + g) * 2 + 0] = *(const f4*)(conv_w + i * 2048 + col - P_GQ); wtab[((which * 4 + i) * 32 + g) * 2 + 1] = *(const f4*)(conv_w + i * 2048 + col - P_GQ + 4); }
    LDS_BARRIER();
    v4u rq[7], rv[7];
    { const int it0 = blockIdx.x, n0_ = it0 & 31, b0_ = it0 >> 7;
#pragma unroll
      for (int i = 0; i < 7; ++i) { const int tr = n0_ * 64 + tt0 - 3 + i;
          if (tr >= 0 && it0 < 2048) { rq[i] = *(const v4u*)(proj + ((size_t)b0_ * SEQ + tr) * PW + colqk); rv[i] = *(const v4u*)(proj + ((size_t)b0_ * SEQ + tr) * PW + colv); }
          else { rq[i] = (v4u){0u, 0u, 0u, 0u}; rv[i] = (v4u){0u, 0u, 0u, 0u}; } } }
#pragma unroll 1
    for (int item = blockIdx.x; item < 2048; item += gridDim.x) {
        const int n = item & 31, bh = item >> 5, h = bh & 3, b = bh >> 2;
        const size_t rowb = (size_t)b * SEQ;
        const int tl0 = n * 64;
        if (wave == 0) {
            float g = Gd[(rowb + tl0 + lane) * 4 + h];
#pragma unroll
            for (int o = 1; o < 64; o <<= 1) { const float t = __shfl_up(g, o); if (lane >= o) g += t; }
            const float gl = __shfl(g, 63);
            bt[lane] = Bd[(rowb + tl0 + lane) * 4 + h]; gc[lane] = g;
            EGg[(size_t)item * 64 + lane] = expf(g); EGLg[(size_t)item * 64 + lane] = expf(gl - g);
        }
        {
#pragma unroll
            for (int j = 0; j < 4; ++j) {
                const int tt = tt0 + j;
                float acc[8];
#pragma unroll
                for (int c = 0; c < 8; ++c) acc[c] = 0.f;
#pragma unroll
                for (int i = 0; i < 4; ++i) { const v4u raw = rq[j + i]; const f4 w0 = wtab[((0 * 4 + i) * 32 + cg) * 2], w1 = wtab[((0 * 4 + i) * 32 + cg) * 2 + 1];
                    acc[0] += bflo(raw.x) * w0.x; acc[1] += bfhi(raw.x) * w0.y; acc[2] += bflo(raw.y) * w0.z; acc[3] += bfhi(raw.y) * w0.w;
                    acc[4] += bflo(raw.z) * w1.x; acc[5] += bfhi(raw.z) * w1.y; acc[6] += bflo(raw.w) * w1.z; acc[7] += bfhi(raw.w) * w1.w; }
                float ss = 0.f;
#pragma unroll
                for (int c = 0; c < 8; ++c) { acc[c] = acc[c] * fsigmoid(acc[c]); ss += acc[c] * acc[c]; }
                ss = row_sum16(ss);
                const float rn = rsqrtf(ss + 1e-6f) * (isk ? 1.0f : 0.08838834764831845f);
                v4u w; w.x = pkh(acc[0] * rn, acc[1] * rn); w.y = pkh(acc[2] * rn, acc[3] * rn); w.z = pkh(acc[4] * rn, acc[5] * rn); w.w = pkh(acc[6] * rn, acc[7] * rn);
                if (!isk) { *(LAS v4u*)(Qh + tt * PT128 + c8qk) = w; *(v4u*)(QHg + ((size_t)item * 64 + tt) * 128 + c8qk) = w; }
                else *(LAS v4u*)(Kh + tt * PT128 + c8qk) = w;
#pragma unroll
                for (int c = 0; c < 8; ++c) acc[c] = 0.f;
#pragma unroll
                for (int i = 0; i < 4; ++i) { const v4u raw = rv[j + i]; const f4 w0 = wtab[((1 * 4 + i) * 32 + cg) * 2], w1 = wtab[((1 * 4 + i) * 32 + cg) * 2 + 1];
                    acc[0] += bflo(raw.x) * w0.x; acc[1] += bfhi(raw.x) * w0.y; acc[2] += bflo(raw.y) * w0.z; acc[3] += bfhi(raw.y) * w0.w;
                    acc[4] += bflo(raw.z) * w1.x; acc[5] += bfhi(raw.z) * w1.y; acc[6] += bflo(raw.w) * w1.z; acc[7] += bfhi(raw.w) * w1.w; }
#pragma unroll
                for (int c = 0; c < 8; ++c) acc[c] = acc[c] * fsigmoid(acc[c]);
                v4u wvv; wvv.x = pkh(acc[0], acc[1]); wvv.y = pkh(acc[2], acc[3]); wvv.z = pkh(acc[4], acc[5]); wvv.w = pkh(acc[6], acc[7]);
                *(v4u*)(VHg + (rowb + tl0 + tt) * 1024 + h * 256 + 8 * cg) = wvv;
            }
            { const int itn = item + (int)gridDim.x, nn = itn & 31, bn = itn >> 7;
#pragma unroll
              for (int i = 0; i < 7; ++i) { const int tr = nn * 64 + tt0 - 3 + i;
                  if (tr >= 0 && itn < 2048) { rq[i] = *(const v4u*)(proj + ((size_t)bn * SEQ + tr) * PW + colqk); rv[i] = *(const v4u*)(proj + ((size_t)bn * SEQ + tr) * PW + colv); }
                  else { rq[i] = (v4u){0u, 0u, 0u, 0u}; rv[i] = (v4u){0u, 0u, 0u, 0u}; } } }
        }
        LDS_BARRIER();
        f16v X = zero16();
        const int q3 = (wave < 3) ? wave : wave - 3, mt = (q3 >= 1) ? 1 : 0, nt = (q3 == 2) ? 1 : 0;
        if (wave < 3) {
            f16v acc = zero16();
#pragma unroll
            for (int ks = 0; ks < 8; ++ks) acc = MFMA32(ld_nat(Kh, PT128, 32 * mt + r32, 16 * ks, hh), ld_nat(Kh, PT128, 32 * nt + r32, 16 * ks, hh), acc);
            const int bcol = 32 * nt + r32; const float gcb = gc[bcol];
            f16v N_;
#pragma unroll
            for (int rg = 0; rg < 16; ++rg) { const int ar = 32 * mt + (rg & 3) + 8 * (rg >> 2) + 4 * hh;
                N_[rg] = (ar > bcol) ? -bt[ar] * acc[rg] * expf(gc[ar] - gcb) : 0.f; X[rg] = N_[rg] + ((ar == bcol) ? 1.0f : 0.0f); }
            tile_store_rm(MB + 0 * MSZ, N_, mt, nt, r32, hh); tile_store_tr(MB + 1 * MSZ, N_, mt, nt, r32, hh);
            tile_store_rm(MB + 2 * MSZ, X, mt, nt, r32, hh);
        } else if (wave < 6) {
            const int jt = (wave == 5) ? 1 : 0, itile = (wave >= 4) ? 1 : 0;
            f16v acc = zero16();
#pragma unroll
            for (int ks = 0; ks < 8; ++ks) acc = MFMA32(ld_nat(Kh, PT128, 32 * jt + r32, 16 * ks, hh), ld_nat(Qh, PT128, 32 * itile + r32, 16 * ks, hh), acc);
            const int icol = 32 * itile + r32; const float gci = gc[icol];
#pragma unroll
            for (int g4 = 0; g4 < 4; ++g4) { const int j0 = 32 * jt + 8 * g4 + 4 * hh; float v[4];
#pragma unroll
                for (int j = 0; j < 4; ++j) { const int jr = j0 + j; v[j] = (icol >= jr) ? acc[4 * g4 + j] * expf(gci - gc[jr]) : 0.f; }
                v2u w; w.x = pkh(v[0], v[1]); w.y = pkh(v[2], v[3]); *(v2u*)(QKg + ((size_t)item * 64 + icol) * 64 + j0) = w; }
        } else if (wave == 6) {
            for (int i = lane; i < 32 * 4; i += 64) { const int row = i >> 2, c = i & 3; *(v4u*)(QKg + ((size_t)item * 64 + row) * 64 + 32 + 8 * c) = (v4u){0u, 0u, 0u, 0u}; }
        }
#pragma unroll
        for (int r = 0; r < 2; ++r) { const int p = tid + 512 * r, d = p & 127, tg = p >> 7;
            const LAS bf16* kp = Kh + (8 * tg) * PT128 + d;
            v4u w; w.x = (unsigned)kp[0] | ((unsigned)kp[PT128] << 16); w.y = (unsigned)kp[2 * PT128] | ((unsigned)kp[3 * PT128] << 16);
            w.z = (unsigned)kp[4 * PT128] | ((unsigned)kp[5 * PT128] << 16); w.w = (unsigned)kp[6 * PT128] | ((unsigned)kp[7 * PT128] << 16);
            *(v4u*)(KHTg + ((size_t)item * 128 + d) * 64 + 8 * tg) = w; }
        LDS_BARRIER();
        if (wave >= 3 && wave < 6) {
            f16v acc = zero16();
#pragma unroll
            for (int ks = 0; ks < 4; ++ks) acc = MFMA32(ld_nat(MB + 0 * MSZ, PT64, 32 * mt + r32, 16 * ks, hh), ld_nat(MB + 1 * MSZ, PT64, 32 * nt + r32, 16 * ks, hh), acc);
            tile_store_rm(MB + 3 * MSZ, acc, mt, nt, r32, hh); tile_store_tr(MB + 4 * MSZ, acc, mt, nt, r32, hh);
        }
        LDS_BARRIER();
#pragma unroll 1
        for (int r = 1; r <= 5; ++r) {
            const int so = ((r - 1) & 1) * 3, sn = (r & 1) * 3;
            LAS bf16* Xo = MB + (2 + so) * MSZ; LAS bf16* Po = MB + (3 + so) * MSZ; LAS bf16* Qo = MB + (4 + so) * MSZ;
            LAS bf16* Xn = MB + (2 + sn) * MSZ; LAS bf16* Pn = MB + (3 + sn) * MSZ; LAS bf16* Qn = MB + (4 + sn) * MSZ;
            if (wave < 3) {
#pragma unroll
                for (int ks = 0; ks < 4; ++ks) X = MFMA32(ld_nat(Xo, PT64, 32 * mt + r32, 16 * ks, hh), ld_nat(Qo, PT64, 32 * nt + r32, 16 * ks, hh), X);
                if (r < 5) tile_store_rm(Xn, X, mt, nt, r32, hh);
            } else if (wave < 6 && r < 5) {
                f16v acc = zero16();
#pragma unroll
                for (int ks = 0; ks < 4; ++ks) acc = MFMA32(ld_nat(Po, PT64, 32 * mt + r32, 16 * ks, hh), ld_nat(Qo, PT64, 32 * nt + r32, 16 * ks, hh), acc);
                tile_store_rm(Pn, acc, mt, nt, r32, hh); tile_store_tr(Qn, acc, mt, nt, r32, hh);
            }
            LDS_BARRIER();
        }
        if (wave < 3) {
            const int jcol = 32 * nt + r32; const float bj = bt[jcol], ej = expf(gc[jcol]);
            f16v U_, W_;
#pragma unroll
            for (int rg = 0; rg < 16; ++rg) { U_[rg] = X[rg] * bj; W_[rg] = U_[rg] * ej; }
            tile_store_rm(MB + 0 * MSZ, U_, mt, nt, r32, hh); tile_store_rm(MB + 3 * MSZ, W_, mt, nt, r32, hh);
        }
        LDS_BARRIER();
        { const int row = tid >> 3, c = tid & 7; const size_t go = ((size_t)item * 64 + row) * 64 + 8 * c;
          *(v4u*)(TUg + go) = *(const LAS v4u*)(MB + 0 * MSZ + row * PT64 + 8 * c); *(v4u*)(TWg + go) = *(const LAS v4u*)(MB + 3 * MSZ + row * PT64 + 8 * c); }
        LDS_BARRIER();
    }
}


__device__ __forceinline__ void phase_rprep(const Args& a, LAS unsigned char* lds) {
    bf16* proj = (bf16*)(a.ws + WS_PROJ);
    const float2* rope = (const float2*)(a.ws + WS_ROPE);
    const int tid = tidx(), lane = tid & 63, wave = tid >> 6;
    const int gw = blockIdx.x * 8 + wave, NGW = gridDim.x * 8;
    const int isk = lane >> 5, h = (lane >> 3) & 3, i0 = 8 * (lane & 7);
    const float lgam = logf(1.0f - exp2f(-5.0f - (float)h));
#pragma unroll 2
    for (int t = gw; t < T; t += NGW) {
        const int tl = t & (SEQ - 1);
        bf16* pr = proj + (size_t)t * PW + (isk ? P_RK : P_RQ) + h * 128;
        const v4u x1 = *(const v4u*)(pr + i0), x2 = *(const v4u*)(pr + 64 + i0);
        const float4* rp = (const float4*)(rope + tl * 64 + i0);
        const float4 c0 = rp[0], c1 = rp[1], c2 = rp[2], c3 = rp[3];
        const float a1[8] = {bflo(x1.x), bfhi(x1.x), bflo(x1.y), bfhi(x1.y), bflo(x1.z), bfhi(x1.z), bflo(x1.w), bfhi(x1.w)};
        const float a2[8] = {bflo(x2.x), bfhi(x2.x), bflo(x2.y), bfhi(x2.y), bflo(x2.z), bfhi(x2.z), bflo(x2.w), bfhi(x2.w)};
        const float cs[8] = {c0.x, c0.z, c1.x, c1.z, c2.x, c2.z, c3.x, c3.z}, sn[8] = {c0.y, c0.w, c1.y, c1.w, c2.y, c2.w, c3.y, c3.w};
        const float sc = isk ? 0.08838834764831845f : expf((float)((tl & 63) + 1) * lgam);
        float o1[8], o2[8];
#pragma unroll
        for (int j = 0; j < 8; ++j) { o1[j] = (a1[j] * cs[j] - a2[j] * sn[j]) * sc; o2[j] = (a1[j] * sn[j] + a2[j] * cs[j]) * sc; }
        v4u w1, w2; w1.x = pkh(o1[0], o1[1]); w1.y = pkh(o1[2], o1[3]); w1.z = pkh(o1[4], o1[5]); w1.w = pkh(o1[6], o1[7]);
        w2.x = pkh(o2[0], o2[1]); w2.y = pkh(o2[2], o2[3]); w2.z = pkh(o2[4], o2[5]); w2.w = pkh(o2[6], o2[7]);
        *(v4u*)(pr + i0) = w1; *(v4u*)(pr + 64 + i0) = w2;
    }
}

__device__ __forceinline__ void tile_to_lds(const f16v& acc, LAS bf16* ot, int r32, int hh) {
#pragma unroll
    for (int g4 = 0; g4 < 4; ++g4) { const int r0 = 8 * g4 + 4 * hh;
        const unsigned p0 = cvtpk(acc[4 * g4 + 0], acc[4 * g4 + 1]), p1 = cvtpk(acc[4 * g4 + 2], acc[4 * g4 + 3]);
        ot[(r0 + 0) * 36 + r32] = (bf16)(p0 & 0xffff); ot[(r0 + 1) * 36 + r32] = (bf16)(p0 >> 16); ot[(r0 + 2) * 36 + r32] = (bf16)(p1 & 0xffff); ot[(r0 + 3) * 36 + r32] = (bf16)(p1 >> 16); }
}
__device__ __forceinline__ void lds_rows_to_global(const LAS bf16* ot, bf16* gtile, int lane) {
    asm volatile("s_waitcnt lgkmcnt(0)" ::: "memory");
    const LAS bf16* rp = ot + (lane & 31) * 36 + (lane >> 5) * 16;
    const v2u a0 = *(const LAS v2u*)rp, a1 = *(const LAS v2u*)(rp + 4), a2 = *(const LAS v2u*)(rp + 8), a3 = *(const LAS v2u*)(rp + 12);
    bf16* gp = gtile + (size_t)(lane & 31) * PW + (lane >> 5) * 16;
    *(v4u*)gp = (v4u){a0.x, a0.y, a1.x, a1.y}; *(v4u*)(gp + 8) = (v4u){a2.x, a2.y, a3.x, a3.y};
}

__device__ __forceinline__ void cjob_store16(const CJob& j, int lane, const f4 (&v)[16], LAS float* tile) {
#pragma unroll
    for (int q4 = 0; q4 < 4; ++q4) {
#pragma unroll
        for (int i = 0; i < 4; ++i) { LAS float* tp = tile + (4 * i + (lane >> 4)) * 65 + 4 * (lane & 15); const f4 x = v[4 * q4 + i]; tp[0] = x[0]; tp[1] = x[1]; tp[2] = x[2]; tp[3] = x[3]; }
        asm volatile("s_waitcnt lgkmcnt(0)" ::: "memory");
        unsigned w[8];
#pragma unroll
        for (int q = 0; q < 8; ++q) w[q] = pkh(tile[(2 * q) * 65 + lane], tile[(2 * q + 1) * 65 + lane]);
        bf16* dp = j.dst + (size_t)lane * j.ldd + 16 * q4;
        *(v4u*)dp = (v4u){w[0], w[1], w[2], w[3]}; *(v4u*)(dp + 8) = (v4u){w[4], w[5], w[6], w[7]};
        asm volatile("s_waitcnt lgkmcnt(0)" ::: "memory");
    }
}

template <int BR, bool HELPER>
__device__ __forceinline__ void scan_mfma_item(const Args& a, LAS unsigned char* lds, int b, int h, int half, int cj0) {
    constexpr int PQ = 132, PK = 68;
    LAS bf16* Tu = (LAS bf16*)lds; LAS bf16* Tw = (LAS bf16*)(lds + 9216); LAS bf16* QK = (LAS bf16*)(lds + 18432); LAS bf16* Qh = (LAS bf16*)(lds + 27136);
    LAS bf16* Kht = (LAS bf16*)(lds + 44032); LAS bf16* nW = (LAS bf16*)(lds + 61440);
    LAS bf16* Qd = (LAS bf16*)lds; LAS bf16* Kr = (LAS bf16*)(lds + 17408); LAS bf16* Kdt = (LAS bf16*)(lds + 34816); LAS bf16* Pm = (LAS bf16*)(lds + 53248);
    LAS float* egs = (LAS float*)(lds + 117760); LAS float* egls = egs + 64;
    bf16* proj = (bf16*)(a.ws + WS_PROJ);
    const int tid0 = tidx();
    const size_t rowb = (size_t)b * SEQ;
    const unsigned char* dout = (const unsigned char*)a.out;
    const bf16* QHg = (const bf16*)(dout + DO_QH); const bf16* KHTg = (const bf16*)(dout + DO_KHT); const bf16* QKg = (const bf16*)(dout + DO_QK);
    const bf16* TUg = (const bf16*)(dout + DO_TU); const bf16* TWg = (const bf16*)(dout + DO_TW);
    const bf16* VHg = (const bf16*)(a.ws + WS_VH); const float* EGg = (const float*)(a.ws + WS_EG); const float* EGLg = (const float*)(a.ws + WS_EGL);
    const float2* rope = (const float2*)(a.ws + WS_ROPE);
    const float lgam = logf(1.0f - exp2f(-5.0f - (float)h));
    LAS float* kdt = egs + 128;
    LAS float* gpw = kdt + 64;
    if (BR == 0) { for (int i = tid0; i < 64 * PT64 / 8; i += 512) ((LAS v4u*)Pm)[i] = (v4u){0u, 0u, 0u, 0u}; }
    if (BR == 0 && tid0 < 64) { kdt[tid0] = expf((float)(63 - tid0) * lgam); gpw[tid0] = expf(-(float)(tid0 + 1) * lgam); }
    v4u pf[7], pfv[4]; float pfe = 0.f;
#define SCAN_PF_A(NN) do { const int n_ = (NN); const int tl_ = n_ * 64, item_ = (b * 4 + h) * 32 + n_; (void)tl_; (void)item_; \
        if (BR == 1) { { const int row = tid >> 3, c = tid & 7; const size_t go = ((size_t)item_ * 64 + row) * 64 + 8 * c; pf[0] = *(const v4u*)(TUg + go); pf[1] = *(const v4u*)(TWg + go); pf[2] = *(const v4u*)(QKg + go); } \
            if (tid < 64) pfe = EGg[(size_t)item_ * 64 + tid]; else if (tid < 128) pfe = EGLg[(size_t)item_ * 64 + tid - 64]; \
        } else { const int p = tid, row = p >> 4, c = p & 15; const bf16* pr = proj + (rowb + tl_ + row) * PW + h * 128 + 8 * c; pf[0] = *(const v4u*)(pr + P_RQ); pf[1] = *(const v4u*)(pr + P_RK); } } while (0)
#define SCAN_PF_B(NN) do { const int n_ = (NN); const int tl_ = n_ * 64, item_ = (b * 4 + h) * 32 + n_; (void)tl_; (void)item_; \
        if (BR == 1) { _Pragma("unroll") for (int r = 0; r < 2; ++r) { const int p = tid + 512 * r; \
                { const int row = p >> 4, c = p & 15; pf[3 + r] = *(const v4u*)(QHg + ((size_t)item_ * 64 + row) * 128 + 8 * c); } \
                { const int row = p >> 3, c = p & 7; pf[5 + r] = *(const v4u*)(KHTg + ((size_t)item_ * 128 + row) * 64 + 8 * c); } } \
        } else { const int p = tid + 512, row = p >> 4, c = p & 15; const bf16* pr = proj + (rowb + tl_ + row) * PW + h * 128 + 8 * c; pf[2] = *(const v4u*)(pr + P_RQ); pf[3] = *(const v4u*)(pr + P_RK); } } while (0)
#define SCAN_PF_C(NN) do { if (!HELPER) { const int n_ = (NN); const int tl_ = n_ * 64; \
        const bf16* vsrc = (BR == 1) ? (VHg + (rowb + tl_ + lane) * 1024 + h * 256 + half * 128 + 32 * (wave & 3)) : (proj + (rowb + tl_ + lane) * PW + P_RV + h * 256 + half * 128 + 32 * (wave & 3)); \
        pfv[0] = ((const v4u*)vsrc)[0]; pfv[1] = ((const v4u*)vsrc)[1]; pfv[2] = ((const v4u*)vsrc)[2]; pfv[3] = ((const v4u*)vsrc)[3]; } } while (0)
#define SCAN_PREFETCH(NN) do { SCAN_PF_A(NN); SCAN_PF_B(NN); SCAN_PF_C(NN); } while (0)
    { const int tid = tid0, lane = tid0 & 63, wave = tid0 >> 6; SCAN_PREFETCH(0); }
    f4 cva[16];
    const int cjn = HELPER ? ((cj0 >= 0) ? 6 : 0) : 0;
    if (HELPER) {
#pragma unroll
        for (int i = 0; i < 16; ++i) cva[i] = (f4){0.f, 0.f, 0.f, 0.f}; }
    f16v S[4];
#pragma unroll
    for (int dt = 0; dt < 4; ++dt) S[dt] = zero16();
#ifndef PROBE_STAGE
#define PROBE_STAGE 0
#endif
    unsigned long long tacc[5] = {0ull, 0ull, 0ull, 0ull, 0ull}, tl = 0ull;
    unsigned long long tsub[4] = {0ull, 0ull, 0ull, 0ull};
#define TSUB(K) do { if (PROBE_STAGE >= 7 && PROBE_STAGE <= 10) { __builtin_amdgcn_sched_barrier(0); const unsigned long long t_ = __builtin_amdgcn_s_memtime(); tsub[K] += t_ - tl2; tl2 = t_; __builtin_amdgcn_sched_barrier(0); } } while (0)
    unsigned long long tl2 = 0ull;
#define TSTAMP(K) do { if (PROBE_STAGE != 0) { const unsigned long long t_ = __builtin_amdgcn_s_memtime(); tacc[K] += t_ - tl; tl = t_; } } while (0)
    if (PROBE_STAGE != 0) tl = __builtin_amdgcn_s_memtime();
#pragma unroll 1
    for (int n = 0; n < 32; ++n) {
        const int tl0 = n * 64, item = (b * 4 + h) * 32 + n;
        int tidL = tid0; asm volatile("" : "+v"(tidL));
        const int tid = tidL, lane = tidL & 63, wave = tidL >> 6, r32 = lane & 31, hh = lane >> 5;
        const int strip = wave & 3;
        LAS bf16* Vt = (LAS bf16*)(lds + 80896 + wave * 4608);
        if (BR == 1) {
            { const int row = tid >> 3, c = tid & 7;
              *(LAS v4u*)(Tu + row * PT64 + 8 * c) = pf[0]; *(LAS v4u*)(Tw + row * PT64 + 8 * c) = pf[1];
              *(LAS v2u*)(QK + row * PK + 8 * c) = (v2u){pf[2].x, pf[2].y}; *(LAS v2u*)(QK + row * PK + 8 * c + 4) = (v2u){pf[2].z, pf[2].w}; }
#pragma unroll
            for (int r = 0; r < 2; ++r) { const int p = tid + 512 * r;
                { const int row = p >> 4, c = p & 15; *(LAS v2u*)(Qh + row * PQ + 8 * c) = (v2u){pf[3 + r].x, pf[3 + r].y}; *(LAS v2u*)(Qh + row * PQ + 8 * c + 4) = (v2u){pf[3 + r].z, pf[3 + r].w}; }
                { const int row = p >> 3, c = p & 7; *(LAS v2u*)(Kht + row * PK + 8 * c) = (v2u){pf[5 + r].x, pf[5 + r].y}; *(LAS v2u*)(Kht + row * PK + 8 * c + 4) = (v2u){pf[5 + r].z, pf[5 + r].w}; } }
            if (tid < 64) egs[tid] = pfe; else if (tid < 128) egls[tid - 64] = pfe;
        } else {
#pragma unroll
            for (int r = 0; r < 2; ++r) { const int p = tid + 512 * r, row = p >> 4, c = p & 15;
                *(LAS v2u*)(Qd + row * PQ + 8 * c) = (v2u){pf[2 * r].x, pf[2 * r].y}; *(LAS v2u*)(Qd + row * PQ + 8 * c + 4) = (v2u){pf[2 * r].z, pf[2 * r].w}; *(LAS v4u*)(Kr + row * PT128 + 8 * c) = pf[2 * r + 1]; }
        }
        if (!HELPER) {
            const unsigned wv[16] = {pfv[0].x, pfv[0].y, pfv[0].z, pfv[0].w, pfv[1].x, pfv[1].y, pfv[1].z, pfv[1].w, pfv[2].x, pfv[2].y, pfv[2].z, pfv[2].w, pfv[3].x, pfv[3].y, pfv[3].z, pfv[3].w};
#pragma unroll
            for (int j = 0; j < 16; ++j) { Vt[(2 * j) * PT64 + lane] = (bf16)(wv[j] & 0xffff); Vt[(2 * j + 1) * PT64 + lane] = (bf16)(wv[j] >> 16); }
        }
        const int nnx = n + 1 < 32 ? n + 1 : 31;
        SCAN_PREFETCH(nnx);
        TSTAMP(0);
        LDS_BARRIER();
        TSTAMP(3);
        if (BR == 1) {
            const int dt = wave >> 1, itile = wave & 1;
            f16v acc = zero16();
#pragma unroll
            for (int ks = 0; ks < 4; ++ks) acc = MFMA32(ld_perm(Kht, PK, 32 * dt + r32, 16 * ks, hh), ld_perm(Tw, PT64, 32 * itile + r32, 16 * ks, hh), acc);
            const int icol = 32 * itile + r32;
#pragma unroll
            for (int g4 = 0; g4 < 4; ++g4) { const int d0 = 32 * dt + 8 * g4 + 4 * hh;
                v2u w; w.x = cvtpk(-acc[4 * g4 + 0], -acc[4 * g4 + 1]); w.y = cvtpk(-acc[4 * g4 + 2], -acc[4 * g4 + 3]); *(LAS v2u*)(nW + icol * PQ + d0) = w; }
        } else {
#pragma unroll
            for (int r = 0; r < 2; ++r) { const int p = tid + 512 * r, d = p & 127, tg = p >> 7;
                const LAS bf16* kp = Kr + (8 * tg) * PT128 + d;
                float kv[8];
#pragma unroll
                for (int i = 0; i < 8; ++i) kv[i] = bf2f(kp[i * PT128]) * kdt[8 * tg + i];
                v4u w; w.x = cvtpk(kv[0], kv[1]); w.y = cvtpk(kv[2], kv[3]); w.z = cvtpk(kv[4], kv[5]); w.w = cvtpk(kv[6], kv[7]);
                *(LAS v4u*)(Kdt + d * PT64 + 8 * tg) = w; }
        }
        if (BR == 0) {
            typedef float f32x4_ __attribute__((ext_vector_type(4)));
            const int l15 = lane & 15, l4 = lane >> 4;
#pragma unroll 1
            for (int q = wave; q < 10; q += 8) {
                const int jb = (q < 4) ? 0 : (q < 7) ? 1 : (q < 9) ? 2 : 3, ib = (q < 4) ? q : (q < 7) ? q - 3 : (q < 9) ? q - 5 : 3;
                f32x4_ acc = {0.f, 0.f, 0.f, 0.f};
                s8v fa4[4], fb4[4];
#pragma unroll
                for (int ks = 0; ks < 4; ++ks) { fa4[ks] = *(const LAS s8v*)(Kr + (16 * jb + l15) * PT128 + 32 * ks + 8 * l4);
                    const LAS bf16* qp = Qd + (16 * ib + l15) * PQ + 32 * ks + 8 * l4; const s4v lo = *(const LAS s4v*)qp, hi = *(const LAS s4v*)(qp + 4);
                    fb4[ks] = __builtin_shufflevector(lo, hi, 0, 1, 2, 3, 4, 5, 6, 7); }
#pragma unroll
                for (int ks = 0; ks < 4; ++ks) acc = __builtin_amdgcn_mfma_f32_16x16x32_bf16(fa4[ks], fb4[ks], acc, 0, 0, 0);
                const int icol = 16 * ib + l15, j0 = 16 * jb + 4 * l4;
                float v[4];
#pragma unroll
                for (int j = 0; j < 4; ++j) { const int jr = j0 + j; v[j] = (icol >= jr) ? acc[j] * gpw[jr] : 0.f; }
                v2u w; w.x = cvtpk(v[0], v[1]); w.y = cvtpk(v[2], v[3]); *(LAS v2u*)(Pm + icol * PT64 + j0) = w;
            }
        }
        TSTAMP(1);
        LDS_BARRIER();
        TSTAMP(3);
        if (PROBE_STAGE >= 7 && PROBE_STAGE <= 10) tl2 = __builtin_amdgcn_s_memtime();
#define SGB_DS(N) __builtin_amdgcn_sched_group_barrier(0x100, (N), 0)
#define SGB_MM(N) __builtin_amdgcn_sched_group_barrier(0x008, (N), 0)
#define LDP4(F, BASE, PITCH, ROW, K0) do { F[0] = ld_perm(BASE, PITCH, ROW, (K0), hh); F[1] = ld_perm(BASE, PITCH, ROW, (K0) + 16, hh); F[2] = ld_perm(BASE, PITCH, ROW, (K0) + 32, hh); F[3] = ld_perm(BASE, PITCH, ROW, (K0) + 48, hh); } while (0)
#define LDN4(F, BASE, PITCH, ROW, K0) do { F[0] = ld_nat(BASE, PITCH, ROW, (K0), hh); F[1] = ld_nat(BASE, PITCH, ROW, (K0) + 16, hh); F[2] = ld_nat(BASE, PITCH, ROW, (K0) + 32, hh); F[3] = ld_nat(BASE, PITCH, ROW, (K0) + 48, hh); } while (0)
        if (!HELPER) {
        s8v Sp[4][2];
#pragma unroll
        for (int dt = 0; dt < 4; ++dt) { Sp[dt][0] = pack8<0>(S[dt]); Sp[dt][1] = pack8<1>(S[dt]); }
        bf16* otile = proj + (rowb + tl0) * PW + (BR == 1 ? P_GV : P_RV) + h * 256 + half * 128 + 32 * strip;
        LAS bf16* ot = (LAS bf16*)(lds + 119808 + wave * 2304);
        s8v fa[4], fb[4];
        TSUB(3);
        if (BR == 1) {
            s8v vb[2][2], vs[2][2];
            LDN4(fb, Vt, PT64, r32, 0);
#pragma unroll
            for (int it = 0; it < 2; ++it) {
                f16v acc = zero16();
                LDN4(fa, Tu, PT64, 32 * it + r32, 0);
                acc = MFMA32(fa[0], fb[0], acc); acc = MFMA32(fa[1], fb[1], acc); acc = MFMA32(fa[2], fb[2], acc); acc = MFMA32(fa[3], fb[3], acc);
                if (it == 0) { SGB_DS(8); } else { SGB_DS(4); } SGB_MM(4);
                LDP4(fa, nW, PQ, 32 * it + r32, 0);
                acc = MFMA32(fa[0], Sp[0][0], acc); acc = MFMA32(fa[1], Sp[0][1], acc); acc = MFMA32(fa[2], Sp[1][0], acc); acc = MFMA32(fa[3], Sp[1][1], acc);
                SGB_DS(4); SGB_MM(4);
                LDP4(fa, nW, PQ, 32 * it + r32, 64);
                acc = MFMA32(fa[0], Sp[2][0], acc); acc = MFMA32(fa[1], Sp[2][1], acc); acc = MFMA32(fa[2], Sp[3][0], acc); acc = MFMA32(fa[3], Sp[3][1], acc);
                SGB_DS(4); SGB_MM(4);
                vb[it][0] = pack8<0>(acc); vb[it][1] = pack8<1>(acc);
#pragma unroll
                for (int g4 = 0; g4 < 4; ++g4) { const f4 e = *(const LAS f4*)(egls + 32 * it + 8 * g4 + 4 * hh); acc[4 * g4 + 0] *= e.x; acc[4 * g4 + 1] *= e.y; acc[4 * g4 + 2] *= e.z; acc[4 * g4 + 3] *= e.w; }
                vs[it][0] = pack8<0>(acc); vs[it][1] = pack8<1>(acc);
            }
            TSUB(0);
#pragma unroll
            for (int it = 0; it < 2; ++it) {
                f16v acc = zero16();
                LDP4(fa, Qh, PQ, 32 * it + r32, 0);
                acc = MFMA32(fa[0], Sp[0][0], acc); acc = MFMA32(fa[1], Sp[0][1], acc); acc = MFMA32(fa[2], Sp[1][0], acc); acc = MFMA32(fa[3], Sp[1][1], acc);
                SGB_DS(4); SGB_MM(4);
                LDP4(fa, Qh, PQ, 32 * it + r32, 64);
                acc = MFMA32(fa[0], Sp[2][0], acc); acc = MFMA32(fa[1], Sp[2][1], acc); acc = MFMA32(fa[2], Sp[3][0], acc); acc = MFMA32(fa[3], Sp[3][1], acc);
                SGB_DS(4); SGB_MM(4);
#pragma unroll
                for (int g4 = 0; g4 < 4; ++g4) { const f4 e = *(const LAS f4*)(egs + 32 * it + 8 * g4 + 4 * hh); acc[4 * g4 + 0] *= e.x; acc[4 * g4 + 1] *= e.y; acc[4 * g4 + 2] *= e.z; acc[4 * g4 + 3] *= e.w; }
                if (it == 0) { fa[0] = ld_perm(QK, PK, r32, 0, hh); fa[1] = ld_perm(QK, PK, r32, 16, hh);
                    acc = MFMA32(fa[0], vb[0][0], acc); acc = MFMA32(fa[1], vb[0][1], acc); }
                else { LDP4(fa, QK, PK, 32 + r32, 0);
                    acc = MFMA32(fa[0], vb[0][0], acc); acc = MFMA32(fa[1], vb[0][1], acc); acc = MFMA32(fa[2], vb[1][0], acc); acc = MFMA32(fa[3], vb[1][1], acc); }
                tile_to_lds(acc, ot, r32, hh); lds_rows_to_global(ot, otile + (size_t)(32 * it) * PW, lane); asm volatile("s_waitcnt lgkmcnt(0)" ::: "memory");
            }
            TSUB(1);
            const float egl_ = egs[63];
#pragma unroll
            for (int dt = 0; dt < 4; ++dt) {
#pragma unroll
                for (int i = 0; i < 16; ++i) S[dt][i] *= egl_;
                LDP4(fa, Kht, PK, 32 * dt + r32, 0);
                S[dt] = MFMA32(fa[0], vs[0][0], S[dt]); S[dt] = MFMA32(fa[1], vs[0][1], S[dt]); S[dt] = MFMA32(fa[2], vs[1][0], S[dt]); S[dt] = MFMA32(fa[3], vs[1][1], S[dt]);
                SGB_DS(4); SGB_MM(4);
            }
            TSUB(2);
        } else {
#pragma unroll
            for (int it = 0; it < 2; ++it) {
                f16v acc = zero16();
                LDP4(fa, Qd, PQ, 32 * it + r32, 0);
                acc = MFMA32(fa[0], Sp[0][0], acc); acc = MFMA32(fa[1], Sp[0][1], acc); acc = MFMA32(fa[2], Sp[1][0], acc); acc = MFMA32(fa[3], Sp[1][1], acc);
                SGB_DS(4); SGB_MM(4);
                LDP4(fa, Qd, PQ, 32 * it + r32, 64);
                acc = MFMA32(fa[0], Sp[2][0], acc); acc = MFMA32(fa[1], Sp[2][1], acc); acc = MFMA32(fa[2], Sp[3][0], acc); acc = MFMA32(fa[3], Sp[3][1], acc);
                SGB_DS(4); SGB_MM(4);
                if (it == 0) { fa[0] = ld_nat(Pm, PT64, r32, 0, hh); fa[1] = ld_nat(Pm, PT64, r32, 16, hh); fb[0] = ld_nat(Vt, PT64, r32, 0, hh); fb[1] = ld_nat(Vt, PT64, r32, 16, hh);
                    acc = MFMA32(fa[0], fb[0], acc); acc = MFMA32(fa[1], fb[1], acc); SGB_DS(4); SGB_MM(2); }
                else { LDN4(fa, Pm, PT64, 32 + r32, 0); LDN4(fb, Vt, PT64, r32, 0);
                    acc = MFMA32(fa[0], fb[0], acc); acc = MFMA32(fa[1], fb[1], acc); acc = MFMA32(fa[2], fb[2], acc); acc = MFMA32(fa[3], fb[3], acc); SGB_DS(8); SGB_MM(4); }
                tile_to_lds(acc, ot, r32, hh); lds_rows_to_global(ot, otile + (size_t)(32 * it) * PW, lane); asm volatile("s_waitcnt lgkmcnt(0)" ::: "memory");
            }
            const float g64 = expf(64.0f * lgam);
#pragma unroll
            for (int dt = 0; dt < 4; ++dt) {
#pragma unroll
                for (int i = 0; i < 16; ++i) S[dt][i] *= g64;
                LDN4(fa, Kdt, PT64, 32 * dt + r32, 0);
                S[dt] = MFMA32(fa[0], fb[0], S[dt]); S[dt] = MFMA32(fa[1], fb[1], S[dt]); S[dt] = MFMA32(fa[2], fb[2], S[dt]); S[dt] = MFMA32(fa[3], fb[3], S[dt]);
                SGB_DS(4); SGB_MM(4);
            }
        }
        } else {
            if (cjn > 0 && n >= 1 && n <= cjn) { const CJob j = cjob_ex(a, cj0 + 1024 * (n - 1)); cjob_store16(j, lane, cva, (LAS float*)Vt); }
            if (n < cjn) { const CJob j = cjob_ex(a, cj0 + 1024 * n); cjob_load(j, lane, cva); }
        }
#undef SGB_DS
#undef SGB_MM
#undef LDP4
#undef LDN4
        TSTAMP(2);
        LDS_BARRIER();
        TSTAMP(3);
    }
    if (PROBE_STAGE >= 7 && PROBE_STAGE <= 10 && BR == 1) { const unsigned long long want = tsub[PROBE_STAGE - 7], t0_ = __builtin_amdgcn_s_memtime(); while (__builtin_amdgcn_s_memtime() - t0_ < want) __builtin_amdgcn_s_sleep(4); LDS_BARRIER(); }
    if (PROBE_STAGE >= 11 && PROBE_STAGE <= 14 && BR == 0) { const unsigned long long want = tacc[PROBE_STAGE - 11], t0_ = __builtin_amdgcn_s_memtime(); while (__builtin_amdgcn_s_memtime() - t0_ < want) __builtin_amdgcn_s_sleep(4); LDS_BARRIER(); }
    if (PROBE_STAGE != 0 && PROBE_STAGE < 7 && ((BR == 1 && PROBE_STAGE <= 5) || (BR == 0 && PROBE_STAGE >= 5))) {
        const unsigned long long want = (PROBE_STAGE >= 5) ? (tacc[0] + tacc[1] + tacc[2] + tacc[3]) : tacc[PROBE_STAGE > 4 ? 0 : PROBE_STAGE - 1], t0_ = __builtin_amdgcn_s_memtime();
        while (__builtin_amdgcn_s_memtime() - t0_ < want) __builtin_amdgcn_s_sleep(4);
        LDS_BARRIER();
    }
#undef TSTAMP
#undef TSUB
}
#undef SCAN_PREFETCH
#undef SCAN_PF_A
#undef SCAN_PF_B
#undef SCAN_PF_C
__device__ __forceinline__ void phase_scan_mfma(const Args& a, LAS unsigned char* lds) {
    const int wv = tidx() >> 6;
    int round = 0;
    for (int id = blockIdx.x; id < 256; id += gridDim.x, ++round) {
        const int xq = id & 7, yq = id >> 3, half = yq & 1, br = (yq >> 1) & 1, bh = xq + 8 * (yq >> 2), b = bh >> 2, h = bh & 3;
        const int cj0 = (gridDim.x == 256 && round == 0) ? (int)blockIdx.x * 4 + (wv - 4) : -1;
        if (wv < 4) { if (br == 0) scan_mfma_item<0, false>(a, lds, b, h, half, -1); else scan_mfma_item<1, false>(a, lds, b, h, half, -1); }
        else        { if (br == 0) scan_mfma_item<0, true>(a, lds, b, h, half, cj0); else scan_mfma_item<1, true>(a, lds, b, h, half, cj0); }
    }
    if (gridDim.x != 256) {
        const int lane = tidx() & 63; LAS float* tile = (LAS float*)(lds + 32768 + wv * 8448); f4 va[16];
        for (int job = blockIdx.x * 8 + wv; job < 6144; job += gridDim.x * 8) { const CJob j = cjob_ex(a, job); cjob_load(j, lane, va); cjob_store(j, lane, va, tile); }
    }
}
__device__ __forceinline__ void phase_merge2(const Args& a, LAS unsigned char* lds) {
    const bf16* proj = (const bf16*)(a.ws + WS_PROJ); const float* gnw = a.in[9];
    bf16* merged = (bf16*)(a.ws + WS_MERGED);
    const int tid = tidx(), lane = tid & 63, wave = tid >> 6;
    const int gw = blockIdx.x * 8 + wave, NGW = gridDim.x * 8;
    const int c0 = 16 * lane, tlast = gw + ((T - 1 - gw) / NGW) * NGW;
    const float4 w0a = *(const float4*)(gnw + (c0 & 255)), w1a = *(const float4*)(gnw + (c0 & 255) + 4), w0b = *(const float4*)(gnw + ((c0 + 8) & 255)), w1b = *(const float4*)(gnw + ((c0 + 8) & 255) + 4);
    v4u nr[2], ng[2], na[2], nb[2];
    { const bf16* pr = proj + (size_t)gw * PW;
#pragma unroll
      for (int part = 0; part < 2; ++part) { nr[part] = *(const v4u*)(pr + P_RV + c0 + 8 * part); ng[part] = *(const v4u*)(pr + P_GV + c0 + 8 * part); na[part] = *(const v4u*)(pr + P_GA + c0 + 8 * part); nb[part] = *(const v4u*)(pr + P_GB + c0 + 8 * part); } }
#pragma unroll 1
    for (int t = gw; t < T; t += NGW) {
        v4u orv[2], ogv[2], gav[2], gbv[2];
#pragma unroll
        for (int part = 0; part < 2; ++part) { orv[part] = nr[part]; ogv[part] = ng[part]; gav[part] = na[part]; gbv[part] = nb[part]; }
        { const int tn = t + NGW <= tlast ? t + NGW : tlast; const bf16* pr = proj + (size_t)tn * PW;
#pragma unroll
          for (int part = 0; part < 2; ++part) { nr[part] = *(const v4u*)(pr + P_RV + c0 + 8 * part); ng[part] = *(const v4u*)(pr + P_GV + c0 + 8 * part); na[part] = *(const v4u*)(pr + P_GA + c0 + 8 * part); nb[part] = *(const v4u*)(pr + P_GB + c0 + 8 * part); } }
        float sr = 0.f, sg = 0.f;
#pragma unroll
        for (int part = 0; part < 2; ++part) {
            const unsigned ru[4] = {orv[part].x, orv[part].y, orv[part].z, orv[part].w}, gu[4] = {ogv[part].x, ogv[part].y, ogv[part].z, ogv[part].w};
#pragma unroll
            for (int j = 0; j < 4; ++j) { sr += bflo(ru[j]) * bflo(ru[j]) + bfhi(ru[j]) * bfhi(ru[j]); sg += bflo(gu[j]) * bflo(gu[j]) + bfhi(gu[j]) * bfhi(gu[j]); } }
        sr = row_sum16(sr); sg = row_sum16(sg);
        const float rr = rsqrtf(sr * (1.0f / 256.0f) + 1e-6f), rg = rsqrtf(sg * (1.0f / 256.0f) + 1e-6f);
#pragma unroll
        for (int part = 0; part < 2; ++part) { const int c = c0 + 8 * part;
            const v4u ga = gav[part], gb = gbv[part], ov = orv[part], gv = ogv[part];
            const float4 w0 = part ? w0b : w0a, w1 = part ? w1b : w1a;
            float o[8];
            o[0] = bflo(ga.x) * bflo(ov.x) * rr + bflo(gb.x) * bflo(gv.x) * rg * w0.x; o[1] = bfhi(ga.x) * bfhi(ov.x) * rr + bfhi(gb.x) * bfhi(gv.x) * rg * w0.y;
            o[2] = bflo(ga.y) * bflo(ov.y) * rr + bflo(gb.y) * bflo(gv.y) * rg * w0.z; o[3] = bfhi(ga.y) * bfhi(ov.y) * rr + bfhi(gb.y) * bfhi(gv.y) * rg * w0.w;
            o[4] = bflo(ga.z) * bflo(ov.z) * rr + bflo(gb.z) * bflo(gv.z) * rg * w1.x; o[5] = bfhi(ga.z) * bfhi(ov.z) * rr + bfhi(gb.z) * bfhi(gv.z) * rg * w1.y;
            o[6] = bflo(ga.w) * bflo(ov.w) * rr + bflo(gb.w) * bflo(gv.w) * rg * w1.z; o[7] = bfhi(ga.w) * bfhi(ov.w) * rr + bfhi(gb.w) * bfhi(gv.w) * rg * w1.w;
            v4u w; w.x = pkh(o[0], o[1]); w.y = pkh(o[2], o[3]); w.z = pkh(o[4], o[5]); w.w = pkh(o[6], o[7]);
            *(v4u*)(merged + (size_t)t * 1024 + c) = w; }
    }
}
}
namespace {
template <int PH> __device__ __forceinline__ void run_phase(const Args& a, LAS unsigned char* lds) {
    if (PH == 0) { phase_rope_part(a, (int)blockIdx.x, (int)gridDim.x);
                   if (gridDim.x < 192 || blockIdx.x < 96) { phase_mod_part(a, lds, (int)blockIdx.x, gridDim.x < 192 ? (int)gridDim.x : 96); __syncthreads(); }
                   phase_convert_all(a, lds); }
    else if (PH == 1) phase_norm1(a, lds);
    else if (PH == 2) phase_inproj(a, lds);
    else if (PH == 3) phase_gprep(a, lds);
    else if (PH == 4) phase_scan_mfma(a, lds);
    else if (PH == 5) phase_merge2(a, lds);
    else if (PH == 6) phase_outproj(a, lds);
    else if (PH == 7) phase_route(a, lds);
    else if (PH == 8) phase_scatter(a, lds);
    else if (PH == 9) phase_moe1(a, lds);
    else if (PH == 10) phase_moe2(a, lds);
    else if (PH == 11) phase_final(a, lds);
}
template <int PH> __global__ void __launch_bounds__(512, 2) k_phase(Args a) {
    extern __shared__ __attribute__((aligned(16))) unsigned char smem[];
    run_phase<PH>(a, (LAS unsigned char*)smem);
}
}
namespace {
#define XB_TMO      128
#define XB_XCNT(j)  (256  + 64 * (j))
#define XB_XSUB(j)  (1280 + 64 * (j))
#define XB_XGEN(j)  (2304 + 64 * (j))
#define XB_TOP      3328
#define XB_TOPGEN   3392
#define XCD_BAR_WORDS 3456
#define XB_SPIN_CAP (1u << 18)

__device__ __forceinline__ unsigned xb_ld(unsigned* p)              { return __hip_atomic_load(p, __ATOMIC_RELAXED, __HIP_MEMORY_SCOPE_AGENT); }
__device__ __forceinline__ unsigned xb_add(unsigned* p, unsigned v) { return __hip_atomic_fetch_add(p, v, __ATOMIC_RELAXED, __HIP_MEMORY_SCOPE_AGENT); }
__device__ __forceinline__ unsigned xb_xcc_id() { return (unsigned)__builtin_amdgcn_s_getreg((3 << 11) | 20) & 0xFu; }
#define XB_SPIN(cond, bar) do { unsigned _sp = 0; while (cond) { __builtin_amdgcn_s_sleep(1); \
    if ((++_sp & 255u) == 0u) { if (xb_ld(&(bar)[XB_TMO])) break; if (_sp > XB_SPIN_CAP) { atomicAdd(&(bar)[XB_TMO], 1u); break; } } } } while (0)

struct XcdBarrier {
    unsigned* bar; unsigned x;
    volatile LAS unsigned* st;
};

__device__ __forceinline__ XcdBarrier xcd_barrier_post(unsigned* bar, volatile LAS unsigned* st) {
    XcdBarrier b; b.bar = bar; b.x = xb_xcc_id(); b.st = st;
    if (threadIdx.x == 0) (void)xb_add(&bar[XB_XCNT(b.x)], 1u);
    return b;
}
__device__ __forceinline__ void xcd_barrier_complete(unsigned* bar, unsigned x, unsigned& nloc, unsigned& nx) {
    const unsigned G = gridDim.x * gridDim.y * gridDim.z;
    unsigned sum, cnt, mine, sp = 0u;
    for (;;) {
        sum = 0u; cnt = 0u; mine = 0u;
#pragma unroll
        for (unsigned j = 0; j < 16; ++j) { const unsigned c = xb_ld(&bar[XB_XCNT(j)]); sum += c; cnt += (c > 0u) ? 1u : 0u; mine = (j == x) ? c : mine; }
        if (sum == G) break;
        __builtin_amdgcn_s_sleep(1);
        if ((++sp & 255u) == 0u) { if (xb_ld(&bar[XB_TMO])) break; if (sp > XB_SPIN_CAP) { atomicAdd(&bar[XB_TMO], 1u); break; } }
    }
    nloc = mine > 0u ? mine : 1u; nx = cnt > 0u ? cnt : 1u;
}

__device__ __forceinline__ void xcd_barrier(const XcdBarrier& b) {
    asm volatile("s_waitcnt vmcnt(0)" ::: "memory");
    __syncthreads();
    if (threadIdx.x == 0) {
        unsigned* bar = b.bar;
        __builtin_amdgcn_s_waitcnt(0);
        unsigned nloc = b.st[0], nx = b.st[1];
        if (nloc == 0u) { xcd_barrier_complete(bar, b.x, nloc, nx); b.st[0] = nloc; b.st[1] = nx; }
        const unsigned old = xb_add(&bar[XB_XSUB(b.x)], 1u);
        const unsigned gen = old / nloc;
        if (old + 1u == (gen + 1u) * nloc) {
            __builtin_amdgcn_fence(__ATOMIC_RELEASE, "agent");
            asm volatile("s_waitcnt vmcnt(0)" ::: "memory");
            const unsigned og = xb_add(&bar[XB_TOP], 1u);
            const unsigned tg = og / nx;
            if (og + 1u == (tg + 1u) * nx) xb_add(&bar[XB_TOPGEN], 1u);
            else XB_SPIN(xb_ld(&bar[XB_TOPGEN]) == tg, bar);
            __builtin_amdgcn_fence(__ATOMIC_ACQUIRE, "agent");
            xb_add(&bar[XB_XGEN(b.x)], 1u);
            asm volatile("s_waitcnt vmcnt(0)" ::: "memory");
        } else {
            XB_SPIN(xb_ld(&bar[XB_XGEN(b.x)]) == gen, bar);
            __builtin_amdgcn_fence(__ATOMIC_ACQUIRE, "agent");
            asm volatile("s_waitcnt vmcnt(0)" ::: "memory");
        }
    }
    __syncthreads();
}

constexpr int LDS_BAR_OFF = LDS_BYTES - 16;
__global__ void __launch_bounds__(512, 2) k_mega(Args a) {
    extern __shared__ __attribute__((aligned(16))) unsigned char smem[];
    LAS unsigned char* lds = (LAS unsigned char*)smem;
    cg::grid_group grid = cg::this_grid();
    if (threadIdx.x == 0) *(LAS v4u*)(lds + LDS_BAR_OFF) = (v4u){0u, 0u, 0u, 0u};
    __syncthreads();
    XcdBarrier bar = xcd_barrier_post((unsigned*)(a.ws + WS_CTL), (volatile LAS unsigned*)(lds + LDS_BAR_OFF));
    if (a.ph_lo == 0x7fffffff) grid.sync();
    run_phase<0>(a, lds); xcd_barrier(bar);
    run_phase<1>(a, lds); xcd_barrier(bar);
    run_phase<2>(a, lds); xcd_barrier(bar);
    run_phase<3>(a, lds); xcd_barrier(bar);
    run_phase<4>(a, lds); xcd_barrier(bar);
    run_phase<5>(a, lds); xcd_barrier(bar);
    run_phase<6>(a, lds); xcd_barrier(bar);
    run_phase<7>(a, lds); xcd_barrier(bar);
    run_phase<8>(a, lds); xcd_barrier(bar);
    run_phase<9>(a, lds); xcd_barrier(bar);
    run_phase<10>(a, lds); xcd_barrier(bar);
    run_phase<11>(a, lds);
}
}
extern "C" void kernel_launch(void* const* d_in, const int* in_sizes, int n_in, void* d_out, int out_size, void* d_ws, size_t ws_size, hipStream_t stream) {
    if (ws_size < 512 * MiB) return;
    static int grid_blocks = 0;
    if (!grid_blocks) {
        int dev = 0, cus = 0, per_cu = 0;
        (void)hipGetDevice(&dev);
        (void)hipDeviceGetAttribute(&cus, hipDeviceAttributeMultiprocessorCount, dev);
        (void)hipFuncSetAttribute((const void*)k_mega, hipFuncAttributeMaxDynamicSharedMemorySize, LDS_BYTES);
        (void)hipOccupancyMaxActiveBlocksPerMultiprocessor(&per_cu, (const void*)k_mega, 512, LDS_BYTES);
        if (per_cu < 1) per_cu = 1;
        grid_blocks = cus * per_cu;
        if (grid_blocks > 256) grid_blocks = 256;
    }
    (void)hipMemsetAsync((unsigned char*)d_ws + WS_CTL, 0, 16384, stream);
    Args a{};
    for (int i = 0; i < 20; ++i) a.in[i] = (const float*)d_in[i];
    a.out = (float*)d_out; a.ws = (unsigned char*)d_ws;
    void* args[] = {&a};
    (void)hipLaunchCooperativeKernel((const void*)k_mega, dim3(grid_blocks), dim3(512), args, LDS_BYTES, stream);
}
```

```cpp
#include <hip/hip_runtime.h>
#include <hip/hip_cooperative_groups.h>
#include <stdint.h>
#include <type_traits>
namespace cg = cooperative_groups;

#define LAS __attribute__((address_space(3)))
typedef unsigned short bf16;
typedef unsigned v4u __attribute__((ext_vector_type(4)));
typedef unsigned v2u __attribute__((ext_vector_type(2)));
typedef float f4 __attribute__((ext_vector_type(4)));

namespace {
constexpr int D = 1024, NB = 16, SEQ = 2048, T = NB * SEQ, DIN = 8200;
constexpr int NH = 4, DK = 128, DV = 256;
constexpr int C_RQ = 0, C_RK = 512, C_RV = 1024, C_RG = 2048, C_GQ = 3072, C_GK = 3584, C_GV = 4096, C_GZ = 5120,
              C_GA = 6144, C_GB = 6148, C_GTA = 6152, C_GTB = 7176;
constexpr int NE = 16, FF = 512;
constexpr int MAXSLOT = 2 * T + NE * 256;
constexpr int PW = 6144, P_RQ = 0, P_RK = 512, P_RV = 1024, P_GQ = 2048, P_GK = 2560, P_GV = 3072, P_GA = 4096, P_GB = 5120;

constexpr size_t MiB = 1u << 20;
constexpr size_t WS_PROJ = 0;
constexpr size_t WS_MERGED = 384 * MiB;
constexpr size_t WS_WTOUT = 448 * MiB;
constexpr size_t WS_CTL = 450 * MiB;
constexpr size_t WS_MOD = 450 * MiB + 64 * 1024;
constexpr size_t WS_ROPE = 451 * MiB;
constexpr size_t WS_BETA = 452 * MiB;
constexpr size_t WS_G = 452 * MiB + 512 * 1024;
constexpr size_t WS_TOKE = 453 * MiB;
constexpr size_t WS_TOKW = 453 * MiB + 256 * 1024;
constexpr size_t WS_TOKS = 453 * MiB + 512 * 1024;
constexpr size_t WS_HIST = 453 * MiB + 768 * 1024;
constexpr size_t WS_META = 453 * MiB + 832 * 1024;
constexpr size_t WS_SSQ = 455 * MiB;
constexpr size_t WS_SLOTTOK = 404 * MiB;
constexpr size_t WS_READY = WS_CTL + 16384;
constexpr size_t WS_ECNT = WS_CTL + 14080;
constexpr size_t WS_WTGU = 456 * MiB;
constexpr size_t WS_WTD = 488 * MiB;
constexpr size_t WS_XF = 0;
constexpr size_t WS_DLT = 64 * MiB;
constexpr size_t WS_HB = 128 * MiB;
constexpr size_t WS_ACT = 200 * MiB;
constexpr size_t WS_Y = 268 * MiB;
constexpr size_t WS_NEED = 504 * MiB;
constexpr size_t DO_XM = 0;
constexpr size_t DO_WTIN = 64 * MiB;
constexpr int LDS_BYTES = 147456;

__device__ __forceinline__ float silu_f(float x) { return x / (1.0f + expf(-x)); }
__device__ __forceinline__ float sigmoid_f(float x) { return 1.0f / (1.0f + expf(-x)); }
__device__ __forceinline__ float fsigmoid(float x) { return __builtin_amdgcn_rcpf(1.0f + __expf(-x)); }
template <int CTRL> __device__ __forceinline__ float dpp_mov(float v) { return __builtin_bit_cast(float, __builtin_amdgcn_update_dpp(0, __builtin_bit_cast(int, v), CTRL, 0xF, 0xF, false)); }
__device__ __forceinline__ float row_sum16(float v) {
    v += dpp_mov<0xB1>(v);
    v += dpp_mov<0x4E>(v);
    v += dpp_mov<0x141>(v);
    v += dpp_mov<0x140>(v);
    return v;
}
__device__ __forceinline__ float wave_sum(float v) { v = row_sum16(v); v += __shfl_xor(v, 16); v += __shfl_xor(v, 32); return v; }
typedef __bf16 bf2v_ __attribute__((ext_vector_type(2)));
typedef float f2v_ __attribute__((ext_vector_type(2)));
__device__ __forceinline__ unsigned pkh(float lo, float hi) { const f2v_ v = {lo, hi}; return __builtin_bit_cast(unsigned, __builtin_convertvector(v, bf2v_)); }
__device__ __forceinline__ unsigned f2bf(float f) { unsigned u = __float_as_uint(f); return (u + 0x7fffu + ((u >> 16) & 1u)) >> 16; }
__device__ __forceinline__ unsigned pk2(float lo, float hi) { return f2bf(lo) | (f2bf(hi) << 16); }
__device__ __forceinline__ float bf2f(unsigned short b) { return __uint_as_float(((unsigned)b) << 16); }
__device__ __forceinline__ float bflo(unsigned w) { return __uint_as_float(w << 16); }
__device__ __forceinline__ float bfhi(unsigned w) { return __uint_as_float(w & 0xffff0000u); }

struct Args { const float* in[20]; float* out; unsigned char* ws; int ph_lo, ph_hi; };
}
namespace pg8 {
#define PG8_LAS __attribute__((address_space(3)))
typedef unsigned short bf16_t;
typedef short bf16x8 __attribute__((ext_vector_type(8)));
typedef float f32x4 __attribute__((ext_vector_type(4)));
typedef unsigned u32x4 __attribute__((ext_vector_type(4)));
constexpr int BM = 256, BK = 64, HALF = 128, HTB = HALF * BK * 2  , STAGE_BYTES = 8 * HTB, NXCD = 8, WGM = 8;

__host__ __device__ __forceinline__ int lds_byte(int r, int c) { const int st = (r >> 4) * 2 + (c >> 5), rr = r & 15, cc = c & 31, ob = rr * 64 + cc * 2; return st * 1024 + (ob ^ (((ob >> 9) & 1) << 5)); }
__host__ __device__ __forceinline__ void stage_rc(int b, int& R, int& C) { const int st = b / 1024, sb = b % 1024, swz = sb ^ (((sb >> 9) & 1) << 5); R = (st >> 1) * 16 + swz / 64; C = (st & 1) * 32 + (swz % 64) / 2; }
__host__ __device__ __forceinline__ int perm32(int rho) { const int n = rho >> 4, i = rho & 15; return 8 * (i >> 2) + 4 * n + (i & 3); }

struct Unit { int pm, pn; };
struct Gemm { const bf16_t* A; const bf16_t* Bt; int M, N, K; };

struct StaticOrder {
    int nM, nN, nwg, G, c, wgm;
    __host__ __device__ void init(int M, int N, int G_, int c_, int wgm_ = WGM) { nM = M / BM; nN = N / BM; nwg = nM * nN; G = G_; c = c_; wgm = wgm_; }
    __host__ __device__ bool next(int i, Unit& u) const {
        const long L = (long)i * G + c; if (L >= nwg) return false;
        int wgid = (int)L; { const int q = nwg / NXCD, r = nwg % NXCD, xcd = wgid % NXCD, off = wgid / NXCD; wgid = (xcd < r ? xcd * (q + 1) : r * (q + 1) + (xcd - r) * q) + off; }
        const int nig = wgm * nN, gid = wgid / nig, fm = gid * wgm, gsz = (nM - fm) < wgm ? (nM - fm) : wgm;
        u.pm = fm + ((wgid % nig) % gsz); u.pn = (wgid % nig) / gsz; return true;
    }
    __device__ __forceinline__ void a_ready(const Unit&) const {}
    __device__ __forceinline__ void done(const Unit&) const {}
};

__device__ __forceinline__ unsigned cvt_pk_bf16(float lo, float hi) { unsigned r; asm volatile("v_cvt_pk_bf16_f32 %0, %1, %2" : "=v"(r) : "v"(lo), "v"(hi)); return r; }
__device__ __forceinline__ float fsig(float x) { return __builtin_amdgcn_rcpf(1.0f + __expf(-x)); }

struct EpiProj {
    static constexpr bool PERM = true, AFTER_DRAIN = false;
    bf16_t* P; int pw; const float* rope;
    __device__ __forceinline__ void operator()(const f32x4 (&acc)[2][2][4][2], const Unit& u, int wr, int wc, int fr, int fq) const {
        const int row0 = u.pm * BM + wr * 64 + fr;
        if (u.pn < 4) {
            const int isk = u.pn >> 1, head = 2 * (u.pn & 1) + (wc >> 1), i0 = 32 * (wc & 1) + 8 * fq;
            const float lgam = __logf(1.0f - exp2f(-5.0f - (float)head));
            bf16_t* base = P + (isk ? 512 : 0) + head * 128 + i0;
#pragma unroll
            for (int ai = 0; ai < 2; ++ai)
#pragma unroll
                for (int m = 0; m < 4; ++m) { const int row = row0 + ai * HALF + m * 16, tl = row & 2047;
                    const f32x4* rp = (const f32x4*)(rope + (size_t)(tl * 64 + i0) * 2);
                    const f32x4 c0 = rp[0], c1 = rp[1], c2 = rp[2], c3 = rp[3];
                    const float cs[8] = {c0[0], c0[2], c1[0], c1[2], c2[0], c2[2], c3[0], c3[2]}, sn[8] = {c0[1], c0[3], c1[1], c1[3], c2[1], c2[3], c3[1], c3[3]};
                    const float sc = isk ? 0.08838834764831845f : __expf((float)((tl & 63) + 1) * lgam);
                    float o1[8], o2[8];
#pragma unroll
                    for (int n = 0; n < 2; ++n)
#pragma unroll
                        for (int j = 0; j < 4; ++j) { const float x1 = acc[ai][0][m][n][j], x2 = acc[ai][1][m][n][j]; const int q = 4 * n + j;
                            o1[q] = (x1 * cs[q] - x2 * sn[q]) * sc; o2[q] = (x1 * sn[q] + x2 * cs[q]) * sc; }
                    u32x4 w1, w2; w1.x = cvt_pk_bf16(o1[0], o1[1]); w1.y = cvt_pk_bf16(o1[2], o1[3]); w1.z = cvt_pk_bf16(o1[4], o1[5]); w1.w = cvt_pk_bf16(o1[6], o1[7]);
                    w2.x = cvt_pk_bf16(o2[0], o2[1]); w2.y = cvt_pk_bf16(o2[2], o2[3]); w2.z = cvt_pk_bf16(o2[4], o2[5]); w2.w = cvt_pk_bf16(o2[6], o2[7]);
                    bf16_t* rowp = base + (size_t)row * pw;
                    *(u32x4*)rowp = w1; *(u32x4*)(rowp + 64) = w2; }
        } else if (u.pn < 16) {
            const int col0 = u.pn * BM + wc * 32 + 8 * fq;
#pragma unroll
            for (int ai = 0; ai < 2; ++ai)
#pragma unroll
                for (int m = 0; m < 4; ++m) { bf16_t* rowp = P + (size_t)(row0 + ai * HALF + m * 16) * pw + col0;
#pragma unroll
                    for (int bj = 0; bj < 2; ++bj) { const f32x4 v0 = acc[ai][bj][m][0], v1 = acc[ai][bj][m][1];
                        u32x4 w; w.x = cvt_pk_bf16(v0[0], v0[1]); w.y = cvt_pk_bf16(v0[2], v0[3]); w.z = cvt_pk_bf16(v1[0], v1[1]); w.w = cvt_pk_bf16(v1[2], v1[3]);
                        *(u32x4*)(rowp + bj * HALF) = w; } }
        } else {
            const int col0 = 4096 + (u.pn - 16) * 128 + wc * 32 + 8 * fq;
#pragma unroll
            for (int ai = 0; ai < 2; ++ai)
#pragma unroll
                for (int m = 0; m < 4; ++m) { bf16_t* rowp = P + (size_t)(row0 + ai * HALF + m * 16) * pw + col0;
                    float o[8];
#pragma unroll
                    for (int n = 0; n < 2; ++n)
#pragma unroll
                        for (int j = 0; j < 4; ++j) { const float g = acc[ai][0][m][n][j], s = acc[ai][1][m][n][j]; o[n * 4 + j] = g * __builtin_amdgcn_rcpf((1.0f + __expf(-g)) * (1.0f + __expf(-s))); }
                    u32x4 w; w.x = cvt_pk_bf16(o[0], o[1]); w.y = cvt_pk_bf16(o[2], o[3]); w.z = cvt_pk_bf16(o[4], o[5]); w.w = cvt_pk_bf16(o[6], o[7]);
                    *(u32x4*)rowp = w; }
        }
    }
};
struct EpiH {
    static constexpr bool PERM = false, AFTER_DRAIN = false;
    const float* x; const float* mod; float* h;
    __device__ __forceinline__ void operator()(const f32x4 (&acc)[2][2][4][2], const Unit& u, int wr, int wc, int fr, int fq) const {
        const int row0 = u.pm * BM + wr * 64 + fr, col0 = u.pn * BM + wc * 32 + 4 * fq;
        const int b = (u.pm * BM) / 2048;
        f32x4 gv[2][2];
#pragma unroll
        for (int bj = 0; bj < 2; ++bj)
#pragma unroll
            for (int n = 0; n < 2; ++n) gv[bj][n] = *(const f32x4*)(mod + (size_t)b * 6144 + 2048 + col0 + bj * HALF + n * 16);
#pragma unroll
        for (int ai = 0; ai < 2; ++ai)
#pragma unroll
            for (int mp = 0; mp < 2; ++mp) {
                f32x4 xv[2][2][2];
#pragma unroll
                for (int mm = 0; mm < 2; ++mm) { const size_t off = (size_t)(row0 + ai * HALF + (2 * mp + mm) * 16) * 1024 + col0;
#pragma unroll
                    for (int bj = 0; bj < 2; ++bj)
#pragma unroll
                        for (int n = 0; n < 2; ++n) xv[mm][bj][n] = *(const f32x4*)(x + off + bj * HALF + n * 16); }
#pragma unroll
                for (int mm = 0; mm < 2; ++mm) { const size_t off = (size_t)(row0 + ai * HALF + (2 * mp + mm) * 16) * 1024 + col0;
#pragma unroll
                    for (int bj = 0; bj < 2; ++bj)
#pragma unroll
                        for (int n = 0; n < 2; ++n) *(f32x4*)(h + off + bj * HALF + n * 16) = xv[mm][bj][n] + gv[bj][n] * acc[ai][bj][2 * mp + mm][n]; }
                asm volatile("" ::: "memory"); }
    }
};
struct EpiD {
    static constexpr bool PERM = true, AFTER_DRAIN = false;
    const float* mod; bf16_t* d;
    __device__ __forceinline__ void operator()(const f32x4 (&acc)[2][2][4][2], const Unit& u, int wr, int wc, int fr, int fq) const {
        const int row0 = u.pm * BM + wr * 64 + fr, col0 = u.pn * BM + wc * 32 + 8 * fq;
        const int b = (u.pm * BM) / 2048;
        f32x4 gv[2][2];
#pragma unroll
        for (int bj = 0; bj < 2; ++bj)
#pragma unroll
            for (int n = 0; n < 2; ++n) gv[bj][n] = *(const f32x4*)(mod + (size_t)b * 6144 + 2048 + col0 + bj * HALF + n * 4);
#pragma unroll
        for (int ai = 0; ai < 2; ++ai)
#pragma unroll
            for (int m = 0; m < 4; ++m) { bf16_t* rowp = d + (size_t)(row0 + ai * HALF + m * 16) * 1024 + col0;
#pragma unroll
                for (int bj = 0; bj < 2; ++bj) { const f32x4 v0 = acc[ai][bj][m][0] * gv[bj][0], v1 = acc[ai][bj][m][1] * gv[bj][1];
                    u32x4 w; w.x = cvt_pk_bf16(v0[0], v0[1]); w.y = cvt_pk_bf16(v0[2], v0[3]); w.z = cvt_pk_bf16(v1[0], v1[1]); w.w = cvt_pk_bf16(v1[2], v1[3]);
                    *(u32x4*)(rowp + bj * HALF) = w; } }
    }
};
struct EpiAct {
    static constexpr bool PERM = true, AFTER_DRAIN = false;
    __amdgpu_buffer_rsrc_t rs;
    __device__ __forceinline__ void operator()(const f32x4 (&acc)[2][2][4][2], const Unit& u, int wr, int wc, int fr, int fq) const {
        const int row0 = u.pm * BM + wr * 64 + fr, col0 = (u.pn & 3) * 128 + wc * 32 + 8 * fq;
#pragma unroll
        for (int ai = 0; ai < 2; ++ai)
#pragma unroll
            for (int m = 0; m < 4; ++m) { const unsigned boff = (unsigned)((row0 + ai * HALF + m * 16) * 512 + col0) * 2u;
                float o[8];
#pragma unroll
                for (int n = 0; n < 2; ++n)
#pragma unroll
                    for (int j = 0; j < 4; ++j) { const float g = acc[ai][0][m][n][j], up = acc[ai][1][m][n][j]; o[n * 4 + j] = g * fsig(g) * up; }
                u32x4 w; w.x = cvt_pk_bf16(o[0], o[1]); w.y = cvt_pk_bf16(o[2], o[3]); w.z = cvt_pk_bf16(o[4], o[5]); w.w = cvt_pk_bf16(o[6], o[7]);
                __builtin_amdgcn_raw_buffer_store_b128(w, rs, boff, 0,   16); }
    }
};
struct EpiY {
    static constexpr bool PERM = true, AFTER_DRAIN = false;
    bf16_t* y;
    __device__ __forceinline__ void operator()(const f32x4 (&acc)[2][2][4][2], const Unit& u, int wr, int wc, int fr, int fq) const {
        const int row0 = u.pm * BM + wr * 64 + fr, col0 = (u.pn & 3) * BM + wc * 32 + 8 * fq;
#pragma unroll
        for (int ai = 0; ai < 2; ++ai)
#pragma unroll
            for (int m = 0; m < 4; ++m) { bf16_t* rowp = y + (size_t)(row0 + ai * HALF + m * 16) * 1024 + col0;
#pragma unroll
                for (int bj = 0; bj < 2; ++bj) { const f32x4 v0 = acc[ai][bj][m][0], v1 = acc[ai][bj][m][1];
                    u32x4 w; w.x = cvt_pk_bf16(v0[0], v0[1]); w.y = cvt_pk_bf16(v0[2], v0[3]); w.z = cvt_pk_bf16(v1[0], v1[1]); w.w = cvt_pk_bf16(v1[2], v1[3]);
                    *(u32x4*)(rowp + bj * HALF) = w; } }
    }
};
__device__ __forceinline__ void moe_table(PG8_LAS int* tab, const int* ecnt, int tid) {
    int cnt[16], tb[17]; tb[0] = 0;
#pragma unroll
    for (int e = 0; e < 16; ++e) { cnt[e] = __builtin_amdgcn_readfirstlane(ecnt[e]); tb[e + 1] = tb[e] + ((cnt[e] + 255) >> 8); }
    if (tid == 0) tab[0] = tb[16];
    if (tid < 16) { int v = 0;
#pragma unroll
        for (int e = 0; e < 16; ++e) v = (tid == e) ? tb[e] : v;
        tab[16 + tid] = v; }
    if (tid < 320) { int e_ = 0, lt = 0, c_ = 0;
#pragma unroll
        for (int e = 0; e < 16; ++e) if (tid >= tb[e] && tid < tb[e + 1]) { e_ = e; lt = tid - tb[e]; c_ = cnt[e]; }
        tab[64 + tid] = e_; tab[384 + tid] = e_ * 32768 + lt * 256; tab[704 + tid] = (tid < tb[16]) ? c_ - lt * 256 : 0; }
}
template <int MODE> struct MoeOrderT {
    const PG8_LAS int* tab; unsigned* ready; int nwg, G, c; mutable unsigned pre; mutable int prepm;
    __device__ void init(const PG8_LAS int* tab_, unsigned* ready_, int G_, int c_) { tab = tab_; ready = ready_; nwg = tab_[0] * 4; G = G_; c = c_; pre = 0u; prepm = -1; }
    __device__ bool next(int i, Unit& u) const {
        long L = (long)i * G + c;
        if constexpr (MODE == 2) {
            const int q = nwg / G, r = nwg % G;
            if (q >= 1 && i >= q - 1) { const int k = i - (q - 1), base = (q - 1) * G, n1 = G - r, p0 = (c - r + G) % G; int cnt = 0; L = -1;
                if (c >= r) { if (k == cnt) L = base + (c - r); ++cnt; }
                if (p0 < 2 * r) { if (k == cnt) L = base + n1 + p0; ++cnt; if (p0 + G < 2 * r) { if (k == cnt) L = base + n1 + p0 + G; ++cnt; } }
                if (L < 0) return false; }
        }
        if (L >= nwg) return false;
        int wgid = (int)L; { const int q = nwg / NXCD, r = nwg % NXCD, xcd = wgid % NXCD, off = wgid / NXCD; wgid = (xcd < r ? xcd * (q + 1) : r * (q + 1) + (xcd - r) * q) + off; }
        u.pm = wgid >> 2; u.pn = __builtin_amdgcn_readfirstlane(tab[64 + u.pm]) * 4 + (wgid & 3);
        if constexpr (MODE == 2) { pre = __hip_atomic_load(ready + 32 * u.pm, __ATOMIC_RELAXED, __HIP_MEMORY_SCOPE_AGENT); prepm = u.pm; }
        return true;
    }
    __device__ __forceinline__ void a_ready(const Unit& u) const {
        if constexpr (MODE == 2) {
            if (threadIdx.x < 64) {
                unsigned sp = 0u;
                if (!(prepm == u.pm && (unsigned)__builtin_amdgcn_readfirstlane(pre) >= 32u))
                while ((unsigned)__builtin_amdgcn_readfirstlane(__hip_atomic_load(ready + 32 * u.pm, __ATOMIC_RELAXED, __HIP_MEMORY_SCOPE_AGENT)) < 32u) { __builtin_amdgcn_s_sleep(1); if (++sp > (1u << 18)) break; }
            }
            asm volatile("" ::: "memory"); __builtin_amdgcn_s_barrier(); asm volatile("" ::: "memory");
        }
    }
    __device__ __forceinline__ void done(const Unit& u) const {
        if constexpr (MODE == 1) {
            asm volatile("s_waitcnt vmcnt(0)" ::: "memory");
            if ((threadIdx.x & 63) == 0) (void)__hip_atomic_fetch_add(ready + 32 * u.pm, 1u, __ATOMIC_RELAXED, __HIP_MEMORY_SCOPE_AGENT);
        }
    }
};
struct NoGather { static constexpr bool ON = false; const int* slot_tok; const PG8_LAS int* tab; };
struct RowGather { static constexpr bool ON = true; const int* slot_tok; const PG8_LAS int* tab; };
template <class Epi, class Sched, bool ALIGN_EPI = false, bool SP2 = false, class AG = NoGather>
__device__ __forceinline__ void gemm_phase(PG8_LAS unsigned char* lds, const Gemm g, const Sched& S, const Epi& E, const AG ag = AG{nullptr, nullptr}) {
    int tid = threadIdx.x; asm volatile("" : "+v"(tid));
    const int wid = __builtin_amdgcn_readfirstlane(tid >> 6), lane = tid & 63, wr = wid >> 2, wc = wid & 3, fr = lane & 15, fq = lane >> 4;
    const int K = g.K, nt = K / BK;
    unsigned voffA[2], voffB[2]; int rowA[2], colA[2];
#pragma unroll
    for (int i = 0; i < 2; ++i) { int R, C; stage_rc(tid * 16 + i * 8192, R, C); const int Rb = Epi::PERM ? ((R & ~31) + perm32(R & 31)) : R;
        voffA[i] = (unsigned)(R * K + C) * 2u; voffB[i] = (unsigned)(Rb * K + C) * 2u; rowA[i] = R; colA[i] = C; }
    unsigned gC[2][2] = {{0u, 0u}, {0u, 0u}}, gN[2][2] = {{0u, 0u}, {0u, 0u}};
    const size_t kstep = (size_t)(BK * 2);
    const size_t hstep = (size_t)HALF * K * 2;
    const size_t tstep = 2 * hstep;
    const unsigned ldsw = (unsigned)wid * 1024u;
    const int aoff = lds_byte(wr * 64 + fr, fq * 8), boff = lds_byte(wc * 32 + fr, fq * 8);
#define PG8_SA(b, h) (((b) * 2 + (h)) * HTB)
#define PG8_SB(b, h) ((4 + (b) * 2 + (h)) * HTB)
#define PG8_STAGE(bufoff, gbase, voff) do { _Pragma("unroll") for (int _i = 0; _i < 2; ++_i) \
        __builtin_amdgcn_global_load_lds((const unsigned*)((const char*)(gbase) + (voff)[_i]), (PG8_LAS unsigned*)(lds + (bufoff) + ldsw + _i * 8192), 16, 0, 0); } while (0)
#define PG8_STAGE_A(bufoff, H, KOFF, NEXT) do { _Pragma("unroll") for (int _i = 0; _i < 2; ++_i) { const char* _p; \
        if constexpr (AG::ON) _p = (const char*)g.A + ((NEXT) ? gN[H][_i] : gC[H][_i]) + (KOFF); else _p = ((NEXT) ? nA : cA) + (size_t)(H) * hstep + voffA[_i] + (KOFF); \
        __builtin_amdgcn_global_load_lds((const unsigned*)_p, (PG8_LAS unsigned*)(lds + (bufoff) + ldsw + _i * 8192), 16, 0, 0); } } while (0)
#define PG8_GATHER(dst, U) do { if constexpr (AG::ON) { _Pragma("unroll") for (int _h = 0; _h < 2; ++_h) _Pragma("unroll") for (int _i = 0; _i < 2; ++_i) { \
        const int _r = _h * HALF + rowA[_i]; int _t = 0; if (_r < ag.tab[704 + (U).pm]) _t = ag.slot_tok[ag.tab[384 + (U).pm] + _r]; dst[_h][_i] = (unsigned)(_t * K + colA[_i]) * 2u; } } } while (0)
#define PG8_LDA(dst, b, h) do { _Pragma("unroll") for (int m = 0; m < 4; ++m) _Pragma("unroll") for (int k = 0; k < 2; ++k) dst[m][k] = *(const PG8_LAS bf16x8*)(lds + PG8_SA(b, h) + aoff + m * 2048 + k * 1024); } while (0)
#define PG8_LDB(dst, b, h) do { _Pragma("unroll") for (int n = 0; n < 2; ++n) _Pragma("unroll") for (int k = 0; k < 2; ++k) dst[n][k] = *(const PG8_LAS bf16x8*)(lds + PG8_SB(b, h) + boff + n * 2048 + k * 1024); } while (0)
#define PG8_MMA(ai, bj, At, Bt) do { __builtin_amdgcn_s_setprio(1); _Pragma("unroll") for (int m = 0; m < 4; ++m) _Pragma("unroll") for (int n = 0; n < 2; ++n) _Pragma("unroll") for (int k = 0; k < 2; ++k) \
        acc[ai][bj][m][n] = __builtin_amdgcn_mfma_f32_16x16x32_bf16(Bt[n][k], At[m][k], acc[ai][bj][m][n], 0, 0, 0); __builtin_amdgcn_s_setprio(0); } while (0)
#define PG8_WAIT_V(n) asm volatile("s_waitcnt vmcnt(" #n ")" ::: "memory")
#define PG8_WAIT_L(n) asm volatile("s_waitcnt lgkmcnt(" #n ")" ::: "memory")
#define PG8_BAR __builtin_amdgcn_s_barrier()
#define PG8_SCHED __builtin_amdgcn_sched_barrier(0)
    Unit cur, nxt; int ui = 0;
    if (!S.next(0, cur)) return;
    f32x4 acc[2][2][4][2];
#pragma unroll
    for (int a = 0; a < 2; ++a)
#pragma unroll
        for (int b = 0; b < 2; ++b)
#pragma unroll
            for (int m = 0; m < 4; ++m)
#pragma unroll
                for (int n = 0; n < 2; ++n) acc[a][b][m][n] = (f32x4){0.f, 0.f, 0.f, 0.f};
    bf16x8 At[4][2], B0[2][2], B1[2][2];
    const char* cA = (const char*)g.A + (size_t)cur.pm * tstep; const char* cB = (const char*)g.Bt + (size_t)cur.pn * tstep;
    S.a_ready(cur);
    PG8_GATHER(gC, cur);
    { const char* nA = cA; (void)nA;
    if constexpr (SP2) {
        PG8_STAGE(PG8_SB(0, 0), cB, voffB); PG8_STAGE(PG8_SB(0, 1), cB + hstep, voffB); PG8_STAGE_A(PG8_SA(0, 0), 0, 0, false); PG8_STAGE_A(PG8_SA(0, 1), 1, 0, false);
        if (wr == 1) PG8_BAR;
        PG8_WAIT_V(2); PG8_BAR;
        PG8_STAGE(PG8_SB(1, 0), cB + kstep, voffB); PG8_STAGE_A(PG8_SA(1, 0), 0, kstep, false); PG8_STAGE(PG8_SB(1, 1), cB + hstep + kstep, voffB);
        PG8_WAIT_V(6); PG8_BAR;
    } else {
        PG8_STAGE(PG8_SB(0, 0), cB, voffB); PG8_STAGE_A(PG8_SA(0, 0), 0, 0, false); PG8_STAGE(PG8_SB(0, 1), cB + hstep, voffB); PG8_STAGE_A(PG8_SA(0, 1), 1, 0, false);
        if (wr == 1) PG8_BAR;
        PG8_WAIT_V(4); PG8_BAR;
        PG8_STAGE(PG8_SB(1, 0), cB + kstep, voffB); PG8_STAGE_A(PG8_SA(1, 0), 0, kstep, false); PG8_STAGE(PG8_SB(1, 1), cB + hstep + kstep, voffB);
        PG8_WAIT_V(6); PG8_BAR;
    }
    }
    for (;;) {
        const bool has_next = S.next(ui + 1, nxt);
        const char* nA = has_next ? (const char*)g.A + (size_t)nxt.pm * tstep : cA; const char* nB = has_next ? (const char*)g.Bt + (size_t)nxt.pn * tstep : cB;
        if constexpr (AG::ON) { if (has_next) { PG8_GATHER(gN, nxt); } else { gN[0][0] = gC[0][0]; gN[0][1] = gC[0][1]; gN[1][0] = gC[1][0]; gN[1][1] = gC[1][1]; } }
        for (int t = 0; t < nt; t += 2) {
            const bool last = (t == nt - 2);
            const char* a1 = cA + (size_t)(t + 1) * kstep;
            const char* a2 = last ? nA : cA + (size_t)(t + 2) * kstep; const char* b2 = last ? nB : cB + (size_t)(t + 2) * kstep;
            const char* a3 = a2 + kstep; const char* b3 = b2 + kstep;
            const size_t k1 = (size_t)(t + 1) * kstep, k2 = last ? (size_t)0 : (size_t)(t + 2) * kstep, k3 = k2 + kstep; (void)a1; (void)a2; (void)a3;
            if (last && has_next) S.a_ready(nxt);
            if constexpr (SP2) {
            PG8_LDB(B0, 0, 0); PG8_LDB(B1, 0, 1); PG8_SCHED; PG8_LDA(At, 0, 0); PG8_STAGE_A(PG8_SA(1, 1), 1, k1, false);
            PG8_WAIT_V(8); PG8_WAIT_L(0); PG8_BAR; PG8_MMA(0, 0, At, B0); PG8_MMA(0, 1, At, B1); PG8_BAR; PG8_SCHED;
            PG8_LDA(At, 0, 1); PG8_STAGE(PG8_SB(0, 0), b2, voffB); PG8_STAGE(PG8_SB(0, 1), b2 + hstep, voffB); PG8_STAGE_A(PG8_SA(0, 0), 0, k2, last);
            PG8_WAIT_V(8); PG8_WAIT_L(0); PG8_BAR; PG8_MMA(1, 0, At, B0); PG8_MMA(1, 1, At, B1); PG8_BAR; PG8_SCHED;
            PG8_LDB(B0, 1, 0); PG8_LDB(B1, 1, 1); PG8_SCHED; PG8_LDA(At, 1, 0); PG8_STAGE_A(PG8_SA(0, 1), 1, k2, last);
            PG8_WAIT_V(8); PG8_WAIT_L(0); PG8_BAR; PG8_MMA(0, 0, At, B0); PG8_MMA(0, 1, At, B1); PG8_BAR; PG8_SCHED;
            PG8_LDA(At, 1, 1); PG8_STAGE(PG8_SB(1, 0), b3, voffB); PG8_STAGE(PG8_SB(1, 1), b3 + hstep, voffB); PG8_STAGE_A(PG8_SA(1, 0), 0, k3, last);
            PG8_WAIT_V(8); PG8_WAIT_L(0); PG8_BAR; PG8_MMA(1, 0, At, B0); PG8_MMA(1, 1, At, B1); PG8_BAR; PG8_SCHED;
            } else {
            PG8_LDB(B0, 0, 0); PG8_SCHED; PG8_LDA(At, 0, 0); PG8_STAGE_A(PG8_SA(1, 1), 1, k1, false);
            PG8_WAIT_L(8); PG8_BAR; PG8_WAIT_L(0); PG8_MMA(0, 0, At, B0); PG8_BAR; PG8_SCHED;
            PG8_LDB(B1, 0, 1); PG8_STAGE(PG8_SB(0, 0), b2, voffB);
            PG8_BAR; PG8_WAIT_L(0); PG8_MMA(0, 1, At, B1); PG8_BAR;
            PG8_LDA(At, 0, 1); PG8_STAGE_A(PG8_SA(0, 0), 0, k2, last);
            PG8_BAR; PG8_WAIT_L(0); PG8_MMA(1, 0, At, B0); PG8_BAR; PG8_SCHED;
            PG8_STAGE(PG8_SB(0, 1), b2 + hstep, voffB);
            PG8_WAIT_V(6); PG8_BAR; PG8_MMA(1, 1, At, B1); PG8_BAR;
            PG8_LDB(B0, 1, 0); PG8_SCHED; PG8_LDA(At, 1, 0); PG8_STAGE_A(PG8_SA(0, 1), 1, k2, last);
            PG8_WAIT_L(8); PG8_BAR; PG8_WAIT_L(0); PG8_MMA(0, 0, At, B0); PG8_BAR; PG8_SCHED;
            PG8_LDB(B1, 1, 1); PG8_STAGE(PG8_SB(1, 0), b3, voffB);
            PG8_BAR; PG8_WAIT_L(0); PG8_MMA(0, 1, At, B1); PG8_BAR;
            PG8_LDA(At, 1, 1); PG8_STAGE_A(PG8_SA(1, 0), 0, k3, last);
            PG8_BAR; PG8_WAIT_L(0); PG8_MMA(1, 0, At, B0); PG8_BAR; PG8_SCHED;
            PG8_STAGE(PG8_SB(1, 1), b3 + hstep, voffB);
            PG8_WAIT_V(6); PG8_BAR; PG8_MMA(1, 1, At, B1); PG8_BAR;
            }
        }
        if constexpr (ALIGN_EPI) { if (wr == 0) PG8_BAR; }
        if constexpr (!Epi::AFTER_DRAIN) { E(acc, cur, wr, wc, fr, fq); S.done(cur); }
        if (!has_next) break;
#pragma unroll
        for (int a = 0; a < 2; ++a)
#pragma unroll
            for (int b = 0; b < 2; ++b)
#pragma unroll
                for (int m = 0; m < 4; ++m)
#pragma unroll
                    for (int n = 0; n < 2; ++n) acc[a][b][m][n] = (f32x4){0.f, 0.f, 0.f, 0.f};
        cur = nxt; cA = nA; cB = nB; ++ui;
        if constexpr (AG::ON) { gC[0][0] = gN[0][0]; gC[0][1] = gN[0][1]; gC[1][0] = gN[1][0]; gC[1][1] = gN[1][1]; }
        if constexpr (ALIGN_EPI) { if (wr == 1) PG8_BAR; }
    }
    PG8_WAIT_V(0);
    if constexpr (!ALIGN_EPI) { if (wr == 0) PG8_BAR; }
    PG8_BAR;
    if constexpr (Epi::AFTER_DRAIN) { E.fused(acc, cur, wr, wc, fr, fq, lds, wid, lane); S.done(cur); }
#undef PG8_SA
#undef PG8_SB
#undef PG8_STAGE
#undef PG8_STAGE_A
#undef PG8_GATHER
#undef PG8_LDA
#undef PG8_LDB
#undef PG8_MMA
#undef PG8_WAIT_V
#undef PG8_WAIT_L
#undef PG8_BAR
#undef PG8_SCHED
}
}
namespace {
__device__ __forceinline__ int tidx() { int t = threadIdx.x; asm volatile("" : "+v"(t)); return t; }
__device__ __forceinline__ void phase_mod_part(const Args& a, LAS unsigned char* lds, int part, int nparts) {
    LAS float* sc = (LAS float*)lds;
    LAS float* part_s = (LAS float*)(lds + 65536);
    const float* c = a.in[1]; const float* mw = a.in[2]; const float* mb = a.in[3];
    float* mod = (float*)(a.ws + WS_MOD);
    const int tid = tidx(), lane = tid & 63, wave = tid >> 6;
    for (int i = tid; i < 16 * 1024; i += 512) sc[i] = silu_f(c[i]);
    __syncthreads();
    for (int cgp = part; cgp < 96; cgp += nparts) {
        const int j0 = cgp * 64;
        float acc[16];
#pragma unroll
        for (int b = 0; b < 16; ++b) acc[b] = 0.f;
        const float* wp = mw + (size_t)(wave * 128) * 6144 + j0 + lane;
#pragma unroll 2
        for (int kk = 0; kk < 128; kk += 8) {
            float w[8];
#pragma unroll
            for (int i = 0; i < 8; ++i) w[i] = wp[(size_t)(kk + i) * 6144];
#pragma unroll
            for (int b = 0; b < 16; ++b) { const f4 s0 = *(const LAS f4*)(sc + b * 1024 + wave * 128 + kk), s1 = *(const LAS f4*)(sc + b * 1024 + wave * 128 + kk + 4);
                acc[b] += s0.x * w[0] + s0.y * w[1] + s0.z * w[2] + s0.w * w[3] + s1.x * w[4] + s1.y * w[5] + s1.z * w[6] + s1.w * w[7]; }
        }
#pragma unroll
        for (int b = 0; b < 16; ++b) part_s[(wave * 16 + b) * 64 + lane] = acc[b];
        __syncthreads();
        for (int q = tid; q < 1024; q += 512) { const int b = q >> 6, cc = q & 63; float sum = mb[j0 + cc];
#pragma unroll
            for (int w8 = 0; w8 < 8; ++w8) sum += part_s[(w8 * 16 + b) * 64 + cc];
            mod[b * 6144 + j0 + cc] = sum; }
        __syncthreads();
    }
}

__device__ __forceinline__ void phase_norm1(const Args& a, LAS unsigned char* lds) {
    LAS f4* wgA = (LAS f4*)lds;
    LAS f4* wgB = (LAS f4*)(lds + 16384);
    LAS float* dots = (LAS float*)(lds + 32768);
    const float* x = a.in[0]; const float* nw = a.in[4]; const float* w_in = a.in[5]; const float* a_log = a.in[7]; const float* dt_bias = a.in[8];
    const float* mod = (const float*)(a.ws + WS_MOD);
    bf16* xm = (bf16*)((unsigned char*)a.out + DO_XM);
    float* Gd = (float*)(a.ws + WS_G); float* Bd = (float*)(a.ws + WS_BETA);
    const int tid = tidx(), lane = tid & 63, wave = tid >> 6;
    const int TPB = T / (int)gridDim.x, wblk = (gridDim.x == 256) ? ((int)(blockIdx.x & 7) * 32 + (int)(blockIdx.x >> 3)) : (int)blockIdx.x, tb0 = wblk * TPB, NP = TPB / 2;
    float4 xnx[2][4];
#pragma unroll
    for (int r = 0; r < 2; ++r)
#pragma unroll
        for (int j = 0; j < 4; ++j) xnx[r][j] = __builtin_bit_cast(float4, __builtin_nontemporal_load((const f4*)(x + (size_t)(tb0 + wave * 2 + r) * D + 4 * lane + 256 * j)));
    for (int k = tid; k < 1024; k += 512) { const int idx = (4 * (k >> 8) + (k & 3)) * 64 + ((k & 255) >> 2);
        wgA[idx] = *(const f4*)(w_in + (size_t)k * DIN + C_GA); wgB[idx] = *(const f4*)(w_in + (size_t)k * DIN + C_GB); }
    float4 gmul[4], gadd[4];
    { const int b = tb0 / SEQ;
#pragma unroll
      for (int j = 0; j < 4; ++j) { const int k = 4 * lane + 256 * j;
          const float4 wv = *(const float4*)(nw + k), sc = *(const float4*)(mod + (size_t)b * 6144 + 1024 + k), sh = *(const float4*)(mod + (size_t)b * 6144 + k);
          gmul[j] = make_float4(wv.x * (1.f + sc.x), wv.y * (1.f + sc.y), wv.z * (1.f + sc.z), wv.w * (1.f + sc.w)); gadd[j] = sh; } }
    __syncthreads();
#pragma unroll 1
    for (int pr = wave; pr < NP; pr += 8) {
        const int t0 = tb0 + pr * 2;
        float4 xv[2][4];
#pragma unroll
        for (int r = 0; r < 2; ++r)
#pragma unroll
            for (int j = 0; j < 4; ++j) xv[r][j] = xnx[r][j];
        { const int prn = (pr + 8 < NP) ? pr + 8 : pr;
#pragma unroll
          for (int r = 0; r < 2; ++r)
#pragma unroll
            for (int j = 0; j < 4; ++j) xnx[r][j] = __builtin_bit_cast(float4, __builtin_nontemporal_load((const f4*)(x + (size_t)(tb0 + prn * 2 + r) * D + 4 * lane + 256 * j))); }
#pragma unroll
        for (int r = 0; r < 2; ++r) {
            float ss = 0.f;
#pragma unroll
            for (int j = 0; j < 4; ++j) ss += xv[r][j].x * xv[r][j].x + xv[r][j].y * xv[r][j].y + xv[r][j].z * xv[r][j].z + xv[r][j].w * xv[r][j].w;
            ss = wave_sum(ss);
            const float rstd = rsqrtf(ss * (1.0f / D) + 1e-6f);
#pragma unroll
            for (int j = 0; j < 4; ++j) { float4 v = xv[r][j];
                v.x = v.x * rstd * gmul[j].x + gadd[j].x; v.y = v.y * rstd * gmul[j].y + gadd[j].y; v.z = v.z * rstd * gmul[j].z + gadd[j].z; v.w = v.w * rstd * gmul[j].w + gadd[j].w;
                xv[r][j] = v;
                v2u w; w.x = pkh(v.x, v.y); w.y = pkh(v.z, v.w);
                *(v2u*)(xm + (size_t)(t0 + r) * D + 4 * lane + 256 * j) = w; }
        }
        float acc[2][8];
#pragma unroll
        for (int r = 0; r < 2; ++r)
#pragma unroll
            for (int q = 0; q < 8; ++q) acc[r][q] = 0.f;
#pragma unroll
        for (int j = 0; j < 4; ++j) {
#pragma unroll
            for (int jj = 0; jj < 4; ++jj) {
                const f4 wa = wgA[(4 * j + jj) * 64 + lane], wb = wgB[(4 * j + jj) * 64 + lane];
#pragma unroll
                for (int r = 0; r < 2; ++r) { const float xe = (jj == 0) ? xv[r][j].x : (jj == 1) ? xv[r][j].y : (jj == 2) ? xv[r][j].z : xv[r][j].w;
                    acc[r][0] += xe * wa.x; acc[r][1] += xe * wa.y; acc[r][2] += xe * wa.z; acc[r][3] += xe * wa.w;
                    acc[r][4] += xe * wb.x; acc[r][5] += xe * wb.y; acc[r][6] += xe * wb.z; acc[r][7] += xe * wb.w; }
            }
            asm volatile("" ::: "memory");
        }
        float mine = 0.f;
#pragma unroll
        for (int r = 0; r < 2; ++r)
#pragma unroll
            for (int q = 0; q < 8; ++q) { const float s = row_sum16(acc[r][q]); if ((lane & 15) == r * 8 + q) mine = s; }
        mine += __shfl_xor(mine, 16); mine += __shfl_xor(mine, 32);
        if (lane < 16) dots[pr * 16 + lane] = mine;
    }
    __syncthreads();
    for (int idx = tid; idx < TPB * 8; idx += 512) { const int q = idx & 7, t = tb0 + (idx >> 3); const float v = dots[idx];
        if (q < 4) { const float z = v + dt_bias[q]; const float sp = (z > 20.f) ? z : log1pf(expf(z)); Gd[t * 4 + q] = -expf(a_log[q]) * sp; }
        else Bd[t * 4 + (q - 4)] = sigmoid_f(v); }
}

struct CJob { const float* src; bf16* dst; int ldsrc, ldd; };
__device__ __forceinline__ void cjob_load(const CJob& j, int lane, f4 (&v)[16]) {
#pragma unroll
    for (int i = 0; i < 16; ++i) v[i] = __builtin_nontemporal_load((const f4*)(j.src + (size_t)(4 * i + (lane >> 4)) * j.ldsrc + 4 * (lane & 15)));
}
__device__ __forceinline__ void cjob_store(const CJob& j, int lane, const f4 (&v)[16], LAS float* tile) {
#pragma unroll
    for (int hf = 0; hf < 2; ++hf) {
#pragma unroll
        for (int i = 0; i < 8; ++i) { LAS float* tp = tile + (4 * i + (lane >> 4)) * 65 + 4 * (lane & 15); const f4 x = v[8 * hf + i]; tp[0] = x[0]; tp[1] = x[1]; tp[2] = x[2]; tp[3] = x[3]; }
        asm volatile("s_waitcnt lgkmcnt(0)" ::: "memory");
        unsigned w[16];
#pragma unroll
        for (int q = 0; q < 16; ++q) w[q] = pkh(tile[(2 * q) * 65 + lane], tile[(2 * q + 1) * 65 + lane]);
        bf16* dp = j.dst + (size_t)lane * j.ldd + 32 * hf;
#pragma unroll
        for (int q = 0; q < 4; ++q) { v4u o; o.x = w[4 * q]; o.y = w[4 * q + 1]; o.z = w[4 * q + 2]; o.w = w[4 * q + 3]; *(v4u*)(dp + 8 * q) = o; }
        asm volatile("s_waitcnt lgkmcnt(0)" ::: "memory");
    }
}
__device__ __forceinline__ int win_srccol(int n0) {
    if (n0 < 1024) { const int base = (n0 < 512) ? C_RQ : C_RK, r = n0 & 511, tile = r >> 8, q = (r & 255) >> 6;
        return base + tile * 256 + (q & 1) * 128 + (q >> 1) * 64; }
    if (n0 < 2048) return C_RV + (n0 - 1024);
    if (n0 < 4096) return C_GQ + (n0 - 2048);
    const int j = (n0 - 4096) >> 8, r = (n0 - 4096) & 255, half = r >> 7, cc = r & 127;
    if (j < 8) return (half ? C_GTA : C_RG) + 128 * j + cc;
    return (half ? C_GTB : C_GZ) + 128 * (j - 8) + cc;
}
__device__ __forceinline__ CJob cjob_in(const Args& a, int job) {
    CJob j;
    if (job < 2048) { const int nt = job >> 4, kt = job & 15; j.src = a.in[5] + (size_t)(kt * 64) * DIN + win_srccol(nt * 64); j.ldsrc = DIN; j.dst = (bf16*)((unsigned char*)a.out + DO_WTIN) + (size_t)(nt * 64) * 1024 + kt * 64; j.ldd = 1024; }
    else { const int jj = job - 2048, nt = jj >> 4, kt = jj & 15; j.src = a.in[10] + (size_t)(kt * 64) * 1024 + nt * 64; j.ldsrc = 1024; j.dst = (bf16*)(a.ws + WS_WTOUT) + (size_t)(nt * 64) * 1024 + kt * 64; j.ldd = 1024; }
    return j;
}
__device__ __forceinline__ void phase_rope_part(const Args& a, int part, int nparts) {
    const int tid = tidx();
    float2* rope = (float2*)(a.ws + WS_ROPE);
    for (int i = part * 512 + tid; i < SEQ * 64; i += nparts * 512) {
        const int t = i >> 6, fi = i & 63;
        const double inv = exp(-((double)fi / 64.0) * 9.210340371976184), ang = (double)t * inv;
        rope[i] = make_float2((float)cos(ang), (float)sin(ang));
    }
}
__device__ __forceinline__ void phase_inproj(const Args& a, LAS unsigned char* lds) {
    pg8::Gemm g{(const bf16*)((unsigned char*)a.out + DO_XM), (const bf16*)((unsigned char*)a.out + DO_WTIN), T, 8192, 1024};
    pg8::StaticOrder S; S.init(T, 8192, (int)gridDim.x, (int)blockIdx.x, 4);
    pg8::EpiProj E{(bf16*)(a.ws + WS_PROJ), PW, (const float*)(a.ws + WS_ROPE)};
    pg8::gemm_phase<pg8::EpiProj, pg8::StaticOrder, true, true>(lds, g, S, E);
}


__device__ __forceinline__ void phase_outproj(const Args& a, LAS unsigned char* lds) {
    pg8::Gemm g{(const bf16*)(a.ws + WS_MERGED), (const bf16*)(a.ws + WS_WTOUT), T, 1024, 1024};
    pg8::StaticOrder S; S.init(T, 1024, (int)gridDim.x, (int)blockIdx.x, 2);
    pg8::EpiD E{(const float*)(a.ws + WS_MOD), (bf16*)(a.ws + WS_DLT)};
    pg8::gemm_phase<pg8::EpiD, pg8::StaticOrder, false, true>(lds, g, S, E);
}

__device__ __forceinline__ void phase_route(const Args& a, LAS unsigned char* lds) {
    LAS f4* wr = (LAS f4*)lds;
    LAS int* hist = (LAS int*)(lds + 5 * 16384);
    LAS float* lgl = (LAS float*)(lds + 5 * 16384 + 256);
    const float* h = a.in[0]; const bf16* dl = (const bf16*)(a.ws + WS_DLT); const float* nw = a.in[11]; const float* w_group = a.in[12]; const float* b_group = a.in[13]; const float* w_router = a.in[14]; const float* b_router = a.in[15];
    const float* mod = (const float*)(a.ws + WS_MOD);
    bf16* xf = (bf16*)(a.ws + WS_XF); bf16* hb = (bf16*)(a.ws + WS_HB);
    int* tok_s = (int*)(a.ws + WS_TOKS); float* tok_w = (float*)(a.ws + WS_TOKW); int* slot_tok = (int*)(a.ws + WS_SLOTTOK); int* ecnt = (int*)(a.ws + WS_ECNT);
    const int tid = tidx(), lane = tid & 63, wave = tid >> 6;
    const int TPB = T / (int)gridDim.x, wblk = (gridDim.x == 256) ? ((int)(blockIdx.x & 7) * 32 + (int)(blockIdx.x >> 3)) : (int)blockIdx.x, tb0 = wblk * TPB;
    float4 xnx[2][4], xmx[2][4]; v2u dnx[2][4], dmx[2][4];
    const int NP = TPB / 2, plast = wave + ((NP - 1 - wave) / 8) * 8;
#pragma unroll
    for (int r = 0; r < 2; ++r)
#pragma unroll
        for (int j = 0; j < 4; ++j) { const int p1 = wave + 8 <= plast ? wave + 8 : plast;
            xnx[r][j] = __builtin_bit_cast(float4, __builtin_nontemporal_load((const f4*)(h + (size_t)(tb0 + wave * 2 + r) * D + 4 * lane + 256 * j))); dnx[r][j] = __builtin_nontemporal_load((const v2u*)(dl + (size_t)(tb0 + wave * 2 + r) * D + 4 * lane + 256 * j));
            xmx[r][j] = __builtin_bit_cast(float4, __builtin_nontemporal_load((const f4*)(h + (size_t)(tb0 + p1 * 2 + r) * D + 4 * lane + 256 * j))); dmx[r][j] = __builtin_nontemporal_load((const v2u*)(dl + (size_t)(tb0 + p1 * 2 + r) * D + 4 * lane + 256 * j)); }
    for (int k = tid; k < 1024; k += 512) { const int idx = (4 * (k >> 8) + (k & 3)) * 64 + ((k & 255) >> 2);
        wr[idx] = *(const f4*)(w_group + (size_t)k * 4);
#pragma unroll
        for (int q = 0; q < 4; ++q) wr[(q + 1) * 1024 + idx] = *(const f4*)(w_router + (size_t)k * 16 + 4 * q); }
    if (tid < 16) hist[tid] = 0;
    __syncthreads();
    float4 gmul[4], gadd[4];
    { const int b = tb0 / SEQ;
#pragma unroll
      for (int j = 0; j < 4; ++j) { const int k = 4 * lane + 256 * j;
          const float4 wv = *(const float4*)(nw + k), sc = *(const float4*)(mod + (size_t)b * 6144 + 4096 + k), sh = *(const float4*)(mod + (size_t)b * 6144 + 3072 + k);
          gmul[j] = make_float4(wv.x * (1.f + sc.x), wv.y * (1.f + sc.y), wv.z * (1.f + sc.z), wv.w * (1.f + sc.w)); gadd[j] = sh; } }
#pragma unroll 1
    for (int pr = wave; pr < NP; pr += 8) {
        const int t0 = tb0 + pr * 2;
        float4 xv[2][4];
#pragma unroll
        for (int r = 0; r < 2; ++r)
#pragma unroll
            for (int j = 0; j < 4; ++j) { const float4 xx = xnx[r][j]; const v2u dd = dnx[r][j];
                xv[r][j] = make_float4(xx.x + bflo(dd.x), xx.y + bfhi(dd.x), xx.z + bflo(dd.y), xx.w + bfhi(dd.y));
                { v2u hw; hw.x = pkh(xv[r][j].x, xv[r][j].y); hw.y = pkh(xv[r][j].z, xv[r][j].w); *(v2u*)(hb + (size_t)(t0 + r) * D + 4 * lane + 256 * j) = hw; }
                xnx[r][j] = xmx[r][j]; dnx[r][j] = dmx[r][j]; }
        { const int prn = (pr + 16 <= plast) ? pr + 16 : plast;
#pragma unroll
          for (int r = 0; r < 2; ++r)
#pragma unroll
            for (int j = 0; j < 4; ++j) { xmx[r][j] = __builtin_bit_cast(float4, __builtin_nontemporal_load((const f4*)(h + (size_t)(tb0 + prn * 2 + r) * D + 4 * lane + 256 * j))); dmx[r][j] = __builtin_nontemporal_load((const v2u*)(dl + (size_t)(tb0 + prn * 2 + r) * D + 4 * lane + 256 * j)); } }
#pragma unroll
        for (int r = 0; r < 2; ++r) {
            float ss = 0.f;
#pragma unroll
            for (int j = 0; j < 4; ++j) { ss += xv[r][j].x * xv[r][j].x + xv[r][j].y * xv[r][j].y + xv[r][j].z * xv[r][j].z + xv[r][j].w * xv[r][j].w; }
            ss = wave_sum(ss);
            const float rstd = rsqrtf(ss * (1.0f / D) + 1e-6f);
#pragma unroll
            for (int j = 0; j < 4; ++j) { float4 v = xv[r][j];
                v.x = v.x * rstd * gmul[j].x + gadd[j].x; v.y = v.y * rstd * gmul[j].y + gadd[j].y; v.z = v.z * rstd * gmul[j].z + gadd[j].z; v.w = v.w * rstd * gmul[j].w + gadd[j].w;
                xv[r][j] = v;
                v2u w; w.x = pkh(v.x, v.y); w.y = pkh(v.z, v.w);
                *(v2u*)(xf + (size_t)(t0 + r) * D + 4 * lane + 256 * j) = w; }
        }
        float accg[2][4];
#pragma unroll
        for (int r = 0; r < 2; ++r)
#pragma unroll
            for (int q = 0; q < 4; ++q) accg[r][q] = 0.f;
#pragma unroll
        for (int j = 0; j < 4; ++j) {
#pragma unroll
            for (int jj = 0; jj < 4; ++jj) {
                const f4 w = wr[(4 * j + jj) * 64 + lane];
#pragma unroll
                for (int r = 0; r < 2; ++r) { const float xe = (jj == 0) ? xv[r][j].x : (jj == 1) ? xv[r][j].y : (jj == 2) ? xv[r][j].z : xv[r][j].w;
                    accg[r][0] += xe * w.x; accg[r][1] += xe * w.y; accg[r][2] += xe * w.z; accg[r][3] += xe * w.w; }
            }
            asm volatile("" ::: "memory");
        }
        float mg = 0.f;
#pragma unroll
        for (int v = 0; v < 8; ++v) { const float s = row_sum16(accg[v >> 2][v & 3]); if ((lane & 15) == v) mg = s; }
        mg += __shfl_xor(mg, 16); mg += __shfl_xor(mg, 32);
        int gsel[2];
#pragma unroll
        for (int r = 0; r < 2; ++r) { float gmax = -1e30f; int g_ = 0;
#pragma unroll
            for (int j = 0; j < 4; ++j) { const float gl = __builtin_bit_cast(float, __builtin_amdgcn_readlane(__builtin_bit_cast(int, mg), r * 4 + j)) + b_group[j]; if (gl > gmax) { gmax = gl; g_ = j; } }
            gsel[r] = g_; }
        float acce[2][4];
#pragma unroll
        for (int r = 0; r < 2; ++r)
#pragma unroll
            for (int q = 0; q < 4; ++q) acce[r][q] = 0.f;
#pragma unroll
        for (int j = 0; j < 4; ++j) {
#pragma unroll
            for (int jj = 0; jj < 4; ++jj) {
#pragma unroll
                for (int r = 0; r < 2; ++r) { const f4 w = wr[(1 + gsel[r]) * 1024 + (4 * j + jj) * 64 + lane];
                    const float xe = (jj == 0) ? xv[r][j].x : (jj == 1) ? xv[r][j].y : (jj == 2) ? xv[r][j].z : xv[r][j].w;
                    acce[r][0] += xe * w.x; acce[r][1] += xe * w.y; acce[r][2] += xe * w.z; acce[r][3] += xe * w.w; }
            }
            asm volatile("" ::: "memory");
        }
        float me = 0.f;
#pragma unroll
        for (int v = 0; v < 8; ++v) { const float s = row_sum16(acce[v >> 2][v & 3]); if ((lane & 15) == v) me = s; }
        me += __shfl_xor(me, 16); me += __shfl_xor(me, 32);
        if (lane < 8) { lgl[pr * 16 + lane] = mg; lgl[pr * 16 + 8 + lane] = me; }
    }
    __syncthreads();
    int e1 = 0, e2 = 0, r1 = 0, r2 = 0;
    if (tid < TPB) {
        const int t = tb0 + tid;
        float lg[4], le[4];
#pragma unroll
        for (int q = 0; q < 4; ++q) { lg[q] = lgl[(tid >> 1) * 16 + (tid & 1) * 4 + q]; le[q] = lgl[(tid >> 1) * 16 + 8 + (tid & 1) * 4 + q]; }
        float gl[4], gmax = -1e30f; int gi = 0;
#pragma unroll
        for (int j = 0; j < 4; ++j) { gl[j] = lg[j] + b_group[j]; if (gl[j] > gmax) { gmax = gl[j]; gi = j; } }
        float gs = 0.f;
#pragma unroll
        for (int j = 0; j < 4; ++j) gs += expf(gl[j] - gmax);
        const float g_top = 1.0f / gs;
        float el[4], emax = -1e30f;
#pragma unroll
        for (int j = 0; j < 4; ++j) { el[j] = le[j] + b_router[gi * 4 + j]; emax = fmaxf(emax, el[j]); }
        float ep[4], es = 0.f;
#pragma unroll
        for (int j = 0; j < 4; ++j) { ep[j] = expf(el[j] - emax); es += ep[j]; }
#pragma unroll
        for (int j = 0; j < 4; ++j) ep[j] /= es;
        int i1 = 0; float p1 = ep[0];
#pragma unroll
        for (int j = 1; j < 4; ++j) if (ep[j] > p1) { p1 = ep[j]; i1 = j; }
        int i2 = -1; float p2 = -1.f;
#pragma unroll
        for (int j = 0; j < 4; ++j) if (j != i1 && ep[j] > p2) { p2 = ep[j]; i2 = j; }
        const float den = p1 + p2;
        e1 = gi * 4 + i1; e2 = gi * 4 + i2;
        tok_w[t * 2 + 0] = g_top * (p1 / den); tok_w[t * 2 + 1] = g_top * (p2 / den);
        r1 = __hip_atomic_fetch_add(&hist[e1], 1, __ATOMIC_RELAXED, __HIP_MEMORY_SCOPE_WORKGROUP); r2 = __hip_atomic_fetch_add(&hist[e2], 1, __ATOMIC_RELAXED, __HIP_MEMORY_SCOPE_WORKGROUP);
    }
    __syncthreads();
    if (tid < 16) hist[16 + tid] = __hip_atomic_fetch_add(&ecnt[tid], hist[tid], __ATOMIC_RELAXED, __HIP_MEMORY_SCOPE_AGENT);
    __syncthreads();
    if (tid < TPB) { const int t = tb0 + tid; const int s1 = hist[16 + e1] + r1, s2 = hist[16 + e2] + r2;
        *(int2*)(tok_s + 2 * t) = make_int2((e1 << 16) | s1, (e2 << 16) | s2); slot_tok[e1 * 32768 + s1] = t; slot_tok[e2 * 32768 + s2] = t; }
}
__device__ __forceinline__ CJob cjob_ex(const Args& a, int job) {
    CJob j;
    if (job < 4096) { const int e = job >> 8, nt = (job >> 4) & 15, kt = job & 15, n0 = nt * 64;
        const int jt = n0 >> 8, r = n0 & 255, half = r >> 7, cc = r & 127;
        j.src = (half ? a.in[17] : a.in[16]) + (size_t)e * 1024 * 512 + (size_t)(kt * 64) * 512 + 128 * jt + cc; j.ldsrc = 512;
        j.dst = (bf16*)(a.ws + WS_WTGU) + (size_t)e * 1024 * 1024 + (size_t)n0 * 1024 + kt * 64; j.ldd = 1024; }
    else { const int jj = job - 4096, e = jj >> 7, nt = (jj >> 3) & 15, kt = jj & 7;
        j.src = a.in[18] + (size_t)e * 512 * 1024 + (size_t)(kt * 64) * 1024 + nt * 64; j.ldsrc = 1024;
        j.dst = (bf16*)(a.ws + WS_WTD) + (size_t)e * 1024 * 512 + (size_t)(nt * 64) * 512 + kt * 64; j.ldd = 512; }
    return j;
}
constexpr int NJ_IN = 2048 + 256;
__device__ __forceinline__ void phase_convert_all(const Args& a, LAS unsigned char* lds) {
    const int tid = tidx(), lane = tid & 63, wave = tid >> 6;
    LAS float* tile = (LAS float*)(lds + 32768 + wave * 8448);
    int j0, j1;
    if (gridDim.x == 256) { if (blockIdx.x < 96) { j0 = (int)blockIdx.x * 6; j1 = j0 + 6; } else { const int q = (int)blockIdx.x - 96; j0 = 576 + q * 10 + (q < 128 ? q : 128); j1 = j0 + 10 + (q < 128 ? 1 : 0); } }
    else { const int per = (NJ_IN + (int)gridDim.x - 1) / (int)gridDim.x; j0 = (int)blockIdx.x * per; j1 = j0 + per < NJ_IN ? j0 + per : NJ_IN; }
    f4 va[16], vb[16];
    int job = j0 + wave;
    if (job < j1) { const CJob j = cjob_in(a, job); cjob_load(j, lane, va); }
#pragma unroll 1
    for (; job < j1; job += 16) {
        if (job + 8 < j1) { const CJob j = cjob_in(a, job + 8); cjob_load(j, lane, vb); }
        { const CJob j = cjob_in(a, job); cjob_store(j, lane, va, tile); }
        if (job + 8 < j1) {
            if (job + 16 < j1) { const CJob j = cjob_in(a, job + 16); cjob_load(j, lane, va); }
            const CJob j = cjob_in(a, job + 8); cjob_store(j, lane, vb, tile); }
    }
}
__device__ __forceinline__ void phase_moe12(const Args& a, LAS unsigned char* lds) {
    LAS int* tab = (LAS int*)(lds + 131072);
    pg8::moe_table(tab, (const int*)(a.ws + WS_ECNT), tidx()); __syncthreads();
    unsigned* ready = (unsigned*)(a.ws + WS_READY);
    {
        pg8::Gemm g{(const bf16*)(a.ws + WS_XF), (const bf16*)(a.ws + WS_WTGU), 0, 0, 1024};
        pg8::MoeOrderT<1> S; S.init(tab, ready, (int)gridDim.x, (int)blockIdx.x);
        pg8::EpiAct E{__builtin_amdgcn_make_buffer_rsrc((void*)(a.ws + WS_ACT), 0, (int)((size_t)MAXSLOT * 512 * 2), 0x00020000)};
        pg8::gemm_phase<pg8::EpiAct, pg8::MoeOrderT<1>, true, true, pg8::RowGather>(lds, g, S, E, pg8::RowGather{(const int*)(a.ws + WS_SLOTTOK), tab});
    }
    {
        pg8::Gemm g{(const bf16*)(a.ws + WS_ACT), (const bf16*)(a.ws + WS_WTD), 0, 0, 512};
        pg8::MoeOrderT<2> S; S.init(tab, ready, (int)gridDim.x, (int)blockIdx.x);
        pg8::EpiY E{(bf16*)(a.ws + WS_Y)};
        pg8::gemm_phase<pg8::EpiY, pg8::MoeOrderT<2>, true, true>(lds, g, S, E);
    }
}
__device__ __forceinline__ void phase_final(const Args& a, LAS unsigned char* lds) {
    const float* mod = (const float*)(a.ws + WS_MOD); const float* now = a.in[19];
    const bf16* y = (const bf16*)(a.ws + WS_Y); const int* tok_s = (const int*)(a.ws + WS_TOKS); const float* tok_w = (const float*)(a.ws + WS_TOKW);
    float* out = a.out; const bf16* hb = (const bf16*)(a.ws + WS_HB);
    const int tid = tidx(), lane = tid & 63, wave = tid >> 6;
    const int gw = blockIdx.x * 8 + wave, NGW = gridDim.x * 8;
    LAS int* sbase = (LAS int*)lds;
    { const int* ecnt = (const int*)(a.ws + WS_ECNT); int off = 0;
#pragma unroll
      for (int e = 0; e < 16; ++e) { const int c = ecnt[e]; if (tid == e) sbase[e] = off; off += ((c + 255) >> 8) << 8; } }
    __syncthreads();
#define SLOT_OF(p) (sbase[(p) >> 16] + ((p) & 0xffff))
    const int tlast = gw + ((T - 1 - gw) / NGW) * NGW;
    const int t1_ = gw + NGW <= tlast ? gw + NGW : tlast, t2_ = gw + 2 * NGW <= tlast ? gw + 2 * NGW : tlast;
    int2 slC = *(const int2*)(tok_s + 2 * t2_); float2 wA = *(const float2*)(tok_w + 2 * gw), wB = *(const float2*)(tok_w + 2 * t1_), wC = *(const float2*)(tok_w + 2 * t2_);
    v2u hA[4], hB[4], y1A[4], y2A[4], y1B[4], y2B[4];
    { const int2 s0 = *(const int2*)(tok_s + 2 * gw), s1 = *(const int2*)(tok_s + 2 * t1_);
#pragma unroll
      for (int j = 0; j < 4; ++j) { const int k = 4 * lane + 256 * j;
          hA[j] = __builtin_nontemporal_load((const v2u*)(hb + (size_t)gw * D + k)); y1A[j] = __builtin_nontemporal_load((const v2u*)(y + (size_t)SLOT_OF(s0.x) * D + k)); y2A[j] = __builtin_nontemporal_load((const v2u*)(y + (size_t)SLOT_OF(s0.y) * D + k));
          hB[j] = __builtin_nontemporal_load((const v2u*)(hb + (size_t)t1_ * D + k)); y1B[j] = __builtin_nontemporal_load((const v2u*)(y + (size_t)SLOT_OF(s1.x) * D + k)); y2B[j] = __builtin_nontemporal_load((const v2u*)(y + (size_t)SLOT_OF(s1.y) * D + k)); } }
    float4 nwh[4];
#pragma unroll
    for (int j = 0; j < 4; ++j) nwh[j] = *(const float4*)(now + 4 * lane + 256 * j);
#pragma unroll 1
    for (int t = gw; t < T; t += NGW) {
        const int b = t / SEQ;
        const float w1 = wA.x, w2 = wA.y;
        float4 hv[4]; v2u a1[4], a2[4];
#pragma unroll
        for (int j = 0; j < 4; ++j) { const v2u hh_ = hA[j]; hv[j] = make_float4(bflo(hh_.x), bfhi(hh_.x), bflo(hh_.y), bfhi(hh_.y)); a1[j] = y1A[j]; a2[j] = y2A[j];
            hA[j] = hB[j]; y1A[j] = y1B[j]; y2A[j] = y2B[j]; }
        wA = wB; wB = wC;
        const int tn2 = t + 2 * NGW <= tlast ? t + 2 * NGW : tlast, tn3 = t + 3 * NGW <= tlast ? t + 3 * NGW : tlast;
#pragma unroll
        for (int j = 0; j < 4; ++j) { const int k = 4 * lane + 256 * j; hB[j] = __builtin_nontemporal_load((const v2u*)(hb + (size_t)tn2 * D + k));
            y1B[j] = __builtin_nontemporal_load((const v2u*)(y + (size_t)SLOT_OF(slC.x) * D + k)); y2B[j] = __builtin_nontemporal_load((const v2u*)(y + (size_t)SLOT_OF(slC.y) * D + k)); }
        slC = *(const int2*)(tok_s + 2 * tn3); wC = *(const float2*)(tok_w + 2 * tn3);
        float4 o[4]; float ss = 0.f;
#pragma unroll
        for (int j = 0; j < 4; ++j) { const int k = 4 * lane + 256 * j;
            const float4 gf = *(const float4*)(mod + (size_t)b * 6144 + 5120 + k);
            float4 v;
            v.x = hv[j].x + gf.x * (w1 * bflo(a1[j].x) + w2 * bflo(a2[j].x)); v.y = hv[j].y + gf.y * (w1 * bfhi(a1[j].x) + w2 * bfhi(a2[j].x));
            v.z = hv[j].z + gf.z * (w1 * bflo(a1[j].y) + w2 * bflo(a2[j].y)); v.w = hv[j].w + gf.w * (w1 * bfhi(a1[j].y) + w2 * bfhi(a2[j].y));
            o[j] = v; ss += v.x * v.x + v.y * v.y + v.z * v.z + v.w * v.w; }
        ss = wave_sum(ss);
        const float rstd = rsqrtf(ss * (1.0f / D) + 1e-6f);
#pragma unroll
        for (int j = 0; j < 4; ++j) { const int k = 4 * lane + 256 * j; const float4 nwv = nwh[j];
            const f4 ov = {o[j].x * rstd * nwv.x, o[j].y * rstd * nwv.y, o[j].z * rstd * nwv.z, o[j].w * rstd * nwv.w}; __builtin_nontemporal_store(ov, (f4*)(out + (size_t)t * D + k)); }
    }
#undef SLOT_OF
}


__device__ __forceinline__ float quad_sum(float v) { v += __shfl_xor(v, 1); v += __shfl_xor(v, 2); return v; }
template <int BR>
__device__ __forceinline__ void scan_item(const Args& a, LAS unsigned char* lds, int b, int h, int half) {
    constexpr int TG = 8;
    LAS float* kf = (LAS float*)lds;
    LAS float* qf = kf + TG * 128;
    LAS float* vf = qf + TG * 128;
    LAS float* of = vf + TG * 128;
    LAS float* sc = of + TG * 128;
    bf16* proj = (bf16*)(a.ws + WS_PROJ);
    const float2* rope = (const float2*)(a.ws + WS_ROPE);
    const float* Gd = (const float*)(a.ws + WS_G); const float* Bd = (const float*)(a.ws + WS_BETA); const float* conv_w = a.in[6];
    float* ssq = (float*)(a.ws + WS_SSQ);
    const int tid = tidx(), v = tid >> 2, qd = tid & 3;
    const size_t row0 = (size_t)b * SEQ;
    const int qcol = (BR == 0 ? P_RQ : P_GQ) + h * 128, kcol = (BR == 0 ? P_RK : P_GK) + h * 128, vcol = (BR == 0 ? P_RV : P_GV) + h * 256 + half * 128;
    const float gamma = 1.0f - exp2f(-5.0f - (float)h);
    LAS float* hv = sc + TG * 2;
    float s[32];
#pragma unroll
    for (int d = 0; d < 32; ++d) s[d] = 0.f;
    for (int i = tid; i < 2 * 3 * 128; i += 512) hv[i] = 0.f;
    __syncthreads();
    for (int t0 = 0; t0 < SEQ; t0 += TG) {
        if (BR == 0) {
#pragma unroll
            for (int r = 0; r < 2; ++r) { const int idx = tid + 512 * r, isk = idx >> 9, tt = (idx >> 6) & 7, i = idx & 63, t = t0 + tt;
                const bf16* pr = proj + (row0 + t) * PW + (isk ? kcol : qcol);
                const float x1 = bf2f(pr[i]), x2 = bf2f(pr[i + 64]); const float2 cs = rope[t * 64 + i];
                const float sc_ = isk ? 0.08838834764831845f : 1.0f;
                LAS float* dst = (isk ? kf : qf) + tt * 128;
                dst[i] = (x1 * cs.x - x2 * cs.y) * sc_; dst[i + 64] = (x1 * cs.y + x2 * cs.x) * sc_; }
#pragma unroll
            for (int r = 0; r < 2; ++r) { const int idx = tid + 512 * r, tt = idx >> 7, c = idx & 127;
                vf[tt * 128 + c] = bf2f(proj[(row0 + t0 + tt) * PW + vcol + c]); }
        } else {
            if (tid < 384) {
                const bool isv = tid >= 256; const int u = isv ? tid - 256 : tid;
                const int tt = isv ? (u >> 4) : (u >> 5), part = isv ? (u & 15) : (u & 31), t = t0 + tt;
                const int col = isv ? (vcol + 8 * part) : (part < 16 ? qcol + 8 * part : kcol + 8 * (part - 16));
                const int cch = col - P_GQ;
                float acc[8];
#pragma unroll
                for (int j = 0; j < 8; ++j) acc[j] = 0.f;
#pragma unroll
                for (int i = 0; i < 4; ++i) { const int tr = t - 3 + i;
                    if (isv && tr < t0) {
                        const LAS float* hp = hv + (((t0 / TG) & 1) * 3 + (tr - (t0 - 3))) * 128 + 8 * part;
                        const float4 w0 = *(const float4*)(conv_w + i * 2048 + cch), w1 = *(const float4*)(conv_w + i * 2048 + cch + 4);
                        acc[0] += hp[0] * w0.x; acc[1] += hp[1] * w0.y; acc[2] += hp[2] * w0.z; acc[3] += hp[3] * w0.w;
                        acc[4] += hp[4] * w1.x; acc[5] += hp[5] * w1.y; acc[6] += hp[6] * w1.z; acc[7] += hp[7] * w1.w;
                    } else if (tr >= 0) { const v4u raw = *(const v4u*)(proj + (row0 + tr) * PW + col);
                        if (isv && i == 3 && tt >= TG - 3) { LAS float* hn = hv + ((((t0 / TG) + 1) & 1) * 3 + (tt - (TG - 3))) * 128 + 8 * part;
                            hn[0] = bflo(raw.x); hn[1] = bfhi(raw.x); hn[2] = bflo(raw.y); hn[3] = bfhi(raw.y); hn[4] = bflo(raw.z); hn[5] = bfhi(raw.z); hn[6] = bflo(raw.w); hn[7] = bfhi(raw.w); }
                        const float4 w0 = *(const float4*)(conv_w + i * 2048 + cch), w1 = *(const float4*)(conv_w + i * 2048 + cch + 4);
                        acc[0] += bflo(raw.x) * w0.x; acc[1] += bfhi(raw.x) * w0.y; acc[2] += bflo(raw.y) * w0.z; acc[3] += bfhi(raw.y) * w0.w;
                        acc[4] += bflo(raw.z) * w1.x; acc[5] += bfhi(raw.z) * w1.y; acc[6] += bflo(raw.w) * w1.z; acc[7] += bfhi(raw.w) * w1.w; } }
                float ss = 0.f;
#pragma unroll
                for (int j = 0; j < 8; ++j) { acc[j] = acc[j] * fsigmoid(acc[j]); ss += acc[j] * acc[j]; }
                if (!isv) {
                    ss += __shfl_xor(ss, 1); ss += __shfl_xor(ss, 2); ss += __shfl_xor(ss, 4); ss += __shfl_xor(ss, 8);
                    const float rn = rsqrtf(ss + 1e-6f) * (part < 16 ? 0.08838834764831845f : 1.0f);
                    LAS float* dst = (part < 16 ? qf : kf) + tt * 128 + 8 * (part & 15);
#pragma unroll
                    for (int j = 0; j < 8; ++j) dst[j] = acc[j] * rn;
                } else { LAS float* dst = vf + tt * 128 + 8 * part;
#pragma unroll
                    for (int j = 0; j < 8; ++j) dst[j] = acc[j]; }
            } else if (tid < 384 + TG) { const int tt = tid - 384; const size_t gi = (row0 + t0 + tt) * 4 + h; sc[tt * 2] = expf(Gd[gi]); sc[tt * 2 + 1] = Bd[gi]; }
        }
        __syncthreads();
#pragma unroll 1
        for (int tt = 0; tt < TG; ++tt) {
            const LAS f4* kp = (const LAS f4*)(kf + tt * 128 + 32 * qd); const LAS f4* qp = (const LAS f4*)(qf + tt * 128 + 32 * qd);
            const float vt = vf[tt * 128 + v];
            float o = 0.f;
            if (BR == 0) {
#pragma unroll
                for (int d4 = 0; d4 < 8; ++d4) { const f4 kk = kp[d4], qq = qp[d4];
                    s[4 * d4 + 0] = gamma * s[4 * d4 + 0] + kk.x * vt; o += qq.x * s[4 * d4 + 0];
                    s[4 * d4 + 1] = gamma * s[4 * d4 + 1] + kk.y * vt; o += qq.y * s[4 * d4 + 1];
                    s[4 * d4 + 2] = gamma * s[4 * d4 + 2] + kk.z * vt; o += qq.z * s[4 * d4 + 2];
                    s[4 * d4 + 3] = gamma * s[4 * d4 + 3] + kk.w * vt; o += qq.w * s[4 * d4 + 3]; }
            } else {
                const float al = sc[tt * 2], bt = sc[tt * 2 + 1];
                float dot = 0.f;
#pragma unroll
                for (int d4 = 0; d4 < 8; ++d4) { const f4 kk = kp[d4];
                    s[4 * d4 + 0] *= al; dot += s[4 * d4 + 0] * kk.x; s[4 * d4 + 1] *= al; dot += s[4 * d4 + 1] * kk.y;
                    s[4 * d4 + 2] *= al; dot += s[4 * d4 + 2] * kk.z; s[4 * d4 + 3] *= al; dot += s[4 * d4 + 3] * kk.w; }
                dot = quad_sum(dot);
                const float vn = bt * (vt - dot);
#pragma unroll
                for (int d4 = 0; d4 < 8; ++d4) { const f4 kk = kp[d4], qq = qp[d4];
                    s[4 * d4 + 0] += kk.x * vn; o += s[4 * d4 + 0] * qq.x; s[4 * d4 + 1] += kk.y * vn; o += s[4 * d4 + 1] * qq.y;
                    s[4 * d4 + 2] += kk.z * vn; o += s[4 * d4 + 2] * qq.z; s[4 * d4 + 3] += kk.w * vn; o += s[4 * d4 + 3] * qq.w; }
            }
            o = quad_sum(o);
            if (qd == 0) of[tt * 128 + v] = o;
        }
        __syncthreads();
        if (tid < 128) { const int tt = tid >> 4, c8 = (tid & 15) * 8;
            const LAS float* src = of + tt * 128 + c8; float ss = 0.f;
#pragma unroll
            for (int j = 0; j < 8; ++j) ss += src[j] * src[j];
            v4u w; w.x = pkh(src[0], src[1]); w.y = pkh(src[2], src[3]); w.z = pkh(src[4], src[5]); w.w = pkh(src[6], src[7]);
            *(v4u*)(proj + (row0 + t0 + tt) * PW + vcol + c8) = w;
            ss += __shfl_xor(ss, 1); ss += __shfl_xor(ss, 2); ss += __shfl_xor(ss, 4); ss += __shfl_xor(ss, 8);
            if ((tid & 15) == 0) ssq[(row0 + t0 + tt) * 16 + BR * 8 + h * 2 + half] = ss; }
        __syncthreads();
    }
}
__device__ __forceinline__ void phase_scan_simple(const Args& a, LAS unsigned char* lds) {
    for (int id = blockIdx.x; id < 256; id += gridDim.x) {
        const int br = (id >> 4) & 1, half = (id >> 3) & 1, bh = (id >> 5) * 8 + (id & 7), b = bh >> 2, h = bh & 3;
        if (br == 0) scan_item<0>(a, lds, b, h, half); else scan_item<1>(a, lds, b, h, half);
        __syncthreads();
    }
}
__device__ __forceinline__ void phase_merge(const Args& a, LAS unsigned char* lds) {
    const bf16* proj = (const bf16*)(a.ws + WS_PROJ); const float* ssq = (const float*)(a.ws + WS_SSQ); const float* gnw = a.in[9];
    bf16* merged = (bf16*)(a.ws + WS_MERGED);
    const int tid = tidx(), lane = tid & 63, wave = tid >> 6;
    const int gw = blockIdx.x * 8 + wave, NGW = gridDim.x * 8;
    for (int t = gw; t < T; t += NGW) {
        const int c0 = 16 * lane, h = lane >> 4;
        const float* sq = ssq + (size_t)t * 16;
        const float rr = rsqrtf((sq[h * 2] + sq[h * 2 + 1]) * (1.0f / 256.0f) + 1e-6f), rg = rsqrtf((sq[8 + h * 2] + sq[8 + h * 2 + 1]) * (1.0f / 256.0f) + 1e-6f);
        const bf16* pr = proj + (size_t)t * PW;
#pragma unroll
        for (int part = 0; part < 2; ++part) { const int c = c0 + 8 * part;
            const v4u orv = *(const v4u*)(pr + P_RV + c), ogv = *(const v4u*)(pr + P_GV + c), ga = *(const v4u*)(pr + P_GA + c), gb = *(const v4u*)(pr + P_GB + c);
            const float4 w0 = *(const float4*)(gnw + (c & 255)), w1 = *(const float4*)(gnw + (c & 255) + 4);
            float o[8];
            o[0] = bflo(ga.x) * bflo(orv.x) * rr + bflo(gb.x) * bflo(ogv.x) * rg * w0.x; o[1] = bfhi(ga.x) * bfhi(orv.x) * rr + bfhi(gb.x) * bfhi(ogv.x) * rg * w0.y;
            o[2] = bflo(ga.y) * bflo(orv.y) * rr + bflo(gb.y) * bflo(ogv.y) * rg * w0.z; o[3] = bfhi(ga.y) * bfhi(orv.y) * rr + bfhi(gb.y) * bfhi(ogv.y) * rg * w0.w;
            o[4] = bflo(ga.z) * bflo(orv.z) * rr + bflo(gb.z) * bflo(ogv.z) * rg * w1.x; o[5] = bfhi(ga.z) * bfhi(orv.z) * rr + bfhi(gb.z) * bfhi(ogv.z) * rg * w1.y;
            o[6] = bflo(ga.w) * bflo(orv.w) * rr + bflo(gb.w) * bflo(ogv.w) * rg * w1.z; o[7] = bfhi(ga.w) * bfhi(orv.w) * rr + bfhi(gb.w) * bfhi(ogv.w) * rg * w1.w;
            v4u w; w.x = pkh(o[0], o[1]); w.y = pkh(o[2], o[3]); w.z = pkh(o[4], o[5]); w.w = pkh(o[6], o[7]);
            *(v4u*)(merged + (size_t)t * 1024 + c) = w; }
    }
}

}
namespace {
typedef short s8v __attribute__((ext_vector_type(8)));
typedef short s4v __attribute__((ext_vector_type(4)));
typedef float f16v __attribute__((ext_vector_type(16)));
#define MFMA32(a, b, c) __builtin_amdgcn_mfma_f32_32x32x16_bf16((a), (b), (c), 0, 0, 0)
#define LDS_BARRIER() do { asm volatile("s_waitcnt lgkmcnt(0)" ::: "memory"); __builtin_amdgcn_s_barrier(); asm volatile("" ::: "memory"); } while (0)
constexpr int PT128 = 136, PT64 = 72;
constexpr size_t DO_QH = 0, DO_KHT = 32 * MiB, DO_QK = 64 * MiB, DO_TU = 80 * MiB, DO_TW = 96 * MiB;
constexpr size_t WS_VH = WS_MERGED;
constexpr size_t WS_EG = 454 * MiB, WS_EGL = 454 * MiB + 512 * 1024;

typedef __bf16 bf2v __attribute__((ext_vector_type(2)));
typedef float f2v __attribute__((ext_vector_type(2)));
__device__ __forceinline__ unsigned cvtpk(float lo, float hi) { const f2v v = {lo, hi}; return __builtin_bit_cast(unsigned, __builtin_convertvector(v, bf2v)); }
__device__ __forceinline__ s8v ld_nat(const LAS bf16* base, int pitch, int row, int k0, int hh) { return *(const LAS s8v*)(base + row * pitch + k0 + 8 * hh); }
__device__ __forceinline__ s8v ld_perm(const LAS bf16* base, int pitch, int row, int k0, int hh) {
    const LAS bf16* p = base + row * pitch + k0 + 4 * hh;
    const s4v lo = *(const LAS s4v*)p, hi = *(const LAS s4v*)(p + 8);
    return __builtin_shufflevector(lo, hi, 0, 1, 2, 3, 4, 5, 6, 7);
}
template <int S> __device__ __forceinline__ s8v pack8(const f16v& x) {
    v4u p; p.x = cvtpk(x[8 * S + 0], x[8 * S + 1]); p.y = cvtpk(x[8 * S + 2], x[8 * S + 3]); p.z = cvtpk(x[8 * S + 4], x[8 * S + 5]); p.w = cvtpk(x[8 * S + 6], x[8 * S + 7]);
    return __builtin_bit_cast(s8v, p);
}
__device__ __forceinline__ f16v zero16() { f16v z;
#pragma unroll
    for (int i = 0; i < 16; ++i) z[i] = 0.f; return z; }

__device__ __forceinline__ void conv8(const bf16* proj, size_t rowbase, int tloc, int col, const float* conv_w, int cch, float (&acc)[8]) {
#pragma unroll
    for (int j = 0; j < 8; ++j) acc[j] = 0.f;
#pragma unroll
    for (int i = 0; i < 4; ++i) { const int tr = tloc - 3 + i;
        if (tr >= 0) { const v4u raw = *(const v4u*)(proj + (rowbase + tr) * PW + col);
            const float4 w0 = *(const float4*)(conv_w + i * 2048 + cch), w1 = *(const float4*)(conv_w + i * 2048 + cch + 4);
            acc[0] += bflo(raw.x) * w0.x; acc[1] += bfhi(raw.x) * w0.y; acc[2] += bflo(raw.y) * w0.z; acc[3] += bfhi(raw.y) * w0.w;
            acc[4] += bflo(raw.z) * w1.x; acc[5] += bfhi(raw.z) * w1.y; acc[6] += bflo(raw.w) * w1.z; acc[7] += bfhi(raw.w) * w1.w; } }
}

__device__ __forceinline__ void tile_store_rm(LAS bf16* buf, const f16v& v, int mt, int nt, int r32, int hh) {
#pragma unroll
    for (int rg = 0; rg < 16; ++rg) buf[(32 * mt + (rg & 3) + 8 * (rg >> 2) + 4 * hh) * PT64 + 32 * nt + r32] = (bf16)f2bf(v[rg]);
}
__device__ __forceinline__ void tile_store_tr(LAS bf16* buf, const f16v& v, int mt, int nt, int r32, int hh) {
#pragma unroll
    for (int g4 = 0; g4 < 4; ++g4) { v2u w; w.x = cvtpk(v[4 * g4 + 0], v[4 * g4 + 1]); w.y = cvtpk(v[4 * g4 + 2], v[4 * g4 + 3]); *(LAS v2u*)(buf + (32 * nt + r32) * PT64 + 32 * mt + 8 * g4 + 4 * hh) = w; }
}
__device__ __forceinline__ void phase_gprep(const Args& a, LAS unsigned char* lds) {
    LAS bf16* Kh = (LAS bf16*)lds;
    LAS bf16* Qh = (LAS bf16*)(lds + 17408);
    LAS bf16* Kht = (LAS bf16*)(lds + 34816);
    LAS float* bt = (LAS float*)(lds + 53248);
    LAS float* gc = bt + 64;
    LAS bf16* MB = (LAS bf16*)(lds + 53760);
    constexpr int MSZ = 64 * PT64;
    const bf16* proj = (const bf16*)(a.ws + WS_PROJ);
    const float* Gd = (const float*)(a.ws + WS_G); const float* Bd = (const float*)(a.ws + WS_BETA); const float* conv_w = a.in[6];
    unsigned char* dout = (unsigned char*)a.out;
    bf16* QHg = (bf16*)(dout + DO_QH); bf16* KHTg = (bf16*)(dout + DO_KHT); bf16* QKg = (bf16*)(dout + DO_QK); bf16* TUg = (bf16*)(dout + DO_TU); bf16* TWg = (bf16*)(dout + DO_TW);
    bf16* VHg = (bf16*)(a.ws + WS_VH); float* EGg = (float*)(a.ws + WS_EG); float* EGLg = (float*)(a.ws + WS_EGL);
    const int tid = tidx(), lane = tid & 63, wave = tid >> 6, r32 = lane & 31, hh = lane >> 5;
    for (int i = tid; i < 8 * MSZ / 8; i += 512) ((LAS v4u*)MB)[i] = (v4u){0u, 0u, 0u, 0u};
    const int cg = tid & 31, run = tid >> 5, isk = cg >> 4, c8qk = 8 * (cg & 15), tt0 = run * 4;
    const int h0 = (blockIdx.x >> 5) & 3;
    const int colqk = (isk ? P_GK : P_GQ) + h0 * 128 + c8qk, colv = P_GV + h0 * 256 + 8 * cg;
    LAS f4* wtab = (LAS f4*)(lds + 127488);
    if (tid < 256) { const int which = tid >> 7, i = (tid >> 5) & 3, g = tid & 31;
        const int col = which ? (P_GV + h0 * 256 + 8 * g) : (((g >> 4) ? P_GK : P_GQ) + h0 * 128 + 8 * (g & 15));
        wtab[(which * 4 + i) * 64 + g] = *(const f4*)(conv_w + i * 2048 + col - P_GQ); wtab[(which * 4 + i) * 64 + 32 + g] = *(const f4*)(conv_w + i * 2048 + col - P_GQ + 4); }
    LDS_BARRIER();
    v4u rq[7], rv[7];
    { const int it0 = blockIdx.x, n0_ = it0 & 31, b0_ = it0 >> 7;
#pragma unroll
      for (int i = 0; i < 7; ++i) { const int tr = n0_ * 64 + tt0 - 3 + i;
          if (tr >= 0 && it0 < 2048) { rq[i] = *(const v4u*)(proj + ((size_t)b0_ * SEQ + tr) * PW + colqk); rv[i] = *(const v4u*)(proj + ((size_t)b0_ * SEQ + tr) * PW + colv); }
          else { rq[i] = (v4u){0u, 0u, 0u, 0u}; rv[i] = (v4u){0u, 0u, 0u, 0u}; } } }
#pragma unroll 1
    for (int item = blockIdx.x; item < 2048; item += gridDim.x) {
        const int n = item & 31, bh = item >> 5, h = bh & 3, b = bh >> 2;
        const int li = n * 64 + bh;
        const size_t rowb = (size_t)b * SEQ;
        const int tl0 = n * 64;
        if (wave == 0) {
            float g = Gd[(rowb + tl0 + lane) * 4 + h];
#pragma unroll
            for (int o = 1; o < 64; o <<= 1) { const float t = __shfl_up(g, o); if (lane >= o) g += t; }
            const float gl = __shfl(g, 63);
            bt[lane] = Bd[(rowb + tl0 + lane) * 4 + h]; gc[lane] = g;
            EGg[(size_t)li * 64 + lane] = expf(g); EGLg[(size_t)li * 64 + lane] = expf(gl - g);
        }
        {
#pragma unroll
            for (int j = 0; j < 4; ++j) {
                const int tt = tt0 + j;
                float acc[8];
#pragma unroll
                for (int c = 0; c < 8; ++c) acc[c] = 0.f;
#pragma unroll
                for (int i = 0; i < 4; ++i) { const v4u raw = rq[j + i]; const f4 w0 = wtab[(0 * 4 + i) * 64 + cg], w1 = wtab[(0 * 4 + i) * 64 + 32 + cg];
                    acc[0] += bflo(raw.x) * w0.x; acc[1] += bfhi(raw.x) * w0.y; acc[2] += bflo(raw.y) * w0.z; acc[3] += bfhi(raw.y) * w0.w;
                    acc[4] += bflo(raw.z) * w1.x; acc[5] += bfhi(raw.z) * w1.y; acc[6] += bflo(raw.w) * w1.z; acc[7] += bfhi(raw.w) * w1.w; }
                float ss = 0.f;
#pragma unroll
                for (int c = 0; c < 8; ++c) { acc[c] = acc[c] * fsigmoid(acc[c]); ss += acc[c] * acc[c]; }
                ss = row_sum16(ss);
                const float rn = rsqrtf(ss + 1e-6f) * (isk ? 1.0f : 0.08838834764831845f);
                v4u w; w.x = pkh(acc[0] * rn, acc[1] * rn); w.y = pkh(acc[2] * rn, acc[3] * rn); w.z = pkh(acc[4] * rn, acc[5] * rn); w.w = pkh(acc[6] * rn, acc[7] * rn);
                if (!isk) { *(LAS v4u*)(Qh + tt * PT128 + c8qk) = w; *(v4u*)(QHg + ((size_t)li * 64 + tt) * 128 + c8qk) = w; }
                else *(LAS v4u*)(Kh + tt * PT128 + c8qk) = w;
#pragma unroll
                for (int c = 0; c < 8; ++c) acc[c] = 0.f;
#pragma unroll
                for (int i = 0; i < 4; ++i) { const v4u raw = rv[j + i]; const f4 w0 = wtab[(1 * 4 + i) * 64 + cg], w1 = wtab[(1 * 4 + i) * 64 + 32 + cg];
                    acc[0] += bflo(raw.x) * w0.x; acc[1] += bfhi(raw.x) * w0.y; acc[2] += bflo(raw.y) * w0.z; acc[3] += bfhi(raw.y) * w0.w;
                    acc[4] += bflo(raw.z) * w1.x; acc[5] += bfhi(raw.z) * w1.y; acc[6] += bflo(raw.w) * w1.z; acc[7] += bfhi(raw.w) * w1.w; }
#pragma unroll
                for (int c = 0; c < 8; ++c) acc[c] = acc[c] * fsigmoid(acc[c]);
                v4u wvv; wvv.x = pkh(acc[0], acc[1]); wvv.y = pkh(acc[2], acc[3]); wvv.z = pkh(acc[4], acc[5]); wvv.w = pkh(acc[6], acc[7]);
                *(v4u*)(VHg + (rowb + tl0 + tt) * 1024 + h * 256 + 8 * cg) = wvv;
            }
            { const int itn = item + (int)gridDim.x, nn = itn & 31, bn = itn >> 7;
#pragma unroll
              for (int i = 0; i < 7; ++i) { const int tr = nn * 64 + tt0 - 3 + i;
                  if (tr >= 0 && itn < 2048) { rq[i] = *(const v4u*)(proj + ((size_t)bn * SEQ + tr) * PW + colqk); rv[i] = *(const v4u*)(proj + ((size_t)bn * SEQ + tr) * PW + colv); }
                  else { rq[i] = (v4u){0u, 0u, 0u, 0u}; rv[i] = (v4u){0u, 0u, 0u, 0u}; } } }
        }
        LDS_BARRIER();
        f16v X = zero16();
        const int q3 = (wave < 3) ? wave : wave - 3, mt = (q3 >= 1) ? 1 : 0, nt = (q3 == 2) ? 1 : 0;
        if (wave < 3) {
            f16v acc = zero16();
#pragma unroll
            for (int ks = 0; ks < 8; ++ks) acc = MFMA32(ld_nat(Kh, PT128, 32 * mt + r32, 16 * ks, hh), ld_nat(Kh, PT128, 32 * nt + r32, 16 * ks, hh), acc);
            const int bcol = 32 * nt + r32; const float gcb = gc[bcol];
            f16v N_;
#pragma unroll
            for (int rg = 0; rg < 16; ++rg) { const int ar = 32 * mt + (rg & 3) + 8 * (rg >> 2) + 4 * hh;
                N_[rg] = (ar > bcol) ? -bt[ar] * acc[rg] * __expf(gc[ar] - gcb) : 0.f; X[rg] = N_[rg] + ((ar == bcol) ? 1.0f : 0.0f); }
            tile_store_rm(MB + 0 * MSZ, N_, mt, nt, r32, hh); tile_store_tr(MB + 1 * MSZ, N_, mt, nt, r32, hh);
            tile_store_rm(MB + 2 * MSZ, X, mt, nt, r32, hh);
        } else if (wave < 6) {
            const int jt = (wave == 5) ? 1 : 0, itile = (wave >= 4) ? 1 : 0;
            f16v acc = zero16();
#pragma unroll
            for (int ks = 0; ks < 8; ++ks) acc = MFMA32(ld_nat(Kh, PT128, 32 * jt + r32, 16 * ks, hh), ld_nat(Qh, PT128, 32 * itile + r32, 16 * ks, hh), acc);
            const int icol = 32 * itile + r32; const float gci = gc[icol];
#pragma unroll
            for (int g4 = 0; g4 < 4; ++g4) { const int j0 = 32 * jt + 8 * g4 + 4 * hh; float v[4];
#pragma unroll
                for (int j = 0; j < 4; ++j) { const int jr = j0 + j; v[j] = (icol >= jr) ? acc[4 * g4 + j] * __expf(gci - gc[jr]) : 0.f; }
                v2u w; w.x = pkh(v[0], v[1]); w.y = pkh(v[2], v[3]); *(v2u*)(QKg + ((size_t)li * 64 + icol) * 64 + j0) = w; }
        } else if (wave == 6) {
            for (int i = lane; i < 32 * 4; i += 64) { const int row = i >> 2, c = i & 3; *(v4u*)(QKg + ((size_t)li * 64 + row) * 64 + 32 + 8 * c) = (v4u){0u, 0u, 0u, 0u}; }
        }
#pragma unroll
        for (int r = 0; r < 2; ++r) { const int p = tid + 512 * r, d = p & 127, tg = p >> 7;
            const LAS bf16* kp = Kh + (8 * tg) * PT128 + d;
            v4u w; w.x = (unsigned)kp[0] | ((unsigned)kp[PT128] << 16); w.y = (unsigned)kp[2 * PT128] | ((unsigned)kp[3 * PT128] << 16);
            w.z = (unsigned)kp[4 * PT128] | ((unsigned)kp[5 * PT128] << 16); w.w = (unsigned)kp[6 * PT128] | ((unsigned)kp[7 * PT128] << 16);
            *(v4u*)(KHTg + ((size_t)li * 128 + d) * 64 + 8 * tg) = w; }
        LDS_BARRIER();
        if (wave >= 3 && wave < 6) {
            f16v acc = zero16();
#pragma unroll
            for (int ks = 0; ks < 4; ++ks) acc = MFMA32(ld_nat(MB + 0 * MSZ, PT64, 32 * mt + r32, 16 * ks, hh), ld_nat(MB + 1 * MSZ, PT64, 32 * nt + r32, 16 * ks, hh), acc);
            tile_store_rm(MB + 3 * MSZ, acc, mt, nt, r32, hh); tile_store_tr(MB + 4 * MSZ, acc, mt, nt, r32, hh);
        }
        LDS_BARRIER();
#pragma unroll 1
        for (int r = 1; r <= 5; ++r) {
            const int so = ((r - 1) & 1) * 3, sn = (r & 1) * 3;
            LAS bf16* Xo = MB + (2 + so) * MSZ; LAS bf16* Po = MB + (3 + so) * MSZ; LAS bf16* Qo = MB + (4 + so) * MSZ;
            LAS bf16* Xn = MB + (2 + sn) * MSZ; LAS bf16* Pn = MB + (3 + sn) * MSZ; LAS bf16* Qn = MB + (4 + sn) * MSZ;
            if (wave < 3) {
#pragma unroll
                for (int ks = 0; ks < 4; ++ks) X = MFMA32(ld_nat(Xo, PT64, 32 * mt + r32, 16 * ks, hh), ld_nat(Qo, PT64, 32 * nt + r32, 16 * ks, hh), X);
                if (r < 5) tile_store_rm(Xn, X, mt, nt, r32, hh);
            } else if (wave < 6 && r < 5) {
                f16v acc = zero16();
#pragma unroll
                for (int ks = 0; ks < 4; ++ks) acc = MFMA32(ld_nat(Po, PT64, 32 * mt + r32, 16 * ks, hh), ld_nat(Qo, PT64, 32 * nt + r32, 16 * ks, hh), acc);
                tile_store_rm(Pn, acc, mt, nt, r32, hh); tile_store_tr(Qn, acc, mt, nt, r32, hh);
            }
            LDS_BARRIER();
        }
        if (wave < 3) {
            const int jcol = 32 * nt + r32; const float bj = bt[jcol];
            f16v U_;
#pragma unroll
            for (int rg = 0; rg < 16; ++rg) U_[rg] = X[rg] * bj;
            tile_store_rm(MB + 0 * MSZ, U_, mt, nt, r32, hh);
        }
        LDS_BARRIER();
        { const int row = tid >> 3, c = tid & 7; const size_t go = ((size_t)li * 64 + row) * 64 + 8 * c;
          *(v4u*)(TUg + go) = *(const LAS v4u*)(MB + 0 * MSZ + row * PT64 + 8 * c); }
        LDS_BARRIER();
    }
}


__device__ __forceinline__ void phase_rprep(const Args& a, LAS unsigned char* lds) {
    bf16* proj = (bf16*)(a.ws + WS_PROJ);
    const float2* rope = (const float2*)(a.ws + WS_ROPE);
    const int tid = tidx(), lane = tid & 63, wave = tid >> 6;
    const int gw = blockIdx.x * 8 + wave, NGW = gridDim.x * 8;
    const int isk = lane >> 5, h = (lane >> 3) & 3, i0 = 8 * (lane & 7);
    const float lgam = logf(1.0f - exp2f(-5.0f - (float)h));
#pragma unroll 2
    for (int t = gw; t < T; t += NGW) {
        const int tl = t & (SEQ - 1);
        bf16* pr = proj + (size_t)t * PW + (isk ? P_RK : P_RQ) + h * 128;
        const v4u x1 = *(const v4u*)(pr + i0), x2 = *(const v4u*)(pr + 64 + i0);
        const float4* rp = (const float4*)(rope + tl * 64 + i0);
        const float4 c0 = rp[0], c1 = rp[1], c2 = rp[2], c3 = rp[3];
        const float a1[8] = {bflo(x1.x), bfhi(x1.x), bflo(x1.y), bfhi(x1.y), bflo(x1.z), bfhi(x1.z), bflo(x1.w), bfhi(x1.w)};
        const float a2[8] = {bflo(x2.x), bfhi(x2.x), bflo(x2.y), bfhi(x2.y), bflo(x2.z), bfhi(x2.z), bflo(x2.w), bfhi(x2.w)};
        const float cs[8] = {c0.x, c0.z, c1.x, c1.z, c2.x, c2.z, c3.x, c3.z}, sn[8] = {c0.y, c0.w, c1.y, c1.w, c2.y, c2.w, c3.y, c3.w};
        const float sc = isk ? 0.08838834764831845f : expf((float)((tl & 63) + 1) * lgam);
        float o1[8], o2[8];
#pragma unroll
        for (int j = 0; j < 8; ++j) { o1[j] = (a1[j] * cs[j] - a2[j] * sn[j]) * sc; o2[j] = (a1[j] * sn[j] + a2[j] * cs[j]) * sc; }
        v4u w1, w2; w1.x = pkh(o1[0], o1[1]); w1.y = pkh(o1[2], o1[3]); w1.z = pkh(o1[4], o1[5]); w1.w = pkh(o1[6], o1[7]);
        w2.x = pkh(o2[0], o2[1]); w2.y = pkh(o2[2], o2[3]); w2.z = pkh(o2[4], o2[5]); w2.w = pkh(o2[6], o2[7]);
        *(v4u*)(pr + i0) = w1; *(v4u*)(pr + 64 + i0) = w2;
    }
}

__device__ __forceinline__ void tile_to_lds(const f16v& acc, LAS bf16* ot, int r32, int hh) {
#pragma unroll
    for (int g4 = 0; g4 < 4; ++g4) { const int r0 = 8 * g4 + 4 * hh;
        const unsigned p0 = cvtpk(acc[4 * g4 + 0], acc[4 * g4 + 1]), p1 = cvtpk(acc[4 * g4 + 2], acc[4 * g4 + 3]);
        ot[(r0 + 0) * 36 + r32] = (bf16)(p0 & 0xffff); ot[(r0 + 1) * 36 + r32] = (bf16)(p0 >> 16); ot[(r0 + 2) * 36 + r32] = (bf16)(p1 & 0xffff); ot[(r0 + 3) * 36 + r32] = (bf16)(p1 >> 16); }
}
__device__ __forceinline__ void lds_rows_to_global(const LAS bf16* ot, bf16* gtile, int lane) {
    asm volatile("s_waitcnt lgkmcnt(0)" ::: "memory");
    const LAS bf16* rp = ot + (lane & 31) * 36 + (lane >> 5) * 16;
    const v2u a0 = *(const LAS v2u*)rp, a1 = *(const LAS v2u*)(rp + 4), a2 = *(const LAS v2u*)(rp + 8), a3 = *(const LAS v2u*)(rp + 12);
    bf16* gp = gtile + (size_t)(lane & 31) * PW + (lane >> 5) * 16;
    *(v4u*)gp = (v4u){a0.x, a0.y, a1.x, a1.y}; *(v4u*)(gp + 8) = (v4u){a2.x, a2.y, a3.x, a3.y};
}

__device__ __forceinline__ void cjob_store16(const CJob& j, int lane, const f4 (&v)[16], LAS float* tile) {
#pragma unroll
    for (int q4 = 0; q4 < 4; ++q4) {
#pragma unroll
        for (int i = 0; i < 4; ++i) { LAS float* tp = tile + (4 * i + (lane >> 4)) * 65 + 4 * (lane & 15); const f4 x = v[4 * q4 + i]; tp[0] = x[0]; tp[1] = x[1]; tp[2] = x[2]; tp[3] = x[3]; }
        asm volatile("s_waitcnt lgkmcnt(0)" ::: "memory");
        unsigned w[8];
#pragma unroll
        for (int q = 0; q < 8; ++q) w[q] = pkh(tile[(2 * q) * 65 + lane], tile[(2 * q + 1) * 65 + lane]);
        bf16* dp = j.dst + (size_t)lane * j.ldd + 16 * q4;
        *(v4u*)dp = (v4u){w[0], w[1], w[2], w[3]}; *(v4u*)(dp + 8) = (v4u){w[4], w[5], w[6], w[7]};
        asm volatile("s_waitcnt lgkmcnt(0)" ::: "memory");
    }
}

template <int BR, bool HELPER>
__device__ __forceinline__ void scan_mfma_item(const Args& a, LAS unsigned char* lds, int b, int h, int half, int cj0) {
    constexpr int PQ = 132, PK = 68;
    LAS bf16* Tu = (LAS bf16*)lds; LAS bf16* Tw = (LAS bf16*)(lds + 9216); LAS bf16* QK = (LAS bf16*)(lds + 18432); LAS bf16* Qh = (LAS bf16*)(lds + 27136);
    LAS bf16* Kht = (LAS bf16*)(lds + 44032); LAS bf16* nW = (LAS bf16*)(lds + 61440);
    LAS bf16* Qd = (LAS bf16*)lds; LAS bf16* Kr = (LAS bf16*)(lds + 17408); LAS bf16* Kdt = (LAS bf16*)(lds + 34816); LAS bf16* Pm = (LAS bf16*)(lds + 53248);
    LAS float* egs = (LAS float*)(lds + 117760); LAS float* egls = egs + 64;
    bf16* proj = (bf16*)(a.ws + WS_PROJ);
    const int tid0 = tidx();
    const size_t rowb = (size_t)b * SEQ;
    const unsigned char* dout = (const unsigned char*)a.out;
    const bf16* QHg = (const bf16*)(dout + DO_QH); const bf16* KHTg = (const bf16*)(dout + DO_KHT); const bf16* QKg = (const bf16*)(dout + DO_QK);
    const bf16* TUg = (const bf16*)(dout + DO_TU); const bf16* TWg = (const bf16*)(dout + DO_TW);
    const bf16* VHg = (const bf16*)(a.ws + WS_VH); const float* EGg = (const float*)(a.ws + WS_EG); const float* EGLg = (const float*)(a.ws + WS_EGL);
    const float lgam = logf(1.0f - exp2f(-5.0f - (float)h));
    LAS float* kdt = egs + 128;
    LAS float* gpw = kdt + 64;
    if (BR == 0) { for (int i = tid0; i < 64 * PT64 / 8; i += 512) ((LAS v4u*)Pm)[i] = (v4u){0u, 0u, 0u, 0u}; }
    if (BR == 0 && tid0 < 64) { kdt[tid0] = expf((float)(63 - tid0) * lgam); gpw[tid0] = expf(-(float)(tid0 + 1) * lgam); }
    auto prefetch = [&](const int nn, v4u (&pf)[14], v4u (&pfv)[4], float& pfe, const int tid) {
        const int tl_ = nn * 64, item_ = nn * 64 + (b * 4 + h); (void)tl_; (void)item_;
        if (HELPER) { const int ht = tid - 256;
            if (BR == 1) {
#pragma unroll
                for (int r = 0; r < 2; ++r) { const int p = ht + 256 * r, row = p >> 3, c = p & 7; const size_t go = ((size_t)item_ * 64 + row) * 64 + 8 * c;
                    pf[r] = *(const v4u*)(TUg + go); pf[4 + r] = *(const v4u*)(QKg + go); }
#pragma unroll
                for (int r = 0; r < 4; ++r) { const int p = ht + 256 * r;
                    { const int row = p >> 4, c = p & 15; pf[6 + r] = *(const v4u*)(QHg + ((size_t)item_ * 64 + row) * 128 + 8 * c); }
                    { const int row = p >> 3, c = p & 7; pf[10 + r] = *(const v4u*)(KHTg + ((size_t)item_ * 128 + row) * 64 + 8 * c); } }
                pfe = (ht < 64 ? EGg : EGLg)[(size_t)item_ * 64 + (ht & 63)];
            } else {
#pragma unroll
                for (int r = 0; r < 4; ++r) { const int p = ht + 256 * r, row = p >> 4, c = p & 15; const bf16* pr = proj + (rowb + tl_ + row) * PW + h * 128 + 8 * c;
                    pf[r] = *(const v4u*)(pr + P_RQ); pf[4 + r] = *(const v4u*)(pr + P_RK); }
            }
        } else { const int lane = tid & 63, wave = tid >> 6;
            const bf16* vsrc = (BR == 1) ? (VHg + (rowb + tl_ + lane) * 1024 + h * 256 + half * 128 + 32 * (wave & 3)) : (proj + (rowb + tl_ + lane) * PW + P_RV + h * 256 + half * 128 + 32 * (wave & 3));
            pfv[0] = ((const v4u*)vsrc)[0]; pfv[1] = ((const v4u*)vsrc)[1]; pfv[2] = ((const v4u*)vsrc)[2]; pfv[3] = ((const v4u*)vsrc)[3]; }
    };
    constexpr int VD = 1;
    v4u pfA[14], pfB[14], pfvA[4], pfvB[4]; float pfeA = 0.f, pfeB = 0.f;
    { int t_ = tid0; asm volatile("" : "+v"(t_)); prefetch(0, pfA, pfvA, pfeA, t_); if (HELPER || VD == 2) prefetch(1, pfB, pfvB, pfeB, t_); }
    f4 cva[16];
    const int n1 = (HELPER && cj0 >= 0) ? 6 : 0;
    if (HELPER) {
        if (n1) { const CJob j = cjob_ex(a, cj0); cjob_load(j, tid0 & 63, cva); }
        else {
#pragma unroll
            for (int i = 0; i < 16; ++i) cva[i] = (f4){0.f, 0.f, 0.f, 0.f}; } }
    f16v S[4];
#pragma unroll
    for (int dt = 0; dt < 4; ++dt) S[dt] = zero16();
    auto body = [&](const int n, auto convtag, v4u (&pf)[14], v4u (&pfv)[4], float& pfe) {
        constexpr bool CONV = decltype(convtag)::value;
        const int tl0 = n * 64;
        int tidL = tid0; asm volatile("" : "+v"(tidL));
        const int tid = tidL, lane = tidL & 63, wave = tidL >> 6, r32 = lane & 31, hh = lane >> 5;
        const int strip = wave & 3;
        LAS bf16* Vt = (LAS bf16*)(lds + 80896 + wave * 4608);
        if (HELPER) { const int ht = tid - 256;
            if (BR == 1) {
#pragma unroll
                for (int r = 0; r < 2; ++r) { const int p = ht + 256 * r, row = p >> 3, c = p & 7;
                    *(LAS v4u*)(Tu + row * PT64 + 8 * c) = pf[r];
                    *(LAS v2u*)(QK + row * PK + 8 * c) = (v2u){pf[4 + r].x, pf[4 + r].y}; *(LAS v2u*)(QK + row * PK + 8 * c + 4) = (v2u){pf[4 + r].z, pf[4 + r].w}; }
#pragma unroll
                for (int r = 0; r < 4; ++r) { const int p = ht + 256 * r;
                    { const int row = p >> 4, c = p & 15; *(LAS v2u*)(Qh + row * PQ + 8 * c) = (v2u){pf[6 + r].x, pf[6 + r].y}; *(LAS v2u*)(Qh + row * PQ + 8 * c + 4) = (v2u){pf[6 + r].z, pf[6 + r].w}; }
                    { const int row = p >> 3, c = p & 7; *(LAS v2u*)(Kht + row * PK + 8 * c) = (v2u){pf[10 + r].x, pf[10 + r].y}; *(LAS v2u*)(Kht + row * PK + 8 * c + 4) = (v2u){pf[10 + r].z, pf[10 + r].w}; } }
                if (ht < 64) egs[ht] = pfe; else if (ht < 128) egls[ht - 64] = pfe;
            } else {
#pragma unroll
                for (int r = 0; r < 4; ++r) { const int p = ht + 256 * r, row = p >> 4, c = p & 15;
                    *(LAS v2u*)(Qd + row * PQ + 8 * c) = (v2u){pf[r].x, pf[r].y}; *(LAS v2u*)(Qd + row * PQ + 8 * c + 4) = (v2u){pf[r].z, pf[r].w}; *(LAS v4u*)(Kr + row * PT128 + 8 * c) = pf[4 + r]; }
            }
        } else {
            const unsigned wv[16] = {pfv[0].x, pfv[0].y, pfv[0].z, pfv[0].w, pfv[1].x, pfv[1].y, pfv[1].z, pfv[1].w, pfv[2].x, pfv[2].y, pfv[2].z, pfv[2].w, pfv[3].x, pfv[3].y, pfv[3].z, pfv[3].w};
#pragma unroll
            for (int j = 0; j < 16; ++j) { Vt[(2 * j) * PT64 + lane] = (bf16)(wv[j] & 0xffff); Vt[(2 * j + 1) * PT64 + lane] = (bf16)(wv[j] >> 16); }
        }
        { const int nd = (HELPER || VD == 2) ? n + 2 : n + 1; prefetch(nd < 32 ? nd : 31, pf, pfv, pfe, tid); }
        LDS_BARRIER();
        if (BR == 1) {
            const int dt = wave >> 1, itile = wave & 1;
            f16v acc = zero16();
#pragma unroll
            for (int ks = 0; ks < 4; ++ks) {
                const s8v tu = ld_perm(Tu, PT64, 32 * itile + r32, 16 * ks, hh);
                const f4 e0 = *(const LAS f4*)(egs + 16 * ks + 4 * hh), e1 = *(const LAS f4*)(egs + 16 * ks + 8 + 4 * hh);
                const v4u tw = __builtin_bit_cast(v4u, tu); v4u o;
                o.x = cvtpk(bflo(tw.x) * e0.x, bfhi(tw.x) * e0.y); o.y = cvtpk(bflo(tw.y) * e0.z, bfhi(tw.y) * e0.w); o.z = cvtpk(bflo(tw.z) * e1.x, bfhi(tw.z) * e1.y); o.w = cvtpk(bflo(tw.w) * e1.z, bfhi(tw.w) * e1.w);
                acc = MFMA32(ld_perm(Kht, PK, 32 * dt + r32, 16 * ks, hh), __builtin_bit_cast(s8v, o), acc); }
            const int icol = 32 * itile + r32;
#pragma unroll
            for (int g4 = 0; g4 < 4; ++g4) { const int d0 = 32 * dt + 8 * g4 + 4 * hh;
                v2u w; w.x = cvtpk(-acc[4 * g4 + 0], -acc[4 * g4 + 1]); w.y = cvtpk(-acc[4 * g4 + 2], -acc[4 * g4 + 3]); *(LAS v2u*)(nW + icol * PQ + d0) = w; }
        } else {
#pragma unroll
            for (int r = 0; r < 2; ++r) { const int p = tid + 512 * r, d = p & 127, tg = p >> 7;
                const LAS bf16* kp = Kr + (8 * tg) * PT128 + d;
                float kv[8];
#pragma unroll
                for (int i = 0; i < 8; ++i) kv[i] = bf2f(kp[i * PT128]) * kdt[8 * tg + i];
                v4u w; w.x = cvtpk(kv[0], kv[1]); w.y = cvtpk(kv[2], kv[3]); w.z = cvtpk(kv[4], kv[5]); w.w = cvtpk(kv[6], kv[7]);
                *(LAS v4u*)(Kdt + d * PT64 + 8 * tg) = w; }
        }
        if (BR == 0) {
            typedef float f32x4_ __attribute__((ext_vector_type(4)));
            const int l15 = lane & 15, l4 = lane >> 4;
#pragma unroll 1
            for (int q = wave; q < 10; q += 8) {
                const int jb = (q < 4) ? 0 : (q < 7) ? 1 : (q < 9) ? 2 : 3, ib = (q < 4) ? q : (q < 7) ? q - 3 : (q < 9) ? q - 5 : 3;
                f32x4_ acc = {0.f, 0.f, 0.f, 0.f};
                s8v fa4[4], fb4[4];
#pragma unroll
                for (int ks = 0; ks < 4; ++ks) { fa4[ks] = *(const LAS s8v*)(Kr + (16 * jb + l15) * PT128 + 32 * ks + 8 * l4);
                    const LAS bf16* qp = Qd + (16 * ib + l15) * PQ + 32 * ks + 8 * l4; const s4v lo = *(const LAS s4v*)qp, hi = *(const LAS s4v*)(qp + 4);
                    fb4[ks] = __builtin_shufflevector(lo, hi, 0, 1, 2, 3, 4, 5, 6, 7); }
#pragma unroll
                for (int ks = 0; ks < 4; ++ks) acc = __builtin_amdgcn_mfma_f32_16x16x32_bf16(fa4[ks], fb4[ks], acc, 0, 0, 0);
                const int icol = 16 * ib + l15, j0 = 16 * jb + 4 * l4;
                float v[4];
#pragma unroll
                for (int j = 0; j < 4; ++j) { const int jr = j0 + j; v[j] = (icol >= jr) ? acc[j] * gpw[jr] : 0.f; }
                v2u w; w.x = cvtpk(v[0], v[1]); w.y = cvtpk(v[2], v[3]); *(LAS v2u*)(Pm + icol * PT64 + j0) = w;
            }
        }
        LDS_BARRIER();
#define SGB_DS(N) __builtin_amdgcn_sched_group_barrier(0x100, (N), 0)
#define SGB_MM(N) __builtin_amdgcn_sched_group_barrier(0x008, (N), 0)
#define LDP4(F, BASE, PITCH, ROW, K0) do { F[0] = ld_perm(BASE, PITCH, ROW, (K0), hh); F[1] = ld_perm(BASE, PITCH, ROW, (K0) + 16, hh); F[2] = ld_perm(BASE, PITCH, ROW, (K0) + 32, hh); F[3] = ld_perm(BASE, PITCH, ROW, (K0) + 48, hh); } while (0)
#define LDN4(F, BASE, PITCH, ROW, K0) do { F[0] = ld_nat(BASE, PITCH, ROW, (K0), hh); F[1] = ld_nat(BASE, PITCH, ROW, (K0) + 16, hh); F[2] = ld_nat(BASE, PITCH, ROW, (K0) + 32, hh); F[3] = ld_nat(BASE, PITCH, ROW, (K0) + 48, hh); } while (0)
        if (!HELPER) {
        s8v Sp[4][2];
#pragma unroll
        for (int dt = 0; dt < 4; ++dt) { Sp[dt][0] = pack8<0>(S[dt]); Sp[dt][1] = pack8<1>(S[dt]); }
        bf16* otile = proj + (rowb + tl0) * PW + (BR == 1 ? P_GV : P_RV) + h * 256 + half * 128 + 32 * strip;
        LAS bf16* ot = (LAS bf16*)(lds + 119808 + wave * 2304);
        s8v fa[4], fb[4];
        if (BR == 1) {
            s8v vb[2][2], vs[2][2];
#pragma unroll
            for (int it = 0; it < 2; ++it) {
                f16v acc = zero16();
                LDN4(fb, Vt, PT64, r32, 0);
                LDN4(fa, Tu, PT64, 32 * it + r32, 0);
                acc = MFMA32(fa[0], fb[0], acc); acc = MFMA32(fa[1], fb[1], acc); acc = MFMA32(fa[2], fb[2], acc); acc = MFMA32(fa[3], fb[3], acc);
                SGB_DS(8); SGB_MM(4);
                LDP4(fa, nW, PQ, 32 * it + r32, 0);
                acc = MFMA32(fa[0], Sp[0][0], acc); acc = MFMA32(fa[1], Sp[0][1], acc); acc = MFMA32(fa[2], Sp[1][0], acc); acc = MFMA32(fa[3], Sp[1][1], acc);
                SGB_DS(4); SGB_MM(4);
                LDP4(fa, nW, PQ, 32 * it + r32, 64);
                acc = MFMA32(fa[0], Sp[2][0], acc); acc = MFMA32(fa[1], Sp[2][1], acc); acc = MFMA32(fa[2], Sp[3][0], acc); acc = MFMA32(fa[3], Sp[3][1], acc);
                SGB_DS(4); SGB_MM(4);
                vb[it][0] = pack8<0>(acc); vb[it][1] = pack8<1>(acc);
#pragma unroll
                for (int g4 = 0; g4 < 4; ++g4) { const f4 e = *(const LAS f4*)(egls + 32 * it + 8 * g4 + 4 * hh); acc[4 * g4 + 0] *= e.x; acc[4 * g4 + 1] *= e.y; acc[4 * g4 + 2] *= e.z; acc[4 * g4 + 3] *= e.w; }
                vs[it][0] = pack8<0>(acc); vs[it][1] = pack8<1>(acc);
            }
#pragma unroll
            for (int it = 0; it < 2; ++it) {
                f16v acc = zero16();
                LDP4(fa, Qh, PQ, 32 * it + r32, 0);
                acc = MFMA32(fa[0], Sp[0][0], acc); acc = MFMA32(fa[1], Sp[0][1], acc); acc = MFMA32(fa[2], Sp[1][0], acc); acc = MFMA32(fa[3], Sp[1][1], acc);
                SGB_DS(4); SGB_MM(4);
                LDP4(fa, Qh, PQ, 32 * it + r32, 64);
                acc = MFMA32(fa[0], Sp[2][0], acc); acc = MFMA32(fa[1], Sp[2][1], acc); acc = MFMA32(fa[2], Sp[3][0], acc); acc = MFMA32(fa[3], Sp[3][1], acc);
                SGB_DS(4); SGB_MM(4);
#pragma unroll
                for (int g4 = 0; g4 < 4; ++g4) { const f4 e = *(const LAS f4*)(egs + 32 * it + 8 * g4 + 4 * hh); acc[4 * g4 + 0] *= e.x; acc[4 * g4 + 1] *= e.y; acc[4 * g4 + 2] *= e.z; acc[4 * g4 + 3] *= e.w; }
                if (it == 0) { fa[0] = ld_perm(QK, PK, r32, 0, hh); fa[1] = ld_perm(QK, PK, r32, 16, hh);
                    acc = MFMA32(fa[0], vb[0][0], acc); acc = MFMA32(fa[1], vb[0][1], acc); }
                else { LDP4(fa, QK, PK, 32 + r32, 0);
                    acc = MFMA32(fa[0], vb[0][0], acc); acc = MFMA32(fa[1], vb[0][1], acc); acc = MFMA32(fa[2], vb[1][0], acc); acc = MFMA32(fa[3], vb[1][1], acc); }
                tile_to_lds(acc, ot, r32, hh); lds_rows_to_global(ot, otile + (size_t)(32 * it) * PW, lane); asm volatile("s_waitcnt lgkmcnt(0)" ::: "memory");
            }
            const float egl_ = egs[63];
#pragma unroll
            for (int dt = 0; dt < 4; ++dt) {
#pragma unroll
                for (int i = 0; i < 16; ++i) S[dt][i] *= egl_;
                LDP4(fa, Kht, PK, 32 * dt + r32, 0);
                S[dt] = MFMA32(fa[0], vs[0][0], S[dt]); S[dt] = MFMA32(fa[1], vs[0][1], S[dt]); S[dt] = MFMA32(fa[2], vs[1][0], S[dt]); S[dt] = MFMA32(fa[3], vs[1][1], S[dt]);
                SGB_DS(4); SGB_MM(4);
            }
        } else {
#pragma unroll
            for (int it = 0; it < 2; ++it) {
                f16v acc = zero16();
                LDP4(fa, Qd, PQ, 32 * it + r32, 0);
                acc = MFMA32(fa[0], Sp[0][0], acc); acc = MFMA32(fa[1], Sp[0][1], acc); acc = MFMA32(fa[2], Sp[1][0], acc); acc = MFMA32(fa[3], Sp[1][1], acc);
                SGB_DS(4); SGB_MM(4);
                LDP4(fa, Qd, PQ, 32 * it + r32, 64);
                acc = MFMA32(fa[0], Sp[2][0], acc); acc = MFMA32(fa[1], Sp[2][1], acc); acc = MFMA32(fa[2], Sp[3][0], acc); acc = MFMA32(fa[3], Sp[3][1], acc);
                SGB_DS(4); SGB_MM(4);
                if (it == 0) { fa[0] = ld_nat(Pm, PT64, r32, 0, hh); fa[1] = ld_nat(Pm, PT64, r32, 16, hh); fb[0] = ld_nat(Vt, PT64, r32, 0, hh); fb[1] = ld_nat(Vt, PT64, r32, 16, hh);
                    acc = MFMA32(fa[0], fb[0], acc); acc = MFMA32(fa[1], fb[1], acc); SGB_DS(4); SGB_MM(2); }
                else { LDN4(fa, Pm, PT64, 32 + r32, 0); LDN4(fb, Vt, PT64, r32, 0);
                    acc = MFMA32(fa[0], fb[0], acc); acc = MFMA32(fa[1], fb[1], acc); acc = MFMA32(fa[2], fb[2], acc); acc = MFMA32(fa[3], fb[3], acc); SGB_DS(8); SGB_MM(4); }
                tile_to_lds(acc, ot, r32, hh); lds_rows_to_global(ot, otile + (size_t)(32 * it) * PW, lane); asm volatile("s_waitcnt lgkmcnt(0)" ::: "memory");
            }
            const float g64 = expf(64.0f * lgam);
#pragma unroll
            for (int dt = 0; dt < 4; ++dt) {
#pragma unroll
                for (int i = 0; i < 16; ++i) S[dt][i] *= g64;
                LDN4(fa, Kdt, PT64, 32 * dt + r32, 0);
                S[dt] = MFMA32(fa[0], fb[0], S[dt]); S[dt] = MFMA32(fa[1], fb[1], S[dt]); S[dt] = MFMA32(fa[2], fb[2], S[dt]); S[dt] = MFMA32(fa[3], fb[3], S[dt]);
                SGB_DS(4); SGB_MM(4);
            }
        }
        } else if (CONV) {
            { const CJob j = cjob_ex(a, cj0 + 1024 * n); cjob_store16(j, lane, cva, (LAS float*)Vt); }
            { const CJob j = cjob_ex(a, cj0 + 1024 * (n + 1 < 6 ? n + 1 : 5)); cjob_load(j, lane, cva); }
        }
#undef SGB_DS
#undef SGB_MM
#undef LDP4
#undef LDN4
        LDS_BARRIER();
    };
#pragma unroll 1
    for (int n = 0; n < n1; n += 2) { body(n, std::true_type{}, pfA, pfvA, pfeA); body(n + 1, std::true_type{}, pfB, (VD == 2 ? pfvB : pfvA), pfeB); }
#pragma unroll 1
    for (int n = n1; n < 32; n += 2) { body(n, std::false_type{}, pfA, pfvA, pfeA); body(n + 1, std::false_type{}, pfB, (VD == 2 ? pfvB : pfvA), pfeB); }
}
__device__ __forceinline__ void phase_scan_mfma(const Args& a, LAS unsigned char* lds) {
    const int wv = tidx() >> 6;
    int round = 0;
    for (int id = blockIdx.x; id < 256; id += gridDim.x, ++round) {
        const int xq = id & 7, yq = id >> 3, half = yq & 1, br = (yq >> 1) & 1, bh = xq + 8 * (yq >> 2), b = bh >> 2, h = bh & 3;
        const int cj0 = (gridDim.x == 256 && round == 0) ? (int)blockIdx.x * 4 + (wv - 4) : -1;
        if (wv < 4) { if (br == 0) scan_mfma_item<0, false>(a, lds, b, h, half, -1); else scan_mfma_item<1, false>(a, lds, b, h, half, -1); }
        else        { if (br == 0) scan_mfma_item<0, true>(a, lds, b, h, half, cj0); else scan_mfma_item<1, true>(a, lds, b, h, half, cj0); }
    }
    if (gridDim.x != 256) {
        const int t2 = tidx(), lane = t2 & 63, wv2 = t2 >> 6; LAS float* tile = (LAS float*)(lds + 32768 + wv2 * 8448); f4 va[16];
        for (int job = blockIdx.x * 8 + wv2; job < 6144; job += gridDim.x * 8) { const CJob j = cjob_ex(a, job); cjob_load(j, lane, va); cjob_store(j, lane, va, tile); }
    }
}
__device__ __forceinline__ void phase_merge2(const Args& a, LAS unsigned char* lds) {
    const bf16* proj = (const bf16*)(a.ws + WS_PROJ); const float* gnw = a.in[9];
    bf16* merged = (bf16*)(a.ws + WS_MERGED);
    const int tid = tidx(), lane = tid & 63, wave = tid >> 6;
    const int gw = blockIdx.x * 8 + wave, NGW = gridDim.x * 8;
    const int c0 = 8 * lane, tlast = gw + ((T - 1 - gw) / NGW) * NGW;
    const float4 w0 = *(const float4*)(gnw + (c0 & 255)), w1 = *(const float4*)(gnw + (c0 & 255) + 4);
    v4u nr[2], ng[2], na[2], nb[2], mr[2], mg[2], ma[2], mb[2];
#define MG_LOAD(R, G_, A_, B_, TROW) do { const bf16* pr_ = proj + (size_t)(TROW) * PW + c0; _Pragma("unroll") for (int part = 0; part < 2; ++part) { \
        R[part] = __builtin_nontemporal_load((const v4u*)(pr_ + P_RV + 512 * part)); G_[part] = __builtin_nontemporal_load((const v4u*)(pr_ + P_GV + 512 * part)); \
        A_[part] = __builtin_nontemporal_load((const v4u*)(pr_ + P_GA + 512 * part)); B_[part] = __builtin_nontemporal_load((const v4u*)(pr_ + P_GB + 512 * part)); } } while (0)
    MG_LOAD(nr, ng, na, nb, gw);
    { const int t1 = gw + NGW <= tlast ? gw + NGW : tlast; MG_LOAD(mr, mg, ma, mb, t1); }
#pragma unroll 1
    for (int t = gw; t < T; t += NGW) {
        v4u orv[2], ogv[2], gav[2], gbv[2];
#pragma unroll
        for (int part = 0; part < 2; ++part) { orv[part] = nr[part]; ogv[part] = ng[part]; gav[part] = na[part]; gbv[part] = nb[part]; nr[part] = mr[part]; ng[part] = mg[part]; na[part] = ma[part]; nb[part] = mb[part]; }
        { const int tn = t + 2 * NGW <= tlast ? t + 2 * NGW : tlast; MG_LOAD(mr, mg, ma, mb, tn); }
#pragma unroll
        for (int part = 0; part < 2; ++part) {
            const v4u ga = gav[part], gb = gbv[part], ov = orv[part], gv = ogv[part];
            const unsigned ru[4] = {ov.x, ov.y, ov.z, ov.w}, gu[4] = {gv.x, gv.y, gv.z, gv.w};
            float sr = 0.f, sg = 0.f;
#pragma unroll
            for (int j = 0; j < 4; ++j) { sr += bflo(ru[j]) * bflo(ru[j]) + bfhi(ru[j]) * bfhi(ru[j]); sg += bflo(gu[j]) * bflo(gu[j]) + bfhi(gu[j]) * bfhi(gu[j]); }
            sr = row_sum16(sr); sg = row_sum16(sg); sr += __shfl_xor(sr, 16); sg += __shfl_xor(sg, 16);
            const float rr = rsqrtf(sr * (1.0f / 256.0f) + 1e-6f), rg = rsqrtf(sg * (1.0f / 256.0f) + 1e-6f);
            float o[8];
            o[0] = bflo(ga.x) * bflo(ov.x) * rr + bflo(gb.x) * bflo(gv.x) * rg * w0.x; o[1] = bfhi(ga.x) * bfhi(ov.x) * rr + bfhi(gb.x) * bfhi(gv.x) * rg * w0.y;
            o[2] = bflo(ga.y) * bflo(ov.y) * rr + bflo(gb.y) * bflo(gv.y) * rg * w0.z; o[3] = bfhi(ga.y) * bfhi(ov.y) * rr + bfhi(gb.y) * bfhi(gv.y) * rg * w0.w;
            o[4] = bflo(ga.z) * bflo(ov.z) * rr + bflo(gb.z) * bflo(gv.z) * rg * w1.x; o[5] = bfhi(ga.z) * bfhi(ov.z) * rr + bfhi(gb.z) * bfhi(gv.z) * rg * w1.y;
            o[6] = bflo(ga.w) * bflo(ov.w) * rr + bflo(gb.w) * bflo(gv.w) * rg * w1.z; o[7] = bfhi(ga.w) * bfhi(ov.w) * rr + bfhi(gb.w) * bfhi(gv.w) * rg * w1.w;
            v4u w; w.x = pkh(o[0], o[1]); w.y = pkh(o[2], o[3]); w.z = pkh(o[4], o[5]); w.w = pkh(o[6], o[7]);
            *(v4u*)(merged + (size_t)t * 1024 + 512 * part + c0) = w; }
    }
#undef MG_LOAD
}
}
namespace {
template <int PH> __device__ __forceinline__ void run_phase(const Args& a, LAS unsigned char* lds) {
    if (PH == 0) { phase_rope_part(a, (int)blockIdx.x, (int)gridDim.x);
                   if (gridDim.x < 192 || blockIdx.x < 96) { phase_mod_part(a, lds, (int)blockIdx.x, gridDim.x < 192 ? (int)gridDim.x : 96); __syncthreads(); }
                   phase_convert_all(a, lds); }
    else if (PH == 1) phase_norm1(a, lds);
    else if (PH == 2) phase_inproj(a, lds);
    else if (PH == 3) phase_gprep(a, lds);
    else if (PH == 4) phase_scan_mfma(a, lds);
    else if (PH == 5) phase_merge2(a, lds);
    else if (PH == 6) phase_outproj(a, lds);
    else if (PH == 7) phase_route(a, lds);
    else if (PH == 9) phase_moe12(a, lds);
    else if (PH == 11) phase_final(a, lds);
}
template <int PH> __global__ void __launch_bounds__(512, 2) k_phase(Args a) {
    extern __shared__ __attribute__((aligned(16))) unsigned char smem[];
    run_phase<PH>(a, (LAS unsigned char*)smem);
}
}
namespace {
#define XB_TMO      128
#define XB_XCNT(j)  (256  + 64 * (j))
#define XB_XSUB(j)  (1280 + 64 * (j))
#define XB_XGEN(j)  (2304 + 64 * (j))
#define XB_TOP      3328
#define XB_TOPGEN   3392
#define XCD_BAR_WORDS 3456
#define XB_SPIN_CAP (1u << 18)

__device__ __forceinline__ unsigned xb_ld(unsigned* p)              { return __hip_atomic_load(p, __ATOMIC_RELAXED, __HIP_MEMORY_SCOPE_AGENT); }
__device__ __forceinline__ unsigned xb_add(unsigned* p, unsigned v) { return __hip_atomic_fetch_add(p, v, __ATOMIC_RELAXED, __HIP_MEMORY_SCOPE_AGENT); }
__device__ __forceinline__ unsigned xb_xcc_id() { return (unsigned)__builtin_amdgcn_s_getreg((3 << 11) | 20) & 0xFu; }
#define XB_SPIN(cond, bar) do { unsigned _sp = 0; while (cond) { __builtin_amdgcn_s_sleep(1); \
    if ((++_sp & 255u) == 0u) { if (xb_ld(&(bar)[XB_TMO])) break; if (_sp > XB_SPIN_CAP) { atomicAdd(&(bar)[XB_TMO], 1u); break; } } } } while (0)

struct XcdBarrier {
    unsigned* bar; unsigned x;
    volatile LAS unsigned* st;
};

__device__ __forceinline__ XcdBarrier xcd_barrier_post(unsigned* bar, volatile LAS unsigned* st) {
    XcdBarrier b; b.bar = bar; b.x = xb_xcc_id(); b.st = st;
    if (threadIdx.x == 0) (void)xb_add(&bar[XB_XCNT(b.x)], 1u);
    return b;
}
__device__ __forceinline__ void xcd_barrier_complete(unsigned* bar, unsigned x, unsigned& nloc, unsigned& nx) {
    const unsigned G = gridDim.x * gridDim.y * gridDim.z;
    unsigned sum, cnt, mine, sp = 0u;
    for (;;) {
        sum = 0u; cnt = 0u; mine = 0u;
#pragma unroll
        for (unsigned j = 0; j < 16; ++j) { const unsigned c = xb_ld(&bar[XB_XCNT(j)]); sum += c; cnt += (c > 0u) ? 1u : 0u; mine = (j == x) ? c : mine; }
        if (sum == G) break;
        __builtin_amdgcn_s_sleep(1);
        if ((++sp & 255u) == 0u) { if (xb_ld(&bar[XB_TMO])) break; if (sp > XB_SPIN_CAP) { atomicAdd(&bar[XB_TMO], 1u); break; } }
    }
    nloc = mine > 0u ? mine : 1u; nx = cnt > 0u ? cnt : 1u;
}

__device__ __forceinline__ void xcd_barrier(const XcdBarrier& b) {
    asm volatile("s_waitcnt vmcnt(0)" ::: "memory");
    __syncthreads();
    if (threadIdx.x == 0) {
        unsigned* bar = b.bar;
        __builtin_amdgcn_s_waitcnt(0);
        unsigned nloc = b.st[0], nx = b.st[1];
        if (nloc == 0u) { xcd_barrier_complete(bar, b.x, nloc, nx); b.st[0] = nloc; b.st[1] = nx; }
        const unsigned old = xb_add(&bar[XB_XSUB(b.x)], 1u);
        const unsigned gen = old / nloc;
        if (old + 1u == (gen + 1u) * nloc) {
            __builtin_amdgcn_fence(__ATOMIC_RELEASE, "agent");
            asm volatile("s_waitcnt vmcnt(0)" ::: "memory");
            const unsigned og = xb_add(&bar[XB_TOP], 1u);
            const unsigned tg = og / nx;
            if (og + 1u == (tg + 1u) * nx) xb_add(&bar[XB_TOPGEN], 1u);
            else XB_SPIN(xb_ld(&bar[XB_TOPGEN]) == tg, bar);
            __builtin_amdgcn_fence(__ATOMIC_ACQUIRE, "agent");
            xb_add(&bar[XB_XGEN(b.x)], 1u);
            asm volatile("s_waitcnt vmcnt(0)" ::: "memory");
        } else {
            XB_SPIN(xb_ld(&bar[XB_XGEN(b.x)]) == gen, bar);
            __builtin_amdgcn_fence(__ATOMIC_ACQUIRE, "agent");
            asm volatile("s_waitcnt vmcnt(0)" ::: "memory");
        }
    }
    __syncthreads();
}

constexpr int LDS_BAR_OFF = LDS_BYTES - 16;
__global__ void __launch_bounds__(512, 2) k_mega(Args a) {
    extern __shared__ __attribute__((aligned(16))) unsigned char smem[];
    LAS unsigned char* lds = (LAS unsigned char*)smem;
    cg::grid_group grid = cg::this_grid();
    if (threadIdx.x == 0) *(LAS v4u*)(lds + LDS_BAR_OFF) = (v4u){0u, 0u, 0u, 0u};
    __syncthreads();
    XcdBarrier bar = xcd_barrier_post((unsigned*)(a.ws + WS_CTL), (volatile LAS unsigned*)(lds + LDS_BAR_OFF));
    if (a.ph_lo == 0x7fffffff) grid.sync();
    run_phase<0>(a, lds); xcd_barrier(bar);
    run_phase<1>(a, lds); xcd_barrier(bar);
    run_phase<2>(a, lds); xcd_barrier(bar);
    run_phase<3>(a, lds); xcd_barrier(bar);
    run_phase<4>(a, lds); xcd_barrier(bar);
    run_phase<5>(a, lds); xcd_barrier(bar);
    run_phase<6>(a, lds); xcd_barrier(bar);
    run_phase<7>(a, lds); xcd_barrier(bar);
    run_phase<9>(a, lds); xcd_barrier(bar);
    run_phase<11>(a, lds);
}
}
extern "C" void kernel_launch(void* const* d_in, const int* in_sizes, int n_in, void* d_out, int out_size, void* d_ws, size_t ws_size, hipStream_t stream) {
    if (ws_size < 512 * MiB) return;
    static int grid_blocks = 0;
    if (!grid_blocks) {
        int dev = 0, cus = 0, per_cu = 0;
        (void)hipGetDevice(&dev);
        (void)hipDeviceGetAttribute(&cus, hipDeviceAttributeMultiprocessorCount, dev);
        (void)hipFuncSetAttribute((const void*)k_mega, hipFuncAttributeMaxDynamicSharedMemorySize, LDS_BYTES);
        (void)hipOccupancyMaxActiveBlocksPerMultiprocessor(&per_cu, (const void*)k_mega, 512, LDS_BYTES);
        if (per_cu < 1) per_cu = 1;
        grid_blocks = cus * per_cu;
        if (grid_blocks > 256) grid_blocks = 256;
    }
    (void)hipMemsetAsync((unsigned char*)d_ws + WS_CTL, 0, 65536, stream);
    Args a{};
    for (int i = 0; i < 20; ++i) a.in[i] = (const float*)d_in[i];
    a.out = (float*)d_out; a.ws = (unsigned char*)d_ws;
    void* args[] = {&a};
    (void)hipLaunchCooperativeKernel((const void*)k_mega, dim3(grid_blocks), dim3(512), args, LDS_BYTES, stream);
}
```
